# Optimizing an MI355X kernel written in HIP

```python
import math
import jax
import jax.numpy as jnp
from jax import lax
import numpy as np

D_MODEL = 1024
BATCH = 16
SEQ = 2048
DEPTH = 1

N_HEADS_A = 8
HEAD_DIM_A = 64
WIDTH_A = N_HEADS_A * HEAD_DIM_A
KV_RANK = 256
N_HEADS_IDX = 8
HEAD_DIM_IDX = 64
TOPK_MAX = 256
Q_BLOCK = 128
N_BUCKETS = 32
MAX_DISTANCE = 128
N_HEADS_M = 4
HEAD_DIM_M = 128
WIDTH_M = N_HEADS_M * HEAD_DIM_M
CONV_WIDTH = 4
CHUNK = 64
N_GROUPS = 4
EXPERTS_PER_GROUP = 4
N_EXPERTS = N_GROUPS * EXPERTS_PER_GROUP
TOP_K_EXP = 2
D_EXPERT = 512
LN_EPS = 1e-5
ALPHA = (2.0 * DEPTH) ** 0.25
BETA = (8.0 * DEPTH) ** -0.25

IN_SPLITS = (
    WIDTH_A,
    KV_RANK,
    N_HEADS_IDX * HEAD_DIM_IDX,
    HEAD_DIM_IDX,
    N_HEADS_IDX,
    2 * WIDTH_M,
    WIDTH_M,
    N_HEADS_M,
    N_HEADS_M,
    WIDTH_M,
    D_MODEL,
    D_MODEL,
)
D_IN = sum(IN_SPLITS)

kernel_name = "hybrid_dsa_mlstm_hmoe_deepnorm"


def split_cols(h):
    idx = np.cumsum(IN_SPLITS)[:-1].tolist()
    return jnp.split(h, idx, axis=-1)


def layer_norm(x, g, b):
    xf = x.astype(jnp.float32)
    mu = jnp.mean(xf, axis=-1, keepdims=True)
    var = jnp.mean(jnp.square(xf - mu), axis=-1, keepdims=True)
    return ((xf - mu) * lax.rsqrt(var + LN_EPS) * g + b).astype(x.dtype)


def rms_norm(x, g):
    xf = x.astype(jnp.float32)
    return (xf * lax.rsqrt(jnp.mean(xf * xf, axis=-1, keepdims=True) + LN_EPS) * g).astype(x.dtype)


def t5_bucket(dist):
    max_exact = N_BUCKETS // 2
    d = jnp.maximum(dist, 0)
    ratio = jnp.log(jnp.maximum(d, 1).astype(jnp.float32) / max_exact) / math.log(MAX_DISTANCE / max_exact)
    large = jnp.minimum(max_exact + (ratio * (N_BUCKETS - max_exact)).astype(jnp.int32), N_BUCKETS - 1)
    return jnp.where(d < max_exact, d, large)


def causal_conv(u, w, b):
    out = lax.conv_general_dilated(
        u, w[:, None, :], window_strides=(1,), padding=[(CONV_WIDTH - 1, 0)],
        dimension_numbers=("NWC", "WIO", "NWC"), feature_group_count=u.shape[-1])
    return out + b


def dsa_attention(q, c_kv, q_idx, k_idx, w_idx, w_uk, w_uv, rel_bias):
    B, S = q.shape[0], q.shape[1]
    topk = min(TOPK_MAX, S // 4)
    n_blk = S // Q_BLOCK
    key_pos = jnp.arange(S)
    q_lat = jnp.einsum("bshd,rhd->bshr", q, w_uk) * (HEAD_DIM_A ** -0.5)

    def block(i):
        t0 = i * Q_BLOCK
        qi = lax.dynamic_slice_in_dim(q_idx, t0, Q_BLOCK, axis=1)
        wi = lax.dynamic_slice_in_dim(w_idx, t0, Q_BLOCK, axis=1)
        ql = lax.dynamic_slice_in_dim(q_lat, t0, Q_BLOCK, axis=1)
        qpos = t0 + jnp.arange(Q_BLOCK)
        dots = jnp.einsum("bthd,bsd->bths", qi, k_idx)
        score = jnp.einsum("bth,bths->bts", wi, jax.nn.relu(dots)).astype(jnp.float32)
        causal = key_pos[None, :] <= qpos[:, None]
        score = jnp.where(causal[None], score, -jnp.inf)
        _, sel = lax.top_k(score, topk)
        valid = sel <= qpos[None, :, None]
        c_sel = jax.vmap(lambda c, ix: c[ix])(c_kv, sel)
        logits = jnp.einsum("bthr,btkr->bthk", ql, c_sel).astype(jnp.float32)
        bias = rel_bias[t5_bucket(qpos[None, :, None] - sel)].astype(jnp.float32)
        logits = logits + jnp.moveaxis(bias, -1, 2)
        logits = jnp.where(valid[:, :, None, :], logits, -jnp.inf)
        p = jax.nn.softmax(logits, axis=-1).astype(c_sel.dtype)
        return jnp.einsum("bthk,btkr->bthr", p, c_sel)

    o_lat = lax.map(block, jnp.arange(n_blk))
    o_lat = jnp.moveaxis(o_lat, 0, 1).reshape(B, S, N_HEADS_A, KV_RANK)
    return jnp.einsum("bshr,rhd->bshd", o_lat, w_uv)


def mlstm(q, k, v, i_pre, f_pre):
    B, S, NH, D = q.shape
    NC = S // CHUNK
    f32 = jnp.float32

    def to_chunks(a):
        a = a.astype(f32).reshape((B, NC, CHUNK) + a.shape[2:])
        return jnp.moveaxis(a, 3, 1)

    qc, kc, vc = to_chunks(q), to_chunks(k) * (D ** -0.5), to_chunks(v)
    ic, fc = to_chunks(i_pre), to_chunks(f_pre)
    log_f = jax.nn.log_sigmoid(fc)
    bcum = jnp.cumsum(log_f, axis=-1)
    b_last = bcum[..., -1]
    causal = jnp.tril(jnp.ones((CHUNK, CHUNK), dtype=bool))
    logD = jnp.where(causal, bcum[..., :, None] - bcum[..., None, :] + ic[..., None, :], -jnp.inf)

    log_w_end = b_last[..., None] - bcum + ic
    m_loc = jnp.max(log_w_end, axis=-1)
    w_end = jnp.exp(log_w_end - m_loc[..., None])
    C_loc = jnp.einsum("bncs,bncsk,bncsv->bnckv", w_end, kc, vc)
    n_loc = jnp.einsum("bncs,bncsk->bnck", w_end, kc)

    def step(carry, inp):
        C, n, m = carry
        Cl, nl, ml, bl = inp
        m_new = jnp.maximum(bl + m, ml)
        a = jnp.exp(bl + m - m_new)
        c = jnp.exp(ml - m_new)
        C_new = a[..., None, None] * C + c[..., None, None] * Cl
        n_new = a[..., None] * n + c[..., None] * nl
        return (C_new, n_new, m_new), (C, n, m)

    init = (jnp.zeros((B, NH, D, D), f32), jnp.zeros((B, NH, D), f32), jnp.zeros((B, NH), f32))
    xs = (jnp.moveaxis(C_loc, 2, 0), jnp.moveaxis(n_loc, 2, 0),
          jnp.moveaxis(m_loc, 2, 0), jnp.moveaxis(b_last, 2, 0))
    _, (C_prev, n_prev, m_prev) = lax.scan(step, init, xs)
    C_prev = jnp.moveaxis(C_prev, 0, 2)
    n_prev = jnp.moveaxis(n_prev, 0, 2)
    m_prev = jnp.moveaxis(m_prev, 0, 2)

    log_inter = bcum + m_prev[..., None]
    m_j = jnp.maximum(log_inter, jnp.max(logD, axis=-1))
    w_inter = jnp.exp(log_inter - m_j)
    s = jnp.einsum("bncjd,bncsd->bncjs", qc, kc) * jnp.exp(logD - m_j[..., None])
    num = jnp.einsum("bncjs,bncsv->bncjv", s, vc) + \
        w_inter[..., None] * jnp.einsum("bncjk,bnckv->bncjv", qc, C_prev)
    den = jnp.sum(s, axis=-1) + w_inter * jnp.einsum("bncjk,bnck->bncj", qc, n_prev)
    h = num / jnp.maximum(jnp.abs(den), jnp.exp(-m_j))[..., None]
    h = jnp.transpose(h, (0, 2, 3, 1, 4)).reshape(B, S, NH, D)
    return h.astype(q.dtype)


def token_mixer(x, w_in, conv_w, conv_b, kv_norm_g, w_uk, w_uv, rel_bias, b_i, b_f,
                mh_norm_g, w_up_a, w_up_m, w_out):
    B, S, _ = x.shape
    h = x @ w_in
    (q_a, c_kv, q_idx, k_idx, w_idx, qk_m, v_m, i_m, f_m, o_m, g_a, g_m) = split_cols(h)
    c_kv = rms_norm(c_kv, kv_norm_g)
    o_a = dsa_attention(q_a.reshape(B, S, N_HEADS_A, HEAD_DIM_A), c_kv,
                        q_idx.reshape(B, S, N_HEADS_IDX, HEAD_DIM_IDX), k_idx, w_idx,
                        w_uk, w_uv, rel_bias).reshape(B, S, WIDTH_A)
    qk_m = jax.nn.silu(causal_conv(qk_m, conv_w, conv_b))
    q_m, k_m = jnp.split(qk_m, 2, axis=-1)
    hd = (B, S, N_HEADS_M, HEAD_DIM_M)
    h_m = mlstm(q_m.reshape(hd), k_m.reshape(hd), v_m.reshape(hd), i_m + b_i, f_m + b_f)
    h_m = jax.nn.sigmoid(o_m.reshape(hd)) * rms_norm(h_m, mh_norm_g)
    h_m = h_m.reshape(B, S, WIDTH_M)
    y = jax.nn.sigmoid(g_a) * (o_a @ w_up_a) + jax.nn.sigmoid(g_m) * (h_m @ w_up_m)
    return y @ w_out


def hier_moe(x, w_grp, b_grp, w_rt, b_rt, w_gate, w_up, w_down):
    B, S, D = x.shape
    t = x.reshape(-1, D)
    grp_prob = jax.nn.softmax((t @ w_grp + b_grp).astype(jnp.float32), axis=-1)
    g_w, g_idx = lax.top_k(grp_prob, 1)
    exp_logits = (t @ w_rt + b_rt).astype(jnp.float32).reshape(-1, N_GROUPS, EXPERTS_PER_GROUP)
    in_grp = jnp.take_along_axis(exp_logits, g_idx[:, :, None], axis=1)[:, 0]
    e_logit, e_idx = lax.top_k(in_grp, TOP_K_EXP)
    e_w = jax.nn.softmax(e_logit, axis=-1) * g_w
    glob = g_idx * EXPERTS_PER_GROUP + e_idx
    combine = jnp.sum(jax.nn.one_hot(glob, N_EXPERTS, dtype=jnp.float32) * e_w[..., None], axis=1)
    combine = combine.astype(t.dtype)
    out = jnp.zeros_like(t)
    for e in range(N_EXPERTS):
        hdn = jax.nn.silu(t @ w_gate[e]) * (t @ w_up[e])
        out = out + combine[:, e:e + 1] * (hdn @ w_down[e])
    return out.reshape(B, S, D)


def setup_inputs(seed: int = 0) -> dict:
    key = jax.random.key(seed)
    ks = jax.random.split(key, 26)
    n = lambda k, shape, s: jax.random.normal(k, shape, jnp.float32) * s
    L = DEPTH
    return {
        "x": n(ks[0], (BATCH, SEQ, D_MODEL), 1.0),
        "w_in": n(ks[1], (L, D_MODEL, D_IN), D_MODEL ** -0.5),
        "conv_w": n(ks[2], (L, CONV_WIDTH, 2 * WIDTH_M), CONV_WIDTH ** -0.5),
        "conv_b": n(ks[3], (L, 2 * WIDTH_M), 0.02),
        "kv_norm_g": 1.0 + n(ks[4], (L, KV_RANK), 0.02),
        "w_uk": n(ks[5], (L, KV_RANK, N_HEADS_A, HEAD_DIM_A), KV_RANK ** -0.5),
        "w_uv": n(ks[6], (L, KV_RANK, N_HEADS_A, HEAD_DIM_A), KV_RANK ** -0.5),
        "rel_bias": n(ks[7], (N_BUCKETS, N_HEADS_A), 0.5),
        "b_i": n(ks[8], (L, N_HEADS_M), 0.1),
        "b_f": jnp.linspace(3.0, 6.0, N_HEADS_M, dtype=jnp.float32)[None, :] + n(ks[9], (L, N_HEADS_M), 0.1),
        "mh_norm_g": 1.0 + n(ks[10], (L, N_HEADS_M, HEAD_DIM_M), 0.02),
        "w_up_a": n(ks[11], (L, WIDTH_A, D_MODEL), WIDTH_A ** -0.5),
        "w_up_m": n(ks[12], (L, WIDTH_M, D_MODEL), WIDTH_M ** -0.5),
        "w_out": n(ks[13], (L, D_MODEL, D_MODEL), BETA * D_MODEL ** -0.5),
        "ln1_g": 1.0 + n(ks[14], (L, D_MODEL), 0.02),
        "ln1_b": n(ks[15], (L, D_MODEL), 0.02),
        "w_grp": n(ks[16], (L, D_MODEL, N_GROUPS), D_MODEL ** -0.5),
        "b_grp": n(ks[17], (L, N_GROUPS), 0.01),
        "w_rt": n(ks[18], (L, D_MODEL, N_EXPERTS), D_MODEL ** -0.5),
        "b_rt": n(ks[19], (L, N_EXPERTS), 0.01),
        "w_gate": n(ks[20], (L, N_EXPERTS, D_MODEL, D_EXPERT), D_MODEL ** -0.5),
        "w_up": n(ks[21], (L, N_EXPERTS, D_MODEL, D_EXPERT), D_MODEL ** -0.5),
        "w_down": n(ks[22], (L, N_EXPERTS, D_EXPERT, D_MODEL), BETA * D_EXPERT ** -0.5),
        "ln2_g": 1.0 + n(ks[23], (L, D_MODEL), 0.02),
        "ln2_b": n(ks[24], (L, D_MODEL), 0.02),
    }


def reference(x, w_in, conv_w, conv_b, kv_norm_g, w_uk, w_uv, rel_bias, b_i, b_f,
              mh_norm_g, w_up_a, w_up_m, w_out, ln1_g, ln1_b, w_grp, b_grp, w_rt, b_rt,
              w_gate, w_up, w_down, ln2_g, ln2_b):
    for l in range(DEPTH):
        mix = token_mixer(x, w_in[l], conv_w[l], conv_b[l], kv_norm_g[l], w_uk[l], w_uv[l],
                          rel_bias, b_i[l], b_f[l], mh_norm_g[l], w_up_a[l], w_up_m[l], w_out[l])
        x = layer_norm(ALPHA * x + mix, ln1_g[l], ln1_b[l])
        ffn = hier_moe(x, w_grp[l], b_grp[l], w_rt[l], b_rt[l], w_gate[l], w_up[l], w_down[l])
        x = layer_norm(ALPHA * x + ffn, ln2_g[l], ln2_b[l])
    return x
```

```cpp
#ifdef EMU
#include "emu/emu.h"
#define DEV static inline
#define DEVM inline
#define WAVE_SYNC() e_wbar()
#define LAS
#else
#include <hip/hip_runtime.h>
#include <cstdio>
#include <cstdint>
#define DEV __device__ __forceinline__
#define DEVM __device__ __forceinline__
#define WAVE_SYNC() asm volatile("s_waitcnt lgkmcnt(0)" ::: "memory")
#define LAS __attribute__((address_space(3)))
typedef short bf16x8 __attribute__((ext_vector_type(8)));
typedef float f32x16 __attribute__((ext_vector_type(16)));
typedef float f32x4 __attribute__((ext_vector_type(4)));
#endif
typedef unsigned u32x4 __attribute__((ext_vector_type(4)));
typedef unsigned u32x2 __attribute__((ext_vector_type(2)));
typedef short s16x4 __attribute__((ext_vector_type(4)));
typedef unsigned short bf16_t;
typedef unsigned long long u64;

#ifndef CFG_B
#define CFG_B 16
#endif
#ifndef CFG_S
#define CFG_S 2048
#endif
constexpr int NB = CFG_B, SEQ = CFG_S, DM = 1024, M = NB * SEQ;
constexpr int HA = 8, DA = 64, WA = 512, KVR = 256, TOPK = (SEQ / 4 < 256) ? SEQ / 4 : 256;
constexpr int NHM = 4, DHM = 128, WM = 512, CHUNK = 64, NCH = SEQ / CHUNK;
constexpr int NE = 16, DE = 512, MPAD = 2 * M + 4096;
constexpr float LN_EPS = 1e-5f, ALPHA = 1.189207115002721f;
constexpr float QSCALE = 0.125f * 1.4426950408889634f;
constexpr float LOG2E = 1.4426950408889634f;
constexpr int NWIN = 5632, LDH = 5376;
constexpr int C_QA = 0, C_CKV = 512, C_QI = 768, C_QM = 1280, C_KM = 1792, C_VM = 2304, C_OM = 2816, C_GA = 3328, C_GM = 4352;
constexpr int NWORDS = SEQ / 32;
constexpr int NWAVES = 8, NTHREADS = 512;

constexpr size_t MiB = 1u << 20;
constexpr size_t WS_CTL = 0, CTL_ZERO_BYTES = 64 * 1024;
constexpr size_t WS_WIN = 1 * MiB, WS_WK = 12 * MiB, WS_WV = 12 * MiB + 512 * 1024, WS_WA = 13 * MiB, WS_WM = 14 * MiB, WS_WO = 15 * MiB;
constexpr size_t WS_WGU = 17 * MiB, WS_WD = 49 * MiB, WS_TOK = 65 * MiB;
constexpr size_t R0 = 66 * MiB;
constexpr size_t R1 = R0 + (size_t)M * 2048;
constexpr size_t R2 = R1 + (size_t)M * LDH * 2;
constexpr size_t WS_KIDX = R2, WS_SM = WS_KIDX + (size_t)M * 128, WS_SSQ = WS_SM + (size_t)M * 64, WS_MASK = WS_SSQ + (size_t)M * 16, WS_END = WS_MASK + (size_t)M * NWORDS * 4;
constexpr size_t WS_K = R0, WS_VT = R0 + (size_t)M * 1024, WS_Y = R0;
#ifdef EMU
constexpr size_t WS_H = R1, WS_Z = R1, WS_X1B = R1 + (size_t)M * 4096, WS_XS = WS_END, WS_HD = WS_XS + (size_t)MPAD * 2048, WS_O2 = WS_HD + (size_t)MPAD * 1024, WS_TOTAL = WS_O2 + (size_t)MPAD * 2048;
#else
constexpr size_t WS_H = R1, WS_Z = R1, WS_X1B = R1 + (size_t)M * 4096, WS_XS = R1 + (size_t)M * 6144;
constexpr size_t WS_HD = R1, WS_O2 = R1 + (size_t)MPAD * 1024, WS_TOTAL = WS_END;
static_assert(WS_XS + (size_t)MPAD * 2048 <= R2, "XS fits in the H region");
static_assert(WS_O2 + (size_t)MPAD * 2048 <= R2, "O2 fits in the H region");
static_assert(WS_END <= 512 * MiB, "workspace budget");
#endif
constexpr int CW_CNT = 4096;
constexpr int CW_BAR = 8192;

struct Args { const float* in[25]; float* out; unsigned char* ws; int ph_lo, ph_hi; };

DEV unsigned fbits(float f) { unsigned u; __builtin_memcpy(&u, &f, 4); return u; }
DEV float bitsf(unsigned u) { float f; __builtin_memcpy(&f, &u, 4); return f; }
DEV unsigned f2bf(float f) { unsigned u = fbits(f); return (u + 0x7fffu + ((u >> 16) & 1u)) >> 16; }
DEV float bf2f(unsigned b) { return bitsf(b << 16); }
DEV unsigned pk2(float lo, float hi) {
#ifdef EMU
    return f2bf(lo) | (f2bf(hi) << 16);
#else
    typedef float f32x2_t __attribute__((ext_vector_type(2))); typedef __bf16 bf16x2_t __attribute__((ext_vector_type(2)));
    f32x2_t v = {lo, hi}; bf16x2_t b = __builtin_convertvector(v, bf16x2_t); return __builtin_bit_cast(unsigned, b);
#endif
}
DEV float lo_bf(unsigned w) { return bitsf(w << 16); }
DEV float hi_bf(unsigned w) { return bitsf(w & 0xffff0000u); }
DEV f32x16 mfma32(bf16x8 a, bf16x8 b, f32x16 c) {
#ifdef EMU
    return emu_mfma_32x32x16_bf16(a, b, c);
#else
    return __builtin_amdgcn_mfma_f32_32x32x16_bf16(a, b, c, 0, 0, 0);
#endif
}
DEV float fast_rcp(float x) {
#ifdef EMU
    return 1.0f / x;
#else
    return __builtin_amdgcn_rcpf(x);
#endif
}
DEV float fast_exp2(float x) {
#ifdef EMU
    return exp2f(x);
#else
    return __builtin_amdgcn_exp2f(x);
#endif
}
DEV float sigmoidf_(float x) { return fast_rcp(1.0f + __expf(-x)); }
DEV int crow(int r, int hi) { return (r & 3) + 8 * (r >> 2) + 4 * hi; }
DEV bf16x8 pack8(float a0, float a1, float a2, float a3, float a4, float a5, float a6, float a7) {
    u32x4 w; w.x = pk2(a0, a1); w.y = pk2(a2, a3); w.z = pk2(a4, a5); w.w = pk2(a6, a7); return __builtin_bit_cast(bf16x8, w);
}
DEV float wave_sum(float v) {
#pragma unroll
    for (int o = 1; o < 64; o <<= 1) v += __shfl_xor(v, o);
    return v;
}

namespace pg8 {
constexpr int BM = 256, BK = 64, HALF = 128, HTB = HALF * BK * 2, STAGE_BYTES = 8 * HTB, NXCD = 8, WGM = 8;
DEV int lds_byte(int r, int c) { const int st = (r >> 4) * 2 + (c >> 5), rr = r & 15, cc = c & 31, ob = rr * 64 + cc * 2; return st * 1024 + (ob ^ (((ob >> 9) & 1) << 5)); }
DEV void stage_rc(int b, int& R, int& C) { const int st = b / 1024, sb = b % 1024, swz = sb ^ (((sb >> 9) & 1) << 5); R = (st >> 1) * 16 + swz / 64; C = (st & 1) * 32 + (swz % 64) / 2; }
DEV int perm32(int rho) { const int n = rho >> 4, i = rho & 15; return 8 * (i >> 2) + 4 * n + (i & 3); }

struct Unit { int pm, pn, e; };
struct SchedStatic {
    int nM, nN, nwg, G, c, K, lda, ldb; const bf16_t* A; const bf16_t* Bt;
    DEVM void init(const bf16_t* A_, int lda_, const bf16_t* Bt_, int ldb_, int M_, int N_, int K_, int G_, int c_) { A = A_; lda = lda_; Bt = Bt_; ldb = ldb_; nM = M_ / BM; nN = N_ / BM; nwg = nM * nN; K = K_; G = G_; c = c_; }
    DEVM bool next(int i, Unit& u) const {
        const long L = (long)i * G + c; if (L >= nwg) return false;
        int wgid = (int)L; { const int q = nwg / NXCD, r = nwg % NXCD, xcd = wgid % NXCD, off = wgid / NXCD; wgid = (xcd < r ? xcd * (q + 1) : r * (q + 1) + (xcd - r) * q) + off; }
        const int nig = WGM * nN, gid = wgid / nig, fm = gid * WGM, gsz = (nM - fm) < WGM ? (nM - fm) : WGM;
        u.pm = fm + ((wgid % nig) % gsz); u.pn = (wgid % nig) / gsz; u.e = 0; return true;
    }
    DEVM const char* baseA(const Unit& u) const { return (const char*)(A + (size_t)u.pm * BM * lda); }
    DEVM const char* baseB(const Unit& u) const { return (const char*)(Bt + (size_t)u.pn * BM * ldb); }
};
struct SchedMoe {
    int ntiles, nN, G, c, K, lda, ldb; const bf16_t* A; const bf16_t* Bt; size_t estride; int tend[NE];
    DEVM bool next(int i, Unit& u) const {
        const long L = (long)i * G + c; if (L >= (long)ntiles * nN) return false;
        u.pm = (int)(L / nN); u.pn = (int)(L % nN); int e = 0;
#pragma unroll
        for (int j = 0; j < NE - 1; ++j) e += (u.pm >= tend[j]) ? 1 : 0;
        u.e = e; return true;
    }
    DEVM const char* baseA(const Unit& u) const { return (const char*)(A + (size_t)u.pm * BM * lda); }
    DEVM const char* baseB(const Unit& u) const { return (const char*)(Bt + (size_t)u.e * estride + (size_t)u.pn * BM * ldb); }
};

#ifdef EMU
template <class Epi, class Sched>
static inline void gemm_phase(unsigned char* lds, const Sched& S, const Epi& E) {
    const int tid = threadIdx.x, wid = tid >> 6, lane = tid & 63, wr = wid >> 2, wc = wid & 3, fr = lane & 15, fq = lane >> 4;
    Unit u;
    for (int i = 0; S.next(i, u); ++i) {
        f32x4 acc[2][2][4][2];
        const bf16_t* A = (const bf16_t*)S.baseA(u); const bf16_t* B = (const bf16_t*)S.baseB(u);
        for (int ai = 0; ai < 2; ++ai) for (int bj = 0; bj < 2; ++bj) for (int m = 0; m < 4; ++m) for (int n = 0; n < 2; ++n) for (int x = 0; x < 4; ++x) {
            const int r = 128 * ai + 64 * wr + 16 * m + fr, c = 128 * bj + 32 * wc + 8 * fq + 4 * n + x; float s = 0.f;
            for (int k = 0; k < S.K; ++k) s += bf2f(A[(size_t)r * S.lda + k]) * bf2f(B[(size_t)c * S.ldb + k]);
            acc[ai][bj][m][n][x] = s; }
        E(acc, u, wr, wc, fr, fq);
    }
    (void)lds;
}
#else
#define PG8_LAS __attribute__((address_space(3)))
template <class Epi, class Sched>
__device__ __forceinline__ void gemm_phase(PG8_LAS unsigned char* lds, const Sched& S, const Epi& E) {
    const int tid = threadIdx.x, wid = __builtin_amdgcn_readfirstlane(tid >> 6), lane = tid & 63, wr = wid >> 2, wc = wid & 3, fr = lane & 15, fq = lane >> 4;
    const int K = S.K, nt = K / BK;
    unsigned voffA[2], voffB[2];
#pragma unroll
    for (int i = 0; i < 2; ++i) { int R, C; stage_rc(tid * 16 + i * 8192, R, C); const int Rb = (R & ~31) + perm32(R & 31);
        voffA[i] = (unsigned)(R * S.lda + C) * 2u; voffB[i] = (unsigned)(Rb * S.ldb + C) * 2u; }
    const size_t kstep = (size_t)(BK * 2);
    const size_t hstepA = (size_t)HALF * S.lda * 2, hstepB = (size_t)HALF * S.ldb * 2;
    const unsigned ldsw = (unsigned)wid * 1024u;
    const int aoff = lds_byte(wr * 64 + fr, fq * 8), boff = lds_byte(wc * 32 + fr, fq * 8);
#define PG8_SA(b, h) (((b) * 2 + (h)) * HTB)
#define PG8_SB(b, h) ((4 + (b) * 2 + (h)) * HTB)
#define PG8_STAGE(bufoff, gbase, voff) do { _Pragma("unroll") for (int _i = 0; _i < 2; ++_i) \
        __builtin_amdgcn_global_load_lds((const unsigned*)((const char*)(gbase) + (voff)[_i]), (PG8_LAS unsigned*)(lds + (bufoff) + ldsw + _i * 8192), 16, 0, 0); } while (0)
#define PG8_LDA(dst, b, h) do { _Pragma("unroll") for (int m = 0; m < 4; ++m) _Pragma("unroll") for (int k = 0; k < 2; ++k) dst[m][k] = *(const PG8_LAS bf16x8*)(lds + PG8_SA(b, h) + aoff + m * 2048 + k * 1024); } while (0)
#define PG8_LDB(dst, b, h) do { _Pragma("unroll") for (int n = 0; n < 2; ++n) _Pragma("unroll") for (int k = 0; k < 2; ++k) dst[n][k] = *(const PG8_LAS bf16x8*)(lds + PG8_SB(b, h) + boff + n * 2048 + k * 1024); } while (0)
#define PG8_MMA(ai, bj, At, Bt) do { __builtin_amdgcn_s_setprio(1); _Pragma("unroll") for (int m = 0; m < 4; ++m) _Pragma("unroll") for (int n = 0; n < 2; ++n) _Pragma("unroll") for (int k = 0; k < 2; ++k) \
        acc[ai][bj][m][n] = __builtin_amdgcn_mfma_f32_16x16x32_bf16(Bt[n][k], At[m][k], acc[ai][bj][m][n], 0, 0, 0); __builtin_amdgcn_s_setprio(0); } while (0)
#define PG8_WAIT_V(n) asm volatile("s_waitcnt vmcnt(" #n ")" ::: "memory")
#define PG8_WAIT_L(n) asm volatile("s_waitcnt lgkmcnt(" #n ")" ::: "memory")
#define PG8_BAR __builtin_amdgcn_s_barrier()
#define PG8_SCHED __builtin_amdgcn_sched_barrier(0)
    Unit cur, nxt; int ui = 0;
    if (!S.next(0, cur)) return;
    f32x4 acc[2][2][4][2];
#pragma unroll
    for (int a = 0; a < 2; ++a)
#pragma unroll
        for (int b = 0; b < 2; ++b)
#pragma unroll
            for (int m = 0; m < 4; ++m)
#pragma unroll
                for (int n = 0; n < 2; ++n) acc[a][b][m][n] = (f32x4){0.f, 0.f, 0.f, 0.f};
    bf16x8 At[4][2], B0[2][2], B1[2][2];
    const char* cA = S.baseA(cur); const char* cB = S.baseB(cur);
    PG8_STAGE(PG8_SB(0, 0), cB, voffB); PG8_STAGE(PG8_SB(0, 1), cB + hstepB, voffB); PG8_STAGE(PG8_SA(0, 0), cA, voffA); PG8_STAGE(PG8_SA(0, 1), cA + hstepA, voffA);
    if (wr == 1) PG8_BAR;
    PG8_WAIT_V(2); PG8_BAR;
    PG8_STAGE(PG8_SB(1, 0), cB + kstep, voffB); PG8_STAGE(PG8_SA(1, 0), cA + kstep, voffA); PG8_STAGE(PG8_SB(1, 1), cB + hstepB + kstep, voffB);
    PG8_WAIT_V(6); PG8_BAR;
    for (;;) {
        const bool has_next = S.next(ui + 1, nxt);
        const char* nA = has_next ? S.baseA(nxt) : cA; const char* nB = has_next ? S.baseB(nxt) : cB;
        for (int t = 0; t < nt; t += 2) {
            const bool last = (t == nt - 2);
            const char* a1 = cA + (size_t)(t + 1) * kstep;
            const char* a2 = last ? nA : cA + (size_t)(t + 2) * kstep; const char* b2 = last ? nB : cB + (size_t)(t + 2) * kstep;
            const char* a3 = a2 + kstep; const char* b3 = b2 + kstep;
            PG8_LDB(B0, 0, 0); PG8_LDB(B1, 0, 1); PG8_SCHED; PG8_LDA(At, 0, 0); PG8_STAGE(PG8_SA(1, 1), a1 + hstepA, voffA);
            PG8_WAIT_V(8); PG8_WAIT_L(0); PG8_BAR; PG8_MMA(0, 0, At, B0); PG8_MMA(0, 1, At, B1); PG8_BAR; PG8_SCHED;
            PG8_LDA(At, 0, 1); PG8_STAGE(PG8_SB(0, 0), b2, voffB); PG8_STAGE(PG8_SB(0, 1), b2 + hstepB, voffB); PG8_STAGE(PG8_SA(0, 0), a2, voffA);
            PG8_WAIT_V(8); PG8_WAIT_L(0); PG8_BAR; PG8_MMA(1, 0, At, B0); PG8_MMA(1, 1, At, B1); PG8_BAR; PG8_SCHED;
            PG8_LDB(B0, 1, 0); PG8_LDB(B1, 1, 1); PG8_SCHED; PG8_LDA(At, 1, 0); PG8_STAGE(PG8_SA(0, 1), a2 + hstepA, voffA);
            PG8_WAIT_V(8); PG8_WAIT_L(0); PG8_BAR; PG8_MMA(0, 0, At, B0); PG8_MMA(0, 1, At, B1); PG8_BAR; PG8_SCHED;
            PG8_LDA(At, 1, 1); PG8_STAGE(PG8_SB(1, 0), b3, voffB); PG8_STAGE(PG8_SB(1, 1), b3 + hstepB, voffB); PG8_STAGE(PG8_SA(1, 0), a3, voffA);
            PG8_WAIT_V(8); PG8_WAIT_L(0); PG8_BAR; PG8_MMA(1, 0, At, B0); PG8_MMA(1, 1, At, B1); PG8_BAR; PG8_SCHED;
        }
        if (wr == 0) PG8_BAR;
        E(acc, cur, wr, wc, fr, fq);
        if (!has_next) break;
#pragma unroll
        for (int a = 0; a < 2; ++a)
#pragma unroll
            for (int b = 0; b < 2; ++b)
#pragma unroll
                for (int m = 0; m < 4; ++m)
#pragma unroll
                    for (int n = 0; n < 2; ++n) acc[a][b][m][n] = (f32x4){0.f, 0.f, 0.f, 0.f};
        cur = nxt; cA = nA; cB = nB; ++ui;
        if (wr == 1) PG8_BAR;
    }
    PG8_WAIT_V(0);
    PG8_BAR;
#undef PG8_SA
#undef PG8_SB
#undef PG8_STAGE
#undef PG8_LDA
#undef PG8_LDB
#undef PG8_MMA
#undef PG8_WAIT_V
#undef PG8_WAIT_L
#undef PG8_BAR
#undef PG8_SCHED
}
#endif
}
using pg8::Unit;

#define EPI_ARGS const f32x4 (&acc)[2][2][4][2], const Unit& u, int wr, int wc, int fr, int fq
DEV u32x4 pack_row8(const f32x4& v0, const f32x4& v1) { u32x4 w; w.x = pk2(v0[0], v0[1]); w.y = pk2(v0[2], v0[3]); w.z = pk2(v1[0], v1[1]); w.w = pk2(v1[2], v1[3]); return w; }

struct EpiInProj {
    bf16_t* H; bf16_t* KIDX; float* SM; float* SSQ;
    DEVM void operator()(EPI_ARGS) const {
        const int row0 = u.pm * 256 + wr * 64 + fr;
        if (u.pn < 21) {
            const int col0 = u.pn * 256 + wc * 32 + 8 * fq; const bool sig = u.pn >= 11;
            if (u.pn == 2) {
#pragma unroll
                for (int ai = 0; ai < 2; ++ai)
#pragma unroll
                    for (int m = 0; m < 4; ++m) { float s = 0.f;
#pragma unroll
                        for (int bj = 0; bj < 2; ++bj)
#pragma unroll
                            for (int n = 0; n < 2; ++n) { const f32x4 x = acc[ai][bj][m][n]; s += (x[0] * x[0] + x[1] * x[1]) + (x[2] * x[2] + x[3] * x[3]); }
                        s += __shfl_xor(s, 16); s += __shfl_xor(s, 32);
                        if (fq == 0) SSQ[(size_t)(row0 + ai * 128 + m * 16) * 4 + wc] = s; }
            }
#pragma unroll
            for (int ai = 0; ai < 2; ++ai)
#pragma unroll
                for (int m = 0; m < 4; ++m) { bf16_t* rowp = H + (size_t)(row0 + ai * 128 + m * 16) * LDH + col0;
#pragma unroll
                    for (int bj = 0; bj < 2; ++bj) { f32x4 v0 = acc[ai][bj][m][0], v1 = acc[ai][bj][m][1];
                        if (sig) {
#pragma unroll
                            for (int x = 0; x < 4; ++x) { v0[x] = sigmoidf_(v0[x]); v1[x] = sigmoidf_(v1[x]); } }
                        *(u32x4*)(rowp + bj * 128) = pack_row8(v0, v1); } }
        } else {
#pragma unroll
            for (int ai = 0; ai < 2; ++ai)
#pragma unroll
                for (int m = 0; m < 4; ++m) { const size_t row = (size_t)(row0 + ai * 128 + m * 16);
                    if (wc < 2) *(u32x4*)(KIDX + row * 64 + wc * 32 + 8 * fq) = pack_row8(acc[ai][0][m][0], acc[ai][0][m][1]);
                    else if (wc == 2 && fq < 2) { *(f32x4*)(SM + row * 16 + 8 * fq) = acc[ai][0][m][0]; *(f32x4*)(SM + row * 16 + 8 * fq + 4) = acc[ai][0][m][1]; } }
        }
    }
};
DEV float rms_scale(const float* SSQ, size_t row) { const f32x4 q = *(const f32x4*)(SSQ + row * 4); return 1.0f / sqrtf(((q[0] + q[1]) + (q[2] + q[3])) * (1.0f / 256.0f) + LN_EPS); }
struct EpiK {
    bf16_t* Kb; const float* SSQ;
    DEVM void operator()(EPI_ARGS) const {
        const int row0 = u.pm * 256 + wr * 64 + fr, col0 = u.pn * 256 + wc * 32 + 8 * fq;
#pragma unroll
        for (int ai = 0; ai < 2; ++ai)
#pragma unroll
            for (int m = 0; m < 4; ++m) { const size_t row = (size_t)(row0 + ai * 128 + m * 16); const float s = rms_scale(SSQ, row);
#pragma unroll
                for (int bj = 0; bj < 2; ++bj) *(u32x4*)(Kb + row * 512 + col0 + bj * 128) = pack_row8(acc[ai][bj][m][0] * s, acc[ai][bj][m][1] * s); }
    }
};
struct EpiVT {
    bf16_t* VT; const float* SSQ;
    DEVM void operator()(EPI_ARGS) const {
        const int row0 = u.pm * 256 + wr * 64 + fr, col0 = u.pn * 256 + wc * 32 + 8 * fq;
        float sc[2][8];
#pragma unroll
        for (int bj = 0; bj < 2; ++bj)
#pragma unroll
            for (int x = 0; x < 8; ++x) sc[bj][x] = rms_scale(SSQ, (size_t)(col0 + bj * 128 + x));
#pragma unroll
        for (int ai = 0; ai < 2; ++ai)
#pragma unroll
            for (int m = 0; m < 4; ++m) { const size_t row = (size_t)(row0 + ai * 128 + m * 16);
#pragma unroll
                for (int bj = 0; bj < 2; ++bj) { f32x4 v0 = acc[ai][bj][m][0], v1 = acc[ai][bj][m][1];
#pragma unroll
                    for (int x = 0; x < 4; ++x) { v0[x] *= sc[bj][x]; v1[x] *= sc[bj][4 + x]; }
                    *(u32x4*)(VT + row * (size_t)M + col0 + bj * 128) = pack_row8(v0, v1); } }
    }
};
struct EpiUpA {
    bf16_t* Y1; const bf16_t* H;
    DEVM void operator()(EPI_ARGS) const {
        const int row0 = u.pm * 256 + wr * 64 + fr, col0 = u.pn * 256 + wc * 32 + 8 * fq;
#pragma unroll
        for (int ai = 0; ai < 2; ++ai)
#pragma unroll
            for (int m = 0; m < 4; ++m) { const size_t row = (size_t)(row0 + ai * 128 + m * 16);
#pragma unroll
                for (int bj = 0; bj < 2; ++bj) { const u32x4 g = *(const u32x4*)(H + row * LDH + C_GA + col0 + bj * 128);
                    f32x4 v0 = acc[ai][bj][m][0], v1 = acc[ai][bj][m][1];
                    v0[0] *= lo_bf(g.x); v0[1] *= hi_bf(g.x); v0[2] *= lo_bf(g.y); v0[3] *= hi_bf(g.y); v1[0] *= lo_bf(g.z); v1[1] *= hi_bf(g.z); v1[2] *= lo_bf(g.w); v1[3] *= hi_bf(g.w);
                    *(u32x4*)(Y1 + row * 1024 + col0 + bj * 128) = pack_row8(v0, v1); } }
    }
};
struct EpiUpM {
    bf16_t* Y; const bf16_t* Y1; const bf16_t* H;
    DEVM void operator()(EPI_ARGS) const {
        const int row0 = u.pm * 256 + wr * 64 + fr, col0 = u.pn * 256 + wc * 32 + 8 * fq;
#pragma unroll
        for (int ai = 0; ai < 2; ++ai)
#pragma unroll
            for (int m = 0; m < 4; ++m) { const size_t row = (size_t)(row0 + ai * 128 + m * 16);
#pragma unroll
                for (int bj = 0; bj < 2; ++bj) { const u32x4 g = *(const u32x4*)(H + row * LDH + C_GM + col0 + bj * 128); const u32x4 y = *(const u32x4*)(Y1 + row * 1024 + col0 + bj * 128);
                    f32x4 v0 = acc[ai][bj][m][0], v1 = acc[ai][bj][m][1];
                    v0[0] = v0[0] * lo_bf(g.x) + lo_bf(y.x); v0[1] = v0[1] * hi_bf(g.x) + hi_bf(y.x); v0[2] = v0[2] * lo_bf(g.y) + lo_bf(y.y); v0[3] = v0[3] * hi_bf(g.y) + hi_bf(y.y);
                    v1[0] = v1[0] * lo_bf(g.z) + lo_bf(y.z); v1[1] = v1[1] * hi_bf(g.z) + hi_bf(y.z); v1[2] = v1[2] * lo_bf(g.w) + lo_bf(y.w); v1[3] = v1[3] * hi_bf(g.w) + hi_bf(y.w);
                    *(u32x4*)(Y + row * 1024 + col0 + bj * 128) = pack_row8(v0, v1); } }
    }
};
struct EpiOut {
    float* Z; const float* X;
    DEVM void operator()(EPI_ARGS) const {
        const int row0 = u.pm * 256 + wr * 64 + fr, col0 = u.pn * 256 + wc * 32 + 8 * fq;
#pragma unroll
        for (int ai = 0; ai < 2; ++ai)
#pragma unroll
            for (int m = 0; m < 4; ++m) { const size_t off = (size_t)(row0 + ai * 128 + m * 16) * 1024 + col0;
#pragma unroll
                for (int bj = 0; bj < 2; ++bj)
#pragma unroll
                    for (int n = 0; n < 2; ++n) { const f32x4 xv = *(const f32x4*)(X + off + bj * 128 + 4 * n); *(f32x4*)(Z + off + bj * 128 + 4 * n) = acc[ai][bj][m][n] + xv * ALPHA; } }
    }
};
struct EpiMoe1 {
    bf16_t* HD;
    DEVM void operator()(EPI_ARGS) const {
        const int row0 = u.pm * 256 + wr * 64 + fr, col0 = u.pn * 128 + wc * 32 + 8 * fq;
#pragma unroll
        for (int ai = 0; ai < 2; ++ai)
#pragma unroll
            for (int m = 0; m < 4; ++m) { const size_t row = (size_t)(row0 + ai * 128 + m * 16);
                f32x4 v0, v1;
#pragma unroll
                for (int x = 0; x < 4; ++x) { const float g0 = acc[ai][0][m][0][x], g1 = acc[ai][0][m][1][x]; v0[x] = g0 * sigmoidf_(g0) * acc[ai][1][m][0][x]; v1[x] = g1 * sigmoidf_(g1) * acc[ai][1][m][1][x]; }
                *(u32x4*)(HD + row * 512 + col0) = pack_row8(v0, v1); }
    }
};
struct EpiMoe2 {
    bf16_t* O2;
    DEVM void operator()(EPI_ARGS) const {
        const int row0 = u.pm * 256 + wr * 64 + fr, col0 = u.pn * 256 + wc * 32 + 8 * fq;
#pragma unroll
        for (int ai = 0; ai < 2; ++ai)
#pragma unroll
            for (int m = 0; m < 4; ++m) { const size_t row = (size_t)(row0 + ai * 128 + m * 16);
#pragma unroll
                for (int bj = 0; bj < 2; ++bj) *(u32x4*)(O2 + row * 1024 + col0 + bj * 128) = pack_row8(acc[ai][bj][m][0], acc[ai][bj][m][1]); }
    }
};

struct Ctx {
    const float* in[25]; float* out; unsigned char* ws;
    int tid, lane, wid, G, bid;
    LAS unsigned char* lds;
};
#define IN_X 0
#define IN_WIN 1
#define IN_CONVW 2
#define IN_CONVB 3
#define IN_KVG 4
#define IN_WUK 5
#define IN_WUV 6
#define IN_RELB 7
#define IN_BI 8
#define IN_BF 9
#define IN_MHG 10
#define IN_WUPA 11
#define IN_WUPM 12
#define IN_WOUT 13
#define IN_LN1G 14
#define IN_LN1B 15
#define IN_WGRP 16
#define IN_BGRP 17
#define IN_WRT 18
#define IN_BRT 19
#define IN_WGATE 20
#define IN_WUP 21
#define IN_WDOWN 22
#define IN_LN2G 23
#define IN_LN2B 24
template <class T> DEV T* wsp(const Ctx& c, size_t off) { return (T*)(c.ws + off); }
DEV void wg_sync() { __syncthreads(); }

DEV int win_src_col(int n) {
    if (n < 1280) return n;
    if (n < 2816) return 1352 + (n - 1280);
    if (n < 5376) return 2896 + (n - 2816);
    if (n < 5440) return 1280 + (n - 5376);
    if (n < 5448) return 1344 + (n - 5440);
    if (n < 5456) return 2888 + (n - 5448);
    return -1;
}
DEV void p0_item(const float* W, const float* W2, int K, int Nsrc, bf16_t* WT, int mode, const float* aux, LAS float* scr, int item, int nblk, int lane) {
    const int kb = item / nblk, nb = item % nblk, k0 = 64 * kb, n0 = 32 * nb;
    const int nn = n0 + (lane & 31);
    int col = nn; const float* src = W; float cs = 1.0f;
    if (mode == 1) { col = win_src_col(nn); cs = (nn < 512) ? QSCALE : 1.0f; }
    if (mode == 3) { const int t = nn >> 8, j = nn & 255; col = t * 128 + (j & 127); src = (j < 128) ? W : W2; }
#pragma unroll 8
    for (int i = 0; i < 32; ++i) { const int kk = 2 * i + (lane >> 5); float v = 0.f;
        if (col >= 0) { v = src[(size_t)(k0 + kk) * Nsrc + col] * cs; if (mode == 2) v *= aux[k0 + kk]; }
        scr[kk * 33 + (lane & 31)] = v; }
    WAVE_SYNC();
    const int c = lane & 7;
#pragma unroll
    for (int j = 0; j < 4; ++j) { const int n = (lane >> 3) + 8 * j; const LAS float* s = scr + (8 * c) * 33 + n;
        u32x4 o; o.x = pk2(s[0 * 33], s[1 * 33]); o.y = pk2(s[2 * 33], s[3 * 33]); o.z = pk2(s[4 * 33], s[5 * 33]); o.w = pk2(s[6 * 33], s[7 * 33]);
        *(u32x4*)(WT + (size_t)(n0 + n) * K + k0 + 8 * c) = o; }
    WAVE_SYNC();
}
DEV void phase_prologue(const Ctx& c) {
    LAS float* scr = (LAS float*)(c.lds + c.wid * 16384);
    const int gw = c.bid * NWAVES + c.wid, NGW = c.G * NWAVES;
    constexpr int I_WIN = 16 * (NWIN / 32), I_KV = 4 * 16, I_UP = 8 * 32, I_WO = 16 * 32, I_GU = 16 * 32, I_D = 8 * 32;
    constexpr int NITEMS = I_WIN + 2 * I_KV + 2 * I_UP + I_WO + NE * I_GU + NE * I_D;
    for (int it = gw; it < NITEMS; it += NGW) {
        int r = it;
        if (r < I_WIN) { p0_item(c.in[IN_WIN], nullptr, 1024, 5456, wsp<bf16_t>(c, WS_WIN), 1, nullptr, scr, r, NWIN / 32, c.lane); continue; } r -= I_WIN;
        if (r < I_KV) { p0_item(c.in[IN_WUK], nullptr, 256, 512, wsp<bf16_t>(c, WS_WK), 2, c.in[IN_KVG], scr, r, 16, c.lane); continue; } r -= I_KV;
        if (r < I_KV) { p0_item(c.in[IN_WUV], nullptr, 256, 512, wsp<bf16_t>(c, WS_WV), 2, c.in[IN_KVG], scr, r, 16, c.lane); continue; } r -= I_KV;
        if (r < I_UP) { p0_item(c.in[IN_WUPA], nullptr, 512, 1024, wsp<bf16_t>(c, WS_WA), 0, nullptr, scr, r, 32, c.lane); continue; } r -= I_UP;
        if (r < I_UP) { p0_item(c.in[IN_WUPM], nullptr, 512, 1024, wsp<bf16_t>(c, WS_WM), 0, nullptr, scr, r, 32, c.lane); continue; } r -= I_UP;
        if (r < I_WO) { p0_item(c.in[IN_WOUT], nullptr, 1024, 1024, wsp<bf16_t>(c, WS_WO), 0, nullptr, scr, r, 32, c.lane); continue; } r -= I_WO;
        if (r < NE * I_GU) { const int e = r / I_GU; p0_item(c.in[IN_WGATE] + (size_t)e * 1024 * 512, c.in[IN_WUP] + (size_t)e * 1024 * 512, 1024, 512, wsp<bf16_t>(c, WS_WGU) + (size_t)e * 1024 * 1024, 3, nullptr, scr, r % I_GU, 32, c.lane); continue; } r -= NE * I_GU;
        { const int e = r / I_D; p0_item(c.in[IN_WDOWN] + (size_t)e * 512 * 1024, nullptr, 512, 1024, wsp<bf16_t>(c, WS_WD) + (size_t)e * 1024 * 512, 0, nullptr, scr, r % I_D, 32, c.lane); }
    }
    const float* X = c.in[IN_X]; bf16_t* XB = wsp<bf16_t>(c, R0);
    for (int m = gw; m < M; m += NGW) {
        const f32x4* xr = (const f32x4*)(X + (size_t)m * DM) + c.lane; u32x2* o = (u32x2*)(XB + (size_t)m * DM) + c.lane;
#pragma unroll
        for (int j = 0; j < 4; ++j) { const f32x4 v = xr[64 * j]; u32x2 w; w.x = pk2(v[0], v[1]); w.y = pk2(v[2], v[3]); o[64 * j] = w; }
    }
}

constexpr int SCP = SEQ + 32;
constexpr int IDX_LDS = 16 * SCP * 4;
constexpr int NR = SEQ / 64;
DEV void idx_unit(const Ctx& c, int b, int qt) {
    const int lane = c.lane, wid = c.wid, r32 = lane & 31, hi = lane >> 5;
    LAS float* sc = (LAS float*)c.lds;
    const bf16_t* H = wsp<bf16_t>(c, WS_H); const bf16_t* KIDX = wsp<bf16_t>(c, WS_KIDX); const float* SM = wsp<float>(c, WS_SM);
    unsigned* MASK = wsp<unsigned>(c, WS_MASK);
    const int t0 = qt * 16; const size_t rowb = (size_t)b * SEQ;
    const int nkc = (t0 + 16 + 31) / 32;
    {
        const int ah = (r32 & 3) + 4 * ((r32 >> 3) & 1), atl = 2 * (r32 >> 4) + ((r32 >> 2) & 1);
#pragma unroll
        for (int Tp = 0; Tp < 2; ++Tp) {
            bf16x8 af[2][4]; float wq[2][2][8];
#pragma unroll
            for (int T = 0; T < 2; ++T) {
#pragma unroll
                for (int ks = 0; ks < 4; ++ks) af[T][ks] = *(const bf16x8*)(H + (rowb + t0 + 4 * (2 * Tp + T) + atl) * LDH + C_QI + ah * 64 + ks * 16 + hi * 8);
#pragma unroll
                for (int jj = 0; jj < 2; ++jj) { const float* wp = SM + (rowb + t0 + 4 * (2 * Tp + T) + 2 * jj + hi) * 16; const f32x4 w0 = *(const f32x4*)wp, w1 = *(const f32x4*)(wp + 4);
#pragma unroll
                    for (int x = 0; x < 4; ++x) { wq[T][jj][x] = w0[x]; wq[T][jj][4 + x] = w1[x]; } }
            }
            for (int kc = wid; kc < nkc; kc += NWAVES) {
                const int key = kc * 32 + r32; bf16x8 bf[4];
#pragma unroll
                for (int ks = 0; ks < 4; ++ks) bf[ks] = *(const bf16x8*)(KIDX + (rowb + key) * 64 + ks * 16 + hi * 8);
#pragma unroll
                for (int T = 0; T < 2; ++T) {
                    f32x16 a = {0.f, 0.f, 0.f, 0.f, 0.f, 0.f, 0.f, 0.f, 0.f, 0.f, 0.f, 0.f, 0.f, 0.f, 0.f, 0.f};
#pragma unroll
                    for (int ks = 0; ks < 4; ++ks) a = mfma32(af[T][ks], bf[ks], a);
                    float s0 = 0.f, s1 = 0.f;
#pragma unroll
                    for (int j = 0; j < 2; ++j)
#pragma unroll
                        for (int i = 0; i < 4; ++i) { s0 += wq[T][0][i + 4 * j] * fmaxf(a[4 * j + i], 0.f); s1 += wq[T][1][i + 4 * j] * fmaxf(a[8 + 4 * j + i], 0.f); }
                    const int tq0 = 4 * (2 * Tp + T) + hi;
                    sc[tq0 * SCP + key] = s0; sc[(tq0 + 2) * SCP + key] = s1;
                }
            }
        }
    }
    wg_sync();
#pragma unroll 1
    for (int qq = 0; qq < 2; ++qq) {
        const int tq = wid + 8 * qq, t = t0 + tq; unsigned* out = MASK + (rowb + t) * NWORDS;
        if (t + 1 <= TOPK) {
            if (lane < NWORDS) { const int lo = 32 * lane; out[lane] = (lo + 31 <= t) ? 0xffffffffu : (lo > t ? 0u : ((1u << (t - lo + 1)) - 1u)); }
        } else {
            unsigned key[NR];
#pragma unroll
            for (int r = 0; r < NR; ++r) { const int s = r * 64 + lane; const float v = sc[tq * SCP + (s <= t ? s : 0)]; unsigned uu = fbits(v); uu = (uu & 0x80000000u) ? ~uu : (uu | 0x80000000u); key[r] = (s <= t) ? uu : 0u; }
            unsigned prefix = 0;
#pragma unroll 1
            for (int bit = 31; bit >= 0; --bit) { const unsigned trial = prefix | (1u << bit); int cnt = 0;
#pragma unroll
                for (int r = 0; r < NR; ++r) cnt += __popcll(__ballot(key[r] >= trial));
                if (cnt >= TOPK) prefix = trial; }
            int cgt = 0;
#pragma unroll
            for (int r = 0; r < NR; ++r) cgt += __popcll(__ballot(key[r] > prefix));
            const int need = TOPK - cgt; int run = 0; u64 mym = 0; const u64 ltm = (lane == 0) ? 0ull : (~0ull >> (64 - lane));
#pragma unroll
            for (int r = 0; r < NR; ++r) { const bool eqp = key[r] == prefix; const u64 eq = __ballot(eqp); const int rank = run + __popcll(eq & ltm);
                const bool sel = (key[r] > prefix) || (eqp && rank < need); const u64 mm = __ballot(sel); if (lane == r) mym = mm; run += __popcll(eq); }
            if (lane < NR) { out[2 * lane] = (unsigned)mym; out[2 * lane + 1] = (unsigned)(mym >> 32); }
        }
    }
    wg_sync();
}

constexpr int QP = 136, TP = 72;
constexpr int L_QS = 0, L_KS = L_QS + 64 * QP * 2, L_KT = L_KS + 64 * QP * 2, L_VT = L_KT + 128 * TP * 2, L_CT = L_VT + 128 * TP * 2, L_N = L_CT + 128 * QP * 2,
              L_G = L_N + 512, L_PART = L_G + NWAVES * 1280, L_CW = L_PART + 1024, L_GN = L_CW + 32 * 40 * 4, ML_LDS = L_GN + 512;
DEV float scan_add(float v, int lane) {
#pragma unroll
    for (int d = 1; d < 64; d <<= 1) { const float o = __shfl_up(v, d); if (lane >= d) v += o; }
    return v;
}
DEV float scan_max(float v, int lane) {
#pragma unroll
    for (int d = 1; d < 64; d <<= 1) { const float o = __shfl_up(v, d); if (lane >= d) v = fmaxf(v, o); }
    return v;
}
DEV void mlstm_unit(const Ctx& c, int b, int head) {
    const int tid = c.tid, lane = c.lane, wid = c.wid, r32 = lane & 31, hi = lane >> 5;
    LAS unsigned char* lds = c.lds;
    LAS bf16_t* QS = (LAS bf16_t*)(lds + L_QS); LAS bf16_t* KS = (LAS bf16_t*)(lds + L_KS); LAS bf16_t* KT = (LAS bf16_t*)(lds + L_KT);
    LAS bf16_t* VTs = (LAS bf16_t*)(lds + L_VT); LAS bf16_t* CT = (LAS bf16_t*)(lds + L_CT); LAS float* NV = (LAS float*)(lds + L_N);
    LAS float* GW = (LAS float*)(lds + L_G + wid * 1280); LAS float* PART = (LAS float*)(lds + L_PART);
    const bf16_t* H = wsp<bf16_t>(c, WS_H); const float* SM = wsp<float>(c, WS_SM); bf16_t* HM = (bf16_t*)c.out;
    const float bi = c.in[IN_BI][head], bfg = c.in[IN_BF][head];
    const int vt = wid >> 1, jt = wid & 1;
    const int which = tid >> 8, rem = tid & 255, cg = rem & 15, rb = rem >> 4;
    LAS float* CWL = (LAS float*)(lds + L_CW); LAS float* GNL = (LAS float*)(lds + L_GN);
    for (int i = tid; i < 32 * 40; i += NTHREADS) { const int grp = i / 40, e = i % 40, wh = grp >> 4, cgi = grp & 15, ch0 = wh * 512 + head * 128 + cgi * 8;
        CWL[i] = (e < 32) ? c.in[IN_CONVW][(e >> 3) * 1024 + ch0 + (e & 7)] : c.in[IN_CONVB][ch0 + (e - 32)]; }
    if (tid < 128) GNL[tid] = c.in[IN_MHG][head * 128 + tid];
    const LAS float* cwp = CWL + (which * 16 + cg) * 40;
    f32x16 accC[2];
#pragma unroll
    for (int x = 0; x < 2; ++x)
#pragma unroll
        for (int r = 0; r < 16; ++r) accC[x][r] = 0.f;
    for (int i = tid; i < 128 * QP / 2; i += NTHREADS) ((LAS unsigned*)CT)[i] = 0u;
    if (tid < 128) NV[tid] = 0.f;
    float m_prev = 0.f;
    wg_sync();
    const size_t colq = (size_t)(which ? C_KM : C_QM) + head * 128 + cg * 8;
    for (int ch = 0; ch < NCH; ++ch) {
        const size_t tok0 = (size_t)b * SEQ + (size_t)ch * 64;
        float wp, a_dec, m_new;
        {
            const float fp = SM[(tok0 + lane) * 16 + 12 + head] + bfg, ip = SM[(tok0 + lane) * 16 + 8 + head] + bi;
            const float lf = fminf(fp, 0.f) - log1pf(__expf(-fabsf(fp)));
            const float bcum = scan_add(lf, lane);
            const float g = ip - bcum, gmax = scan_max(g, lane);
            const float mj = fmaxf(bcum + m_prev, bcum + gmax);
            const float blast = __shfl(bcum, 63), gmx = __shfl(gmax, 63);
            m_new = fmaxf(blast + m_prev, blast + gmx);
            a_dec = __expf(blast + m_prev - m_new);
            wp = __expf(blast + g - m_new);
            GW[lane] = g; GW[64 + lane] = bcum - mj; GW[128 + lane] = __expf(bcum + m_prev - mj); GW[192 + lane] = __expf(-mj);
        }
        {
            float y[4][8];
#pragma unroll
            for (int o = 0; o < 4; ++o)
#pragma unroll
                for (int x = 0; x < 8; ++x) y[o][x] = cwp[32 + x];
#pragma unroll
            for (int i = 0; i < 7; ++i) {
                const int tt = ch * 64 + rb * 4 - 3 + i;
                u32x4 raw = {0u, 0u, 0u, 0u};
                if (tt >= 0) raw = *(const u32x4*)(H + ((size_t)b * SEQ + tt) * LDH + colq);
                float rv[8] = {lo_bf(raw.x), hi_bf(raw.x), lo_bf(raw.y), hi_bf(raw.y), lo_bf(raw.z), hi_bf(raw.z), lo_bf(raw.w), hi_bf(raw.w)};
#pragma unroll
                for (int o = 0; o < 4; ++o) { const int j = i - o; if (j >= 0 && j < 4) {
#pragma unroll
                    for (int x = 0; x < 8; ++x) y[o][x] += cwp[j * 8 + x] * rv[x]; } }
            }
#pragma unroll
            for (int o = 0; o < 4; ++o) {
                const int rr = rb * 4 + o;
                const float wpr = __shfl(wp, rr);
#pragma unroll
                for (int x = 0; x < 8; ++x) { const float v = y[o][x]; y[o][x] = v * sigmoidf_(v) * (which ? 0.08838834764831845f : 1.0f); }
                const bf16x8 pk = pack8(y[o][0], y[o][1], y[o][2], y[o][3], y[o][4], y[o][5], y[o][6], y[o][7]);
                if (which == 0) *(LAS bf16x8*)(QS + rr * QP + cg * 8) = pk;
                else { *(LAS bf16x8*)(KS + rr * QP + cg * 8) = pk;
#pragma unroll
                    for (int x = 0; x < 8; ++x) KT[(cg * 8 + x) * TP + rr] = (bf16_t)f2bf(y[o][x] * wpr); }
            }
#pragma unroll
            for (int p2 = 0; p2 < 2; ++p2) { const int p = tid + 512 * p2, row = p >> 4, cgv = p & 15;
                const u32x4 raw = *(const u32x4*)(H + (tok0 + row) * LDH + C_VM + head * 128 + cgv * 8);
                const unsigned w4[4] = {raw.x, raw.y, raw.z, raw.w};
#pragma unroll
                for (int x = 0; x < 4; ++x) { VTs[(cgv * 8 + 2 * x) * TP + row] = (bf16_t)(w4[x] & 0xffffu); VTs[(cgv * 8 + 2 * x + 1) * TP + row] = (bf16_t)(w4[x] >> 16); } }
        }
        wg_sync();
        float hval[16]; const int jl = 32 * jt + r32;
        {
            const float ejl = GW[64 + jl], wint = GW[128 + jl], flo = GW[192 + jl];
            f32x16 num = {0.f, 0.f, 0.f, 0.f, 0.f, 0.f, 0.f, 0.f, 0.f, 0.f, 0.f, 0.f, 0.f, 0.f, 0.f, 0.f};
            float den = 0.f;
            bf16x8 qf[8];
#pragma unroll
            for (int ks = 0; ks < 8; ++ks) qf[ks] = *(const LAS bf16x8*)(QS + jl * QP + ks * 16 + hi * 8);
#pragma unroll
            for (int a = 0; a < 2; ++a) {
                if (a <= jt) {
                    f32x16 st = {0.f, 0.f, 0.f, 0.f, 0.f, 0.f, 0.f, 0.f, 0.f, 0.f, 0.f, 0.f, 0.f, 0.f, 0.f, 0.f};
#pragma unroll
                    for (int ks = 0; ks < 8; ++ks) st = mfma32(*(const LAS bf16x8*)(KS + (32 * a + r32) * QP + ks * 16 + hi * 8), qf[ks], st);
                    float pv[16];
#pragma unroll
                    for (int g4 = 0; g4 < 4; ++g4) { const int sb = 32 * a + 8 * g4 + 4 * hi; const f32x4 gg = *(const LAS f32x4*)(GW + sb);
#pragma unroll
                        for (int x = 0; x < 4; ++x) { const int s = sb + x; const float v = (s <= jl) ? st[4 * g4 + x] * __expf(gg[x] + ejl) : 0.f; pv[4 * g4 + x] = v; den += v; } }
#pragma unroll
                    for (int s2 = 0; s2 < 2; ++s2) {
                        const bf16x8 pf = pack8(pv[8 * s2], pv[8 * s2 + 1], pv[8 * s2 + 2], pv[8 * s2 + 3], pv[8 * s2 + 4], pv[8 * s2 + 5], pv[8 * s2 + 6], pv[8 * s2 + 7]);
                        const LAS bf16_t* vp = VTs + (32 * vt + r32) * TP + 32 * a + 16 * s2 + 4 * hi;
                        const s16x4 v0 = *(const LAS s16x4*)vp, v1 = *(const LAS s16x4*)(vp + 8);
                        const bf16x8 vf = {v0[0], v0[1], v0[2], v0[3], v1[0], v1[1], v1[2], v1[3]};
                        num = mfma32(vf, pf, num);
                    }
                }
            }
            f32x16 ni = {0.f, 0.f, 0.f, 0.f, 0.f, 0.f, 0.f, 0.f, 0.f, 0.f, 0.f, 0.f, 0.f, 0.f, 0.f, 0.f};
#pragma unroll
            for (int ks = 0; ks < 8; ++ks) ni = mfma32(*(const LAS bf16x8*)(CT + (32 * vt + r32) * QP + ks * 16 + hi * 8), qf[ks], ni);
            float qn = 0.f;
#pragma unroll
            for (int ks = 0; ks < 8; ++ks) { const f32x4 n0 = *(const LAS f32x4*)(NV + 16 * ks + 8 * hi), n1 = *(const LAS f32x4*)(NV + 16 * ks + 8 * hi + 4); const u32x4 qw = __builtin_bit_cast(u32x4, qf[ks]);
                qn += lo_bf(qw.x) * n0[0] + hi_bf(qw.x) * n0[1] + lo_bf(qw.y) * n0[2] + hi_bf(qw.y) * n0[3] + lo_bf(qw.z) * n1[0] + hi_bf(qw.z) * n1[1] + lo_bf(qw.w) * n1[2] + hi_bf(qw.w) * n1[3]; }
            qn += __shfl_xor(qn, 32); den += __shfl_xor(den, 32);
            const float dtot = den + wint * qn; const float inv = 1.0f / fmaxf(fabsf(dtot), flo);
            float ssq = 0.f;
#pragma unroll
            for (int r = 0; r < 16; ++r) { hval[r] = (num[r] + wint * ni[r]) * inv; ssq += hval[r] * hval[r]; }
            ssq += __shfl_xor(ssq, 32);
            if (hi == 0) PART[vt * 64 + jl] = ssq;
        }
        wg_sync();
        {
#pragma unroll
            for (int x = 0; x < 2; ++x) { const int kt = 2 * jt + x;
#pragma unroll
                for (int r = 0; r < 16; ++r) accC[x][r] *= a_dec;
#pragma unroll
                for (int ks = 0; ks < 4; ++ks) accC[x] = mfma32(*(const LAS bf16x8*)(VTs + (32 * vt + r32) * TP + ks * 16 + hi * 8), *(const LAS bf16x8*)(KT + (32 * kt + r32) * TP + ks * 16 + hi * 8), accC[x]);
#pragma unroll
                for (int r = 0; r < 16; ++r) CT[(32 * vt + crow(r, hi)) * QP + 32 * kt + r32] = (bf16_t)f2bf(accC[x][r]); }
            { const int kd = 16 * wid + (lane & 15), sq = lane >> 4; float s = 0.f;
              const u32x4 k0 = *(const LAS u32x4*)(KT + kd * TP + 16 * sq), k1 = *(const LAS u32x4*)(KT + kd * TP + 16 * sq + 8);
              s = (lo_bf(k0.x) + hi_bf(k0.x)) + (lo_bf(k0.y) + hi_bf(k0.y)) + (lo_bf(k0.z) + hi_bf(k0.z)) + (lo_bf(k0.w) + hi_bf(k0.w)) + (lo_bf(k1.x) + hi_bf(k1.x)) + (lo_bf(k1.y) + hi_bf(k1.y)) + (lo_bf(k1.z) + hi_bf(k1.z)) + (lo_bf(k1.w) + hi_bf(k1.w));
              s += __shfl_xor(s, 16); s += __shfl_xor(s, 32);
              const float nn = a_dec * NV[kd] + s; if (sq == 0) NV[kd] = nn; }
            const float stot = (PART[jl] + PART[64 + jl]) + (PART[128 + jl] + PART[192 + jl]);
            const float rstd = 1.0f / sqrtf(stot * (1.0f / 128.0f) + LN_EPS);
            const size_t tok = tok0 + jl;
#pragma unroll
            for (int g4 = 0; g4 < 4; ++g4) { const int v0 = 32 * vt + 8 * g4 + 4 * hi; const f32x4 gq = *(const LAS f32x4*)(GNL + v0); const float gn[16] = {gq[0], gq[1], gq[2], gq[3], gq[0], gq[1], gq[2], gq[3], gq[0], gq[1], gq[2], gq[3], gq[0], gq[1], gq[2], gq[3]};
                const u32x2 sg = *(const u32x2*)(H + tok * LDH + C_OM + head * 128 + v0);
                u32x2 o; o.x = pk2(hval[4 * g4] * rstd * gn[4 * g4] * lo_bf(sg.x), hval[4 * g4 + 1] * rstd * gn[4 * g4 + 1] * hi_bf(sg.x));
                o.y = pk2(hval[4 * g4 + 2] * rstd * gn[4 * g4 + 2] * lo_bf(sg.y), hval[4 * g4 + 3] * rstd * gn[4 * g4 + 3] * hi_bf(sg.y));
                *(u32x2*)(HM + tok * 512 + head * 128 + v0) = o; }
        }
        m_prev = m_new;
        wg_sync();
    }
}

constexpr int KP = 72, VP = 68;
constexpr int A_KS = 0, A_VS = 2 * 64 * KP * 2, A_BT = A_VS + 2 * 64 * VP * 2, AT_LDS = A_BT + 129 * 4 + 12;
DEV int t5_bucket(int d) {
    if (d < 16) return d;
    if (d >= 114) return 31;
    int bk = 16;
    const int th[15] = {19, 21, 24, 27, 31, 35, 40, 46, 52, 59, 67, 77, 87, 99, 113};
#pragma unroll
    for (int i = 0; i < 15; ++i) bk += (d >= th[i]) ? 1 : 0;
    return bk;
}
DEV void attn_unit(const Ctx& c, int b, int h, int qb) {
    const int tid = c.tid, lane = c.lane, wid = c.wid, r32 = lane & 31, hi = lane >> 5;
    LAS unsigned char* lds = c.lds;
    LAS bf16_t* Ks = (LAS bf16_t*)(lds + A_KS); LAS bf16_t* Vs = (LAS bf16_t*)(lds + A_VS); LAS float* BT = (LAS float*)(lds + A_BT);
    bf16_t* Hq = wsp<bf16_t>(c, WS_H); const bf16_t* Kb = wsp<bf16_t>(c, WS_K); const bf16_t* VT = wsp<bf16_t>(c, WS_VT); const unsigned* MASK = wsp<unsigned>(c, WS_MASK);
    const size_t rowb = (size_t)b * SEQ; const int q0 = qb * 256, qw0 = q0 + 32 * wid, q = qw0 + r32;
    const int NT = (q0 + 256) / 64;
    if (tid <= 128) { const float far = c.in[IN_RELB][31 * 8 + h]; BT[tid] = (tid < 128) ? (c.in[IN_RELB][t5_bucket(tid) * 8 + h] - far) * LOG2E : 0.f; }
    bf16x8 qf[4];
#pragma unroll
    for (int ks = 0; ks < 4; ++ks) qf[ks] = *(const bf16x8*)(Hq + (rowb + q) * LDH + C_QA + h * 64 + ks * 16 + hi * 8);
    const int srow = tid >> 3, spc = tid & 7;
    const bf16_t* ksrc = Kb + (rowb + srow) * 512 + h * 64 + spc * 8;
    const bf16_t* vsrc = VT + (size_t)(h * 64 + srow) * M + rowb + spc * 8;
    u32x4 kreg = *(const u32x4*)ksrc, vreg = *(const u32x4*)vsrc;
    *(LAS u32x4*)(Ks + srow * KP + spc * 8) = kreg;
    { LAS u32x2* vd = (LAS u32x2*)(Vs + srow * VP + spc * 8); u32x2 a = {vreg.x, vreg.y}, bb = {vreg.z, vreg.w}; vd[0] = a; vd[1] = bb; }
    float mrun = -1e30f, lsum = 0.f;
    f32x16 o[2];
#pragma unroll
    for (int d = 0; d < 2; ++d)
#pragma unroll
        for (int r = 0; r < 16; ++r) o[d][r] = 0.f;
    wg_sync();
    for (int kt = 0; kt < NT; ++kt) {
        const int buf = kt & 1;
        if (kt + 1 < NT) { kreg = *(const u32x4*)(ksrc + (size_t)(kt + 1) * 64 * 512); vreg = *(const u32x4*)(vsrc + (size_t)(kt + 1) * 64); }
        if (64 * kt <= qw0 + 31) {
            const LAS bf16_t* kb = Ks + buf * 64 * KP; const LAS bf16_t* vb = Vs + buf * 64 * VP;
            const u32x2 mw = *(const u32x2*)(MASK + (rowb + q) * NWORDS + 2 * kt);
            f32x16 s[2];
#pragma unroll
            for (int a = 0; a < 2; ++a) {
#pragma unroll
                for (int r = 0; r < 16; ++r) s[a][r] = 0.f;
#pragma unroll
                for (int ks = 0; ks < 4; ++ks) s[a] = mfma32(*(const LAS bf16x8*)(kb + (32 * a + r32) * KP + ks * 16 + hi * 8), qf[ks], s[a]);
            }
            if (64 * kt + 63 + 128 > qw0) {
#pragma unroll
                for (int a = 0; a < 2; ++a)
#pragma unroll
                    for (int r = 0; r < 16; ++r) { int d = q - (64 * kt + 32 * a + crow(r, hi)); d = d < 0 ? 128 : (d > 128 ? 128 : d); s[a][r] += BT[d]; }
            }
            float mx = s[0][0];
#pragma unroll
            for (int a = 0; a < 2; ++a)
#pragma unroll
                for (int r = 0; r < 16; ++r) mx = fmaxf(mx, s[a][r]);
            mx = fmaxf(mx, __shfl_xor(mx, 32));
            const float mnew = fmaxf(mrun, mx), resc = fast_exp2(mrun - mnew);
            mrun = mnew; lsum *= resc;
#pragma unroll
            for (int d = 0; d < 2; ++d)
#pragma unroll
                for (int r = 0; r < 16; ++r) o[d][r] *= resc;
            float ps = 0.f;
#pragma unroll
            for (int a = 0; a < 2; ++a) {
                const unsigned w = (a ? mw.y : mw.x) >> (4 * hi);
                float p[16];
#pragma unroll
                for (int r = 0; r < 16; ++r) { const float e = fast_exp2(s[a][r] - mnew); p[r] = ((w >> ((r & 3) + 8 * (r >> 2))) & 1u) ? e : 0.f; ps += p[r]; }
#pragma unroll
                for (int s2 = 0; s2 < 2; ++s2) {
                    const bf16x8 pf = pack8(p[8 * s2], p[8 * s2 + 1], p[8 * s2 + 2], p[8 * s2 + 3], p[8 * s2 + 4], p[8 * s2 + 5], p[8 * s2 + 6], p[8 * s2 + 7]);
#pragma unroll
                    for (int d = 0; d < 2; ++d) {
                        const LAS bf16_t* vp = vb + (32 * d + r32) * VP + 32 * a + 16 * s2 + 4 * hi;
                        const s16x4 v0 = *(const LAS s16x4*)vp, v1 = *(const LAS s16x4*)(vp + 8);
                        const bf16x8 vf = {v0[0], v0[1], v0[2], v0[3], v1[0], v1[1], v1[2], v1[3]};
                        o[d] = mfma32(vf, pf, o[d]);
                    }
                }
            }
            lsum += ps;
        }
        if (kt + 1 < NT) {
            const int nb = buf ^ 1;
            *(LAS u32x4*)(Ks + nb * 64 * KP + srow * KP + spc * 8) = kreg;
            LAS u32x2* vd = (LAS u32x2*)(Vs + nb * 64 * VP + srow * VP + spc * 8); u32x2 a = {vreg.x, vreg.y}, bb = {vreg.z, vreg.w}; vd[0] = a; vd[1] = bb;
        }
        wg_sync();
    }
    lsum += __shfl_xor(lsum, 32);
    const float il = 1.0f / lsum;
#pragma unroll
    for (int d = 0; d < 2; ++d)
#pragma unroll
        for (int g4 = 0; g4 < 4; ++g4) { u32x2 w; w.x = pk2(o[d][4 * g4] * il, o[d][4 * g4 + 1] * il); w.y = pk2(o[d][4 * g4 + 2] * il, o[d][4 * g4 + 3] * il);
            *(u32x2*)(Hq + (rowb + q) * LDH + C_QA + h * 64 + 32 * d + 8 * g4 + 4 * hi) = w; }
}

DEV void ln_row(const f32x4 (&v)[4], const float* g, const float* bta, int lane, f32x4 (&y)[4]) {
    float s = 0.f;
#pragma unroll
    for (int j = 0; j < 4; ++j) s += (v[j][0] + v[j][1]) + (v[j][2] + v[j][3]);
    const float mean = wave_sum(s) * (1.0f / DM); float s2 = 0.f;
#pragma unroll
    for (int j = 0; j < 4; ++j) { const f32x4 d = v[j] - mean; s2 += (d[0] * d[0] + d[1] * d[1]) + (d[2] * d[2] + d[3] * d[3]); }
    const float rstd = 1.0f / sqrtf(wave_sum(s2) * (1.0f / DM) + LN_EPS);
#pragma unroll
    for (int j = 0; j < 4; ++j) { const f32x4 gg = *((const f32x4*)g + lane + 64 * j), bb = *((const f32x4*)bta + lane + 64 * j); y[j] = (v[j] - mean) * rstd * gg + bb; }
}
DEV void phase_ln1_router(const Ctx& c) {
    LAS float* RW = (LAS float*)c.lds; LAS int* LC = (LAS int*)(c.lds + 1024 * 20 * 4); LAS int* GB = LC + 16;
    for (int i = c.tid; i < 1024 * 20; i += NTHREADS) { const int k = i / 20, j = i % 20; RW[i] = (j < 4) ? c.in[IN_WGRP][k * 4 + j] : c.in[IN_WRT][k * 16 + (j - 4)]; }
    if (c.tid < 16) LC[c.tid] = 0;
    wg_sync();
    const float* Z = wsp<float>(c, WS_Z); float* X1 = c.out; bf16_t* X1B = wsp<bf16_t>(c, WS_X1B);
    int* TOKE = wsp<int>(c, WS_TOK); int* TOKS = TOKE + 2 * M; float* TOKW = (float*)(TOKS + 2 * M);
    const int rpw = (M + c.G - 1) / c.G, r0 = c.bid * rpw, r1 = (r0 + rpw < M) ? r0 + rpw : M;
    for (int m = r0 + c.wid; m < r1; m += NWAVES) {
        f32x4 v[4], y[4];
#pragma unroll
        for (int j = 0; j < 4; ++j) v[j] = *((const f32x4*)(Z + (size_t)m * DM) + c.lane + 64 * j);
        ln_row(v, c.in[IN_LN1G], c.in[IN_LN1B], c.lane, y);
#pragma unroll
        for (int j = 0; j < 4; ++j) { *((f32x4*)(X1 + (size_t)m * DM) + c.lane + 64 * j) = y[j]; u32x2 w; w.x = pk2(y[j][0], y[j][1]); w.y = pk2(y[j][2], y[j][3]); *((u32x2*)(X1B + (size_t)m * DM) + c.lane + 64 * j) = w; }
        float lg[20];
#pragma unroll
        for (int e = 0; e < 20; ++e) lg[e] = 0.f;
#pragma unroll
        for (int j = 0; j < 4; ++j)
#pragma unroll
            for (int x = 0; x < 4; ++x) { const int k = 4 * c.lane + 256 * j + x; const float xv = y[j][x];
#pragma unroll
                for (int e4 = 0; e4 < 5; ++e4) { const f32x4 w = *(const LAS f32x4*)(RW + k * 20 + 4 * e4); lg[4 * e4] += xv * w[0]; lg[4 * e4 + 1] += xv * w[1]; lg[4 * e4 + 2] += xv * w[2]; lg[4 * e4 + 3] += xv * w[3]; } }
#pragma unroll
        for (int e = 0; e < 20; ++e) lg[e] = wave_sum(lg[e]);
        if (c.lane == 0) {
            float gl[4]; int gi = 0;
#pragma unroll
            for (int j = 0; j < 4; ++j) gl[j] = lg[j] + c.in[IN_BGRP][j];
#pragma unroll
            for (int j = 1; j < 4; ++j) if (gl[j] > gl[gi]) gi = j;
            float se = 0.f;
#pragma unroll
            for (int j = 0; j < 4; ++j) se += __expf(gl[j] - gl[gi]);
            const float gw = 1.0f / se;
            float el[4];
#pragma unroll
            for (int j = 0; j < 4; ++j) { float t = 0.f;
#pragma unroll
                for (int g2 = 0; g2 < 4; ++g2) if (g2 == gi) t = lg[4 + 4 * g2 + j] + c.in[IN_BRT][4 * g2 + j];
                el[j] = t; }
            int i0 = 0;
#pragma unroll
            for (int j = 1; j < 4; ++j) if (el[j] > el[i0]) i0 = j;
            int i1 = (i0 == 0) ? 1 : 0;
#pragma unroll
            for (int j = 0; j < 4; ++j) if (j != i0 && el[j] > el[i1]) i1 = j;
            const float p1 = 1.0f / (1.0f + __expf(el[i1] - el[i0]));
            const int e0 = gi * 4 + i0, e1 = gi * 4 + i1;
            const int s0 = atomicAdd((int*)&LC[e0], 1), s1 = atomicAdd((int*)&LC[e1], 1);
            TOKE[2 * m] = e0; TOKE[2 * m + 1] = e1; TOKS[2 * m] = s0; TOKS[2 * m + 1] = s1; TOKW[2 * m] = p1 * gw; TOKW[2 * m + 1] = (1.0f - p1) * gw;
        }
    }
#ifndef EMU
    __threadfence_block();
#endif
    wg_sync();
    if (c.tid < 16) GB[c.tid] = (int)atomicAdd(wsp<unsigned>(c, WS_CTL) + CW_CNT + c.tid, (unsigned)LC[c.tid]);
    wg_sync();
    for (int i = r0 * 2 + c.tid; i < r1 * 2; i += NTHREADS) TOKS[i] += GB[TOKE[i]];
}
DEV void moe_bases(const Ctx& c, int (&base)[NE], int& total_tiles) {
    const unsigned* cnt = wsp<unsigned>(c, WS_CTL) + CW_CNT; int acc = 0;
#pragma unroll
    for (int e = 0; e < NE; ++e) { base[e] = acc; acc += (((int)cnt[e] + 255) / 256) * 256; }
    total_tiles = acc / 256;
}
DEV void phase_gather(const Ctx& c) {
    int base[NE], nt; moe_bases(c, base, nt);
    const bf16_t* X1B = wsp<bf16_t>(c, WS_X1B); bf16_t* XS = wsp<bf16_t>(c, WS_XS);
    int* TOKE = wsp<int>(c, WS_TOK); int* TOKS = TOKE + 2 * M;
    const int gw = c.bid * NWAVES + c.wid, NGW = c.G * NWAVES;
    for (int m = gw; m < M; m += NGW) {
        const u32x4 v0 = *((const u32x4*)(X1B + (size_t)m * DM) + c.lane), v1 = *((const u32x4*)(X1B + (size_t)m * DM) + 64 + c.lane);
#pragma unroll
        for (int a = 0; a < 2; ++a) { const int e = TOKE[2 * m + a]; int bs = 0;
#pragma unroll
            for (int j = 0; j < NE; ++j) if (j == e) bs = base[j];
            const int pos = bs + TOKS[2 * m + a];
            *((u32x4*)(XS + (size_t)pos * DM) + c.lane) = v0; *((u32x4*)(XS + (size_t)pos * DM) + 64 + c.lane) = v1; }
    }
}
DEV void phase_final(const Ctx& c) {
    int base[NE], nt; moe_bases(c, base, nt);
    const bf16_t* O2 = wsp<bf16_t>(c, WS_O2); float* X1 = c.out;
    const int* TOKE = wsp<int>(c, WS_TOK); const int* TOKS = TOKE + 2 * M; const float* TOKW = (const float*)(TOKS + 2 * M);
    const int gw = c.bid * NWAVES + c.wid, NGW = c.G * NWAVES;
    for (int m = gw; m < M; m += NGW) {
        int pos[2]; float w[2];
#pragma unroll
        for (int a = 0; a < 2; ++a) { const int e = TOKE[2 * m + a]; int bs = 0;
#pragma unroll
            for (int j = 0; j < NE; ++j) if (j == e) bs = base[j];
            pos[a] = bs + TOKS[2 * m + a]; w[a] = TOKW[2 * m + a]; }
        f32x4 v[4], y[4];
#pragma unroll
        for (int j = 0; j < 4; ++j) { const f32x4 xv = *((const f32x4*)(X1 + (size_t)m * DM) + c.lane + 64 * j);
            const u32x2 a0 = *((const u32x2*)(O2 + (size_t)pos[0] * DM) + c.lane + 64 * j), a1 = *((const u32x2*)(O2 + (size_t)pos[1] * DM) + c.lane + 64 * j);
            f32x4 t; t[0] = xv[0] * ALPHA + w[0] * lo_bf(a0.x) + w[1] * lo_bf(a1.x); t[1] = xv[1] * ALPHA + w[0] * hi_bf(a0.x) + w[1] * hi_bf(a1.x);
            t[2] = xv[2] * ALPHA + w[0] * lo_bf(a0.y) + w[1] * lo_bf(a1.y); t[3] = xv[3] * ALPHA + w[0] * hi_bf(a0.y) + w[1] * hi_bf(a1.y); v[j] = t; }
        ln_row(v, c.in[IN_LN2G], c.in[IN_LN2B], c.lane, y);
#pragma unroll
        for (int j = 0; j < 4; ++j) *((f32x4*)(c.out + (size_t)m * DM) + c.lane + 64 * j) = y[j];
    }
}

#ifndef EMU
#define XB_TMO      128
#define XB_XCNT(j)  (256  + 64 * (j))
#define XB_XSUB(j)  (1280 + 64 * (j))
#define XB_XGEN(j)  (2304 + 64 * (j))
#define XB_TOP      3328
#define XB_TOPGEN   3392
#define XCD_BAR_WORDS 3456
#define XB_SPIN_CAP (1u << 22)
__device__ __forceinline__ unsigned xb_ld(unsigned* p)              { return __hip_atomic_load(p, __ATOMIC_RELAXED, __HIP_MEMORY_SCOPE_AGENT); }
__device__ __forceinline__ unsigned xb_add(unsigned* p, unsigned v) { return __hip_atomic_fetch_add(p, v, __ATOMIC_RELAXED, __HIP_MEMORY_SCOPE_AGENT); }
__device__ __forceinline__ unsigned xb_xcc_id() { return (unsigned)__builtin_amdgcn_s_getreg((3 << 11) | 20) & 0xFu; }
#define XB_SPIN(cond, bar) do { unsigned _sp = 0; while (cond) { __builtin_amdgcn_s_sleep(1); \
    if ((++_sp & 255u) == 0u) { if (xb_ld(&(bar)[XB_TMO])) break; if (_sp > XB_SPIN_CAP) { atomicAdd(&(bar)[XB_TMO], 1u); break; } } } } while (0)
struct XcdBarrier { unsigned* bar; unsigned x; volatile LAS unsigned* st; };
__device__ __forceinline__ XcdBarrier xcd_barrier_post(unsigned* bar, volatile LAS unsigned* st) {
    XcdBarrier b; b.bar = bar; b.x = xb_xcc_id(); b.st = st;
    if (threadIdx.x == 0) (void)xb_add(&bar[XB_XCNT(b.x)], 1u);
    return b;
}
__device__ __forceinline__ void xcd_barrier_complete(unsigned* bar, unsigned x, unsigned& nloc, unsigned& nx) {
    const unsigned G = gridDim.x * gridDim.y * gridDim.z;
    unsigned sum, cnt, mine, sp = 0u;
    for (;;) {
        sum = 0u; cnt = 0u; mine = 0u;
#pragma unroll
        for (unsigned j = 0; j < 16; ++j) { const unsigned c = xb_ld(&bar[XB_XCNT(j)]); sum += c; cnt += (c > 0u) ? 1u : 0u; mine = (j == x) ? c : mine; }
        if (sum == G) break;
        __builtin_amdgcn_s_sleep(1);
        if ((++sp & 255u) == 0u) { if (xb_ld(&bar[XB_TMO])) break; if (sp > XB_SPIN_CAP) { atomicAdd(&bar[XB_TMO], 1u); break; } }
    }
    nloc = mine > 0u ? mine : 1u; nx = cnt > 0u ? cnt : 1u;
}
__device__ __forceinline__ void xcd_barrier(const XcdBarrier& b) {
    asm volatile("s_waitcnt vmcnt(0)" ::: "memory");
    __syncthreads();
    if (threadIdx.x == 0) {
        unsigned* bar = b.bar;
        __builtin_amdgcn_s_waitcnt(0);
        unsigned nloc = b.st[0], nx = b.st[1];
        if (nloc == 0u) { xcd_barrier_complete(bar, b.x, nloc, nx); b.st[0] = nloc; b.st[1] = nx; }
        const unsigned old = xb_add(&bar[XB_XSUB(b.x)], 1u);
        const unsigned gen = old / nloc;
        if (old + 1u == (gen + 1u) * nloc) {
            __builtin_amdgcn_fence(__ATOMIC_RELEASE, "agent");
            asm volatile("s_waitcnt vmcnt(0)" ::: "memory");
            const unsigned og = xb_add(&bar[XB_TOP], 1u);
            const unsigned tg = og / nx;
            if (og + 1u == (tg + 1u) * nx) xb_add(&bar[XB_TOPGEN], 1u);
            else XB_SPIN(xb_ld(&bar[XB_TOPGEN]) == tg, bar);
            __builtin_amdgcn_fence(__ATOMIC_ACQUIRE, "agent");
            xb_add(&bar[XB_XGEN(b.x)], 1u);
            asm volatile("s_waitcnt vmcnt(0)" ::: "memory");
        } else {
            XB_SPIN(xb_ld(&bar[XB_XGEN(b.x)]) == gen, bar);
            __builtin_amdgcn_fence(__ATOMIC_ACQUIRE, "agent");
            asm volatile("s_waitcnt vmcnt(0)" ::: "memory");
        }
    }
    __syncthreads();
}
#endif

constexpr int NPHASE = 11;
constexpr int LDS_BYTES = 144 * 1024;
static_assert(pg8::STAGE_BYTES <= LDS_BYTES - 1024 && IDX_LDS <= LDS_BYTES - 1024 && ML_LDS <= LDS_BYTES - 1024 && AT_LDS <= LDS_BYTES - 1024 && 8 * 16384 <= LDS_BYTES - 1024, "LDS budget");
constexpr int MISC_OFF = LDS_BYTES - 64;

DEV void run_phase(const Ctx& c, int ph) {
    using namespace pg8;
#ifdef EMU
    unsigned char* glds = c.lds;
#else
    PG8_LAS unsigned char* glds = c.lds;
#endif
    if (ph == 0) { phase_prologue(c); return; }
    if (ph == 1) {
        SchedStatic S; S.init(wsp<bf16_t>(c, R0), DM, wsp<bf16_t>(c, WS_WIN), DM, M, NWIN, DM, c.G, c.bid);
        EpiInProj E{wsp<bf16_t>(c, WS_H), wsp<bf16_t>(c, WS_KIDX), wsp<float>(c, WS_SM), wsp<float>(c, WS_SSQ)};
        gemm_phase(glds, S, E); return;
    }
    if (ph == 2) {
        const int nml = (c.G >= 4) ? c.G / 4 : 0;
        if (c.bid < nml) {
#ifndef P2_NO_ML
            for (int u = c.bid; u < NB * NHM; u += nml) mlstm_unit(c, u / NHM, u % NHM);
#endif
        } else {
            const int g2 = c.G - nml, c2 = c.bid - nml;
            { SchedStatic S; S.init(wsp<bf16_t>(c, WS_H) + C_CKV, LDH, wsp<bf16_t>(c, WS_WK), KVR, M, 512, KVR, g2, c2); EpiK E{wsp<bf16_t>(c, WS_K), wsp<float>(c, WS_SSQ)}; gemm_phase(glds, S, E); }
            { SchedStatic S; S.init(wsp<bf16_t>(c, WS_WV), KVR, wsp<bf16_t>(c, WS_H) + C_CKV, LDH, 512, M, KVR, g2, c2); EpiVT E{wsp<bf16_t>(c, WS_VT), wsp<float>(c, WS_SSQ)}; gemm_phase(glds, S, E); }
            wg_sync();
            const int nq = SEQ / 16, nunits = NB * nq;
#ifndef P2_NO_IDX
            for (int u = c2; u < nunits; u += g2) { const int qt = nq - 1 - u / NB, b = u % NB; idx_unit(c, b, qt); }
#endif
        }
        return;
    }
    if (ph == 3) {
        const int nqb = SEQ / 256, nun = NB * HA * nqb;
        for (int u = c.bid; u < nun; u += c.G) {
            const int bh = u / nqb; int qi = u % nqb; const int round = (u / c.G) & 1; if (round) qi = nqb - 1 - qi;
            attn_unit(c, bh / HA, bh % HA, qi);
            wg_sync();
        }
        return;
    }
    if (ph == 4) {
        { SchedStatic S; S.init(wsp<bf16_t>(c, WS_H) + C_QA, LDH, wsp<bf16_t>(c, WS_WA), WA, M, DM, WA, c.G, c.bid); EpiUpA E{(bf16_t*)((unsigned char*)c.out + (size_t)M * 1024), wsp<bf16_t>(c, WS_H)}; gemm_phase(glds, S, E); }
        { SchedStatic S; S.init((const bf16_t*)c.out, WM, wsp<bf16_t>(c, WS_WM), WM, M, DM, WM, c.G, c.bid); EpiUpM E{wsp<bf16_t>(c, WS_Y), (const bf16_t*)((unsigned char*)c.out + (size_t)M * 1024), wsp<bf16_t>(c, WS_H)}; gemm_phase(glds, S, E); }
        return;
    }
    if (ph == 5) {
        SchedStatic S; S.init(wsp<bf16_t>(c, WS_Y), DM, wsp<bf16_t>(c, WS_WO), DM, M, DM, DM, c.G, c.bid); EpiOut E{wsp<float>(c, WS_Z), c.in[IN_X]}; gemm_phase(glds, S, E); return;
    }
    if (ph == 6) { phase_ln1_router(c); return; }
    if (ph == 7) { phase_gather(c); return; }
    if (ph == 8 || ph == 9) {
        int base[NE], nt; moe_bases(c, base, nt);
        SchedMoe S; S.ntiles = nt; S.nN = 4; S.G = c.G; S.c = c.bid;
#pragma unroll
        for (int e = 0; e < NE; ++e) S.tend[e] = ((e + 1 < NE) ? base[e + 1] : nt * 256) / 256;
        if (ph == 8) { S.K = DM; S.lda = DM; S.ldb = DM; S.A = wsp<bf16_t>(c, WS_XS); S.Bt = wsp<bf16_t>(c, WS_WGU); S.estride = (size_t)1024 * 1024; EpiMoe1 E{wsp<bf16_t>(c, WS_HD)}; gemm_phase(glds, S, E); }
        else { S.K = DE; S.lda = DE; S.ldb = DE; S.A = wsp<bf16_t>(c, WS_HD); S.Bt = wsp<bf16_t>(c, WS_WD); S.estride = (size_t)1024 * 512; EpiMoe2 E{wsp<bf16_t>(c, WS_O2)}; gemm_phase(glds, S, E); }
        return;
    }
    if (ph == 10) { phase_final(c); return; }
}

#ifndef EMU
__global__ void __launch_bounds__(NTHREADS, 2) fwd_kernel(Args args) {
    extern __shared__ __attribute__((aligned(16))) unsigned char lds_raw[];
    Ctx c;
#pragma unroll
    for (int i = 0; i < 25; ++i) c.in[i] = args.in[i];
    c.out = args.out; c.ws = args.ws; c.tid = threadIdx.x; c.lane = c.tid & 63; c.wid = __builtin_amdgcn_readfirstlane(c.tid >> 6); c.G = gridDim.x; c.bid = blockIdx.x;
    c.lds = (LAS unsigned char*)lds_raw;
    volatile LAS unsigned* MISC = (volatile LAS unsigned*)(c.lds + MISC_OFF);
    if (c.tid < 16) MISC[c.tid] = 0u;
    __syncthreads();
    const bool multi = (args.ph_hi - args.ph_lo) > 1;
    XcdBarrier bar; bar.bar = (unsigned*)(args.ws + WS_CTL) + CW_BAR; bar.x = 0; bar.st = nullptr;
    if (multi) bar = xcd_barrier_post((unsigned*)(args.ws + WS_CTL) + CW_BAR, MISC + 8);
#ifndef ONLY_PHASE
#define ONLY_PHASE -1
#endif
#define PHASE(k) if ((ONLY_PHASE < 0 || ONLY_PHASE == (k)) && args.ph_lo <= (k) && (k) < args.ph_hi) { run_phase(c, (k)); if ((k) + 1 < args.ph_hi) xcd_barrier(bar); }
    PHASE(0) PHASE(1) PHASE(2) PHASE(3) PHASE(4) PHASE(5) PHASE(6) PHASE(7) PHASE(8) PHASE(9) PHASE(10)
#undef PHASE
}

#ifndef N_LAUNCH_MODE
#define N_LAUNCH_MODE 1
#endif
extern "C" void kernel_launch(void* const* d_in, const int* in_sizes, int n_in, void* d_out, int out_size, void* d_ws, size_t ws_size, hipStream_t stream) {
    static int grid = 0;
    if (grid == 0) {
        if (n_in != 25 || out_size != M * DM || ws_size < WS_END) { fprintf(stderr, "kernel_launch: unexpected shapes (n_in %d out %d ws %zu need %zu)\n", n_in, out_size, ws_size, (size_t)WS_END); grid = -1; return; }
        int dev = 0, cus = 0, per_cu = 0;
        if (hipGetDevice(&dev) != hipSuccess || hipDeviceGetAttribute(&cus, hipDeviceAttributeMultiprocessorCount, dev) != hipSuccess) { grid = -1; return; }
        if (hipFuncSetAttribute((const void*)fwd_kernel, hipFuncAttributeMaxDynamicSharedMemorySize, LDS_BYTES) != hipSuccess) { fprintf(stderr, "kernel_launch: hipFuncSetAttribute failed\n"); grid = -1; return; }
        if (hipOccupancyMaxActiveBlocksPerMultiprocessor(&per_cu, (const void*)fwd_kernel, NTHREADS, LDS_BYTES) != hipSuccess || per_cu < 1) fprintf(stderr, "kernel_launch: occupancy query reports %d\n", per_cu);
        (void)hipGetLastError();
        grid = cus;
    }
    if (grid < 0) return;
    (void)hipMemsetAsync((char*)d_ws + WS_CTL, 0, CTL_ZERO_BYTES, stream);
    Args a{};
    for (int i = 0; i < 25; ++i) a.in[i] = (const float*)d_in[i];
    a.out = (float*)d_out; a.ws = (unsigned char*)d_ws;
    if (N_LAUNCH_MODE == 0) { a.ph_lo = 0; a.ph_hi = NPHASE; hipLaunchKernelGGL(fwd_kernel, dim3(grid), dim3(NTHREADS), LDS_BYTES, stream, a); }
    else { for (int p = 0; p < NPHASE; ++p) { a.ph_lo = p; a.ph_hi = p + 1; hipLaunchKernelGGL(fwd_kernel, dim3(grid), dim3(NTHREADS), LDS_BYTES, stream, a); } }
    (void)in_sizes;
}
#endif
```

```cpp
#ifdef EMU
#include "emu/emu.h"
#define DEV static inline
#define DEVM inline
#define WAVE_SYNC() e_wbar()
#define LAS
#else
#include <hip/hip_runtime.h>
#include <cstdio>
#include <cstdint>
#define DEV __device__ __forceinline__
#define DEVM __device__ __forceinline__
#define WAVE_SYNC() asm volatile("s_waitcnt lgkmcnt(0)" ::: "memory")
#define LAS __attribute__((address_space(3)))
typedef short bf16x8 __attribute__((ext_vector_type(8)));
typedef float f32x16 __attribute__((ext_vector_type(16)));
typedef float f32x4 __attribute__((ext_vector_type(4)));
#endif
typedef unsigned u32x4 __attribute__((ext_vector_type(4)));
typedef unsigned u32x2 __attribute__((ext_vector_type(2)));
typedef short s16x4 __attribute__((ext_vector_type(4)));
typedef unsigned short bf16_t;
typedef unsigned long long u64;

#ifndef CFG_B
#define CFG_B 16
#endif
#ifndef CFG_S
#define CFG_S 2048
#endif
constexpr int NB = CFG_B, SEQ = CFG_S, DM = 1024, M = NB * SEQ;
constexpr int HA = 8, DA = 64, WA = 512, KVR = 256, TOPK = (SEQ / 4 < 256) ? SEQ / 4 : 256;
constexpr int NHM = 4, DHM = 128, WM = 512, CHUNK = 64, NCH = SEQ / CHUNK;
constexpr int NE = 16, DE = 512, MPAD = 2 * M + 4096;
constexpr float LN_EPS = 1e-5f, ALPHA = 1.189207115002721f;
constexpr float QSCALE = 0.125f * 1.4426950408889634f;
constexpr float LOG2E = 1.4426950408889634f;
constexpr int NWIN = 5632, LDH = 5376;
constexpr int C_QA = 0, C_CKV = 512, C_QI = 768, C_QM = 1280, C_KM = 1792, C_VM = 2304, C_OM = 2816, C_GA = 3328, C_GM = 4352;
constexpr int NWORDS = SEQ / 32;
constexpr int NWAVES = 8, NTHREADS = 512;

constexpr size_t MiB = 1u << 20;
constexpr size_t WS_CTL = 0, CTL_ZERO_BYTES = 64 * 1024;
constexpr size_t WS_WIN = 1 * MiB, WS_WK = 12 * MiB, WS_WV = 12 * MiB + 512 * 1024, WS_WA = 13 * MiB, WS_WM = 14 * MiB, WS_WO = 15 * MiB;
constexpr size_t WS_WGU = 17 * MiB, WS_WD = 49 * MiB, WS_TOK = 65 * MiB;
constexpr size_t R0 = 66 * MiB;
constexpr size_t R1 = R0 + (size_t)M * 2048;
constexpr size_t R2 = R1 + (size_t)M * LDH * 2;
constexpr size_t WS_KIDX = R2, WS_SM = WS_KIDX + (size_t)M * 128, WS_SSQ = WS_SM + (size_t)M * 64, WS_MASK = WS_SSQ + (size_t)M * 16, WS_END = WS_MASK + (size_t)M * NWORDS * 4;
constexpr size_t WS_K = R0, WS_VT = R0 + (size_t)M * 1024, WS_Y = R0;
#ifdef EMU
constexpr size_t WS_H = R1, WS_Z = R1, WS_X1B = R1 + (size_t)M * 4096, WS_XS = WS_END, WS_HD = WS_XS + (size_t)MPAD * 2048, WS_O2 = WS_HD + (size_t)MPAD * 1024, WS_TOTAL = WS_O2 + (size_t)MPAD * 2048;
#else
constexpr size_t WS_H = R1, WS_Z = R1, WS_X1B = R1 + (size_t)M * 4096, WS_XS = R1 + (size_t)M * 6144;
constexpr size_t WS_HD = R1, WS_O2 = R1 + (size_t)MPAD * 1024, WS_TOTAL = WS_END;
static_assert(WS_XS + (size_t)MPAD * 2048 <= R2, "XS fits in the H region");
static_assert(WS_O2 + (size_t)MPAD * 2048 <= R2, "O2 fits in the H region");
static_assert(WS_END <= 512 * MiB, "workspace budget");
#endif
constexpr int CW_CNT = 4096;
constexpr int CW_BAR = 8192;

struct Args { const float* in[25]; float* out; unsigned char* ws; int ph_lo, ph_hi; };

DEV unsigned fbits(float f) { unsigned u; __builtin_memcpy(&u, &f, 4); return u; }
DEV float bitsf(unsigned u) { float f; __builtin_memcpy(&f, &u, 4); return f; }
DEV unsigned f2bf(float f) { unsigned u = fbits(f); return (u + 0x7fffu + ((u >> 16) & 1u)) >> 16; }
DEV float bf2f(unsigned b) { return bitsf(b << 16); }
DEV unsigned pk2(float lo, float hi) {
#ifdef EMU
    return f2bf(lo) | (f2bf(hi) << 16);
#else
    typedef float f32x2_t __attribute__((ext_vector_type(2))); typedef __bf16 bf16x2_t __attribute__((ext_vector_type(2)));
    f32x2_t v = {lo, hi}; bf16x2_t b = __builtin_convertvector(v, bf16x2_t); return __builtin_bit_cast(unsigned, b);
#endif
}
DEV float lo_bf(unsigned w) { return bitsf(w << 16); }
DEV float hi_bf(unsigned w) { return bitsf(w & 0xffff0000u); }
DEV f32x16 mfma32(bf16x8 a, bf16x8 b, f32x16 c) {
#ifdef EMU
    return emu_mfma_32x32x16_bf16(a, b, c);
#else
    return __builtin_amdgcn_mfma_f32_32x32x16_bf16(a, b, c, 0, 0, 0);
#endif
}
DEV float fast_rcp(float x) {
#ifdef EMU
    return 1.0f / x;
#else
    return __builtin_amdgcn_rcpf(x);
#endif
}
DEV float fast_exp2(float x) {
#ifdef EMU
    return exp2f(x);
#else
    return __builtin_amdgcn_exp2f(x);
#endif
}
DEV float sigmoidf_(float x) { return fast_rcp(1.0f + __expf(-x)); }
DEV int crow(int r, int hi) { return (r & 3) + 8 * (r >> 2) + 4 * hi; }
DEV bf16x8 pack8(float a0, float a1, float a2, float a3, float a4, float a5, float a6, float a7) {
    u32x4 w; w.x = pk2(a0, a1); w.y = pk2(a2, a3); w.z = pk2(a4, a5); w.w = pk2(a6, a7); return __builtin_bit_cast(bf16x8, w);
}
DEV float wave_sum(float v) {
#pragma unroll
    for (int o = 1; o < 64; o <<= 1) v += __shfl_xor(v, o);
    return v;
}

namespace pg8 {
constexpr int BM = 256, BK = 64, HALF = 128, HTB = HALF * BK * 2, STAGE_BYTES = 8 * HTB, NXCD = 8, WGM = 8;
DEV int lds_byte(int r, int c) { const int st = (r >> 4) * 2 + (c >> 5), rr = r & 15, cc = c & 31, ob = rr * 64 + cc * 2; return st * 1024 + (ob ^ (((ob >> 9) & 1) << 5)); }
DEV void stage_rc(int b, int& R, int& C) { const int st = b / 1024, sb = b % 1024, swz = sb ^ (((sb >> 9) & 1) << 5); R = (st >> 1) * 16 + swz / 64; C = (st & 1) * 32 + (swz % 64) / 2; }
DEV int perm32(int rho) { const int n = rho >> 4, i = rho & 15; return 8 * (i >> 2) + 4 * n + (i & 3); }

struct Unit { int pm, pn, e; };
struct SchedStatic {
    int nM, nN, nwg, G, c, K, lda, ldb; const bf16_t* A; const bf16_t* Bt;
    DEVM void init(const bf16_t* A_, int lda_, const bf16_t* Bt_, int ldb_, int M_, int N_, int K_, int G_, int c_) { A = A_; lda = lda_; Bt = Bt_; ldb = ldb_; nM = M_ / BM; nN = N_ / BM; nwg = nM * nN; K = K_; G = G_; c = c_; }
    DEVM bool next(int i, Unit& u) const {
        const long L = (long)i * G + c; if (L >= nwg) return false;
        int wgid = (int)L; { const int q = nwg / NXCD, r = nwg % NXCD, xcd = wgid % NXCD, off = wgid / NXCD; wgid = (xcd < r ? xcd * (q + 1) : r * (q + 1) + (xcd - r) * q) + off; }
        const int nig = WGM * nN, gid = wgid / nig, fm = gid * WGM, gsz = (nM - fm) < WGM ? (nM - fm) : WGM;
        u.pm = fm + ((wgid % nig) % gsz); u.pn = (wgid % nig) / gsz; u.e = 0; return true;
    }
    DEVM const char* baseA(const Unit& u) const { return (const char*)(A + (size_t)u.pm * BM * lda); }
    DEVM const char* baseB(const Unit& u) const { return (const char*)(Bt + (size_t)u.pn * BM * ldb); }
};
struct SchedMoe {
    int ntiles, nN, G, c, K, lda, ldb; const bf16_t* A; const bf16_t* Bt; size_t estride; int tend[NE];
    DEVM bool next(int i, Unit& u) const {
        const long L = (long)i * G + c; if (L >= (long)ntiles * nN) return false;
        u.pm = (int)(L / nN); u.pn = (int)(L % nN); int e = 0;
#pragma unroll
        for (int j = 0; j < NE - 1; ++j) e += (u.pm >= tend[j]) ? 1 : 0;
        u.e = e; return true;
    }
    DEVM const char* baseA(const Unit& u) const { return (const char*)(A + (size_t)u.pm * BM * lda); }
    DEVM const char* baseB(const Unit& u) const { return (const char*)(Bt + (size_t)u.e * estride + (size_t)u.pn * BM * ldb); }
};

#ifdef EMU
template <class Epi, class Sched>
static inline void gemm_phase(unsigned char* lds, const Sched& S, const Epi& E) {
    const int tid = threadIdx.x, wid = tid >> 6, lane = tid & 63, wr = wid >> 2, wc = wid & 3, fr = lane & 15, fq = lane >> 4;
    Unit u;
    for (int i = 0; S.next(i, u); ++i) {
        f32x4 acc[2][2][4][2];
        const bf16_t* A = (const bf16_t*)S.baseA(u); const bf16_t* B = (const bf16_t*)S.baseB(u);
        for (int ai = 0; ai < 2; ++ai) for (int bj = 0; bj < 2; ++bj) for (int m = 0; m < 4; ++m) for (int n = 0; n < 2; ++n) for (int x = 0; x < 4; ++x) {
            const int r = 128 * ai + 64 * wr + 16 * m + fr, c = 128 * bj + 32 * wc + 8 * fq + 4 * n + x; float s = 0.f;
            for (int k = 0; k < S.K; ++k) s += bf2f(A[(size_t)r * S.lda + k]) * bf2f(B[(size_t)c * S.ldb + k]);
            acc[ai][bj][m][n][x] = s; }
        E(acc, u, wr, wc, fr, fq);
    }
    (void)lds;
}
#else
#define PG8_LAS __attribute__((address_space(3)))
template <class Epi, class Sched>
__device__ __forceinline__ void gemm_phase(PG8_LAS unsigned char* lds, const Sched& S, const Epi& E) {
    const int tid = threadIdx.x, wid = __builtin_amdgcn_readfirstlane(tid >> 6), lane = tid & 63, wr = wid >> 2, wc = wid & 3, fr = lane & 15, fq = lane >> 4;
    const int K = S.K, nt = K / BK;
    unsigned voffA[2], voffB[2];
#pragma unroll
    for (int i = 0; i < 2; ++i) { int R, C; stage_rc(tid * 16 + i * 8192, R, C); const int Rb = (R & ~31) + perm32(R & 31);
        voffA[i] = (unsigned)(R * S.lda + C) * 2u; voffB[i] = (unsigned)(Rb * S.ldb + C) * 2u; }
    const size_t kstep = (size_t)(BK * 2);
    const size_t hstepA = (size_t)HALF * S.lda * 2, hstepB = (size_t)HALF * S.ldb * 2;
    const unsigned ldsw = (unsigned)wid * 1024u;
    const int aoff = lds_byte(wr * 64 + fr, fq * 8), boff = lds_byte(wc * 32 + fr, fq * 8);
#define PG8_SA(b, h) (((b) * 2 + (h)) * HTB)
#define PG8_SB(b, h) ((4 + (b) * 2 + (h)) * HTB)
#define PG8_STAGE(bufoff, gbase, voff) do { _Pragma("unroll") for (int _i = 0; _i < 2; ++_i) \
        __builtin_amdgcn_global_load_lds((const unsigned*)((const char*)(gbase) + (voff)[_i]), (PG8_LAS unsigned*)(lds + (bufoff) + ldsw + _i * 8192), 16, 0, 0); } while (0)
#define PG8_LDA(dst, b, h) do { _Pragma("unroll") for (int m = 0; m < 4; ++m) _Pragma("unroll") for (int k = 0; k < 2; ++k) dst[m][k] = *(const PG8_LAS bf16x8*)(lds + PG8_SA(b, h) + aoff + m * 2048 + k * 1024); } while (0)
#define PG8_LDB(dst, b, h) do { _Pragma("unroll") for (int n = 0; n < 2; ++n) _Pragma("unroll") for (int k = 0; k < 2; ++k) dst[n][k] = *(const PG8_LAS bf16x8*)(lds + PG8_SB(b, h) + boff + n * 2048 + k * 1024); } while (0)
#define PG8_MMA(ai, bj, At, Bt) do { __builtin_amdgcn_s_setprio(1); _Pragma("unroll") for (int m = 0; m < 4; ++m) _Pragma("unroll") for (int n = 0; n < 2; ++n) _Pragma("unroll") for (int k = 0; k < 2; ++k) \
        acc[ai][bj][m][n] = __builtin_amdgcn_mfma_f32_16x16x32_bf16(Bt[n][k], At[m][k], acc[ai][bj][m][n], 0, 0, 0); __builtin_amdgcn_s_setprio(0); } while (0)
#define PG8_WAIT_V(n) asm volatile("s_waitcnt vmcnt(" #n ")" ::: "memory")
#define PG8_WAIT_L(n) asm volatile("s_waitcnt lgkmcnt(" #n ")" ::: "memory")
#define PG8_BAR __builtin_amdgcn_s_barrier()
#define PG8_SCHED __builtin_amdgcn_sched_barrier(0)
    Unit cur, nxt; int ui = 0;
    if (!S.next(0, cur)) return;
    f32x4 acc[2][2][4][2];
#pragma unroll
    for (int a = 0; a < 2; ++a)
#pragma unroll
        for (int b = 0; b < 2; ++b)
#pragma unroll
            for (int m = 0; m < 4; ++m)
#pragma unroll
                for (int n = 0; n < 2; ++n) acc[a][b][m][n] = (f32x4){0.f, 0.f, 0.f, 0.f};
    bf16x8 At[4][2], B0[2][2], B1[2][2];
    const char* cA = S.baseA(cur); const char* cB = S.baseB(cur);
    PG8_STAGE(PG8_SB(0, 0), cB, voffB); PG8_STAGE(PG8_SB(0, 1), cB + hstepB, voffB); PG8_STAGE(PG8_SA(0, 0), cA, voffA); PG8_STAGE(PG8_SA(0, 1), cA + hstepA, voffA);
    if (wr == 1) PG8_BAR;
    PG8_WAIT_V(2); PG8_BAR;
    PG8_STAGE(PG8_SB(1, 0), cB + kstep, voffB); PG8_STAGE(PG8_SA(1, 0), cA + kstep, voffA); PG8_STAGE(PG8_SB(1, 1), cB + hstepB + kstep, voffB);
    PG8_WAIT_V(6); PG8_BAR;
    for (;;) {
        const bool has_next = S.next(ui + 1, nxt);
        const char* nA = has_next ? S.baseA(nxt) : cA; const char* nB = has_next ? S.baseB(nxt) : cB;
        for (int t = 0; t < nt; t += 2) {
            const bool last = (t == nt - 2);
            const char* a1 = cA + (size_t)(t + 1) * kstep;
            const char* a2 = last ? nA : cA + (size_t)(t + 2) * kstep; const char* b2 = last ? nB : cB + (size_t)(t + 2) * kstep;
            const char* a3 = a2 + kstep; const char* b3 = b2 + kstep;
            PG8_LDB(B0, 0, 0); PG8_LDB(B1, 0, 1); PG8_SCHED; PG8_LDA(At, 0, 0); PG8_STAGE(PG8_SA(1, 1), a1 + hstepA, voffA);
            PG8_WAIT_V(8); PG8_WAIT_L(0); PG8_BAR; PG8_MMA(0, 0, At, B0); PG8_MMA(0, 1, At, B1); PG8_BAR; PG8_SCHED;
            PG8_LDA(At, 0, 1); PG8_STAGE(PG8_SB(0, 0), b2, voffB); PG8_STAGE(PG8_SB(0, 1), b2 + hstepB, voffB); PG8_STAGE(PG8_SA(0, 0), a2, voffA);
            PG8_WAIT_V(8); PG8_WAIT_L(0); PG8_BAR; PG8_MMA(1, 0, At, B0); PG8_MMA(1, 1, At, B1); PG8_BAR; PG8_SCHED;
            PG8_LDB(B0, 1, 0); PG8_LDB(B1, 1, 1); PG8_SCHED; PG8_LDA(At, 1, 0); PG8_STAGE(PG8_SA(0, 1), a2 + hstepA, voffA);
            PG8_WAIT_V(8); PG8_WAIT_L(0); PG8_BAR; PG8_MMA(0, 0, At, B0); PG8_MMA(0, 1, At, B1); PG8_BAR; PG8_SCHED;
            PG8_LDA(At, 1, 1); PG8_STAGE(PG8_SB(1, 0), b3, voffB); PG8_STAGE(PG8_SB(1, 1), b3 + hstepB, voffB); PG8_STAGE(PG8_SA(1, 0), a3, voffA);
            PG8_WAIT_V(8); PG8_WAIT_L(0); PG8_BAR; PG8_MMA(1, 0, At, B0); PG8_MMA(1, 1, At, B1); PG8_BAR; PG8_SCHED;
        }
        if (wr == 0) PG8_BAR;
        E(acc, cur, wr, wc, fr, fq);
        if (!has_next) break;
#pragma unroll
        for (int a = 0; a < 2; ++a)
#pragma unroll
            for (int b = 0; b < 2; ++b)
#pragma unroll
                for (int m = 0; m < 4; ++m)
#pragma unroll
                    for (int n = 0; n < 2; ++n) acc[a][b][m][n] = (f32x4){0.f, 0.f, 0.f, 0.f};
        cur = nxt; cA = nA; cB = nB; ++ui;
        if (wr == 1) PG8_BAR;
    }
    PG8_WAIT_V(0);
    PG8_BAR;
#undef PG8_SA
#undef PG8_SB
#undef PG8_STAGE
#undef PG8_LDA
#undef PG8_LDB
#undef PG8_MMA
#undef PG8_WAIT_V
#undef PG8_WAIT_L
#undef PG8_BAR
#undef PG8_SCHED
}
#endif
}
using pg8::Unit;

#define EPI_ARGS const f32x4 (&acc)[2][2][4][2], const Unit& u, int wr, int wc, int fr, int fq
DEV u32x4 pack_row8(const f32x4& v0, const f32x4& v1) { u32x4 w; w.x = pk2(v0[0], v0[1]); w.y = pk2(v0[2], v0[3]); w.z = pk2(v1[0], v1[1]); w.w = pk2(v1[2], v1[3]); return w; }

struct EpiInProj {
    bf16_t* H; bf16_t* KIDX; float* SM; float* SSQ;
    DEVM void operator()(EPI_ARGS) const {
        const int row0 = u.pm * 256 + wr * 64 + fr;
        if (u.pn < 21) {
            const int col0 = u.pn * 256 + wc * 32 + 8 * fq; const bool sig = u.pn >= 11;
            if (u.pn == 2) {
#pragma unroll
                for (int ai = 0; ai < 2; ++ai)
#pragma unroll
                    for (int m = 0; m < 4; ++m) { float s = 0.f;
#pragma unroll
                        for (int bj = 0; bj < 2; ++bj)
#pragma unroll
                            for (int n = 0; n < 2; ++n) { const f32x4 x = acc[ai][bj][m][n]; s += (x[0] * x[0] + x[1] * x[1]) + (x[2] * x[2] + x[3] * x[3]); }
                        s += __shfl_xor(s, 16); s += __shfl_xor(s, 32);
                        if (fq == 0) SSQ[(size_t)(row0 + ai * 128 + m * 16) * 4 + wc] = s; }
            }
#pragma unroll
            for (int ai = 0; ai < 2; ++ai)
#pragma unroll
                for (int m = 0; m < 4; ++m) { bf16_t* rowp = H + (size_t)(row0 + ai * 128 + m * 16) * LDH + col0;
#pragma unroll
                    for (int bj = 0; bj < 2; ++bj) { f32x4 v0 = acc[ai][bj][m][0], v1 = acc[ai][bj][m][1];
                        if (sig) {
#pragma unroll
                            for (int x = 0; x < 4; ++x) { v0[x] = sigmoidf_(v0[x]); v1[x] = sigmoidf_(v1[x]); } }
                        *(u32x4*)(rowp + bj * 128) = pack_row8(v0, v1); } }
        } else {
#pragma unroll
            for (int ai = 0; ai < 2; ++ai)
#pragma unroll
                for (int m = 0; m < 4; ++m) { const size_t row = (size_t)(row0 + ai * 128 + m * 16);
                    if (wc < 2) *(u32x4*)(KIDX + row * 64 + wc * 32 + 8 * fq) = pack_row8(acc[ai][0][m][0], acc[ai][0][m][1]);
                    else if (wc == 2 && fq < 2) { *(f32x4*)(SM + row * 16 + 8 * fq) = acc[ai][0][m][0]; *(f32x4*)(SM + row * 16 + 8 * fq + 4) = acc[ai][0][m][1]; } }
        }
    }
};
DEV float rms_scale(const float* SSQ, size_t row) { const f32x4 q = *(const f32x4*)(SSQ + row * 4); return 1.0f / sqrtf(((q[0] + q[1]) + (q[2] + q[3])) * (1.0f / 256.0f) + LN_EPS); }
struct EpiK {
    bf16_t* Kb; const float* SSQ;
    DEVM void operator()(EPI_ARGS) const {
        const int row0 = u.pm * 256 + wr * 64 + fr, col0 = u.pn * 256 + wc * 32 + 8 * fq;
#pragma unroll
        for (int ai = 0; ai < 2; ++ai)
#pragma unroll
            for (int m = 0; m < 4; ++m) { const size_t row = (size_t)(row0 + ai * 128 + m * 16); const float s = rms_scale(SSQ, row);
#pragma unroll
                for (int bj = 0; bj < 2; ++bj) *(u32x4*)(Kb + row * 512 + col0 + bj * 128) = pack_row8(acc[ai][bj][m][0] * s, acc[ai][bj][m][1] * s); }
    }
};
struct EpiVT {
    bf16_t* VT; const float* SSQ;
    DEVM void operator()(EPI_ARGS) const {
        const int row0 = u.pm * 256 + wr * 64 + fr, col0 = u.pn * 256 + wc * 32 + 8 * fq;
        float sc[2][8];
#pragma unroll
        for (int bj = 0; bj < 2; ++bj)
#pragma unroll
            for (int x = 0; x < 8; ++x) sc[bj][x] = rms_scale(SSQ, (size_t)(col0 + bj * 128 + x));
#pragma unroll
        for (int ai = 0; ai < 2; ++ai)
#pragma unroll
            for (int m = 0; m < 4; ++m) { const size_t row = (size_t)(row0 + ai * 128 + m * 16);
#pragma unroll
                for (int bj = 0; bj < 2; ++bj) { f32x4 v0 = acc[ai][bj][m][0], v1 = acc[ai][bj][m][1];
#pragma unroll
                    for (int x = 0; x < 4; ++x) { v0[x] *= sc[bj][x]; v1[x] *= sc[bj][4 + x]; }
                    *(u32x4*)(VT + row * (size_t)M + col0 + bj * 128) = pack_row8(v0, v1); } }
    }
};
struct EpiUpA {
    bf16_t* Y1; const bf16_t* H;
    DEVM void operator()(EPI_ARGS) const {
        const int row0 = u.pm * 256 + wr * 64 + fr, col0 = u.pn * 256 + wc * 32 + 8 * fq;
#pragma unroll
        for (int ai = 0; ai < 2; ++ai)
#pragma unroll
            for (int m = 0; m < 4; ++m) { const size_t row = (size_t)(row0 + ai * 128 + m * 16);
#pragma unroll
                for (int bj = 0; bj < 2; ++bj) { const u32x4 g = *(const u32x4*)(H + row * LDH + C_GA + col0 + bj * 128);
                    f32x4 v0 = acc[ai][bj][m][0], v1 = acc[ai][bj][m][1];
                    v0[0] *= lo_bf(g.x); v0[1] *= hi_bf(g.x); v0[2] *= lo_bf(g.y); v0[3] *= hi_bf(g.y); v1[0] *= lo_bf(g.z); v1[1] *= hi_bf(g.z); v1[2] *= lo_bf(g.w); v1[3] *= hi_bf(g.w);
                    *(u32x4*)(Y1 + row * 1024 + col0 + bj * 128) = pack_row8(v0, v1); } }
    }
};
struct EpiUpM {
    bf16_t* Y; const bf16_t* Y1; const bf16_t* H;
    DEVM void operator()(EPI_ARGS) const {
        const int row0 = u.pm * 256 + wr * 64 + fr, col0 = u.pn * 256 + wc * 32 + 8 * fq;
#pragma unroll
        for (int ai = 0; ai < 2; ++ai)
#pragma unroll
            for (int m = 0; m < 4; ++m) { const size_t row = (size_t)(row0 + ai * 128 + m * 16);
#pragma unroll
                for (int bj = 0; bj < 2; ++bj) { const u32x4 g = *(const u32x4*)(H + row * LDH + C_GM + col0 + bj * 128); const u32x4 y = *(const u32x4*)(Y1 + row * 1024 + col0 + bj * 128);
                    f32x4 v0 = acc[ai][bj][m][0], v1 = acc[ai][bj][m][1];
                    v0[0] = v0[0] * lo_bf(g.x) + lo_bf(y.x); v0[1] = v0[1] * hi_bf(g.x) + hi_bf(y.x); v0[2] = v0[2] * lo_bf(g.y) + lo_bf(y.y); v0[3] = v0[3] * hi_bf(g.y) + hi_bf(y.y);
                    v1[0] = v1[0] * lo_bf(g.z) + lo_bf(y.z); v1[1] = v1[1] * hi_bf(g.z) + hi_bf(y.z); v1[2] = v1[2] * lo_bf(g.w) + lo_bf(y.w); v1[3] = v1[3] * hi_bf(g.w) + hi_bf(y.w);
                    *(u32x4*)(Y + row * 1024 + col0 + bj * 128) = pack_row8(v0, v1); } }
    }
};
struct EpiOut {
    float* Z; const float* X;
    DEVM void operator()(EPI_ARGS) const {
        const int row0 = u.pm * 256 + wr * 64 + fr, col0 = u.pn * 256 + wc * 32 + 8 * fq;
#pragma unroll
        for (int ai = 0; ai < 2; ++ai)
#pragma unroll
            for (int m = 0; m < 4; ++m) { const size_t off = (size_t)(row0 + ai * 128 + m * 16) * 1024 + col0;
#pragma unroll
                for (int bj = 0; bj < 2; ++bj)
#pragma unroll
                    for (int n = 0; n < 2; ++n) { const f32x4 xv = *(const f32x4*)(X + off + bj * 128 + 4 * n); *(f32x4*)(Z + off + bj * 128 + 4 * n) = acc[ai][bj][m][n] + xv * ALPHA; } }
    }
};
struct EpiMoe1 {
    bf16_t* HD;
    DEVM void operator()(EPI_ARGS) const {
        const int row0 = u.pm * 256 + wr * 64 + fr, col0 = u.pn * 128 + wc * 32 + 8 * fq;
#pragma unroll
        for (int ai = 0; ai < 2; ++ai)
#pragma unroll
            for (int m = 0; m < 4; ++m) { const size_t row = (size_t)(row0 + ai * 128 + m * 16);
                f32x4 v0, v1;
#pragma unroll
                for (int x = 0; x < 4; ++x) { const float g0 = acc[ai][0][m][0][x], g1 = acc[ai][0][m][1][x]; v0[x] = g0 * sigmoidf_(g0) * acc[ai][1][m][0][x]; v1[x] = g1 * sigmoidf_(g1) * acc[ai][1][m][1][x]; }
                *(u32x4*)(HD + row * 512 + col0) = pack_row8(v0, v1); }
    }
};
struct EpiMoe2 {
    bf16_t* O2;
    DEVM void operator()(EPI_ARGS) const {
        const int row0 = u.pm * 256 + wr * 64 + fr, col0 = u.pn * 256 + wc * 32 + 8 * fq;
#pragma unroll
        for (int ai = 0; ai < 2; ++ai)
#pragma unroll
            for (int m = 0; m < 4; ++m) { const size_t row = (size_t)(row0 + ai * 128 + m * 16);
#pragma unroll
                for (int bj = 0; bj < 2; ++bj) *(u32x4*)(O2 + row * 1024 + col0 + bj * 128) = pack_row8(acc[ai][bj][m][0], acc[ai][bj][m][1]); }
    }
};

struct Ctx {
    const float* in[25]; float* out; unsigned char* ws;
    int tid, lane, wid, G, bid;
    LAS unsigned char* lds;
};
#define IN_X 0
#define IN_WIN 1
#define IN_CONVW 2
#define IN_CONVB 3
#define IN_KVG 4
#define IN_WUK 5
#define IN_WUV 6
#define IN_RELB 7
#define IN_BI 8
#define IN_BF 9
#define IN_MHG 10
#define IN_WUPA 11
#define IN_WUPM 12
#define IN_WOUT 13
#define IN_LN1G 14
#define IN_LN1B 15
#define IN_WGRP 16
#define IN_BGRP 17
#define IN_WRT 18
#define IN_BRT 19
#define IN_WGATE 20
#define IN_WUP 21
#define IN_WDOWN 22
#define IN_LN2G 23
#define IN_LN2B 24
template <class T> DEV T* wsp(const Ctx& c, size_t off) { return (T*)(c.ws + off); }
DEV void wg_sync() { __syncthreads(); }

DEV int win_src_col(int n) {
    if (n < 1280) return n;
    if (n < 2816) return 1352 + (n - 1280);
    if (n < 5376) return 2896 + (n - 2816);
    if (n < 5440) return 1280 + (n - 5376);
    if (n < 5448) return 1344 + (n - 5440);
    if (n < 5456) return 2888 + (n - 5448);
    return -1;
}
DEV void p0_item(const float* W, const float* W2, int K, int Nsrc, bf16_t* WT, int mode, const float* aux, LAS float* scr, int item, int nblk, int lane) {
    const int kb = item / nblk, nb = item % nblk, k0 = 64 * kb, n0 = 32 * nb;
    const int nn = n0 + (lane & 31);
    int col = nn; const float* src = W; float cs = 1.0f;
    if (mode == 1) { col = win_src_col(nn); cs = (nn < 512) ? QSCALE : 1.0f; }
    if (mode == 3) { const int t = nn >> 8, j = nn & 255; col = t * 128 + (j & 127); src = (j < 128) ? W : W2; }
#pragma unroll 8
    for (int i = 0; i < 32; ++i) { const int kk = 2 * i + (lane >> 5); float v = 0.f;
        if (col >= 0) { v = src[(size_t)(k0 + kk) * Nsrc + col] * cs; if (mode == 2) v *= aux[k0 + kk]; }
        scr[kk * 33 + (lane & 31)] = v; }
    WAVE_SYNC();
    const int c = lane & 7;
#pragma unroll
    for (int j = 0; j < 4; ++j) { const int n = (lane >> 3) + 8 * j; const LAS float* s = scr + (8 * c) * 33 + n;
        u32x4 o; o.x = pk2(s[0 * 33], s[1 * 33]); o.y = pk2(s[2 * 33], s[3 * 33]); o.z = pk2(s[4 * 33], s[5 * 33]); o.w = pk2(s[6 * 33], s[7 * 33]);
        *(u32x4*)(WT + (size_t)(n0 + n) * K + k0 + 8 * c) = o; }
    WAVE_SYNC();
}
DEV void phase_prologue(const Ctx& c) {
    LAS float* scr = (LAS float*)(c.lds + c.wid * 16384);
    const int gw = c.bid * NWAVES + c.wid, NGW = c.G * NWAVES;
    constexpr int I_WIN = 16 * (NWIN / 32), I_KV = 4 * 16, I_UP = 8 * 32, I_WO = 16 * 32, I_GU = 16 * 32, I_D = 8 * 32;
    constexpr int NITEMS = I_WIN + 2 * I_KV + 2 * I_UP + I_WO + NE * I_GU + NE * I_D;
    for (int it = gw; it < NITEMS; it += NGW) {
        int r = it;
        if (r < I_WIN) { p0_item(c.in[IN_WIN], nullptr, 1024, 5456, wsp<bf16_t>(c, WS_WIN), 1, nullptr, scr, r, NWIN / 32, c.lane); continue; } r -= I_WIN;
        if (r < I_KV) { p0_item(c.in[IN_WUK], nullptr, 256, 512, wsp<bf16_t>(c, WS_WK), 2, c.in[IN_KVG], scr, r, 16, c.lane); continue; } r -= I_KV;
        if (r < I_KV) { p0_item(c.in[IN_WUV], nullptr, 256, 512, wsp<bf16_t>(c, WS_WV), 2, c.in[IN_KVG], scr, r, 16, c.lane); continue; } r -= I_KV;
        if (r < I_UP) { p0_item(c.in[IN_WUPA], nullptr, 512, 1024, wsp<bf16_t>(c, WS_WA), 0, nullptr, scr, r, 32, c.lane); continue; } r -= I_UP;
        if (r < I_UP) { p0_item(c.in[IN_WUPM], nullptr, 512, 1024, wsp<bf16_t>(c, WS_WM), 0, nullptr, scr, r, 32, c.lane); continue; } r -= I_UP;
        if (r < I_WO) { p0_item(c.in[IN_WOUT], nullptr, 1024, 1024, wsp<bf16_t>(c, WS_WO), 0, nullptr, scr, r, 32, c.lane); continue; } r -= I_WO;
        if (r < NE * I_GU) { const int e = r / I_GU; p0_item(c.in[IN_WGATE] + (size_t)e * 1024 * 512, c.in[IN_WUP] + (size_t)e * 1024 * 512, 1024, 512, wsp<bf16_t>(c, WS_WGU) + (size_t)e * 1024 * 1024, 3, nullptr, scr, r % I_GU, 32, c.lane); continue; } r -= NE * I_GU;
        { const int e = r / I_D; p0_item(c.in[IN_WDOWN] + (size_t)e * 512 * 1024, nullptr, 512, 1024, wsp<bf16_t>(c, WS_WD) + (size_t)e * 1024 * 512, 0, nullptr, scr, r % I_D, 32, c.lane); }
    }
    const float* X = c.in[IN_X]; bf16_t* XB = wsp<bf16_t>(c, R0);
    for (int m = gw; m < M; m += NGW) {
        const f32x4* xr = (const f32x4*)(X + (size_t)m * DM) + c.lane; u32x2* o = (u32x2*)(XB + (size_t)m * DM) + c.lane;
#pragma unroll
        for (int j = 0; j < 4; ++j) { const f32x4 v = xr[64 * j]; u32x2 w; w.x = pk2(v[0], v[1]); w.y = pk2(v[2], v[3]); o[64 * j] = w; }
    }
}

constexpr int SCP = SEQ + 32;
constexpr int IDX_LDS = 16 * SCP * 4;
constexpr int NR = SEQ / 64;
DEV void idx_unit(const Ctx& c, int b, int qt) {
    const int lane = c.lane, wid = c.wid, r32 = lane & 31, hi = lane >> 5;
    LAS float* sc = (LAS float*)c.lds;
    const bf16_t* H = wsp<bf16_t>(c, WS_H); const bf16_t* KIDX = wsp<bf16_t>(c, WS_KIDX); const float* SM = wsp<float>(c, WS_SM);
    unsigned* MASK = wsp<unsigned>(c, WS_MASK);
    const int t0 = qt * 16; const size_t rowb = (size_t)b * SEQ;
    const int nkc = (t0 + 16 + 31) / 32;
    {
        const int ah = (r32 & 3) + 4 * ((r32 >> 3) & 1), atl = 2 * (r32 >> 4) + ((r32 >> 2) & 1);
#pragma unroll
        for (int Tp = 0; Tp < 2; ++Tp) {
            bf16x8 af[2][4]; float wq[2][2][8];
#pragma unroll
            for (int T = 0; T < 2; ++T) {
#pragma unroll
                for (int ks = 0; ks < 4; ++ks) af[T][ks] = *(const bf16x8*)(H + (rowb + t0 + 4 * (2 * Tp + T) + atl) * LDH + C_QI + ah * 64 + ks * 16 + hi * 8);
#pragma unroll
                for (int jj = 0; jj < 2; ++jj) { const float* wp = SM + (rowb + t0 + 4 * (2 * Tp + T) + 2 * jj + hi) * 16; const f32x4 w0 = *(const f32x4*)wp, w1 = *(const f32x4*)(wp + 4);
#pragma unroll
                    for (int x = 0; x < 4; ++x) { wq[T][jj][x] = w0[x]; wq[T][jj][4 + x] = w1[x]; } }
            }
            for (int kc = wid; kc < nkc; kc += NWAVES) {
                const int key = kc * 32 + r32; bf16x8 bf[4];
#pragma unroll
                for (int ks = 0; ks < 4; ++ks) bf[ks] = *(const bf16x8*)(KIDX + (rowb + key) * 64 + ks * 16 + hi * 8);
#pragma unroll
                for (int T = 0; T < 2; ++T) {
                    f32x16 a = {0.f, 0.f, 0.f, 0.f, 0.f, 0.f, 0.f, 0.f, 0.f, 0.f, 0.f, 0.f, 0.f, 0.f, 0.f, 0.f};
#pragma unroll
                    for (int ks = 0; ks < 4; ++ks) a = mfma32(af[T][ks], bf[ks], a);
                    float s0 = 0.f, s1 = 0.f;
#pragma unroll
                    for (int j = 0; j < 2; ++j)
#pragma unroll
                        for (int i = 0; i < 4; ++i) { s0 += wq[T][0][i + 4 * j] * fmaxf(a[4 * j + i], 0.f); s1 += wq[T][1][i + 4 * j] * fmaxf(a[8 + 4 * j + i], 0.f); }
                    const int tq0 = 4 * (2 * Tp + T) + hi;
                    sc[tq0 * SCP + key] = s0; sc[(tq0 + 2) * SCP + key] = s1;
                }
            }
        }
    }
    wg_sync();
#pragma unroll 1
    for (int qq = 0; qq < 2; ++qq) {
        const int tq = wid + 8 * qq, t = t0 + tq; unsigned* out = MASK + (rowb + t) * NWORDS;
        if (t + 1 <= TOPK) {
            if (lane < NWORDS) { const int lo = 32 * lane; out[lane] = (lo + 31 <= t) ? 0xffffffffu : (lo > t ? 0u : ((1u << (t - lo + 1)) - 1u)); }
        } else {
            unsigned key[NR];
#pragma unroll
            for (int r = 0; r < NR; ++r) { const int s = r * 64 + lane; const float v = sc[tq * SCP + (s <= t ? s : 0)]; unsigned uu = fbits(v); uu = (uu & 0x80000000u) ? ~uu : (uu | 0x80000000u); key[r] = (s <= t) ? uu : 0u; }
            unsigned prefix = 0;
#pragma unroll 1
            for (int bit = 31; bit >= 0; --bit) { const unsigned trial = prefix | (1u << bit); int cnt = 0;
#pragma unroll
                for (int r = 0; r < NR; ++r) cnt += __popcll(__ballot(key[r] >= trial));
                if (cnt >= TOPK) prefix = trial; }
            int cgt = 0;
#pragma unroll
            for (int r = 0; r < NR; ++r) cgt += __popcll(__ballot(key[r] > prefix));
            const int need = TOPK - cgt; int run = 0; u64 mym = 0; const u64 ltm = (lane == 0) ? 0ull : (~0ull >> (64 - lane));
#pragma unroll
            for (int r = 0; r < NR; ++r) { const bool eqp = key[r] == prefix; const u64 eq = __ballot(eqp); const int rank = run + __popcll(eq & ltm);
                const bool sel = (key[r] > prefix) || (eqp && rank < need); const u64 mm = __ballot(sel); if (lane == r) mym = mm; run += __popcll(eq); }
            if (lane < NR) { out[2 * lane] = (unsigned)mym; out[2 * lane + 1] = (unsigned)(mym >> 32); }
        }
    }
    wg_sync();
}

constexpr int QP = 136, TP = 72;
constexpr int L_QS = 0, L_KS = L_QS + 64 * QP * 2, L_KT = L_KS + 64 * QP * 2, L_VT = L_KT + 128 * TP * 2, L_CT = L_VT + 128 * TP * 2, L_N = L_CT + 128 * QP * 2,
              L_G = L_N + 512, L_PART = L_G + NWAVES * 1280, L_CW = L_PART + 1024, L_GN = L_CW + 32 * 40 * 4, ML_LDS = L_GN + 512;
DEV float scan_add(float v, int lane) {
#pragma unroll
    for (int d = 1; d < 64; d <<= 1) { const float o = __shfl_up(v, d); if (lane >= d) v += o; }
    return v;
}
DEV float scan_max(float v, int lane) {
#pragma unroll
    for (int d = 1; d < 64; d <<= 1) { const float o = __shfl_up(v, d); if (lane >= d) v = fmaxf(v, o); }
    return v;
}
DEV void mlstm_unit(const Ctx& c, int b, int head) {
    const int tid = c.tid, lane = c.lane, wid = c.wid, r32 = lane & 31, hi = lane >> 5;
    LAS unsigned char* lds = c.lds;
    LAS bf16_t* QS = (LAS bf16_t*)(lds + L_QS); LAS bf16_t* KS = (LAS bf16_t*)(lds + L_KS); LAS bf16_t* KT = (LAS bf16_t*)(lds + L_KT);
    LAS bf16_t* VTs = (LAS bf16_t*)(lds + L_VT); LAS bf16_t* CT = (LAS bf16_t*)(lds + L_CT); LAS float* NV = (LAS float*)(lds + L_N);
    LAS float* GW = (LAS float*)(lds + L_G + wid * 1280); LAS float* PART = (LAS float*)(lds + L_PART);
    const bf16_t* H = wsp<bf16_t>(c, WS_H); const float* SM = wsp<float>(c, WS_SM); bf16_t* HM = (bf16_t*)c.out;
    const float bi = c.in[IN_BI][head], bfg = c.in[IN_BF][head];
    const int vt = wid >> 1, jt = wid & 1;
    const int which = tid >> 8, rem = tid & 255, cg = rem & 15, rb = rem >> 4;
    LAS float* CWL = (LAS float*)(lds + L_CW); LAS float* GNL = (LAS float*)(lds + L_GN);
    for (int i = tid; i < 32 * 40; i += NTHREADS) { const int grp = i / 40, e = i % 40, wh = grp >> 4, cgi = grp & 15, ch0 = wh * 512 + head * 128 + cgi * 8;
        CWL[i] = (e < 32) ? c.in[IN_CONVW][(e >> 3) * 1024 + ch0 + (e & 7)] : c.in[IN_CONVB][ch0 + (e - 32)]; }
    if (tid < 128) GNL[tid] = c.in[IN_MHG][head * 128 + tid];
    const LAS float* cwp = CWL + (which * 16 + cg) * 40;
    f32x16 accC[2];
#pragma unroll
    for (int x = 0; x < 2; ++x)
#pragma unroll
        for (int r = 0; r < 16; ++r) accC[x][r] = 0.f;
    for (int i = tid; i < 128 * QP / 2; i += NTHREADS) ((LAS unsigned*)CT)[i] = 0u;
    if (tid < 128) NV[tid] = 0.f;
    float m_prev = 0.f;
    wg_sync();
    const size_t colq = (size_t)(which ? C_KM : C_QM) + head * 128 + cg * 8;
    for (int ch = 0; ch < NCH; ++ch) {
        const size_t tok0 = (size_t)b * SEQ + (size_t)ch * 64;
        float wp, a_dec, m_new;
        {
            const float fp = SM[(tok0 + lane) * 16 + 12 + head] + bfg, ip = SM[(tok0 + lane) * 16 + 8 + head] + bi;
            const float lf = fminf(fp, 0.f) - log1pf(__expf(-fabsf(fp)));
            const float bcum = scan_add(lf, lane);
            const float g = ip - bcum, gmax = scan_max(g, lane);
            const float mj = fmaxf(bcum + m_prev, bcum + gmax);
            const float blast = __shfl(bcum, 63), gmx = __shfl(gmax, 63);
            m_new = fmaxf(blast + m_prev, blast + gmx);
            a_dec = __expf(blast + m_prev - m_new);
            wp = __expf(blast + g - m_new);
            GW[lane] = g; GW[64 + lane] = bcum - mj; GW[128 + lane] = __expf(bcum + m_prev - mj); GW[192 + lane] = __expf(-mj);
        }
        {
            float y[4][8];
#pragma unroll
            for (int o = 0; o < 4; ++o)
#pragma unroll
                for (int x = 0; x < 8; ++x) y[o][x] = cwp[32 + x];
#pragma unroll
            for (int i = 0; i < 7; ++i) {
                const int tt = ch * 64 + rb * 4 - 3 + i;
                u32x4 raw = {0u, 0u, 0u, 0u};
                if (tt >= 0) raw = *(const u32x4*)(H + ((size_t)b * SEQ + tt) * LDH + colq);
                float rv[8] = {lo_bf(raw.x), hi_bf(raw.x), lo_bf(raw.y), hi_bf(raw.y), lo_bf(raw.z), hi_bf(raw.z), lo_bf(raw.w), hi_bf(raw.w)};
#pragma unroll
                for (int o = 0; o < 4; ++o) { const int j = i - o; if (j >= 0 && j < 4) {
#pragma unroll
                    for (int x = 0; x < 8; ++x) y[o][x] += cwp[j * 8 + x] * rv[x]; } }
            }
#pragma unroll
            for (int o = 0; o < 4; ++o) {
                const int rr = rb * 4 + o;
                const float wpr = __shfl(wp, rr);
#pragma unroll
                for (int x = 0; x < 8; ++x) { const float v = y[o][x]; y[o][x] = v * sigmoidf_(v) * (which ? 0.08838834764831845f : 1.0f); }
                const bf16x8 pk = pack8(y[o][0], y[o][1], y[o][2], y[o][3], y[o][4], y[o][5], y[o][6], y[o][7]);
                if (which == 0) *(LAS bf16x8*)(QS + rr * QP + cg * 8) = pk;
                else { *(LAS bf16x8*)(KS + rr * QP + cg * 8) = pk;
#pragma unroll
                    for (int x = 0; x < 8; ++x) KT[(cg * 8 + x) * TP + rr] = (bf16_t)f2bf(y[o][x] * wpr); }
            }
#pragma unroll
            for (int p2 = 0; p2 < 2; ++p2) { const int p = tid + 512 * p2, row = p >> 4, cgv = p & 15;
                const u32x4 raw = *(const u32x4*)(H + (tok0 + row) * LDH + C_VM + head * 128 + cgv * 8);
                const unsigned w4[4] = {raw.x, raw.y, raw.z, raw.w};
#pragma unroll
                for (int x = 0; x < 4; ++x) { VTs[(cgv * 8 + 2 * x) * TP + row] = (bf16_t)(w4[x] & 0xffffu); VTs[(cgv * 8 + 2 * x + 1) * TP + row] = (bf16_t)(w4[x] >> 16); } }
        }
        wg_sync();
        float hval[16]; const int jl = 32 * jt + r32;
        {
            const float ejl = GW[64 + jl], wint = GW[128 + jl], flo = GW[192 + jl];
            f32x16 num = {0.f, 0.f, 0.f, 0.f, 0.f, 0.f, 0.f, 0.f, 0.f, 0.f, 0.f, 0.f, 0.f, 0.f, 0.f, 0.f};
            float den = 0.f;
            bf16x8 qf[8];
#pragma unroll
            for (int ks = 0; ks < 8; ++ks) qf[ks] = *(const LAS bf16x8*)(QS + jl * QP + ks * 16 + hi * 8);
#pragma unroll
            for (int a = 0; a < 2; ++a) {
                if (a <= jt) {
                    f32x16 st = {0.f, 0.f, 0.f, 0.f, 0.f, 0.f, 0.f, 0.f, 0.f, 0.f, 0.f, 0.f, 0.f, 0.f, 0.f, 0.f};
#pragma unroll
                    for (int ks = 0; ks < 8; ++ks) st = mfma32(*(const LAS bf16x8*)(KS + (32 * a + r32) * QP + ks * 16 + hi * 8), qf[ks], st);
                    float pv[16];
#pragma unroll
                    for (int g4 = 0; g4 < 4; ++g4) { const int sb = 32 * a + 8 * g4 + 4 * hi; const f32x4 gg = *(const LAS f32x4*)(GW + sb);
#pragma unroll
                        for (int x = 0; x < 4; ++x) { const int s = sb + x; const float v = (s <= jl) ? st[4 * g4 + x] * __expf(gg[x] + ejl) : 0.f; pv[4 * g4 + x] = v; den += v; } }
#pragma unroll
                    for (int s2 = 0; s2 < 2; ++s2) {
                        const bf16x8 pf = pack8(pv[8 * s2], pv[8 * s2 + 1], pv[8 * s2 + 2], pv[8 * s2 + 3], pv[8 * s2 + 4], pv[8 * s2 + 5], pv[8 * s2 + 6], pv[8 * s2 + 7]);
                        const LAS bf16_t* vp = VTs + (32 * vt + r32) * TP + 32 * a + 16 * s2 + 4 * hi;
                        const s16x4 v0 = *(const LAS s16x4*)vp, v1 = *(const LAS s16x4*)(vp + 8);
                        const bf16x8 vf = {v0[0], v0[1], v0[2], v0[3], v1[0], v1[1], v1[2], v1[3]};
                        num = mfma32(vf, pf, num);
                    }
                }
            }
            f32x16 ni = {0.f, 0.f, 0.f, 0.f, 0.f, 0.f, 0.f, 0.f, 0.f, 0.f, 0.f, 0.f, 0.f, 0.f, 0.f, 0.f};
#pragma unroll
            for (int ks = 0; ks < 8; ++ks) ni = mfma32(*(const LAS bf16x8*)(CT + (32 * vt + r32) * QP + ks * 16 + hi * 8), qf[ks], ni);
            float qn = 0.f;
#pragma unroll
            for (int ks = 0; ks < 8; ++ks) { const f32x4 n0 = *(const LAS f32x4*)(NV + 16 * ks + 8 * hi), n1 = *(const LAS f32x4*)(NV + 16 * ks + 8 * hi + 4); const u32x4 qw = __builtin_bit_cast(u32x4, qf[ks]);
                qn += lo_bf(qw.x) * n0[0] + hi_bf(qw.x) * n0[1] + lo_bf(qw.y) * n0[2] + hi_bf(qw.y) * n0[3] + lo_bf(qw.z) * n1[0] + hi_bf(qw.z) * n1[1] + lo_bf(qw.w) * n1[2] + hi_bf(qw.w) * n1[3]; }
            qn += __shfl_xor(qn, 32); den += __shfl_xor(den, 32);
            const float dtot = den + wint * qn; const float inv = 1.0f / fmaxf(fabsf(dtot), flo);
            float ssq = 0.f;
#pragma unroll
            for (int r = 0; r < 16; ++r) { hval[r] = (num[r] + wint * ni[r]) * inv; ssq += hval[r] * hval[r]; }
            ssq += __shfl_xor(ssq, 32);
            if (hi == 0) PART[vt * 64 + jl] = ssq;
        }
        wg_sync();
        {
#pragma unroll
            for (int x = 0; x < 2; ++x) { const int kt = 2 * jt + x;
#pragma unroll
                for (int r = 0; r < 16; ++r) accC[x][r] *= a_dec;
#pragma unroll
                for (int ks = 0; ks < 4; ++ks) accC[x] = mfma32(*(const LAS bf16x8*)(VTs + (32 * vt + r32) * TP + ks * 16 + hi * 8), *(const LAS bf16x8*)(KT + (32 * kt + r32) * TP + ks * 16 + hi * 8), accC[x]);
#pragma unroll
                for (int r = 0; r < 16; ++r) CT[(32 * vt + crow(r, hi)) * QP + 32 * kt + r32] = (bf16_t)f2bf(accC[x][r]); }
            { const int kd = 16 * wid + (lane & 15), sq = lane >> 4; float s = 0.f;
              const u32x4 k0 = *(const LAS u32x4*)(KT + kd * TP + 16 * sq), k1 = *(const LAS u32x4*)(KT + kd * TP + 16 * sq + 8);
              s = (lo_bf(k0.x) + hi_bf(k0.x)) + (lo_bf(k0.y) + hi_bf(k0.y)) + (lo_bf(k0.z) + hi_bf(k0.z)) + (lo_bf(k0.w) + hi_bf(k0.w)) + (lo_bf(k1.x) + hi_bf(k1.x)) + (lo_bf(k1.y) + hi_bf(k1.y)) + (lo_bf(k1.z) + hi_bf(k1.z)) + (lo_bf(k1.w) + hi_bf(k1.w));
              s += __shfl_xor(s, 16); s += __shfl_xor(s, 32);
              const float nn = a_dec * NV[kd] + s; if (sq == 0) NV[kd] = nn; }
            const float stot = (PART[jl] + PART[64 + jl]) + (PART[128 + jl] + PART[192 + jl]);
            const float rstd = 1.0f / sqrtf(stot * (1.0f / 128.0f) + LN_EPS);
            const size_t tok = tok0 + jl;
#pragma unroll
            for (int g4 = 0; g4 < 4; ++g4) { const int v0 = 32 * vt + 8 * g4 + 4 * hi; const f32x4 gq = *(const LAS f32x4*)(GNL + v0); const float gn[16] = {gq[0], gq[1], gq[2], gq[3], gq[0], gq[1], gq[2], gq[3], gq[0], gq[1], gq[2], gq[3], gq[0], gq[1], gq[2], gq[3]};
                const u32x2 sg = *(const u32x2*)(H + tok * LDH + C_OM + head * 128 + v0);
                u32x2 o; o.x = pk2(hval[4 * g4] * rstd * gn[4 * g4] * lo_bf(sg.x), hval[4 * g4 + 1] * rstd * gn[4 * g4 + 1] * hi_bf(sg.x));
                o.y = pk2(hval[4 * g4 + 2] * rstd * gn[4 * g4 + 2] * lo_bf(sg.y), hval[4 * g4 + 3] * rstd * gn[4 * g4 + 3] * hi_bf(sg.y));
                *(u32x2*)(HM + tok * 512 + head * 128 + v0) = o; }
        }
        m_prev = m_new;
        wg_sync();
    }
}

constexpr int KP = 72, VP = 68;
constexpr int A_KS = 0, A_VS = 2 * 64 * KP * 2, A_BT = A_VS + 2 * 64 * VP * 2, AT_LDS = A_BT + 129 * 4 + 12;
DEV int t5_bucket(int d) {
    if (d < 16) return d;
    if (d >= 114) return 31;
    int bk = 16;
    const int th[15] = {19, 21, 24, 27, 31, 35, 40, 46, 52, 59, 67, 77, 87, 99, 113};
#pragma unroll
    for (int i = 0; i < 15; ++i) bk += (d >= th[i]) ? 1 : 0;
    return bk;
}
DEV void attn_unit(const Ctx& c, int b, int h, int qb) {
    const int tid = c.tid, lane = c.lane, wid = c.wid, r32 = lane & 31, hi = lane >> 5;
    LAS unsigned char* lds = c.lds;
    LAS bf16_t* Ks = (LAS bf16_t*)(lds + A_KS); LAS bf16_t* Vs = (LAS bf16_t*)(lds + A_VS); LAS float* BT = (LAS float*)(lds + A_BT);
    bf16_t* Hq = wsp<bf16_t>(c, WS_H); const bf16_t* Kb = wsp<bf16_t>(c, WS_K); const bf16_t* VT = wsp<bf16_t>(c, WS_VT); const unsigned* MASK = wsp<unsigned>(c, WS_MASK);
    const size_t rowb = (size_t)b * SEQ; const int q0 = qb * 256, qw0 = q0 + 32 * wid, q = qw0 + r32;
    const int NT = (q0 + 256) / 64;
    if (tid <= 128) { const float far = c.in[IN_RELB][31 * 8 + h]; BT[tid] = (tid < 128) ? (c.in[IN_RELB][t5_bucket(tid) * 8 + h] - far) * LOG2E : 0.f; }
    bf16x8 qf[4];
#pragma unroll
    for (int ks = 0; ks < 4; ++ks) qf[ks] = *(const bf16x8*)(Hq + (rowb + q) * LDH + C_QA + h * 64 + ks * 16 + hi * 8);
    const int srow = tid >> 3, spc = tid & 7;
    const bf16_t* ksrc = Kb + (rowb + srow) * 512 + h * 64 + spc * 8;
    const bf16_t* vsrc = VT + (size_t)(h * 64 + srow) * M + rowb + spc * 8;
    u32x4 kreg = *(const u32x4*)ksrc, vreg = *(const u32x4*)vsrc;
    *(LAS u32x4*)(Ks + srow * KP + spc * 8) = kreg;
    { LAS u32x2* vd = (LAS u32x2*)(Vs + srow * VP + spc * 8); u32x2 a = {vreg.x, vreg.y}, bb = {vreg.z, vreg.w}; vd[0] = a; vd[1] = bb; }
    float mrun = -1e30f, lsum = 0.f;
    f32x16 o[2];
#pragma unroll
    for (int d = 0; d < 2; ++d)
#pragma unroll
        for (int r = 0; r < 16; ++r) o[d][r] = 0.f;
    wg_sync();
    for (int kt = 0; kt < NT; ++kt) {
        const int buf = kt & 1;
        if (kt + 1 < NT) { kreg = *(const u32x4*)(ksrc + (size_t)(kt + 1) * 64 * 512); vreg = *(const u32x4*)(vsrc + (size_t)(kt + 1) * 64); }
        if (64 * kt <= qw0 + 31) {
            const LAS bf16_t* kb = Ks + buf * 64 * KP; const LAS bf16_t* vb = Vs + buf * 64 * VP;
            const u32x2 mw = *(const u32x2*)(MASK + (rowb + q) * NWORDS + 2 * kt);
            f32x16 s[2];
#pragma unroll
            for (int a = 0; a < 2; ++a) {
#pragma unroll
                for (int r = 0; r < 16; ++r) s[a][r] = 0.f;
#pragma unroll
                for (int ks = 0; ks < 4; ++ks) s[a] = mfma32(*(const LAS bf16x8*)(kb + (32 * a + r32) * KP + ks * 16 + hi * 8), qf[ks], s[a]);
            }
            if (64 * kt + 63 + 128 > qw0) {
#pragma unroll
                for (int a = 0; a < 2; ++a)
#pragma unroll
                    for (int r = 0; r < 16; ++r) { int d = q - (64 * kt + 32 * a + crow(r, hi)); d = d < 0 ? 128 : (d > 128 ? 128 : d); s[a][r] += BT[d]; }
            }
            float mx = s[0][0];
#pragma unroll
            for (int a = 0; a < 2; ++a)
#pragma unroll
                for (int r = 0; r < 16; ++r) mx = fmaxf(mx, s[a][r]);
            mx = fmaxf(mx, __shfl_xor(mx, 32));
            const float mnew = fmaxf(mrun, mx), resc = fast_exp2(mrun - mnew);
            mrun = mnew; lsum *= resc;
#pragma unroll
            for (int d = 0; d < 2; ++d)
#pragma unroll
                for (int r = 0; r < 16; ++r) o[d][r] *= resc;
            float ps = 0.f;
#pragma unroll
            for (int a = 0; a < 2; ++a) {
                const unsigned w = (a ? mw.y : mw.x) >> (4 * hi);
                float p[16];
#pragma unroll
                for (int r = 0; r < 16; ++r) { const float e = fast_exp2(s[a][r] - mnew); p[r] = ((w >> ((r & 3) + 8 * (r >> 2))) & 1u) ? e : 0.f; ps += p[r]; }
#pragma unroll
                for (int s2 = 0; s2 < 2; ++s2) {
                    const bf16x8 pf = pack8(p[8 * s2], p[8 * s2 + 1], p[8 * s2 + 2], p[8 * s2 + 3], p[8 * s2 + 4], p[8 * s2 + 5], p[8 * s2 + 6], p[8 * s2 + 7]);
#pragma unroll
                    for (int d = 0; d < 2; ++d) {
                        const LAS bf16_t* vp = vb + (32 * d + r32) * VP + 32 * a + 16 * s2 + 4 * hi;
                        const s16x4 v0 = *(const LAS s16x4*)vp, v1 = *(const LAS s16x4*)(vp + 8);
                        const bf16x8 vf = {v0[0], v0[1], v0[2], v0[3], v1[0], v1[1], v1[2], v1[3]};
                        o[d] = mfma32(vf, pf, o[d]);
                    }
                }
            }
            lsum += ps;
        }
        if (kt + 1 < NT) {
            const int nb = buf ^ 1;
            *(LAS u32x4*)(Ks + nb * 64 * KP + srow * KP + spc * 8) = kreg;
            LAS u32x2* vd = (LAS u32x2*)(Vs + nb * 64 * VP + srow * VP + spc * 8); u32x2 a = {vreg.x, vreg.y}, bb = {vreg.z, vreg.w}; vd[0] = a; vd[1] = bb;
        }
        wg_sync();
    }
    lsum += __shfl_xor(lsum, 32);
    const float il = 1.0f / lsum;
#pragma unroll
    for (int d = 0; d < 2; ++d)
#pragma unroll
        for (int g4 = 0; g4 < 4; ++g4) { u32x2 w; w.x = pk2(o[d][4 * g4] * il, o[d][4 * g4 + 1] * il); w.y = pk2(o[d][4 * g4 + 2] * il, o[d][4 * g4 + 3] * il);
            *(u32x2*)(Hq + (rowb + q) * LDH + C_QA + h * 64 + 32 * d + 8 * g4 + 4 * hi) = w; }
}

DEV void ln_row(const f32x4 (&v)[4], const float* g, const float* bta, int lane, f32x4 (&y)[4]) {
    float s = 0.f;
#pragma unroll
    for (int j = 0; j < 4; ++j) s += (v[j][0] + v[j][1]) + (v[j][2] + v[j][3]);
    const float mean = wave_sum(s) * (1.0f / DM); float s2 = 0.f;
#pragma unroll
    for (int j = 0; j < 4; ++j) { const f32x4 d = v[j] - mean; s2 += (d[0] * d[0] + d[1] * d[1]) + (d[2] * d[2] + d[3] * d[3]); }
    const float rstd = 1.0f / sqrtf(wave_sum(s2) * (1.0f / DM) + LN_EPS);
#pragma unroll
    for (int j = 0; j < 4; ++j) { const f32x4 gg = *((const f32x4*)g + lane + 64 * j), bb = *((const f32x4*)bta + lane + 64 * j); y[j] = (v[j] - mean) * rstd * gg + bb; }
}
DEV void phase_ln1_router(const Ctx& c) {
    LAS float* RW = (LAS float*)c.lds; LAS int* LC = (LAS int*)(c.lds + 1024 * 20 * 4); LAS int* GB = LC + 16;
    for (int i = c.tid; i < 1024 * 20; i += NTHREADS) { const int k = i / 20, j = i % 20; RW[i] = (j < 4) ? c.in[IN_WGRP][k * 4 + j] : c.in[IN_WRT][k * 16 + (j - 4)]; }
    if (c.tid < 16) LC[c.tid] = 0;
    wg_sync();
    const float* Z = wsp<float>(c, WS_Z); float* X1 = c.out; bf16_t* X1B = wsp<bf16_t>(c, WS_X1B);
    int* TOKE = wsp<int>(c, WS_TOK); int* TOKS = TOKE + 2 * M; float* TOKW = (float*)(TOKS + 2 * M);
    const int rpw = (M + c.G - 1) / c.G, r0 = c.bid * rpw, r1 = (r0 + rpw < M) ? r0 + rpw : M;
    for (int m = r0 + c.wid; m < r1; m += NWAVES) {
        f32x4 v[4], y[4];
#pragma unroll
        for (int j = 0; j < 4; ++j) v[j] = *((const f32x4*)(Z + (size_t)m * DM) + c.lane + 64 * j);
        ln_row(v, c.in[IN_LN1G], c.in[IN_LN1B], c.lane, y);
#pragma unroll
        for (int j = 0; j < 4; ++j) { *((f32x4*)(X1 + (size_t)m * DM) + c.lane + 64 * j) = y[j]; u32x2 w; w.x = pk2(y[j][0], y[j][1]); w.y = pk2(y[j][2], y[j][3]); *((u32x2*)(X1B + (size_t)m * DM) + c.lane + 64 * j) = w; }
        float lg[20];
#pragma unroll
        for (int e = 0; e < 20; ++e) lg[e] = 0.f;
#pragma unroll
        for (int j = 0; j < 4; ++j)
#pragma unroll
            for (int x = 0; x < 4; ++x) { const int k = 4 * c.lane + 256 * j + x; const float xv = y[j][x];
#pragma unroll
                for (int e4 = 0; e4 < 5; ++e4) { const f32x4 w = *(const LAS f32x4*)(RW + k * 20 + 4 * e4); lg[4 * e4] += xv * w[0]; lg[4 * e4 + 1] += xv * w[1]; lg[4 * e4 + 2] += xv * w[2]; lg[4 * e4 + 3] += xv * w[3]; } }
#pragma unroll
        for (int e = 0; e < 20; ++e) lg[e] = wave_sum(lg[e]);
        if (c.lane == 0) {
            float gl[4]; int gi = 0;
#pragma unroll
            for (int j = 0; j < 4; ++j) gl[j] = lg[j] + c.in[IN_BGRP][j];
#pragma unroll
            for (int j = 1; j < 4; ++j) if (gl[j] > gl[gi]) gi = j;
            float se = 0.f;
#pragma unroll
            for (int j = 0; j < 4; ++j) se += __expf(gl[j] - gl[gi]);
            const float gw = 1.0f / se;
            float el[4];
#pragma unroll
            for (int j = 0; j < 4; ++j) { float t = 0.f;
#pragma unroll
                for (int g2 = 0; g2 < 4; ++g2) if (g2 == gi) t = lg[4 + 4 * g2 + j] + c.in[IN_BRT][4 * g2 + j];
                el[j] = t; }
            int i0 = 0;
#pragma unroll
            for (int j = 1; j < 4; ++j) if (el[j] > el[i0]) i0 = j;
            int i1 = (i0 == 0) ? 1 : 0;
#pragma unroll
            for (int j = 0; j < 4; ++j) if (j != i0 && el[j] > el[i1]) i1 = j;
            const float p1 = 1.0f / (1.0f + __expf(el[i1] - el[i0]));
            const int e0 = gi * 4 + i0, e1 = gi * 4 + i1;
            const int s0 = atomicAdd((int*)&LC[e0], 1), s1 = atomicAdd((int*)&LC[e1], 1);
            TOKE[2 * m] = e0; TOKE[2 * m + 1] = e1; TOKS[2 * m] = s0; TOKS[2 * m + 1] = s1; TOKW[2 * m] = p1 * gw; TOKW[2 * m + 1] = (1.0f - p1) * gw;
        }
    }
#ifndef EMU
    __threadfence_block();
#endif
    wg_sync();
    if (c.tid < 16) GB[c.tid] = (int)atomicAdd(wsp<unsigned>(c, WS_CTL) + CW_CNT + c.tid, (unsigned)LC[c.tid]);
    wg_sync();
    for (int i = r0 * 2 + c.tid; i < r1 * 2; i += NTHREADS) TOKS[i] += GB[TOKE[i]];
}
DEV void moe_bases(const Ctx& c, int (&base)[NE], int& total_tiles) {
    const unsigned* cnt = wsp<unsigned>(c, WS_CTL) + CW_CNT; int acc = 0;
#pragma unroll
    for (int e = 0; e < NE; ++e) { base[e] = acc; acc += (((int)cnt[e] + 255) / 256) * 256; }
    total_tiles = acc / 256;
}
DEV void phase_gather(const Ctx& c) {
    int base[NE], nt; moe_bases(c, base, nt);
    const bf16_t* X1B = wsp<bf16_t>(c, WS_X1B); bf16_t* XS = wsp<bf16_t>(c, WS_XS);
    int* TOKE = wsp<int>(c, WS_TOK); int* TOKS = TOKE + 2 * M;
    const int gw = c.bid * NWAVES + c.wid, NGW = c.G * NWAVES;
    for (int m = gw; m < M; m += NGW) {
        const u32x4 v0 = *((const u32x4*)(X1B + (size_t)m * DM) + c.lane), v1 = *((const u32x4*)(X1B + (size_t)m * DM) + 64 + c.lane);
#pragma unroll
        for (int a = 0; a < 2; ++a) { const int e = TOKE[2 * m + a]; int bs = 0;
#pragma unroll
            for (int j = 0; j < NE; ++j) if (j == e) bs = base[j];
            const int pos = bs + TOKS[2 * m + a];
            *((u32x4*)(XS + (size_t)pos * DM) + c.lane) = v0; *((u32x4*)(XS + (size_t)pos * DM) + 64 + c.lane) = v1; }
    }
}
DEV void phase_final(const Ctx& c) {
    int base[NE], nt; moe_bases(c, base, nt);
    const bf16_t* O2 = wsp<bf16_t>(c, WS_O2); float* X1 = c.out;
    const int* TOKE = wsp<int>(c, WS_TOK); const int* TOKS = TOKE + 2 * M; const float* TOKW = (const float*)(TOKS + 2 * M);
    const int gw = c.bid * NWAVES + c.wid, NGW = c.G * NWAVES;
    for (int m = gw; m < M; m += NGW) {
        int pos[2]; float w[2];
#pragma unroll
        for (int a = 0; a < 2; ++a) { const int e = TOKE[2 * m + a]; int bs = 0;
#pragma unroll
            for (int j = 0; j < NE; ++j) if (j == e) bs = base[j];
            pos[a] = bs + TOKS[2 * m + a]; w[a] = TOKW[2 * m + a]; }
        f32x4 v[4], y[4];
#pragma unroll
        for (int j = 0; j < 4; ++j) { const f32x4 xv = *((const f32x4*)(X1 + (size_t)m * DM) + c.lane + 64 * j);
            const u32x2 a0 = *((const u32x2*)(O2 + (size_t)pos[0] * DM) + c.lane + 64 * j), a1 = *((const u32x2*)(O2 + (size_t)pos[1] * DM) + c.lane + 64 * j);
            f32x4 t; t[0] = xv[0] * ALPHA + w[0] * lo_bf(a0.x) + w[1] * lo_bf(a1.x); t[1] = xv[1] * ALPHA + w[0] * hi_bf(a0.x) + w[1] * hi_bf(a1.x);
            t[2] = xv[2] * ALPHA + w[0] * lo_bf(a0.y) + w[1] * lo_bf(a1.y); t[3] = xv[3] * ALPHA + w[0] * hi_bf(a0.y) + w[1] * hi_bf(a1.y); v[j] = t; }
        ln_row(v, c.in[IN_LN2G], c.in[IN_LN2B], c.lane, y);
#pragma unroll
        for (int j = 0; j < 4; ++j) *((f32x4*)(c.out + (size_t)m * DM) + c.lane + 64 * j) = y[j];
    }
}

#ifndef EMU
#define XB_TMO      128
#define XB_XCNT(j)  (256  + 64 * (j))
#define XB_XSUB(j)  (1280 + 64 * (j))
#define XB_XGEN(j)  (2304 + 64 * (j))
#define XB_TOP      3328
#define XB_TOPGEN   3392
#define XCD_BAR_WORDS 3456
#define XB_SPIN_CAP (1u << 22)
__device__ __forceinline__ unsigned xb_ld(unsigned* p)              { return __hip_atomic_load(p, __ATOMIC_RELAXED, __HIP_MEMORY_SCOPE_AGENT); }
__device__ __forceinline__ unsigned xb_add(unsigned* p, unsigned v) { return __hip_atomic_fetch_add(p, v, __ATOMIC_RELAXED, __HIP_MEMORY_SCOPE_AGENT); }
__device__ __forceinline__ unsigned xb_xcc_id() { return (unsigned)__builtin_amdgcn_s_getreg((3 << 11) | 20) & 0xFu; }
#define XB_SPIN(cond, bar) do { unsigned _sp = 0; while (cond) { __builtin_amdgcn_s_sleep(1); \
    if ((++_sp & 255u) == 0u) { if (xb_ld(&(bar)[XB_TMO])) break; if (_sp > XB_SPIN_CAP) { atomicAdd(&(bar)[XB_TMO], 1u); break; } } } } while (0)
struct XcdBarrier { unsigned* bar; unsigned x; volatile LAS unsigned* st; };
__device__ __forceinline__ XcdBarrier xcd_barrier_post(unsigned* bar, volatile LAS unsigned* st) {
    XcdBarrier b; b.bar = bar; b.x = xb_xcc_id(); b.st = st;
    if (threadIdx.x == 0) (void)xb_add(&bar[XB_XCNT(b.x)], 1u);
    return b;
}
__device__ __forceinline__ void xcd_barrier_complete(unsigned* bar, unsigned x, unsigned& nloc, unsigned& nx) {
    const unsigned G = gridDim.x * gridDim.y * gridDim.z;
    unsigned sum, cnt, mine, sp = 0u;
    for (;;) {
        sum = 0u; cnt = 0u; mine = 0u;
#pragma unroll
        for (unsigned j = 0; j < 16; ++j) { const unsigned c = xb_ld(&bar[XB_XCNT(j)]); sum += c; cnt += (c > 0u) ? 1u : 0u; mine = (j == x) ? c : mine; }
        if (sum == G) break;
        __builtin_amdgcn_s_sleep(1);
        if ((++sp & 255u) == 0u) { if (xb_ld(&bar[XB_TMO])) break; if (sp > XB_SPIN_CAP) { atomicAdd(&bar[XB_TMO], 1u); break; } }
    }
    nloc = mine > 0u ? mine : 1u; nx = cnt > 0u ? cnt : 1u;
}
__device__ __forceinline__ void xcd_barrier(const XcdBarrier& b) {
    asm volatile("s_waitcnt vmcnt(0)" ::: "memory");
    __syncthreads();
    if (threadIdx.x == 0) {
        unsigned* bar = b.bar;
        __builtin_amdgcn_s_waitcnt(0);
        unsigned nloc = b.st[0], nx = b.st[1];
        if (nloc == 0u) { xcd_barrier_complete(bar, b.x, nloc, nx); b.st[0] = nloc; b.st[1] = nx; }
        const unsigned old = xb_add(&bar[XB_XSUB(b.x)], 1u);
        const unsigned gen = old / nloc;
        if (old + 1u == (gen + 1u) * nloc) {
            __builtin_amdgcn_fence(__ATOMIC_RELEASE, "agent");
            asm volatile("s_waitcnt vmcnt(0)" ::: "memory");
            const unsigned og = xb_add(&bar[XB_TOP], 1u);
            const unsigned tg = og / nx;
            if (og + 1u == (tg + 1u) * nx) xb_add(&bar[XB_TOPGEN], 1u);
            else XB_SPIN(xb_ld(&bar[XB_TOPGEN]) == tg, bar);
            __builtin_amdgcn_fence(__ATOMIC_ACQUIRE, "agent");
            xb_add(&bar[XB_XGEN(b.x)], 1u);
            asm volatile("s_waitcnt vmcnt(0)" ::: "memory");
        } else {
            XB_SPIN(xb_ld(&bar[XB_XGEN(b.x)]) == gen, bar);
            __builtin_amdgcn_fence(__ATOMIC_ACQUIRE, "agent");
            asm volatile("s_waitcnt vmcnt(0)" ::: "memory");
        }
    }
    __syncthreads();
}
#endif

constexpr int NPHASE = 11;
constexpr int LDS_BYTES = 144 * 1024;
static_assert(pg8::STAGE_BYTES <= LDS_BYTES - 1024 && IDX_LDS <= LDS_BYTES - 1024 && ML_LDS <= LDS_BYTES - 1024 && AT_LDS <= LDS_BYTES - 1024 && 8 * 16384 <= LDS_BYTES - 1024, "LDS budget");
constexpr int MISC_OFF = LDS_BYTES - 64;

DEV void run_phase(const Ctx& c, int ph) {
    using namespace pg8;
#ifdef EMU
    unsigned char* glds = c.lds;
#else
    PG8_LAS unsigned char* glds = c.lds;
#endif
    if (ph == 0) { phase_prologue(c); return; }
    if (ph == 1) {
        SchedStatic S; S.init(wsp<bf16_t>(c, R0), DM, wsp<bf16_t>(c, WS_WIN), DM, M, NWIN, DM, c.G, c.bid);
        EpiInProj E{wsp<bf16_t>(c, WS_H), wsp<bf16_t>(c, WS_KIDX), wsp<float>(c, WS_SM), wsp<float>(c, WS_SSQ)};
        gemm_phase(glds, S, E); return;
    }
    if (ph == 2) {
        const int nml = (c.G >= 4) ? c.G / 4 : 0;
        if (c.bid < nml) {
#ifndef P2_NO_ML
            for (int u = c.bid; u < NB * NHM; u += nml) mlstm_unit(c, u / NHM, u % NHM);
#endif
        } else {
            const int g2 = c.G - nml, c2 = c.bid - nml;
            { SchedStatic S; S.init(wsp<bf16_t>(c, WS_H) + C_CKV, LDH, wsp<bf16_t>(c, WS_WK), KVR, M, 512, KVR, g2, c2); EpiK E{wsp<bf16_t>(c, WS_K), wsp<float>(c, WS_SSQ)}; gemm_phase(glds, S, E); }
            { SchedStatic S; S.init(wsp<bf16_t>(c, WS_WV), KVR, wsp<bf16_t>(c, WS_H) + C_CKV, LDH, 512, M, KVR, g2, c2); EpiVT E{wsp<bf16_t>(c, WS_VT), wsp<float>(c, WS_SSQ)}; gemm_phase(glds, S, E); }
            wg_sync();
            const int nq = SEQ / 16, nunits = NB * nq;
#ifndef P2_NO_IDX
            for (int u = c2; u < nunits; u += g2) { const int qt = nq - 1 - u / NB, b = u % NB; idx_unit(c, b, qt); }
#endif
        }
        return;
    }
    if (ph == 3) {
        const int nqb = SEQ / 256, nun = NB * HA * nqb;
        for (int u = c.bid; u < nun; u += c.G) {
            const int bh = u / nqb; int qi = u % nqb; const int round = (u / c.G) & 1; if (round) qi = nqb - 1 - qi;
            attn_unit(c, bh / HA, bh % HA, qi);
            wg_sync();
        }
        return;
    }
    if (ph == 4) {
        { SchedStatic S; S.init(wsp<bf16_t>(c, WS_H) + C_QA, LDH, wsp<bf16_t>(c, WS_WA), WA, M, DM, WA, c.G, c.bid); EpiUpA E{(bf16_t*)((unsigned char*)c.out + (size_t)M * 1024), wsp<bf16_t>(c, WS_H)}; gemm_phase(glds, S, E); }
        { SchedStatic S; S.init((const bf16_t*)c.out, WM, wsp<bf16_t>(c, WS_WM), WM, M, DM, WM, c.G, c.bid); EpiUpM E{wsp<bf16_t>(c, WS_Y), (const bf16_t*)((unsigned char*)c.out + (size_t)M * 1024), wsp<bf16_t>(c, WS_H)}; gemm_phase(glds, S, E); }
        return;
    }
    if (ph == 5) {
        SchedStatic S; S.init(wsp<bf16_t>(c, WS_Y), DM, wsp<bf16_t>(c, WS_WO), DM, M, DM, DM, c.G, c.bid); EpiOut E{wsp<float>(c, WS_Z), c.in[IN_X]}; gemm_phase(glds, S, E); return;
    }
    if (ph == 6) { phase_ln1_router(c); return; }
    if (ph == 7) { phase_gather(c); return; }
    if (ph == 8 || ph == 9) {
        int base[NE], nt; moe_bases(c, base, nt);
        SchedMoe S; S.ntiles = nt; S.nN = 4; S.G = c.G; S.c = c.bid;
#pragma unroll
        for (int e = 0; e < NE; ++e) S.tend[e] = ((e + 1 < NE) ? base[e + 1] : nt * 256) / 256;
        if (ph == 8) { S.K = DM; S.lda = DM; S.ldb = DM; S.A = wsp<bf16_t>(c, WS_XS); S.Bt = wsp<bf16_t>(c, WS_WGU); S.estride = (size_t)1024 * 1024; EpiMoe1 E{wsp<bf16_t>(c, WS_HD)}; gemm_phase(glds, S, E); }
        else { S.K = DE; S.lda = DE; S.ldb = DE; S.A = wsp<bf16_t>(c, WS_HD); S.Bt = wsp<bf16_t>(c, WS_WD); S.estride = (size_t)1024 * 512; EpiMoe2 E{wsp<bf16_t>(c, WS_O2)}; gemm_phase(glds, S, E); }
        return;
    }
    if (ph == 10) { phase_final(c); return; }
}

#ifndef EMU
__global__ void __launch_bounds__(NTHREADS, 2) fwd_kernel(Args args) {
    extern __shared__ __attribute__((aligned(16))) unsigned char lds_raw[];
    Ctx c;
#pragma unroll
    for (int i = 0; i < 25; ++i) c.in[i] = args.in[i];
    c.out = args.out; c.ws = args.ws; c.tid = threadIdx.x; c.lane = c.tid & 63; c.wid = __builtin_amdgcn_readfirstlane(c.tid >> 6); c.G = gridDim.x; c.bid = blockIdx.x;
    c.lds = (LAS unsigned char*)lds_raw;
    volatile LAS unsigned* MISC = (volatile LAS unsigned*)(c.lds + MISC_OFF);
    if (c.tid < 16) MISC[c.tid] = 0u;
    __syncthreads();
    const bool multi = (args.ph_hi - args.ph_lo) > 1;
    XcdBarrier bar; bar.bar = (unsigned*)(args.ws + WS_CTL) + CW_BAR; bar.x = 0; bar.st = nullptr;
    if (multi) bar = xcd_barrier_post((unsigned*)(args.ws + WS_CTL) + CW_BAR, MISC + 8);
#ifndef ONLY_PHASE
#define ONLY_PHASE -1
#endif
#define PHASE(k) if ((ONLY_PHASE < 0 || ONLY_PHASE == (k)) && args.ph_lo <= (k) && (k) < args.ph_hi) { run_phase(c, (k)); if ((k) + 1 < args.ph_hi) xcd_barrier(bar); }
    PHASE(0) PHASE(1) PHASE(2) PHASE(3) PHASE(4) PHASE(5) PHASE(6) PHASE(7) PHASE(8) PHASE(9) PHASE(10)
#undef PHASE
}

#ifndef N_LAUNCH_MODE
#define N_LAUNCH_MODE 0
#endif
extern "C" void kernel_launch(void* const* d_in, const int* in_sizes, int n_in, void* d_out, int out_size, void* d_ws, size_t ws_size, hipStream_t stream) {
    static int grid = 0;
    if (grid == 0) {
        if (n_in != 25 || out_size != M * DM || ws_size < WS_END) { fprintf(stderr, "kernel_launch: unexpected shapes (n_in %d out %d ws %zu need %zu)\n", n_in, out_size, ws_size, (size_t)WS_END); grid = -1; return; }
        int dev = 0, cus = 0, per_cu = 0;
        if (hipGetDevice(&dev) != hipSuccess || hipDeviceGetAttribute(&cus, hipDeviceAttributeMultiprocessorCount, dev) != hipSuccess) { grid = -1; return; }
        if (hipFuncSetAttribute((const void*)fwd_kernel, hipFuncAttributeMaxDynamicSharedMemorySize, LDS_BYTES) != hipSuccess) { fprintf(stderr, "kernel_launch: hipFuncSetAttribute failed\n"); grid = -1; return; }
        if (hipOccupancyMaxActiveBlocksPerMultiprocessor(&per_cu, (const void*)fwd_kernel, NTHREADS, LDS_BYTES) != hipSuccess || per_cu < 1) fprintf(stderr, "kernel_launch: occupancy query reports %d\n", per_cu);
        (void)hipGetLastError();
        grid = cus;
    }
    if (grid < 0) return;
    (void)hipMemsetAsync((char*)d_ws + WS_CTL, 0, CTL_ZERO_BYTES, stream);
    Args a{};
    for (int i = 0; i < 25; ++i) a.in[i] = (const float*)d_in[i];
    a.out = (float*)d_out; a.ws = (unsigned char*)d_ws;
    if (N_LAUNCH_MODE == 0) { a.ph_lo = 0; a.ph_hi = NPHASE; hipLaunchKernelGGL(fwd_kernel, dim3(grid), dim3(NTHREADS), LDS_BYTES, stream, a); }
    else { for (int p = 0; p < NPHASE; ++p) { a.ph_lo = p; a.ph_hi = p + 1; hipLaunchKernelGGL(fwd_kernel, dim3(grid), dim3(NTHREADS), LDS_BYTES, stream, a); } }
    (void)in_sizes;
}
#endif
```

```cpp
#ifdef EMU
#include "emu/emu.h"
#define DEV static inline
#define DEVM inline
#define LAUNDER(x) do {} while (0)
#define WAVE_SYNC() e_wbar()
#define LAS
#else
#include <hip/hip_runtime.h>
#include <cstdio>
#include <cstdint>
#define DEV __device__ __forceinline__
#define DEVM __device__ __forceinline__
#define LAUNDER(x) asm volatile("" : "+v"(x))
#define WAVE_SYNC() asm volatile("s_waitcnt lgkmcnt(0)" ::: "memory")
#define LAS __attribute__((address_space(3)))
typedef short bf16x8 __attribute__((ext_vector_type(8)));
typedef float f32x16 __attribute__((ext_vector_type(16)));
typedef float f32x4 __attribute__((ext_vector_type(4)));
#endif
typedef unsigned u32x4 __attribute__((ext_vector_type(4)));
typedef unsigned u32x2 __attribute__((ext_vector_type(2)));
typedef short s16x4 __attribute__((ext_vector_type(4)));
typedef unsigned short bf16_t;
typedef unsigned long long u64;

#ifndef CFG_B
#define CFG_B 16
#endif
#ifndef CFG_S
#define CFG_S 2048
#endif
constexpr int NB = CFG_B, SEQ = CFG_S, DM = 1024, M = NB * SEQ;
constexpr int HA = 8, DA = 64, WA = 512, KVR = 256, TOPK = (SEQ / 4 < 256) ? SEQ / 4 : 256;
constexpr int NHM = 4, DHM = 128, WM = 512, CHUNK = 64, NCH = SEQ / CHUNK;
constexpr int NE = 16, DE = 512, MPAD = 2 * M + 4096;
constexpr float LN_EPS = 1e-5f, ALPHA = 1.189207115002721f;
constexpr float QSCALE = 0.125f * 1.4426950408889634f;
constexpr float LOG2E = 1.4426950408889634f;
constexpr int NWIN = 5632, LDH = 5376;
constexpr int C_OA = 768;
constexpr int C_QA = 0, C_CKV = 512, C_QI = 768, C_QM = 1280, C_KM = 1792, C_VM = 2304, C_OM = 2816, C_GA = 3328, C_GM = 4352;
constexpr int NWORDS = SEQ / 32;
constexpr int NWAVES = 8, NTHREADS = 512;

constexpr size_t MiB = 1u << 20;
constexpr size_t WS_CTL = 0, CTL_ZERO_BYTES = 64 * 1024;
constexpr size_t WS_WIN = 1 * MiB, WS_WK = 12 * MiB, WS_WV = 12 * MiB + 512 * 1024, WS_WA = 13 * MiB, WS_WM = 14 * MiB, WS_WO = 15 * MiB;
constexpr size_t WS_WGU = 17 * MiB, WS_WD = 49 * MiB, WS_TOK = 65 * MiB, WS_PAR = 65 * MiB + 768 * 1024;
static_assert((size_t)M * 24 <= 768 * 1024, "token tables fit below the parameter block");
constexpr int P_CONVW = 0, P_CONVB = 4096, P_BI = 5120, P_BF = 5124, P_MHG = 5128, P_RELB = 5640, P_LN1G = 5896, P_LN1B = 6920, P_WGRP = 7944, P_BGRP = 12040, P_WRT = 12044, P_BRT = 28428, P_LN2G = 28444, P_LN2B = 29468, P_END = 30492;
constexpr size_t R0 = 66 * MiB;
constexpr size_t R1 = R0 + (size_t)M * 2048;
constexpr size_t R2 = R1 + (size_t)M * LDH * 2;
constexpr size_t WS_KIDX = R2, WS_SM = WS_KIDX + (size_t)M * 128, WS_SSQ = WS_SM + (size_t)M * 64, WS_MASK = WS_SSQ + (size_t)M * 16, WS_END = WS_MASK + (size_t)M * NWORDS * 4;
constexpr size_t WS_K = R0, WS_VT = R0 + (size_t)M * 1024, WS_Y = R0;
#ifdef EMU
constexpr size_t WS_H = R1, WS_Z = R1, WS_X1B = R1 + (size_t)M * 4096, WS_XS = WS_END, WS_HD = WS_XS + (size_t)MPAD * 2048, WS_O2 = WS_HD + (size_t)MPAD * 1024, WS_TOTAL = WS_O2 + (size_t)MPAD * 2048;
#else
constexpr size_t WS_H = R1, WS_Z = R1, WS_X1B = R1 + (size_t)M * 4096, WS_XS = R1 + (size_t)M * 6144;
constexpr size_t WS_HD = R1, WS_O2 = R1 + (size_t)MPAD * 1024, WS_TOTAL = WS_END;
static_assert(WS_XS + (size_t)MPAD * 2048 <= R2, "XS fits in the H region");
static_assert(WS_O2 + (size_t)MPAD * 2048 <= R2, "O2 fits in the H region");
static_assert(WS_END <= 512 * MiB, "workspace budget");
#endif
constexpr int CW_CNT = 4096;
constexpr int CW_BAR = 8192;

struct Args { const float* in[25]; float* out; unsigned char* ws; int ph_lo, ph_hi; };

DEV unsigned fbits(float f) { unsigned u; __builtin_memcpy(&u, &f, 4); return u; }
DEV float bitsf(unsigned u) { float f; __builtin_memcpy(&f, &u, 4); return f; }
DEV unsigned f2bf(float f) { unsigned u = fbits(f); return (u + 0x7fffu + ((u >> 16) & 1u)) >> 16; }
DEV float bf2f(unsigned b) { return bitsf(b << 16); }
DEV unsigned pk2(float lo, float hi) {
#ifdef EMU
    return f2bf(lo) | (f2bf(hi) << 16);
#else
    typedef float f32x2_t __attribute__((ext_vector_type(2))); typedef __bf16 bf16x2_t __attribute__((ext_vector_type(2)));
    f32x2_t v = {lo, hi}; bf16x2_t b = __builtin_convertvector(v, bf16x2_t); return __builtin_bit_cast(unsigned, b);
#endif
}
DEV float lo_bf(unsigned w) { return bitsf(w << 16); }
DEV float hi_bf(unsigned w) { return bitsf(w & 0xffff0000u); }
DEV f32x16 mfma32(bf16x8 a, bf16x8 b, f32x16 c) {
#ifdef EMU
    return emu_mfma_32x32x16_bf16(a, b, c);
#else
    return __builtin_amdgcn_mfma_f32_32x32x16_bf16(a, b, c, 0, 0, 0);
#endif
}
DEV float fast_rcp(float x) {
#ifdef EMU
    return 1.0f / x;
#else
    return __builtin_amdgcn_rcpf(x);
#endif
}
DEV float fast_exp2(float x) {
#ifdef EMU
    return exp2f(x);
#else
    return __builtin_amdgcn_exp2f(x);
#endif
}
DEV float sigmoidf_(float x) { return fast_rcp(1.0f + __expf(-x)); }
DEV int crow(int r, int hi) { return (r & 3) + 8 * (r >> 2) + 4 * hi; }
DEV bf16x8 pack8(float a0, float a1, float a2, float a3, float a4, float a5, float a6, float a7) {
    u32x4 w; w.x = pk2(a0, a1); w.y = pk2(a2, a3); w.z = pk2(a4, a5); w.w = pk2(a6, a7); return __builtin_bit_cast(bf16x8, w);
}
DEV float wave_sum(float v) {
#pragma unroll
    for (int o = 1; o < 64; o <<= 1) v += __shfl_xor(v, o);
    return v;
}

namespace pg8 {
constexpr int BM = 256, BK = 64, HALF = 128, HTB = HALF * BK * 2, STAGE_BYTES = 8 * HTB, NXCD = 8, WGM = 8;
DEV int lds_byte(int r, int c) { const int st = (r >> 4) * 2 + (c >> 5), rr = r & 15, cc = c & 31, ob = rr * 64 + cc * 2; return st * 1024 + (ob ^ (((ob >> 9) & 1) << 5)); }
DEV void stage_rc(int b, int& R, int& C) { const int st = b / 1024, sb = b % 1024, swz = sb ^ (((sb >> 9) & 1) << 5); R = (st >> 1) * 16 + swz / 64; C = (st & 1) * 32 + (swz % 64) / 2; }
DEV int perm32(int rho) { const int n = rho >> 4, i = rho & 15; return 8 * (i >> 2) + 4 * n + (i & 3); }

struct Unit { int pm, pn, e; };
struct SchedStatic {
    int nM, nN, nwg, G, c, K, lda, ldb; const bf16_t* A; const bf16_t* Bt;
    DEVM void init(const bf16_t* A_, int lda_, const bf16_t* Bt_, int ldb_, int M_, int N_, int K_, int G_, int c_) { A = A_; lda = lda_; Bt = Bt_; ldb = ldb_; nM = M_ / BM; nN = N_ / BM; nwg = nM * nN; K = K_; G = G_; c = c_; }
    DEVM bool next(int i, Unit& u) const {
        const long L = (long)i * G + c; if (L >= nwg) return false;
        int wgid = (int)L; { const int q = nwg / NXCD, r = nwg % NXCD, xcd = wgid % NXCD, off = wgid / NXCD; wgid = (xcd < r ? xcd * (q + 1) : r * (q + 1) + (xcd - r) * q) + off; }
        const int nig = WGM * nN, gid = wgid / nig, fm = gid * WGM, gsz = (nM - fm) < WGM ? (nM - fm) : WGM;
        u.pm = fm + ((wgid % nig) % gsz); u.pn = (wgid % nig) / gsz; u.e = 0; return true;
    }
    DEVM const char* baseA(const Unit& u) const { return (const char*)(A + (size_t)u.pm * BM * lda); }
    DEVM const char* baseB(const Unit& u) const { return (const char*)(Bt + (size_t)u.pn * BM * ldb); }
};
struct SchedMoe {
    int ntiles, nN, G, c, K, lda, ldb; const bf16_t* A; const bf16_t* Bt; size_t estride; int tend[NE];
    DEVM bool next(int i, Unit& u) const {
        const long L = (long)i * G + c; if (L >= (long)ntiles * nN) return false;
        u.pm = (int)(L / nN); u.pn = (int)(L % nN); int e = 0;
#pragma unroll
        for (int j = 0; j < NE - 1; ++j) e += (u.pm >= tend[j]) ? 1 : 0;
        u.e = e; return true;
    }
    DEVM const char* baseA(const Unit& u) const { return (const char*)(A + (size_t)u.pm * BM * lda); }
    DEVM const char* baseB(const Unit& u) const { return (const char*)(Bt + (size_t)u.e * estride + (size_t)u.pn * BM * ldb); }
};

#ifdef EMU
template <class Epi, class Sched>
static inline void gemm_phase(unsigned char* lds, const Sched& S, const Epi& E) {
    const int tid = threadIdx.x, wid = tid >> 6, lane = tid & 63, wr = wid >> 2, wc = wid & 3, fr = lane & 15, fq = lane >> 4;
    Unit u;
    for (int i = 0; S.next(i, u); ++i) {
        f32x4 acc[2][2][4][2];
        const bf16_t* A = (const bf16_t*)S.baseA(u); const bf16_t* B = (const bf16_t*)S.baseB(u);
        for (int ai = 0; ai < 2; ++ai) for (int bj = 0; bj < 2; ++bj) for (int m = 0; m < 4; ++m) for (int n = 0; n < 2; ++n) for (int x = 0; x < 4; ++x) {
            const int r = 128 * ai + 64 * wr + 16 * m + fr, c = 128 * bj + 32 * wc + 8 * fq + 4 * n + x; float s = 0.f;
            for (int k = 0; k < S.K; ++k) s += bf2f(A[(size_t)r * S.lda + k]) * bf2f(B[(size_t)c * S.ldb + k]);
            acc[ai][bj][m][n][x] = s; }
        E(acc, u, wr, wc, fr, fq);
    }
    (void)lds;
}
#else
#define PG8_LAS __attribute__((address_space(3)))
template <class Epi, class Sched>
__device__ __forceinline__ void gemm_phase(PG8_LAS unsigned char* lds, const Sched& S, const Epi& E) {
    int tid = threadIdx.x; asm volatile("" : "+v"(tid));
    const int wid = __builtin_amdgcn_readfirstlane(tid >> 6), lane = tid & 63, wr = wid >> 2, wc = wid & 3, fr = lane & 15, fq = lane >> 4;
    const int K = S.K, nt = K / BK;
    unsigned voffA[2], voffB[2];
#pragma unroll
    for (int i = 0; i < 2; ++i) { int R, C; stage_rc(tid * 16 + i * 8192, R, C); const int Rb = (R & ~31) + perm32(R & 31);
        voffA[i] = (unsigned)(R * S.lda + C) * 2u; voffB[i] = (unsigned)(Rb * S.ldb + C) * 2u; }
    const size_t kstep = (size_t)(BK * 2);
    const size_t hstepA = (size_t)HALF * S.lda * 2, hstepB = (size_t)HALF * S.ldb * 2;
    const unsigned ldsw = (unsigned)wid * 1024u;
    const int aoff = lds_byte(wr * 64 + fr, fq * 8), boff = lds_byte(wc * 32 + fr, fq * 8);
#define PG8_SA(b, h) (((b) * 2 + (h)) * HTB)
#define PG8_SB(b, h) ((4 + (b) * 2 + (h)) * HTB)
#define PG8_STAGE(bufoff, gbase, voff) do { _Pragma("unroll") for (int _i = 0; _i < 2; ++_i) \
        __builtin_amdgcn_global_load_lds((const unsigned*)((const char*)(gbase) + (voff)[_i]), (PG8_LAS unsigned*)(lds + (bufoff) + ldsw + _i * 8192), 16, 0, 0); } while (0)
#define PG8_LDA(dst, b, h) do { _Pragma("unroll") for (int m = 0; m < 4; ++m) _Pragma("unroll") for (int k = 0; k < 2; ++k) dst[m][k] = *(const PG8_LAS bf16x8*)(lds + PG8_SA(b, h) + aoff + m * 2048 + k * 1024); } while (0)
#define PG8_LDB(dst, b, h) do { _Pragma("unroll") for (int n = 0; n < 2; ++n) _Pragma("unroll") for (int k = 0; k < 2; ++k) dst[n][k] = *(const PG8_LAS bf16x8*)(lds + PG8_SB(b, h) + boff + n * 2048 + k * 1024); } while (0)
#define PG8_MMA(ai, bj, At, Bt) do { __builtin_amdgcn_s_setprio(1); _Pragma("unroll") for (int m = 0; m < 4; ++m) _Pragma("unroll") for (int n = 0; n < 2; ++n) _Pragma("unroll") for (int k = 0; k < 2; ++k) \
        acc[ai][bj][m][n] = __builtin_amdgcn_mfma_f32_16x16x32_bf16(Bt[n][k], At[m][k], acc[ai][bj][m][n], 0, 0, 0); __builtin_amdgcn_s_setprio(0); } while (0)
#define PG8_WAIT_V(n) asm volatile("s_waitcnt vmcnt(" #n ")" ::: "memory")
#define PG8_WAIT_L(n) asm volatile("s_waitcnt lgkmcnt(" #n ")" ::: "memory")
#define PG8_BAR __builtin_amdgcn_s_barrier()
#define PG8_SCHED __builtin_amdgcn_sched_barrier(0)
    Unit cur, nxt; int ui = 0;
    if (!S.next(0, cur)) return;
    f32x4 acc[2][2][4][2];
#pragma unroll
    for (int a = 0; a < 2; ++a)
#pragma unroll
        for (int b = 0; b < 2; ++b)
#pragma unroll
            for (int m = 0; m < 4; ++m)
#pragma unroll
                for (int n = 0; n < 2; ++n) acc[a][b][m][n] = (f32x4){0.f, 0.f, 0.f, 0.f};
    bf16x8 At[4][2], B0[2][2], B1[2][2];
    const char* cA = S.baseA(cur); const char* cB = S.baseB(cur);
    PG8_STAGE(PG8_SB(0, 0), cB, voffB); PG8_STAGE(PG8_SB(0, 1), cB + hstepB, voffB); PG8_STAGE(PG8_SA(0, 0), cA, voffA); PG8_STAGE(PG8_SA(0, 1), cA + hstepA, voffA);
    if (wr == 1) PG8_BAR;
    PG8_WAIT_V(2); PG8_BAR;
    PG8_STAGE(PG8_SB(1, 0), cB + kstep, voffB); PG8_STAGE(PG8_SA(1, 0), cA + kstep, voffA); PG8_STAGE(PG8_SB(1, 1), cB + hstepB + kstep, voffB);
    PG8_WAIT_V(6); PG8_BAR;
    for (;;) {
        const bool has_next = S.next(ui + 1, nxt);
        const char* nA = has_next ? S.baseA(nxt) : cA; const char* nB = has_next ? S.baseB(nxt) : cB;
        for (int t = 0; t < nt; t += 2) {
            const bool last = (t == nt - 2);
            const char* a1 = cA + (size_t)(t + 1) * kstep;
            const char* a2 = last ? nA : cA + (size_t)(t + 2) * kstep; const char* b2 = last ? nB : cB + (size_t)(t + 2) * kstep;
            const char* a3 = a2 + kstep; const char* b3 = b2 + kstep;
            PG8_LDB(B0, 0, 0); PG8_LDB(B1, 0, 1); PG8_SCHED; PG8_LDA(At, 0, 0); PG8_STAGE(PG8_SA(1, 1), a1 + hstepA, voffA);
            PG8_WAIT_V(8); PG8_WAIT_L(0); PG8_BAR; PG8_MMA(0, 0, At, B0); PG8_MMA(0, 1, At, B1); PG8_BAR; PG8_SCHED;
            PG8_LDA(At, 0, 1); PG8_STAGE(PG8_SB(0, 0), b2, voffB); PG8_STAGE(PG8_SB(0, 1), b2 + hstepB, voffB); PG8_STAGE(PG8_SA(0, 0), a2, voffA);
            PG8_WAIT_V(8); PG8_WAIT_L(0); PG8_BAR; PG8_MMA(1, 0, At, B0); PG8_MMA(1, 1, At, B1); PG8_BAR; PG8_SCHED;
            PG8_LDB(B0, 1, 0); PG8_LDB(B1, 1, 1); PG8_SCHED; PG8_LDA(At, 1, 0); PG8_STAGE(PG8_SA(0, 1), a2 + hstepA, voffA);
            PG8_WAIT_V(8); PG8_WAIT_L(0); PG8_BAR; PG8_MMA(0, 0, At, B0); PG8_MMA(0, 1, At, B1); PG8_BAR; PG8_SCHED;
            PG8_LDA(At, 1, 1); PG8_STAGE(PG8_SB(1, 0), b3, voffB); PG8_STAGE(PG8_SB(1, 1), b3 + hstepB, voffB); PG8_STAGE(PG8_SA(1, 0), a3, voffA);
            PG8_WAIT_V(8); PG8_WAIT_L(0); PG8_BAR; PG8_MMA(1, 0, At, B0); PG8_MMA(1, 1, At, B1); PG8_BAR; PG8_SCHED;
        }
        if (wr == 0) PG8_BAR;
        E(acc, cur, wr, wc, fr, fq);
        if (!has_next) break;
#pragma unroll
        for (int a = 0; a < 2; ++a)
#pragma unroll
            for (int b = 0; b < 2; ++b)
#pragma unroll
                for (int m = 0; m < 4; ++m)
#pragma unroll
                    for (int n = 0; n < 2; ++n) acc[a][b][m][n] = (f32x4){0.f, 0.f, 0.f, 0.f};
        cur = nxt; cA = nA; cB = nB; ++ui;
        if (wr == 1) PG8_BAR;
    }
    PG8_WAIT_V(0);
    PG8_BAR;
#undef PG8_SA
#undef PG8_SB
#undef PG8_STAGE
#undef PG8_LDA
#undef PG8_LDB
#undef PG8_MMA
#undef PG8_WAIT_V
#undef PG8_WAIT_L
#undef PG8_BAR
#undef PG8_SCHED
}
#endif
}
using pg8::Unit;

#define EPI_ARGS const f32x4 (&acc)[2][2][4][2], const Unit& u, int wr, int wc, int fr, int fq
DEV u32x4 pack_row8(const f32x4& v0, const f32x4& v1) { u32x4 w; w.x = pk2(v0[0], v0[1]); w.y = pk2(v0[2], v0[3]); w.z = pk2(v1[0], v1[1]); w.w = pk2(v1[2], v1[3]); return w; }

struct EpiInProj {
    bf16_t* H; bf16_t* KIDX; float* SM; float* SSQ;
    DEVM void operator()(EPI_ARGS) const {
        const int row0 = u.pm * 256 + wr * 64 + fr;
        if (u.pn < 21) {
            const int col0 = u.pn * 256 + wc * 32 + 8 * fq; const bool sig = u.pn >= 11;
            if (u.pn == 2) {
#pragma unroll
                for (int ai = 0; ai < 2; ++ai)
#pragma unroll
                    for (int m = 0; m < 4; ++m) { float s = 0.f;
#pragma unroll
                        for (int bj = 0; bj < 2; ++bj)
#pragma unroll
                            for (int n = 0; n < 2; ++n) { const f32x4 x = acc[ai][bj][m][n]; s += (x[0] * x[0] + x[1] * x[1]) + (x[2] * x[2] + x[3] * x[3]); }
                        s += __shfl_xor(s, 16); s += __shfl_xor(s, 32);
                        if (fq == 0) SSQ[(size_t)(row0 + ai * 128 + m * 16) * 4 + wc] = s; }
            }
#pragma unroll
            for (int ai = 0; ai < 2; ++ai)
#pragma unroll
                for (int m = 0; m < 4; ++m) { bf16_t* rowp = H + (size_t)(row0 + ai * 128 + m * 16) * LDH + col0;
#pragma unroll
                    for (int bj = 0; bj < 2; ++bj) { f32x4 v0 = acc[ai][bj][m][0], v1 = acc[ai][bj][m][1];
                        if (sig) {
#pragma unroll
                            for (int x = 0; x < 4; ++x) { v0[x] = sigmoidf_(v0[x]); v1[x] = sigmoidf_(v1[x]); } }
                        *(u32x4*)(rowp + bj * 128) = pack_row8(v0, v1); } }
        } else {
#pragma unroll
            for (int ai = 0; ai < 2; ++ai)
#pragma unroll
                for (int m = 0; m < 4; ++m) { const size_t row = (size_t)(row0 + ai * 128 + m * 16);
                    if (wc < 2) *(u32x4*)(KIDX + row * 64 + wc * 32 + 8 * fq) = pack_row8(acc[ai][0][m][0], acc[ai][0][m][1]);
                    else if (wc == 2 && fq < 2) { *(f32x4*)(SM + row * 16 + 8 * fq) = acc[ai][0][m][0]; *(f32x4*)(SM + row * 16 + 8 * fq + 4) = acc[ai][0][m][1]; } }
        }
    }
};
DEV float rms_scale(const float* SSQ, size_t row) { const f32x4 q = *(const f32x4*)(SSQ + row * 4); return 1.0f / sqrtf(((q[0] + q[1]) + (q[2] + q[3])) * (1.0f / 256.0f) + LN_EPS); }
struct EpiK {
    bf16_t* Kb; const float* SSQ;
    DEVM void operator()(EPI_ARGS) const {
        const int row0 = u.pm * 256 + wr * 64 + fr, col0 = u.pn * 256 + wc * 32 + 8 * fq;
#pragma unroll
        for (int ai = 0; ai < 2; ++ai)
#pragma unroll
            for (int m = 0; m < 4; ++m) { const size_t row = (size_t)(row0 + ai * 128 + m * 16); const float s = rms_scale(SSQ, row);
#pragma unroll
                for (int bj = 0; bj < 2; ++bj) *(u32x4*)(Kb + row * 512 + col0 + bj * 128) = pack_row8(acc[ai][bj][m][0] * s, acc[ai][bj][m][1] * s); }
    }
};
struct EpiVT {
    bf16_t* VT; const float* SSQ;
    DEVM void operator()(EPI_ARGS) const {
        const int row0 = u.pm * 256 + wr * 64 + fr, col0 = u.pn * 256 + wc * 32 + 8 * fq;
        float sc[2][8];
#pragma unroll
        for (int bj = 0; bj < 2; ++bj)
#pragma unroll
            for (int x = 0; x < 8; ++x) sc[bj][x] = rms_scale(SSQ, (size_t)(col0 + bj * 128 + x));
#pragma unroll
        for (int ai = 0; ai < 2; ++ai)
#pragma unroll
            for (int m = 0; m < 4; ++m) { const size_t row = (size_t)(row0 + ai * 128 + m * 16);
#pragma unroll
                for (int bj = 0; bj < 2; ++bj) { f32x4 v0 = acc[ai][bj][m][0], v1 = acc[ai][bj][m][1];
#pragma unroll
                    for (int x = 0; x < 4; ++x) { v0[x] *= sc[bj][x]; v1[x] *= sc[bj][4 + x]; }
                    *(u32x4*)(VT + row * (size_t)M + col0 + bj * 128) = pack_row8(v0, v1); } }
    }
};
struct EpiUpA {
    bf16_t* Y1; const bf16_t* H;
    DEVM void operator()(EPI_ARGS) const {
        const int row0 = u.pm * 256 + wr * 64 + fr, col0 = u.pn * 256 + wc * 32 + 8 * fq;
#pragma unroll
        for (int ai = 0; ai < 2; ++ai)
#pragma unroll
            for (int m = 0; m < 4; ++m) { const size_t row = (size_t)(row0 + ai * 128 + m * 16);
#pragma unroll
                for (int bj = 0; bj < 2; ++bj) { const u32x4 g = *(const u32x4*)(H + row * LDH + C_GA + col0 + bj * 128);
                    f32x4 v0 = acc[ai][bj][m][0], v1 = acc[ai][bj][m][1];
                    v0[0] *= lo_bf(g.x); v0[1] *= hi_bf(g.x); v0[2] *= lo_bf(g.y); v0[3] *= hi_bf(g.y); v1[0] *= lo_bf(g.z); v1[1] *= hi_bf(g.z); v1[2] *= lo_bf(g.w); v1[3] *= hi_bf(g.w);
                    *(u32x4*)(Y1 + row * 1024 + col0 + bj * 128) = pack_row8(v0, v1); } }
    }
};
struct EpiUpM {
    bf16_t* Y; const bf16_t* Y1; const bf16_t* H;
    DEVM void operator()(EPI_ARGS) const {
        const int row0 = u.pm * 256 + wr * 64 + fr, col0 = u.pn * 256 + wc * 32 + 8 * fq;
#pragma unroll
        for (int ai = 0; ai < 2; ++ai)
#pragma unroll
            for (int m = 0; m < 4; ++m) { const size_t row = (size_t)(row0 + ai * 128 + m * 16);
#pragma unroll
                for (int bj = 0; bj < 2; ++bj) { const u32x4 g = *(const u32x4*)(H + row * LDH + C_GM + col0 + bj * 128); const u32x4 y = *(const u32x4*)(Y1 + row * 1024 + col0 + bj * 128);
                    f32x4 v0 = acc[ai][bj][m][0], v1 = acc[ai][bj][m][1];
                    v0[0] = v0[0] * lo_bf(g.x) + lo_bf(y.x); v0[1] = v0[1] * hi_bf(g.x) + hi_bf(y.x); v0[2] = v0[2] * lo_bf(g.y) + lo_bf(y.y); v0[3] = v0[3] * hi_bf(g.y) + hi_bf(y.y);
                    v1[0] = v1[0] * lo_bf(g.z) + lo_bf(y.z); v1[1] = v1[1] * hi_bf(g.z) + hi_bf(y.z); v1[2] = v1[2] * lo_bf(g.w) + lo_bf(y.w); v1[3] = v1[3] * hi_bf(g.w) + hi_bf(y.w);
                    *(u32x4*)(Y + row * 1024 + col0 + bj * 128) = pack_row8(v0, v1); } }
    }
};
struct EpiOut {
    float* Z; const float* X;
    DEVM void operator()(EPI_ARGS) const {
        const int row0 = u.pm * 256 + wr * 64 + fr, col0 = u.pn * 256 + wc * 32 + 8 * fq;
#pragma unroll
        for (int ai = 0; ai < 2; ++ai)
#pragma unroll
            for (int m = 0; m < 4; ++m) { const size_t off = (size_t)(row0 + ai * 128 + m * 16) * 1024 + col0;
#pragma unroll
                for (int bj = 0; bj < 2; ++bj)
#pragma unroll
                    for (int n = 0; n < 2; ++n) { const f32x4 xv = *(const f32x4*)(X + off + bj * 128 + 4 * n); *(f32x4*)(Z + off + bj * 128 + 4 * n) = acc[ai][bj][m][n] + xv * ALPHA; } }
    }
};
struct EpiMoe1 {
    bf16_t* HD;
    DEVM void operator()(EPI_ARGS) const {
        const int row0 = u.pm * 256 + wr * 64 + fr, col0 = u.pn * 128 + wc * 32 + 8 * fq;
#pragma unroll
        for (int ai = 0; ai < 2; ++ai)
#pragma unroll
            for (int m = 0; m < 4; ++m) { const size_t row = (size_t)(row0 + ai * 128 + m * 16);
                f32x4 v0, v1;
#pragma unroll
                for (int x = 0; x < 4; ++x) { const float g0 = acc[ai][0][m][0][x], g1 = acc[ai][0][m][1][x]; v0[x] = g0 * sigmoidf_(g0) * acc[ai][1][m][0][x]; v1[x] = g1 * sigmoidf_(g1) * acc[ai][1][m][1][x]; }
                *(u32x4*)(HD + row * 512 + col0) = pack_row8(v0, v1); }
    }
};
struct EpiMoe2 {
    bf16_t* O2;
    DEVM void operator()(EPI_ARGS) const {
        const int row0 = u.pm * 256 + wr * 64 + fr, col0 = u.pn * 256 + wc * 32 + 8 * fq;
#pragma unroll
        for (int ai = 0; ai < 2; ++ai)
#pragma unroll
            for (int m = 0; m < 4; ++m) { const size_t row = (size_t)(row0 + ai * 128 + m * 16);
#pragma unroll
                for (int bj = 0; bj < 2; ++bj) *(u32x4*)(O2 + row * 1024 + col0 + bj * 128) = pack_row8(acc[ai][bj][m][0], acc[ai][bj][m][1]); }
    }
};

struct Ctx {
    const float* in[25]; float* out; unsigned char* ws;
    int tid, lane, wid, G, bid;
    LAS unsigned char* lds;
};
#define IN_X 0
#define IN_WIN 1
#define IN_CONVW 2
#define IN_CONVB 3
#define IN_KVG 4
#define IN_WUK 5
#define IN_WUV 6
#define IN_RELB 7
#define IN_BI 8
#define IN_BF 9
#define IN_MHG 10
#define IN_WUPA 11
#define IN_WUPM 12
#define IN_WOUT 13
#define IN_LN1G 14
#define IN_LN1B 15
#define IN_WGRP 16
#define IN_BGRP 17
#define IN_WRT 18
#define IN_BRT 19
#define IN_WGATE 20
#define IN_WUP 21
#define IN_WDOWN 22
#define IN_LN2G 23
#define IN_LN2B 24
template <class T> DEV T* wsp(const Ctx& c, size_t off) { return (T*)(c.ws + off); }
DEV const float* par(const Ctx& c, int off) { return (const float*)(c.ws + WS_PAR) + off; }
DEV void wg_sync() { __syncthreads(); }

DEV int win_src_col(int n) {
    if (n < 1280) return n;
    if (n < 2816) return 1352 + (n - 1280);
    if (n < 5376) return 2896 + (n - 2816);
    if (n < 5440) return 1280 + (n - 5376);
    if (n < 5448) return 1344 + (n - 5440);
    if (n < 5456) return 2888 + (n - 5448);
    return -1;
}
DEV void p0_item(const float* W, const float* W2, int K, int Nsrc, bf16_t* WT, int mode, const float* aux, LAS float* scr, int item, int nblk, int lane) {
    const int kb = item / nblk, nb = item % nblk, k0 = 64 * kb, n0 = 32 * nb;
    const int nn = n0 + (lane & 31);
    int col = nn; const float* src = W; float cs = 1.0f;
    if (mode == 1) { col = win_src_col(nn); cs = (nn < 512) ? QSCALE : 1.0f; }
    if (mode == 3) { const int t = nn >> 8, j = nn & 255; col = t * 128 + (j & 127); src = (j < 128) ? W : W2; }
#pragma unroll 8
    for (int i = 0; i < 32; ++i) { const int kk = 2 * i + (lane >> 5); float v = 0.f;
        if (col >= 0) { v = src[(size_t)(k0 + kk) * Nsrc + col] * cs; if (mode == 2) v *= aux[k0 + kk]; }
        scr[kk * 33 + (lane & 31)] = v; }
    WAVE_SYNC();
    const int c = lane & 7;
#pragma unroll
    for (int j = 0; j < 4; ++j) { const int n = (lane >> 3) + 8 * j; const LAS float* s = scr + (8 * c) * 33 + n;
        u32x4 o; o.x = pk2(s[0 * 33], s[1 * 33]); o.y = pk2(s[2 * 33], s[3 * 33]); o.z = pk2(s[4 * 33], s[5 * 33]); o.w = pk2(s[6 * 33], s[7 * 33]);
        *(u32x4*)(WT + (size_t)(n0 + n) * K + k0 + 8 * c) = o; }
    WAVE_SYNC();
}
DEV void phase_prologue(const Ctx& c) {
    LAS float* scr = (LAS float*)(c.lds + c.wid * 16384);
    const int gw = c.bid * NWAVES + c.wid, NGW = c.G * NWAVES;
    constexpr int I_WIN = 16 * (NWIN / 32), I_KV = 4 * 16, I_UP = 8 * 32, I_WO = 16 * 32, I_GU = 16 * 32, I_D = 8 * 32;
    constexpr int NITEMS = I_WIN + 2 * I_KV + 2 * I_UP + I_WO + NE * I_GU + NE * I_D;
    for (int it = gw; it < NITEMS; it += NGW) {
        int r = it;
        if (r < I_WIN) { p0_item(c.in[IN_WIN], nullptr, 1024, 5456, wsp<bf16_t>(c, WS_WIN), 1, nullptr, scr, r, NWIN / 32, c.lane); continue; } r -= I_WIN;
        if (r < I_KV) { p0_item(c.in[IN_WUK], nullptr, 256, 512, wsp<bf16_t>(c, WS_WK), 2, c.in[IN_KVG], scr, r, 16, c.lane); continue; } r -= I_KV;
        if (r < I_KV) { p0_item(c.in[IN_WUV], nullptr, 256, 512, wsp<bf16_t>(c, WS_WV), 2, c.in[IN_KVG], scr, r, 16, c.lane); continue; } r -= I_KV;
        if (r < I_UP) { p0_item(c.in[IN_WUPA], nullptr, 512, 1024, wsp<bf16_t>(c, WS_WA), 0, nullptr, scr, r, 32, c.lane); continue; } r -= I_UP;
        if (r < I_UP) { p0_item(c.in[IN_WUPM], nullptr, 512, 1024, wsp<bf16_t>(c, WS_WM), 0, nullptr, scr, r, 32, c.lane); continue; } r -= I_UP;
        if (r < I_WO) { p0_item(c.in[IN_WOUT], nullptr, 1024, 1024, wsp<bf16_t>(c, WS_WO), 0, nullptr, scr, r, 32, c.lane); continue; } r -= I_WO;
        if (r < NE * I_GU) { const int e = r / I_GU; p0_item(c.in[IN_WGATE] + (size_t)e * 1024 * 512, c.in[IN_WUP] + (size_t)e * 1024 * 512, 1024, 512, wsp<bf16_t>(c, WS_WGU) + (size_t)e * 1024 * 1024, 3, nullptr, scr, r % I_GU, 32, c.lane); continue; } r -= NE * I_GU;
        { const int e = r / I_D; p0_item(c.in[IN_WDOWN] + (size_t)e * 512 * 1024, nullptr, 512, 1024, wsp<bf16_t>(c, WS_WD) + (size_t)e * 1024 * 512, 0, nullptr, scr, r % I_D, 32, c.lane); }
    }
    { float* P = wsp<float>(c, WS_PAR); const int gt = c.bid * NTHREADS + c.tid, ngt = c.G * NTHREADS;
      for (int i = gt; i < P_END; i += ngt) { float v;
        if (i < P_CONVB) v = c.in[IN_CONVW][i]; else if (i < P_BI) v = c.in[IN_CONVB][i - P_CONVB]; else if (i < P_BF) v = c.in[IN_BI][i - P_BI]; else if (i < P_MHG) v = c.in[IN_BF][i - P_BF];
        else if (i < P_RELB) v = c.in[IN_MHG][i - P_MHG]; else if (i < P_LN1G) v = c.in[IN_RELB][i - P_RELB]; else if (i < P_LN1B) v = c.in[IN_LN1G][i - P_LN1G]; else if (i < P_WGRP) v = c.in[IN_LN1B][i - P_LN1B];
        else if (i < P_BGRP) v = c.in[IN_WGRP][i - P_WGRP]; else if (i < P_WRT) v = c.in[IN_BGRP][i - P_BGRP]; else if (i < P_BRT) v = c.in[IN_WRT][i - P_WRT]; else if (i < P_LN2G) v = c.in[IN_BRT][i - P_BRT];
        else if (i < P_LN2B) v = c.in[IN_LN2G][i - P_LN2G]; else v = c.in[IN_LN2B][i - P_LN2B];
        P[i] = v; } }
    const float* X = c.in[IN_X]; bf16_t* XB = wsp<bf16_t>(c, R0);
    for (int m = gw; m < M; m += NGW) {
        const f32x4* xr = (const f32x4*)(X + (size_t)m * DM) + c.lane; u32x2* o = (u32x2*)(XB + (size_t)m * DM) + c.lane;
#pragma unroll
        for (int j = 0; j < 4; ++j) { const f32x4 v = xr[64 * j]; u32x2 w; w.x = pk2(v[0], v[1]); w.y = pk2(v[2], v[3]); o[64 * j] = w; }
    }
}

constexpr int SCP = SEQ + 32;
constexpr int I_WQ = 16 * SCP * 4, I_CAND = I_WQ + 512, I_HIST = I_CAND + NWAVES * 320, IDX_LDS = I_HIST + NWAVES * 1024;
constexpr int NR = SEQ / 64, NGRP = NR / 8;
static_assert(NR % 8 == 0, "SEQ must be a multiple of 512");
DEV unsigned lds_add(LAS unsigned* p, unsigned v) {
#ifdef EMU
    return __atomic_fetch_add(p, v, __ATOMIC_RELAXED);
#else
    return __hip_atomic_fetch_add(p, v, __ATOMIC_RELAXED, __HIP_MEMORY_SCOPE_WORKGROUP);
#endif
}
DEV void idx_select_row(const LAS float* scrow, int t, unsigned* out, LAS unsigned* hist, LAS unsigned* cand_lds, int lane) {
    if (t + 1 <= TOPK) {
        if (lane < NWORDS) { const int lo = 32 * lane; out[lane] = (lo + 31 <= t) ? 0xffffffffu : (lo > t ? 0u : ((1u << (t - lo + 1)) - 1u)); }
        return;
    }
    const int ng = (t >> 9) + 1;
    unsigned key[NR];
#pragma unroll
    for (int g = 0; g < NGRP; ++g) {
#pragma unroll
        for (int r8 = 0; r8 < 8; ++r8) key[8 * g + r8] = 0u;
        if (g < ng) {
#pragma unroll
            for (int r8 = 0; r8 < 8; ++r8) { const int s = (8 * g + r8) * 64 + lane; const float v = scrow[s <= t ? s : 0]; unsigned uu = fbits(v); uu = (uu & 0x80000000u) ? ~uu : (uu | 0x80000000u); key[8 * g + r8] = (s <= t) ? uu : 0u; }
        }
    }
    unsigned prefix = 0u; int cnt_hi = 0, und = 1 << 30, shift = 24;
#pragma unroll 1
    for (; shift >= 0; shift -= 8) {
        { u32x4 z = {0u, 0u, 0u, 0u}; *(LAS u32x4*)(hist + 4 * lane) = z; }
        WAVE_SYNC();
        const unsigned pfx = (shift == 24) ? 0u : (prefix >> (shift + 8));
#pragma unroll
        for (int g = 0; g < NGRP; ++g) if (g < ng) {
#pragma unroll
            for (int r8 = 0; r8 < 8; ++r8) { const unsigned k = key[8 * g + r8]; const bool m = (shift == 24) ? true : ((k >> (shift + 8)) == pfx); if (m) lds_add(hist + ((k >> shift) & 255u), 1u); }
        }
        WAVE_SYNC();
        const u32x4 h = *(const LAS u32x4*)(hist + 4 * lane);
        WAVE_SYNC();
        const int s4 = (int)(h.x + h.y + h.z + h.w); int suf = s4;
#pragma unroll
        for (int d = 1; d < 64; d <<= 1) { const int o = __shfl_down(suf, d); if (lane + d < 64) suf += o; }
        const int c3 = cnt_hi + suf - s4, c2 = c3 + (int)h.w, c1 = c2 + (int)h.z, c0 = c1 + (int)h.y;
        const bool f3 = c3 < TOPK && c3 + (int)h.w >= TOPK, f2 = c2 < TOPK && c2 + (int)h.z >= TOPK, f1 = c1 < TOPK && c1 + (int)h.y >= TOPK, f0 = c0 < TOPK && c0 + (int)h.x >= TOPK;
        const u64 fm = __ballot(f0 || f1 || f2 || f3);
        const int fl = (fm == 0ull) ? 0 : (63 - __builtin_clzll(fm));
        const int myd = f3 ? 3 : (f2 ? 2 : (f1 ? 1 : 0)), myc = f3 ? c3 : (f2 ? c2 : (f1 ? c1 : c0)), myu = (int)(f3 ? h.w : (f2 ? h.z : (f1 ? h.y : h.x)));
        const int D = 4 * fl + __shfl(myd, fl); cnt_hi = __shfl(myc, fl); und = __shfl(myu, fl);
        prefix |= (unsigned)D << shift;
        if (und <= 64) break;
    }
    unsigned lo = prefix; int cgt, cge;
    if (shift >= 0) {
        if (lane == 0) cand_lds[64] = 0u;
        WAVE_SYNC();
        const unsigned pfx = prefix >> shift;
#pragma unroll
        for (int g = 0; g < NGRP; ++g) if (g < ng) {
#pragma unroll
            for (int r8 = 0; r8 < 8; ++r8) { const unsigned k = key[8 * g + r8]; if ((k >> shift) == pfx) { const unsigned pos = lds_add(cand_lds + 64, 1u); cand_lds[pos & 63u] = k; } }
        }
        WAVE_SYNC();
        const bool cv = lane < und; const unsigned cand = cv ? cand_lds[lane] : 0u;
        WAVE_SYNC();
#pragma unroll 1
        for (int bit = shift - 1; bit >= 0; --bit) { const unsigned trial = lo | (1u << bit); const int cc = cnt_hi + __popcll(__ballot(cv && cand >= trial)); if (cc >= TOPK) lo = trial; }
        cgt = cnt_hi + __popcll(__ballot(cv && cand > lo)); cge = cnt_hi + __popcll(__ballot(cv && cand >= lo));
    } else { cgt = cnt_hi; cge = cnt_hi + und; }
    const int need = TOPK - cgt; u64 mym = 0;
    if (cge - cgt == need) {
#pragma unroll
        for (int g = 0; g < NGRP; ++g) if (g < ng) {
#pragma unroll
            for (int r8 = 0; r8 < 8; ++r8) { const u64 mm = __ballot(key[8 * g + r8] >= lo); if (lane == 8 * g + r8) mym = mm; }
        }
    } else {
        const u64 ltm = (lane == 0) ? 0ull : (~0ull >> (64 - lane)); int run = 0;
#pragma unroll
        for (int g = 0; g < NGRP; ++g) if (g < ng) {
#pragma unroll
            for (int r8 = 0; r8 < 8; ++r8) { const unsigned k = key[8 * g + r8]; const bool eqp = k == lo; const u64 eq = __ballot(eqp); const int rank = run + __popcll(eq & ltm);
                const bool sel = (k > lo) || (eqp && rank < need); const u64 mm = __ballot(sel); if (lane == 8 * g + r8) mym = mm; run += __popcll(eq); }
        }
    }
    if (lane < NR) { out[2 * lane] = (unsigned)mym; out[2 * lane + 1] = (unsigned)(mym >> 32); }
}
DEV void idx_load_b(bf16x8 (&bf)[4], const bf16_t* KIDX, size_t rowb, int kc, int r32, int hi) {
    const bf16_t* p = KIDX + (rowb + kc * 32 + r32) * 64 + hi * 8;
#pragma unroll
    for (int ks = 0; ks < 4; ++ks) bf[ks] = *(const bf16x8*)(p + ks * 16);
}
DEV void idx_unit(const Ctx& c, int b, int qt) {
    const int lane = c.lane, wid = c.wid, r32 = lane & 31, hi = lane >> 5;
    LAS float* sc = (LAS float*)c.lds; LAS float* WQ = (LAS float*)(c.lds + I_WQ); LAS unsigned* CAND = (LAS unsigned*)(c.lds + I_CAND) + wid * 80; LAS unsigned* HIST = (LAS unsigned*)(c.lds + I_HIST) + wid * 256;
    const bf16_t* H = wsp<bf16_t>(c, WS_H); const bf16_t* KIDX = wsp<bf16_t>(c, WS_KIDX); const float* SM = wsp<float>(c, WS_SM);
    unsigned* MASK = wsp<unsigned>(c, WS_MASK);
    const int t0 = qt * 16; const size_t rowb = (size_t)b * SEQ;
    const int nkc = (t0 + 16 + 31) / 32;
    if (c.tid < 128) WQ[c.tid] = SM[(rowb + t0 + (c.tid >> 3)) * 16 + (c.tid & 7)];
    {
        const int ah = (r32 & 3) + 4 * ((r32 >> 3) & 1), atl = 2 * (r32 >> 4) + ((r32 >> 2) & 1);
        bf16x8 af[4][4];
#pragma unroll
        for (int T = 0; T < 4; ++T)
#pragma unroll
            for (int ks = 0; ks < 4; ++ks) af[T][ks] = *(const bf16x8*)(H + (rowb + t0 + 4 * T + atl) * LDH + C_QI + ah * 64 + ks * 16 + hi * 8);
        bf16x8 bcur[4], bnxt[4];
        if (wid < nkc) idx_load_b(bcur, KIDX, rowb, wid, r32, hi);
        wg_sync();
        for (int kc = wid; kc < nkc; kc += NWAVES) {
            const bool more = kc + NWAVES < nkc;
            if (more) idx_load_b(bnxt, KIDX, rowb, kc + NWAVES, r32, hi);
            const int key = kc * 32 + r32;
#pragma unroll
            for (int T = 0; T < 4; ++T) {
                f32x16 a = {0.f, 0.f, 0.f, 0.f, 0.f, 0.f, 0.f, 0.f, 0.f, 0.f, 0.f, 0.f, 0.f, 0.f, 0.f, 0.f};
#pragma unroll
                for (int ks = 0; ks < 4; ++ks) a = mfma32(af[T][ks], bcur[ks], a);
                const int tq0 = 4 * T + hi;
                const f32x4 w00 = *(const LAS f32x4*)(WQ + tq0 * 8), w01 = *(const LAS f32x4*)(WQ + tq0 * 8 + 4), w10 = *(const LAS f32x4*)(WQ + (tq0 + 2) * 8), w11 = *(const LAS f32x4*)(WQ + (tq0 + 2) * 8 + 4);
                float s0 = 0.f, s1 = 0.f;
#pragma unroll
                for (int i = 0; i < 4; ++i) { s0 += w00[i] * fmaxf(a[i], 0.f) + w01[i] * fmaxf(a[4 + i], 0.f); s1 += w10[i] * fmaxf(a[8 + i], 0.f) + w11[i] * fmaxf(a[12 + i], 0.f); }
                sc[tq0 * SCP + key] = s0; sc[(tq0 + 2) * SCP + key] = s1;
            }
            if (more) {
#pragma unroll
                for (int ks = 0; ks < 4; ++ks) bcur[ks] = bnxt[ks]; }
        }
    }
    wg_sync();
#pragma unroll 1
    for (int qq = 0; qq < 2; ++qq) { const int tq = wid + 8 * qq, t = t0 + tq; idx_select_row(sc + tq * SCP, t, MASK + (rowb + t) * NWORDS, HIST, CAND, lane); }
    wg_sync();
}

constexpr int QP = 136, TP = 72;
constexpr int L_QS = 0, L_KS = L_QS + 64 * QP * 2, L_KT = L_KS + 64 * QP * 2, L_VT = L_KT + 128 * TP * 2, L_CT = L_VT + 128 * TP * 2, L_N = L_CT + 128 * QP * 2,
              L_G = L_N + 512, L_PART = L_G + NWAVES * 1280, L_CW = L_PART + 1024, L_GN = L_CW + 32 * 40 * 4, ML_LDS = L_GN + 512;
DEV float scan_add(float v, int lane) {
#pragma unroll
    for (int d = 1; d < 64; d <<= 1) { const float o = __shfl_up(v, d); if (lane >= d) v += o; }
    return v;
}
DEV float scan_max(float v, int lane) {
#pragma unroll
    for (int d = 1; d < 64; d <<= 1) { const float o = __shfl_up(v, d); if (lane >= d) v = fmaxf(v, o); }
    return v;
}
DEV int tsw(int d) { return 2 * ((d >> 3) & 7); }
struct MlRaw { u32x4 qk[7]; u32x4 v[2]; float fp, ip; };
DEV void ml_load_gates(MlRaw& R, const float* SM, int b, int head, int ch, int lane, float bfg, float bi) {
    const float* base = SM + ((size_t)b * SEQ + (size_t)ch * 64) * 16 + head;
    R.fp = *(const float*)((const char*)base + (unsigned)(lane * 64 + 48)) + bfg; R.ip = *(const float*)((const char*)base + (unsigned)(lane * 64 + 32)) + bi;
}
DEV void ml_load_bulk(MlRaw& R, const bf16_t* H, int b, int head, int ch, unsigned qoff, unsigned voff, bool first_rows, int tid) {
    const size_t rowc = (size_t)b * SEQ + (size_t)ch * 64;
#pragma unroll
    for (int i = 0; i < 7; ++i) {
        const bool neg = first_rows && ch == 0 && i < 3;
        const bf16_t* base = H + ((long)rowc + i - 3) * LDH;
        const u32x4 raw = *(const u32x4*)((const char*)base + (qoff + (neg ? 3u * LDH * 2u : 0u)));
        const u32x4 z = {0u, 0u, 0u, 0u};
        R.qk[i] = neg ? z : raw; }
#pragma unroll
    for (int o = 0; o < 2; ++o) { const bf16_t* base = H + (rowc + o) * LDH + C_VM + head * 128; R.v[o] = *(const u32x4*)((const char*)base + voff); }
    (void)tid;
}
DEV void mlstm_unit(const Ctx& c, int b, int head) {
    int tid = c.tid; LAUNDER(tid);
    const int lane = tid & 63, wid = c.wid;
    LAS unsigned char* lds = c.lds;
    LAS bf16_t* QS = (LAS bf16_t*)(lds + L_QS); LAS bf16_t* KS = (LAS bf16_t*)(lds + L_KS); LAS bf16_t* KT = (LAS bf16_t*)(lds + L_KT);
    LAS bf16_t* VTs = (LAS bf16_t*)(lds + L_VT); LAS bf16_t* CT = (LAS bf16_t*)(lds + L_CT); LAS float* NV = (LAS float*)(lds + L_N);
    LAS float* GW = (LAS float*)(lds + L_G + wid * 1280); LAS float* PART = (LAS float*)(lds + L_PART);
    const bf16_t* H = wsp<bf16_t>(c, WS_H); const float* SM = wsp<float>(c, WS_SM); bf16_t* HM = (bf16_t*)c.out;
    const float bi = par(c, P_BI)[head], bfg = par(c, P_BF)[head];
    const int vt = wid >> 1, jt = wid & 1;
    const int which = tid >> 8, cg0 = tid & 15, rb0 = (tid & 255) >> 4;
    LAS float* CWL = (LAS float*)(lds + L_CW); LAS float* GNL = (LAS float*)(lds + L_GN);
    for (int i = tid; i < 32 * 40; i += NTHREADS) { const int grp = i / 40, e = i % 40, wh = grp >> 4, cgi = grp & 15, ch0 = wh * 512 + head * 128 + cgi * 8;
        CWL[i] = (e < 32) ? par(c, P_CONVW)[(e >> 3) * 1024 + ch0 + (e & 7)] : par(c, P_CONVB)[ch0 + (e - 32)]; }
    if (tid < 128) GNL[tid] = par(c, P_MHG)[head * 128 + tid];
    f32x16 accC[2];
#pragma unroll
    for (int x = 0; x < 2; ++x)
#pragma unroll
        for (int r = 0; r < 16; ++r) accC[x][r] = 0.f;
    for (int i = tid; i < 128 * QP / 2; i += NTHREADS) ((LAS unsigned*)CT)[i] = 0u;
    if (tid < 128) NV[tid] = 0.f;
    float m_prev = 0.f;
    const unsigned qoff = (unsigned)((rb0 * 4 * LDH + (which ? C_KM : C_QM) + head * 128 + cg0 * 8) * 2), voff = (unsigned)(((tid >> 4) * 2 * LDH + (tid & 15) * 8) * 2);
    MlRaw R; ml_load_gates(R, SM, b, head, 0, lane, bfg, bi); ml_load_bulk(R, H, b, head, 0, qoff, voff, rb0 == 0, tid);
    wg_sync();
    for (int ch = 0; ch < NCH; ++ch) {
        const size_t tok0 = (size_t)b * SEQ + (size_t)ch * 64;
        int tidc = tid; LAUNDER(tidc);
        const int lanec = tidc & 63, r32 = lanec & 31, hi = lanec >> 5, cg = tidc & 15, rb = (tidc & 255) >> 4;
        const LAS float* cwp = CWL + (which * 16 + cg) * 40;
        float wp, a_dec, m_new;
        {
            const float fp = R.fp, ip = R.ip;
            const float lf = fminf(fp, 0.f) - __logf(1.0f + __expf(-fabsf(fp)));
            const float bcum = scan_add(lf, lanec);
            const float g = ip - bcum, gmax = scan_max(g, lanec);
            const float mj = fmaxf(bcum + m_prev, bcum + gmax);
            const float blast = __shfl(bcum, 63), gmx = __shfl(gmax, 63);
            m_new = fmaxf(blast + m_prev, blast + gmx);
            a_dec = __expf(blast + m_prev - m_new);
            wp = __expf(blast + g - m_new);
            GW[lanec] = g; GW[64 + lanec] = bcum - mj; GW[128 + lanec] = __expf(bcum + m_prev - mj); GW[192 + lanec] = __expf(-mj);
        }
        {
            float y[4][8];
#pragma unroll
            for (int o = 0; o < 4; ++o)
#pragma unroll
                for (int x = 0; x < 8; ++x) y[o][x] = cwp[32 + x];
#pragma unroll
            for (int i = 0; i < 7; ++i) {
                const u32x4 raw = R.qk[i];
                const float rv[8] = {lo_bf(raw.x), hi_bf(raw.x), lo_bf(raw.y), hi_bf(raw.y), lo_bf(raw.z), hi_bf(raw.z), lo_bf(raw.w), hi_bf(raw.w)};
#pragma unroll
                for (int o = 0; o < 4; ++o) { const int j = i - o; if (j >= 0 && j < 4) {
#pragma unroll
                    for (int x = 0; x < 8; ++x) y[o][x] += cwp[j * 8 + x] * rv[x]; } }
            }
            float wpr[4];
#pragma unroll
            for (int o = 0; o < 4; ++o) wpr[o] = __shfl(wp, rb * 4 + o);
#pragma unroll
            for (int o = 0; o < 4; ++o) {
                const int rr = rb * 4 + o;
#pragma unroll
                for (int x = 0; x < 8; ++x) { const float v = y[o][x]; y[o][x] = v * sigmoidf_(v) * (which ? 0.08838834764831845f : 1.0f); }
                const bf16x8 pk = pack8(y[o][0], y[o][1], y[o][2], y[o][3], y[o][4], y[o][5], y[o][6], y[o][7]);
                if (which == 0) *(LAS bf16x8*)(QS + rr * QP + cg * 8) = pk; else *(LAS bf16x8*)(KS + rr * QP + cg * 8) = pk;
            }
            if (which) {
#pragma unroll
                for (int x = 0; x < 8; ++x) { const int d = cg * 8 + x; u32x2 w; w.x = pk2(y[0][x] * wpr[0], y[1][x] * wpr[1]); w.y = pk2(y[2][x] * wpr[2], y[3][x] * wpr[3]);
                    *(LAS u32x2*)(KT + d * TP + 4 * (rb ^ tsw(d))) = w; }
            }
            { const int cgv = tidc & 15, rg2 = tidc >> 4;
                const unsigned w0[4] = {R.v[0].x, R.v[0].y, R.v[0].z, R.v[0].w}, w1[4] = {R.v[1].x, R.v[1].y, R.v[1].z, R.v[1].w};
#pragma unroll
                for (int x2 = 0; x2 < 4; ++x2) {
                    const int d0 = cgv * 8 + 2 * x2;
                    *(LAS unsigned*)(VTs + d0 * TP + 4 * ((rg2 >> 1) ^ tsw(d0)) + 2 * (rg2 & 1)) = (w0[x2] & 0xffffu) | (w1[x2] << 16);
                    *(LAS unsigned*)(VTs + (d0 + 1) * TP + 4 * ((rg2 >> 1) ^ tsw(d0 + 1)) + 2 * (rg2 & 1)) = (w0[x2] >> 16) | (w1[x2] & 0xffff0000u); }
            }
        }
        if (ch + 1 < NCH) ml_load_gates(R, SM, b, head, ch + 1, lanec, bfg, bi);
        wg_sync();
        float hval[16]; const int jl = 32 * jt + r32;
        {
            const float ejl = GW[64 + jl], wint = GW[128 + jl], flo = GW[192 + jl];
            f32x16 num = {0.f, 0.f, 0.f, 0.f, 0.f, 0.f, 0.f, 0.f, 0.f, 0.f, 0.f, 0.f, 0.f, 0.f, 0.f, 0.f};
            float den = 0.f;
            bf16x8 qf[8];
#pragma unroll
            for (int ks = 0; ks < 8; ++ks) qf[ks] = *(const LAS bf16x8*)(QS + jl * QP + ks * 16 + hi * 8);
            const int dv = 32 * vt + r32, swv = tsw(dv);
#pragma unroll
            for (int a = 0; a < 2; ++a) {
                if (a <= jt) {
                    f32x16 st = {0.f, 0.f, 0.f, 0.f, 0.f, 0.f, 0.f, 0.f, 0.f, 0.f, 0.f, 0.f, 0.f, 0.f, 0.f, 0.f};
#pragma unroll
                    for (int ks = 0; ks < 8; ++ks) st = mfma32(*(const LAS bf16x8*)(KS + (32 * a + r32) * QP + ks * 16 + hi * 8), qf[ks], st);
                    float pv[16];
#pragma unroll
                    for (int g4 = 0; g4 < 4; ++g4) { const int sb = 32 * a + 8 * g4 + 4 * hi; const f32x4 gg = *(const LAS f32x4*)(GW + sb);
#pragma unroll
                        for (int x = 0; x < 4; ++x) { const int s = sb + x; const float v = (s <= jl) ? st[4 * g4 + x] * __expf(gg[x] + ejl) : 0.f; pv[4 * g4 + x] = v; den += v; } }
#pragma unroll
                    for (int s2 = 0; s2 < 2; ++s2) {
                        const bf16x8 pf = pack8(pv[8 * s2], pv[8 * s2 + 1], pv[8 * s2 + 2], pv[8 * s2 + 3], pv[8 * s2 + 4], pv[8 * s2 + 5], pv[8 * s2 + 6], pv[8 * s2 + 7]);
                        const int b0 = 8 * a + 4 * s2 + hi;
                        const s16x4 v0 = *(const LAS s16x4*)(VTs + dv * TP + 4 * (b0 ^ swv)), v1 = *(const LAS s16x4*)(VTs + dv * TP + 4 * ((b0 + 2) ^ swv));
                        const bf16x8 vf = {v0[0], v0[1], v0[2], v0[3], v1[0], v1[1], v1[2], v1[3]};
                        num = mfma32(vf, pf, num);
                    }
                }
            }
#pragma unroll
            for (int ks = 0; ks < 8; ++ks) { const u32x4 qw = __builtin_bit_cast(u32x4, qf[ks]);
                const bf16x8 qsc = pack8(lo_bf(qw.x) * wint, hi_bf(qw.x) * wint, lo_bf(qw.y) * wint, hi_bf(qw.y) * wint, lo_bf(qw.z) * wint, hi_bf(qw.z) * wint, lo_bf(qw.w) * wint, hi_bf(qw.w) * wint);
                num = mfma32(*(const LAS bf16x8*)(CT + (32 * vt + r32) * QP + ks * 16 + hi * 8), qsc, num); }
            float qn = 0.f;
#pragma unroll
            for (int ks = 0; ks < 8; ++ks) { const f32x4 n0 = *(const LAS f32x4*)(NV + 16 * ks + 8 * hi), n1 = *(const LAS f32x4*)(NV + 16 * ks + 8 * hi + 4); const u32x4 qw = __builtin_bit_cast(u32x4, qf[ks]);
                qn += lo_bf(qw.x) * n0[0] + hi_bf(qw.x) * n0[1] + lo_bf(qw.y) * n0[2] + hi_bf(qw.y) * n0[3] + lo_bf(qw.z) * n1[0] + hi_bf(qw.z) * n1[1] + lo_bf(qw.w) * n1[2] + hi_bf(qw.w) * n1[3]; }
            qn += __shfl_xor(qn, 32); den += __shfl_xor(den, 32);
            const float dtot = den + wint * qn; const float inv = 1.0f / fmaxf(fabsf(dtot), flo);
            float ssq = 0.f;
#pragma unroll
            for (int r = 0; r < 16; ++r) { hval[r] = num[r] * inv; ssq += hval[r] * hval[r]; }
            ssq += __shfl_xor(ssq, 32);
            if (hi == 0) PART[vt * 64 + jl] = ssq;
        }
        wg_sync();
        if (ch + 1 < NCH) ml_load_bulk(R, H, b, head, ch + 1, qoff, voff, rb0 == 0, tid);
        {
            const int dv = 32 * vt + r32, swv = tsw(dv);
#pragma unroll
            for (int x = 0; x < 2; ++x) { const int kt = 2 * jt + x; const int dk = 32 * kt + r32, swk = tsw(dk);
#pragma unroll
                for (int r = 0; r < 16; ++r) accC[x][r] *= a_dec;
#pragma unroll
                for (int ks = 0; ks < 4; ++ks) accC[x] = mfma32(*(const LAS bf16x8*)(VTs + dv * TP + 4 * ((4 * ks + 2 * hi) ^ swv)), *(const LAS bf16x8*)(KT + dk * TP + 4 * ((4 * ks + 2 * hi) ^ swk)), accC[x]);
#pragma unroll
                for (int r = 0; r < 16; ++r) CT[(32 * vt + crow(r, hi)) * QP + 32 * kt + r32] = (bf16_t)f2bf(accC[x][r]); }
            { const int kd = 16 * wid + (lanec & 15), sq = lanec >> 4; float s = 0.f;
              const u32x4 k0 = *(const LAS u32x4*)(KT + kd * TP + 16 * sq), k1 = *(const LAS u32x4*)(KT + kd * TP + 16 * sq + 8);
              s = (lo_bf(k0.x) + hi_bf(k0.x)) + (lo_bf(k0.y) + hi_bf(k0.y)) + (lo_bf(k0.z) + hi_bf(k0.z)) + (lo_bf(k0.w) + hi_bf(k0.w)) + (lo_bf(k1.x) + hi_bf(k1.x)) + (lo_bf(k1.y) + hi_bf(k1.y)) + (lo_bf(k1.z) + hi_bf(k1.z)) + (lo_bf(k1.w) + hi_bf(k1.w));
              s += __shfl_xor(s, 16); s += __shfl_xor(s, 32);
              const float nn = a_dec * NV[kd] + s; if (sq == 0) NV[kd] = nn; }
            const float stot = (PART[jl] + PART[64 + jl]) + (PART[128 + jl] + PART[192 + jl]);
            const float rstd = 1.0f / sqrtf(stot * (1.0f / 128.0f) + LN_EPS);
            const char* sgb = (const char*)(H + tok0 * LDH + C_OM + head * 128); char* hmb = (char*)(HM + tok0 * 512 + head * 128);
            const unsigned sgo = (unsigned)((jl * LDH + 32 * vt + 4 * hi) * 2), hmo = (unsigned)((jl * 512 + 32 * vt + 4 * hi) * 2);
#pragma unroll
            for (int g4 = 0; g4 < 4; ++g4) { const int v0 = 32 * vt + 8 * g4 + 4 * hi; const f32x4 gq = *(const LAS f32x4*)(GNL + v0);
                const u32x2 sg = *(const u32x2*)(sgb + (sgo + 16u * g4));
                u32x2 o; o.x = pk2(hval[4 * g4] * rstd * gq[0] * lo_bf(sg.x), hval[4 * g4 + 1] * rstd * gq[1] * hi_bf(sg.x));
                o.y = pk2(hval[4 * g4 + 2] * rstd * gq[2] * lo_bf(sg.y), hval[4 * g4 + 3] * rstd * gq[3] * hi_bf(sg.y));
                *(u32x2*)(hmb + (hmo + 16u * g4)) = o; }
        }
        m_prev = m_new;
        wg_sync();
    }
}

constexpr int KP = 72, VP = 68;
constexpr int A_KS = 0, A_VS = 2 * 64 * KP * 2, A_BT = A_VS + 2 * 64 * VP * 2, AT_LDS = A_BT + 129 * 4 + 12;
DEV int t5_bucket(int d) {
    if (d < 16) return d;
    if (d >= 114) return 31;
    int bk = 16;
    const int th[15] = {19, 21, 24, 27, 31, 35, 40, 46, 52, 59, 67, 77, 87, 99, 113};
#pragma unroll
    for (int i = 0; i < 15; ++i) bk += (d >= th[i]) ? 1 : 0;
    return bk;
}
DEV void attn_unit(const Ctx& c, int b, int h, int qb) {
    const int tid = c.tid, lane = c.lane, wid = c.wid, r32 = lane & 31, hi = lane >> 5;
    LAS unsigned char* lds = c.lds;
    LAS bf16_t* Ks = (LAS bf16_t*)(lds + A_KS); LAS bf16_t* Vs = (LAS bf16_t*)(lds + A_VS); LAS float* BT = (LAS float*)(lds + A_BT);
    bf16_t* Hq = wsp<bf16_t>(c, WS_H); const bf16_t* Kb = wsp<bf16_t>(c, WS_K); const bf16_t* VT = wsp<bf16_t>(c, WS_VT); const unsigned* MASK = wsp<unsigned>(c, WS_MASK);
    const size_t rowb = (size_t)b * SEQ; const int q0 = qb * 256, qw0 = q0 + 32 * wid, q = qw0 + r32;
    const int NT = (q0 + 256) / 64;
    if (tid <= 128) { const float far = par(c, P_RELB)[31 * 8 + h]; BT[tid] = (tid < 128) ? (par(c, P_RELB)[t5_bucket(tid) * 8 + h] - far) * LOG2E : 0.f; }
    bf16x8 qf[4];
#pragma unroll
    for (int ks = 0; ks < 4; ++ks) qf[ks] = *(const bf16x8*)(Hq + (rowb + q) * LDH + C_QA + h * 64 + ks * 16 + hi * 8);
    const int srow = tid >> 3, spc = tid & 7;
    const bf16_t* ksrc = Kb + (rowb + srow) * 512 + h * 64 + spc * 8;
    const bf16_t* vsrc = VT + (size_t)(h * 64 + srow) * M + rowb + spc * 8;
    u32x4 kreg = *(const u32x4*)ksrc, vreg = *(const u32x4*)vsrc;
    *(LAS u32x4*)(Ks + srow * KP + spc * 8) = kreg;
    { LAS u32x2* vd = (LAS u32x2*)(Vs + srow * VP + spc * 8); u32x2 a = {vreg.x, vreg.y}, bb = {vreg.z, vreg.w}; vd[0] = a; vd[1] = bb; }
    float mrun = -1e30f, lsum = 0.f;
    f32x16 o[2];
#pragma unroll
    for (int d = 0; d < 2; ++d)
#pragma unroll
        for (int r = 0; r < 16; ++r) o[d][r] = 0.f;
    wg_sync();
    for (int kt = 0; kt < NT; ++kt) {
        const int buf = kt & 1;
        if (kt + 1 < NT) { kreg = *(const u32x4*)(ksrc + (size_t)(kt + 1) * 64 * 512); vreg = *(const u32x4*)(vsrc + (size_t)(kt + 1) * 64); }
        if (64 * kt <= qw0 + 31) {
            const LAS bf16_t* kb = Ks + buf * 64 * KP; const LAS bf16_t* vb = Vs + buf * 64 * VP;
            const u32x2 mw = *(const u32x2*)(MASK + (rowb + q) * NWORDS + 2 * kt);
            f32x16 s[2];
#pragma unroll
            for (int a = 0; a < 2; ++a) {
#pragma unroll
                for (int r = 0; r < 16; ++r) s[a][r] = 0.f;
#pragma unroll
                for (int ks = 0; ks < 4; ++ks) s[a] = mfma32(*(const LAS bf16x8*)(kb + (32 * a + r32) * KP + ks * 16 + hi * 8), qf[ks], s[a]);
            }
            if (64 * kt + 63 + 128 > qw0) {
#pragma unroll
                for (int a = 0; a < 2; ++a)
#pragma unroll
                    for (int r = 0; r < 16; ++r) { int d = q - (64 * kt + 32 * a + crow(r, hi)); d = d < 0 ? 128 : (d > 128 ? 128 : d); s[a][r] += BT[d]; }
            }
            float mx = s[0][0];
#pragma unroll
            for (int a = 0; a < 2; ++a)
#pragma unroll
                for (int r = 0; r < 16; ++r) mx = fmaxf(mx, s[a][r]);
            mx = fmaxf(mx, __shfl_xor(mx, 32));
            const float mnew = fmaxf(mrun, mx), resc = fast_exp2(mrun - mnew);
            mrun = mnew; lsum *= resc;
#pragma unroll
            for (int d = 0; d < 2; ++d)
#pragma unroll
                for (int r = 0; r < 16; ++r) o[d][r] *= resc;
            float ps = 0.f;
#pragma unroll
            for (int a = 0; a < 2; ++a) {
                const unsigned w = (a ? mw.y : mw.x) >> (4 * hi);
                float p[16];
#pragma unroll
                for (int r = 0; r < 16; ++r) { const float e = fast_exp2(s[a][r] - mnew); p[r] = ((w >> ((r & 3) + 8 * (r >> 2))) & 1u) ? e : 0.f; ps += p[r]; }
#pragma unroll
                for (int s2 = 0; s2 < 2; ++s2) {
                    const bf16x8 pf = pack8(p[8 * s2], p[8 * s2 + 1], p[8 * s2 + 2], p[8 * s2 + 3], p[8 * s2 + 4], p[8 * s2 + 5], p[8 * s2 + 6], p[8 * s2 + 7]);
#pragma unroll
                    for (int d = 0; d < 2; ++d) {
                        const LAS bf16_t* vp = vb + (32 * d + r32) * VP + 32 * a + 16 * s2 + 4 * hi;
                        const s16x4 v0 = *(const LAS s16x4*)vp, v1 = *(const LAS s16x4*)(vp + 8);
                        const bf16x8 vf = {v0[0], v0[1], v0[2], v0[3], v1[0], v1[1], v1[2], v1[3]};
                        o[d] = mfma32(vf, pf, o[d]);
                    }
                }
            }
            lsum += ps;
        }
        if (kt + 1 < NT) {
            const int nb = buf ^ 1;
            *(LAS u32x4*)(Ks + nb * 64 * KP + srow * KP + spc * 8) = kreg;
            LAS u32x2* vd = (LAS u32x2*)(Vs + nb * 64 * VP + srow * VP + spc * 8); u32x2 a = {vreg.x, vreg.y}, bb = {vreg.z, vreg.w}; vd[0] = a; vd[1] = bb;
        }
        wg_sync();
    }
    lsum += __shfl_xor(lsum, 32);
    const float il = 1.0f / lsum;
#pragma unroll
    for (int d = 0; d < 2; ++d)
#pragma unroll
        for (int g4 = 0; g4 < 4; ++g4) { u32x2 w; w.x = pk2(o[d][4 * g4] * il, o[d][4 * g4 + 1] * il); w.y = pk2(o[d][4 * g4 + 2] * il, o[d][4 * g4 + 3] * il);
            *(u32x2*)(Hq + (rowb + q) * LDH + C_OA + h * 64 + 32 * d + 8 * g4 + 4 * hi) = w; }
}

DEV void ln_row(const f32x4 (&v)[4], const float* g, const float* bta, int lane, f32x4 (&y)[4]) {
    float s = 0.f;
#pragma unroll
    for (int j = 0; j < 4; ++j) s += (v[j][0] + v[j][1]) + (v[j][2] + v[j][3]);
    const float mean = wave_sum(s) * (1.0f / DM); float s2 = 0.f;
#pragma unroll
    for (int j = 0; j < 4; ++j) { const f32x4 d = v[j] - mean; s2 += (d[0] * d[0] + d[1] * d[1]) + (d[2] * d[2] + d[3] * d[3]); }
    const float rstd = 1.0f / sqrtf(wave_sum(s2) * (1.0f / DM) + LN_EPS);
#pragma unroll
    for (int j = 0; j < 4; ++j) { const f32x4 gg = *((const f32x4*)g + lane + 64 * j), bb = *((const f32x4*)bta + lane + 64 * j); y[j] = (v[j] - mean) * rstd * gg + bb; }
}
DEV void phase_ln1_router(const Ctx& c) {
    LAS float* RW = (LAS float*)c.lds; LAS int* LC = (LAS int*)(c.lds + 1024 * 20 * 4); LAS int* GB = LC + 16;
    for (int i = c.tid; i < 1024 * 20; i += NTHREADS) { const int k = i / 20, j = i % 20; RW[i] = (j < 4) ? par(c, P_WGRP)[k * 4 + j] : par(c, P_WRT)[k * 16 + (j - 4)]; }
    if (c.tid < 16) LC[c.tid] = 0;
    wg_sync();
    const float* Z = wsp<float>(c, WS_Z); float* X1 = c.out; bf16_t* X1B = wsp<bf16_t>(c, WS_X1B);
    int* TOKE = wsp<int>(c, WS_TOK); int* TOKS = TOKE + 2 * M; float* TOKW = (float*)(TOKS + 2 * M);
    const int rpw = (M + c.G - 1) / c.G, r0 = c.bid * rpw, r1 = (r0 + rpw < M) ? r0 + rpw : M;
    for (int m = r0 + c.wid; m < r1; m += NWAVES) {
        f32x4 v[4], y[4];
#pragma unroll
        for (int j = 0; j < 4; ++j) v[j] = *((const f32x4*)(Z + (size_t)m * DM) + c.lane + 64 * j);
        ln_row(v, par(c, P_LN1G), par(c, P_LN1B), c.lane, y);
#pragma unroll
        for (int j = 0; j < 4; ++j) { *((f32x4*)(X1 + (size_t)m * DM) + c.lane + 64 * j) = y[j]; u32x2 w; w.x = pk2(y[j][0], y[j][1]); w.y = pk2(y[j][2], y[j][3]); *((u32x2*)(X1B + (size_t)m * DM) + c.lane + 64 * j) = w; }
        float lg[20];
#pragma unroll
        for (int e = 0; e < 20; ++e) lg[e] = 0.f;
#pragma unroll
        for (int j = 0; j < 4; ++j)
#pragma unroll
            for (int x = 0; x < 4; ++x) { const int k = 4 * c.lane + 256 * j + x; const float xv = y[j][x];
#pragma unroll
                for (int e4 = 0; e4 < 5; ++e4) { const f32x4 w = *(const LAS f32x4*)(RW + k * 20 + 4 * e4); lg[4 * e4] += xv * w[0]; lg[4 * e4 + 1] += xv * w[1]; lg[4 * e4 + 2] += xv * w[2]; lg[4 * e4 + 3] += xv * w[3]; } }
#pragma unroll
        for (int e = 0; e < 20; ++e) lg[e] = wave_sum(lg[e]);
        if (c.lane == 0) {
            float gl[4]; int gi = 0;
#pragma unroll
            for (int j = 0; j < 4; ++j) gl[j] = lg[j] + par(c, P_BGRP)[j];
#pragma unroll
            for (int j = 1; j < 4; ++j) if (gl[j] > gl[gi]) gi = j;
            float se = 0.f;
#pragma unroll
            for (int j = 0; j < 4; ++j) se += __expf(gl[j] - gl[gi]);
            const float gw = 1.0f / se;
            float el[4];
#pragma unroll
            for (int j = 0; j < 4; ++j) { float t = 0.f;
#pragma unroll
                for (int g2 = 0; g2 < 4; ++g2) if (g2 == gi) t = lg[4 + 4 * g2 + j] + par(c, P_BRT)[4 * g2 + j];
                el[j] = t; }
            int i0 = 0;
#pragma unroll
            for (int j = 1; j < 4; ++j) if (el[j] > el[i0]) i0 = j;
            int i1 = (i0 == 0) ? 1 : 0;
#pragma unroll
            for (int j = 0; j < 4; ++j) if (j != i0 && el[j] > el[i1]) i1 = j;
            const float p1 = 1.0f / (1.0f + __expf(el[i1] - el[i0]));
            const int e0 = gi * 4 + i0, e1 = gi * 4 + i1;
            const int s0 = atomicAdd((int*)&LC[e0], 1), s1 = atomicAdd((int*)&LC[e1], 1);
            TOKE[2 * m] = e0; TOKE[2 * m + 1] = e1; TOKS[2 * m] = s0; TOKS[2 * m + 1] = s1; TOKW[2 * m] = p1 * gw; TOKW[2 * m + 1] = (1.0f - p1) * gw;
        }
    }
#ifndef EMU
    __threadfence_block();
#endif
    wg_sync();
    if (c.tid < 16) GB[c.tid] = (int)atomicAdd(wsp<unsigned>(c, WS_CTL) + CW_CNT + c.tid, (unsigned)LC[c.tid]);
    wg_sync();
    for (int i = r0 * 2 + c.tid; i < r1 * 2; i += NTHREADS) TOKS[i] += GB[TOKE[i]];
}
DEV void moe_bases(const Ctx& c, int (&base)[NE], int& total_tiles) {
    const unsigned* cnt = wsp<unsigned>(c, WS_CTL) + CW_CNT; int acc = 0;
#pragma unroll
    for (int e = 0; e < NE; ++e) { base[e] = acc; acc += (((int)cnt[e] + 255) / 256) * 256; }
    total_tiles = acc / 256;
}
DEV void phase_gather(const Ctx& c) {
    int base[NE], nt; moe_bases(c, base, nt);
    const bf16_t* X1B = wsp<bf16_t>(c, WS_X1B); bf16_t* XS = wsp<bf16_t>(c, WS_XS);
    int* TOKE = wsp<int>(c, WS_TOK); int* TOKS = TOKE + 2 * M;
    const int gw = c.bid * NWAVES + c.wid, NGW = c.G * NWAVES;
    for (int m = gw; m < M; m += NGW) {
        const u32x4 v0 = *((const u32x4*)(X1B + (size_t)m * DM) + c.lane), v1 = *((const u32x4*)(X1B + (size_t)m * DM) + 64 + c.lane);
#pragma unroll
        for (int a = 0; a < 2; ++a) { const int e = TOKE[2 * m + a]; int bs = 0;
#pragma unroll
            for (int j = 0; j < NE; ++j) if (j == e) bs = base[j];
            const int pos = bs + TOKS[2 * m + a];
            *((u32x4*)(XS + (size_t)pos * DM) + c.lane) = v0; *((u32x4*)(XS + (size_t)pos * DM) + 64 + c.lane) = v1; }
    }
}
DEV void phase_final(const Ctx& c) {
    int base[NE], nt; moe_bases(c, base, nt);
    const bf16_t* O2 = wsp<bf16_t>(c, WS_O2); float* X1 = c.out;
    const int* TOKE = wsp<int>(c, WS_TOK); const int* TOKS = TOKE + 2 * M; const float* TOKW = (const float*)(TOKS + 2 * M);
    const int gw = c.bid * NWAVES + c.wid, NGW = c.G * NWAVES;
    for (int m = gw; m < M; m += NGW) {
        int pos[2]; float w[2];
#pragma unroll
        for (int a = 0; a < 2; ++a) { const int e = TOKE[2 * m + a]; int bs = 0;
#pragma unroll
            for (int j = 0; j < NE; ++j) if (j == e) bs = base[j];
            pos[a] = bs + TOKS[2 * m + a]; w[a] = TOKW[2 * m + a]; }
        f32x4 v[4], y[4];
#pragma unroll
        for (int j = 0; j < 4; ++j) { const f32x4 xv = *((const f32x4*)(X1 + (size_t)m * DM) + c.lane + 64 * j);
            const u32x2 a0 = *((const u32x2*)(O2 + (size_t)pos[0] * DM) + c.lane + 64 * j), a1 = *((const u32x2*)(O2 + (size_t)pos[1] * DM) + c.lane + 64 * j);
            f32x4 t; t[0] = xv[0] * ALPHA + w[0] * lo_bf(a0.x) + w[1] * lo_bf(a1.x); t[1] = xv[1] * ALPHA + w[0] * hi_bf(a0.x) + w[1] * hi_bf(a1.x);
            t[2] = xv[2] * ALPHA + w[0] * lo_bf(a0.y) + w[1] * lo_bf(a1.y); t[3] = xv[3] * ALPHA + w[0] * hi_bf(a0.y) + w[1] * hi_bf(a1.y); v[j] = t; }
        ln_row(v, par(c, P_LN2G), par(c, P_LN2B), c.lane, y);
#pragma unroll
        for (int j = 0; j < 4; ++j) *((f32x4*)(c.out + (size_t)m * DM) + c.lane + 64 * j) = y[j];
    }
}

#ifndef EMU
#define XB_TMO      128
#define XB_XCNT(j)  (256  + 64 * (j))
#define XB_XSUB(j)  (1280 + 64 * (j))
#define XB_XGEN(j)  (2304 + 64 * (j))
#define XB_TOP      3328
#define XB_TOPGEN   3392
#define XCD_BAR_WORDS 3456
#define XB_SPIN_CAP (1u << 22)
__device__ __forceinline__ unsigned xb_ld(unsigned* p)              { return __hip_atomic_load(p, __ATOMIC_RELAXED, __HIP_MEMORY_SCOPE_AGENT); }
__device__ __forceinline__ unsigned xb_add(unsigned* p, unsigned v) { return __hip_atomic_fetch_add(p, v, __ATOMIC_RELAXED, __HIP_MEMORY_SCOPE_AGENT); }
__device__ __forceinline__ unsigned xb_xcc_id() { return (unsigned)__builtin_amdgcn_s_getreg((3 << 11) | 20) & 0xFu; }
#define XB_SPIN(cond, bar) do { unsigned _sp = 0; while (cond) { __builtin_amdgcn_s_sleep(1); \
    if ((++_sp & 255u) == 0u) { if (xb_ld(&(bar)[XB_TMO])) break; if (_sp > XB_SPIN_CAP) { atomicAdd(&(bar)[XB_TMO], 1u); break; } } } } while (0)
struct XcdBarrier { unsigned* bar; unsigned x; volatile LAS unsigned* st; };
__device__ __forceinline__ XcdBarrier xcd_barrier_post(unsigned* bar, volatile LAS unsigned* st) {
    XcdBarrier b; b.bar = bar; b.x = xb_xcc_id(); b.st = st;
    if (threadIdx.x == 0) (void)xb_add(&bar[XB_XCNT(b.x)], 1u);
    return b;
}
__device__ __forceinline__ void xcd_barrier_complete(unsigned* bar, unsigned x, unsigned& nloc, unsigned& nx) {
    const unsigned G = gridDim.x * gridDim.y * gridDim.z;
    unsigned sum, cnt, mine, sp = 0u;
    for (;;) {
        sum = 0u; cnt = 0u; mine = 0u;
#pragma unroll
        for (unsigned j = 0; j < 16; ++j) { const unsigned c = xb_ld(&bar[XB_XCNT(j)]); sum += c; cnt += (c > 0u) ? 1u : 0u; mine = (j == x) ? c : mine; }
        if (sum == G) break;
        __builtin_amdgcn_s_sleep(1);
        if ((++sp & 255u) == 0u) { if (xb_ld(&bar[XB_TMO])) break; if (sp > XB_SPIN_CAP) { atomicAdd(&bar[XB_TMO], 1u); break; } }
    }
    nloc = mine > 0u ? mine : 1u; nx = cnt > 0u ? cnt : 1u;
}
__device__ __forceinline__ void xcd_barrier(const XcdBarrier& b) {
    asm volatile("s_waitcnt vmcnt(0)" ::: "memory");
    __syncthreads();
    if (threadIdx.x == 0) {
        unsigned* bar = b.bar;
        __builtin_amdgcn_s_waitcnt(0);
        unsigned nloc = b.st[0], nx = b.st[1];
        if (nloc == 0u) { xcd_barrier_complete(bar, b.x, nloc, nx); b.st[0] = nloc; b.st[1] = nx; }
        const unsigned old = xb_add(&bar[XB_XSUB(b.x)], 1u);
        const unsigned gen = old / nloc;
        if (old + 1u == (gen + 1u) * nloc) {
            __builtin_amdgcn_fence(__ATOMIC_RELEASE, "agent");
            asm volatile("s_waitcnt vmcnt(0)" ::: "memory");
            const unsigned og = xb_add(&bar[XB_TOP], 1u);
            const unsigned tg = og / nx;
            if (og + 1u == (tg + 1u) * nx) xb_add(&bar[XB_TOPGEN], 1u);
            else XB_SPIN(xb_ld(&bar[XB_TOPGEN]) == tg, bar);
            __builtin_amdgcn_fence(__ATOMIC_ACQUIRE, "agent");
            xb_add(&bar[XB_XGEN(b.x)], 1u);
            asm volatile("s_waitcnt vmcnt(0)" ::: "memory");
        } else {
            XB_SPIN(xb_ld(&bar[XB_XGEN(b.x)]) == gen, bar);
            __builtin_amdgcn_fence(__ATOMIC_ACQUIRE, "agent");
            asm volatile("s_waitcnt vmcnt(0)" ::: "memory");
        }
    }
    __syncthreads();
}
#endif

constexpr int NPHASE = 11;
constexpr int LDS_BYTES = 144 * 1024;
static_assert(pg8::STAGE_BYTES <= LDS_BYTES - 1024 && IDX_LDS <= LDS_BYTES - 1024 && ML_LDS <= LDS_BYTES - 1024 && AT_LDS <= LDS_BYTES - 1024 && 8 * 16384 <= LDS_BYTES - 1024, "LDS budget");
constexpr int MISC_OFF = LDS_BYTES - 64;

DEV void run_phase(const Ctx& c0, int ph) {
    using namespace pg8;
    Ctx c = c0;
#ifndef EMU
    { int t = threadIdx.x; asm volatile("" : "+v"(t)); c.tid = t; c.lane = t & 63; c.wid = __builtin_amdgcn_readfirstlane(t >> 6); }
#endif
#ifdef EMU
    unsigned char* glds = c.lds;
#else
    PG8_LAS unsigned char* glds = c.lds;
#endif
    if (ph == 0) { phase_prologue(c); return; }
    if (ph == 1) {
        SchedStatic S; S.init(wsp<bf16_t>(c, R0), DM, wsp<bf16_t>(c, WS_WIN), DM, M, NWIN, DM, c.G, c.bid);
        EpiInProj E{wsp<bf16_t>(c, WS_H), wsp<bf16_t>(c, WS_KIDX), wsp<float>(c, WS_SM), wsp<float>(c, WS_SSQ)};
        gemm_phase(glds, S, E); return;
    }
    if (ph == 2 || ph == 11 || ph == 12) {
        const int nml = (ph == 12) ? 0 : ((c.G >= 4) ? c.G / 4 : 0);
        if (ph == 11) { for (int u = c.bid; u < NB * NHM; u += c.G) mlstm_unit(c, u / NHM, u % NHM); return; }
        if (c.bid < nml) {
#ifndef P2_REP_ML
#define P2_REP_ML 1
#endif
#ifndef P2_SKIP_ML
            for (int rep = 0; rep < P2_REP_ML; ++rep) for (int u = c.bid; u < NB * NHM; u += nml) mlstm_unit(c, u / NHM, u % NHM);
#endif
        } else {
            const int g2 = c.G - nml, c2 = c.bid - nml;
#ifndef P2_SKIP_KV
            { SchedStatic S; S.init(wsp<bf16_t>(c, WS_H) + C_CKV, LDH, wsp<bf16_t>(c, WS_WK), KVR, M, 512, KVR, g2, c2); EpiK E{wsp<bf16_t>(c, WS_K), wsp<float>(c, WS_SSQ)}; gemm_phase(glds, S, E); }
            { SchedStatic S; S.init(wsp<bf16_t>(c, WS_WV), KVR, wsp<bf16_t>(c, WS_H) + C_CKV, LDH, 512, M, KVR, g2, (c2 + (2 * g2) / 3) % g2); EpiVT E{wsp<bf16_t>(c, WS_VT), wsp<float>(c, WS_SSQ)}; gemm_phase(glds, S, E); }
#endif
            wg_sync();
            const int nq = SEQ / 16, nunits = NB * nq;
#ifndef P2_REP_IDX
#define P2_REP_IDX 1
#endif
#ifndef P2_SKIP_IDX
            for (int rep = 0; rep < P2_REP_IDX; ++rep) for (int u = c2; u < nunits; u += g2) { const int qt = nq - 1 - u / NB, b = u % NB; idx_unit(c, b, qt); }
#endif
        }
        return;
    }
    if (ph == 3) {
        const int nqb = SEQ / 256, nun = NB * HA * nqb;
        for (int u = c.bid; u < nun; u += c.G) {
            const int bh = u / nqb; int qi = u % nqb; const int round = (u / c.G) & 1; if (round) qi = nqb - 1 - qi;
            attn_unit(c, bh / HA, bh % HA, qi);
            wg_sync();
        }
        return;
    }
    if (ph == 4) {
        { SchedStatic S; S.init(wsp<bf16_t>(c, WS_H) + C_OA, LDH, wsp<bf16_t>(c, WS_WA), WA, M, DM, WA, c.G, c.bid); EpiUpA E{(bf16_t*)((unsigned char*)c.out + (size_t)M * 1024), wsp<bf16_t>(c, WS_H)}; gemm_phase(glds, S, E); }
        { SchedStatic S; S.init((const bf16_t*)c.out, WM, wsp<bf16_t>(c, WS_WM), WM, M, DM, WM, c.G, c.bid); EpiUpM E{wsp<bf16_t>(c, WS_Y), (const bf16_t*)((unsigned char*)c.out + (size_t)M * 1024), wsp<bf16_t>(c, WS_H)}; gemm_phase(glds, S, E); }
        return;
    }
    if (ph == 5) {
        SchedStatic S; S.init(wsp<bf16_t>(c, WS_Y), DM, wsp<bf16_t>(c, WS_WO), DM, M, DM, DM, c.G, c.bid); EpiOut E{wsp<float>(c, WS_Z), c.in[IN_X]}; gemm_phase(glds, S, E); return;
    }
    if (ph == 6) { phase_ln1_router(c); return; }
    if (ph == 7) { phase_gather(c); return; }
    if (ph == 8 || ph == 9) {
        int base[NE], nt; moe_bases(c, base, nt);
        SchedMoe S; S.ntiles = nt; S.nN = 4; S.G = c.G; S.c = c.bid;
#pragma unroll
        for (int e = 0; e < NE; ++e) S.tend[e] = ((e + 1 < NE) ? base[e + 1] : nt * 256) / 256;
        if (ph == 8) { S.K = DM; S.lda = DM; S.ldb = DM; S.A = wsp<bf16_t>(c, WS_XS); S.Bt = wsp<bf16_t>(c, WS_WGU); S.estride = (size_t)1024 * 1024; EpiMoe1 E{wsp<bf16_t>(c, WS_HD)}; gemm_phase(glds, S, E); }
        else { S.K = DE; S.lda = DE; S.ldb = DE; S.A = wsp<bf16_t>(c, WS_HD); S.Bt = wsp<bf16_t>(c, WS_WD); S.estride = (size_t)1024 * 512; EpiMoe2 E{wsp<bf16_t>(c, WS_O2)}; gemm_phase(glds, S, E); }
        return;
    }
    if (ph == 10) { phase_final(c); return; }
}

#ifndef EMU
__global__ void __launch_bounds__(NTHREADS, 2) fwd_kernel(Args args) {
    extern __shared__ __attribute__((aligned(16))) unsigned char lds_raw[];
    Ctx c;
#pragma unroll
    for (int i = 0; i < 25; ++i) c.in[i] = args.in[i];
    c.out = args.out; c.ws = args.ws; c.tid = threadIdx.x; c.lane = c.tid & 63; c.wid = __builtin_amdgcn_readfirstlane(c.tid >> 6); c.G = gridDim.x; c.bid = blockIdx.x;
    c.lds = (LAS unsigned char*)lds_raw;
    volatile LAS unsigned* MISC = (volatile LAS unsigned*)(c.lds + MISC_OFF);
    if (c.tid < 16) MISC[c.tid] = 0u;
    __syncthreads();
    const bool multi = (args.ph_hi - args.ph_lo) > 1;
    XcdBarrier bar; bar.bar = (unsigned*)(args.ws + WS_CTL) + CW_BAR; bar.x = 0; bar.st = nullptr;
    if (multi) bar = xcd_barrier_post((unsigned*)(args.ws + WS_CTL) + CW_BAR, MISC + 8);
#ifndef ONLY_PHASE
#define ONLY_PHASE -1
#endif
#ifndef DOUBLE_PHASE
#define DOUBLE_PHASE 8
#endif
#ifndef DOUBLE_PHASE2
#define DOUBLE_PHASE2 9
#endif
#define PHASE(k) if ((ONLY_PHASE < 0 || ONLY_PHASE == (k)) && args.ph_lo <= (k) && (k) < args.ph_hi) { if (DOUBLE_PHASE == (k) || DOUBLE_PHASE2 == (k)) { run_phase(c, (k)); xcd_barrier(bar); } run_phase(c, (k)); if ((k) + 1 < args.ph_hi) xcd_barrier(bar); }
#ifdef SPLIT_P2
    PHASE(0) PHASE(1) { run_phase(c, 11); xcd_barrier(bar); run_phase(c, 12); xcd_barrier(bar); } PHASE(3)
#else
    PHASE(0) PHASE(1) PHASE(2) PHASE(3)
#endif
    PHASE(4) PHASE(5) PHASE(6) PHASE(7) PHASE(8) PHASE(9) PHASE(10)
#undef PHASE
}

#ifndef N_LAUNCH_MODE
#define N_LAUNCH_MODE 0
#endif
extern "C" void kernel_launch(void* const* d_in, const int* in_sizes, int n_in, void* d_out, int out_size, void* d_ws, size_t ws_size, hipStream_t stream) {
    static int grid = 0;
    if (grid == 0) {
        if (n_in != 25 || out_size != M * DM || ws_size < WS_END) { fprintf(stderr, "kernel_launch: unexpected shapes (n_in %d out %d ws %zu need %zu)\n", n_in, out_size, ws_size, (size_t)WS_END); grid = -1; return; }
        int dev = 0, cus = 0, per_cu = 0;
        if (hipGetDevice(&dev) != hipSuccess || hipDeviceGetAttribute(&cus, hipDeviceAttributeMultiprocessorCount, dev) != hipSuccess) { grid = -1; return; }
        if (hipFuncSetAttribute((const void*)fwd_kernel, hipFuncAttributeMaxDynamicSharedMemorySize, LDS_BYTES) != hipSuccess) { fprintf(stderr, "kernel_launch: hipFuncSetAttribute failed\n"); grid = -1; return; }
        if (hipOccupancyMaxActiveBlocksPerMultiprocessor(&per_cu, (const void*)fwd_kernel, NTHREADS, LDS_BYTES) != hipSuccess || per_cu < 1) fprintf(stderr, "kernel_launch: occupancy query reports %d\n", per_cu);
        (void)hipGetLastError();
        grid = cus;
    }
    if (grid < 0) return;
    (void)hipMemsetAsync((char*)d_ws + WS_CTL, 0, CTL_ZERO_BYTES, stream);
    Args a{};
    for (int i = 0; i < 25; ++i) a.in[i] = (const float*)d_in[i];
    a.out = (float*)d_out; a.ws = (unsigned char*)d_ws;
    if (N_LAUNCH_MODE == 0) { a.ph_lo = 0; a.ph_hi = NPHASE; hipLaunchKernelGGL(fwd_kernel, dim3(grid), dim3(NTHREADS), LDS_BYTES, stream, a); }
    else { for (int p = 0; p < NPHASE; ++p) { a.ph_lo = p; a.ph_hi = p + 1; hipLaunchKernelGGL(fwd_kernel, dim3(grid), dim3(NTHREADS), LDS_BYTES, stream, a); } }
    (void)in_sizes;
}
#endif
```

```cpp
#ifdef EMU
#include "emu/emu.h"
#define DEV static inline
#define DEVM inline
#define LDS_SYNC() __syncthreads()
#define LAUNDER(x) do {} while (0)
#define WAVE_SYNC() e_wbar()
#define LAS
#else
#include <hip/hip_runtime.h>
#include <cstdio>
#include <cstdint>
#define DEV __device__ __forceinline__
#define DEVM __device__ __forceinline__
#define LDS_SYNC() asm volatile("s_waitcnt lgkmcnt(0)\n\ts_barrier" ::: "memory")
#define LAUNDER(x) asm volatile("" : "+v"(x))
#define WAVE_SYNC() asm volatile("s_waitcnt lgkmcnt(0)" ::: "memory")
#define LAS __attribute__((address_space(3)))
typedef short bf16x8 __attribute__((ext_vector_type(8)));
typedef float f32x16 __attribute__((ext_vector_type(16)));
typedef float f32x4 __attribute__((ext_vector_type(4)));
#endif
typedef unsigned u32x4 __attribute__((ext_vector_type(4)));
typedef unsigned u32x2 __attribute__((ext_vector_type(2)));
typedef short s16x4 __attribute__((ext_vector_type(4)));
typedef unsigned short bf16_t;
typedef unsigned long long u64;

#ifndef CFG_B
#define CFG_B 16
#endif
#ifndef CFG_S
#define CFG_S 2048
#endif
constexpr int NB = CFG_B, SEQ = CFG_S, DM = 1024, M = NB * SEQ;
constexpr int HA = 8, DA = 64, WA = 512, KVR = 256, TOPK = (SEQ / 4 < 256) ? SEQ / 4 : 256;
constexpr int NHM = 4, DHM = 128, WM = 512, CHUNK = 64, NCH = SEQ / CHUNK;
constexpr int NE = 16, DE = 512, MPAD = 2 * M + 4096;
constexpr float LN_EPS = 1e-5f, ALPHA = 1.189207115002721f;
constexpr float QSCALE = 0.125f * 1.4426950408889634f;
constexpr float LOG2E = 1.4426950408889634f;
constexpr int NWIN = 5632, LDH = 5376;
constexpr int C_OA = 768;
constexpr int C_QA = 0, C_CKV = 512, C_QI = 768, C_QM = 1280, C_KM = 1792, C_VM = 2304, C_OM = 2816, C_GA = 3328, C_GM = 4352;
constexpr int NWORDS = SEQ / 32;
constexpr int NWAVES = 8, NTHREADS = 512;

constexpr size_t MiB = 1u << 20;
constexpr size_t WS_CTL = 0, CTL_ZERO_BYTES = 64 * 1024;
constexpr size_t WS_WIN = 1 * MiB, WS_WK = 12 * MiB, WS_WV = 12 * MiB + 512 * 1024, WS_WA = 13 * MiB, WS_WM = 14 * MiB, WS_WO = 15 * MiB;
constexpr size_t WS_WGU = 17 * MiB, WS_WD = 49 * MiB, WS_TOK = 65 * MiB, WS_PAR = 65 * MiB + 768 * 1024;
static_assert((size_t)M * 24 <= 768 * 1024, "token tables fit below the parameter block");
constexpr int P_CONVW = 0, P_CONVB = 4096, P_BI = 5120, P_BF = 5124, P_MHG = 5128, P_RELB = 5640, P_LN1G = 5896, P_LN1B = 6920, P_WGRP = 7944, P_BGRP = 12040, P_WRT = 12044, P_BRT = 28428, P_LN2G = 28444, P_LN2B = 29468, P_END = 30492;
constexpr size_t R0 = 66 * MiB;
constexpr size_t R1 = R0 + (size_t)M * 2048;
constexpr size_t R2 = R1 + (size_t)M * LDH * 2;
constexpr size_t WS_KIDX = R2, WS_SM = WS_KIDX + (size_t)M * 128, WS_SSQ = WS_SM + (size_t)M * 64, WS_MASK = WS_SSQ + (size_t)M * 16, WS_END = WS_MASK + (size_t)M * NWORDS * 4;
constexpr size_t WS_K = R0, WS_VT = R0 + (size_t)M * 1024, WS_Y = R0;
#ifdef EMU
constexpr size_t WS_H = R1, WS_Z = R1, WS_X1B = R1 + (size_t)M * 4096, WS_XS = WS_END, WS_HD = WS_XS + (size_t)MPAD * 2048, WS_O2 = WS_HD + (size_t)MPAD * 1024, WS_TOTAL = WS_O2 + (size_t)MPAD * 2048;
#else
constexpr size_t WS_H = R1, WS_Z = R1, WS_X1B = R1 + (size_t)M * 4096, WS_XS = R1 + (size_t)M * 6144;
constexpr size_t WS_HD = R1, WS_O2 = R1 + (size_t)MPAD * 1024, WS_TOTAL = WS_END;
static_assert(WS_XS + (size_t)MPAD * 2048 <= R2, "XS fits in the H region");
static_assert(WS_O2 + (size_t)MPAD * 2048 <= R2, "O2 fits in the H region");
static_assert(WS_END <= 512 * MiB, "workspace budget");
#endif
constexpr int CW_CNT = 4096;
constexpr int CW_BAR = 8192;

struct Args { const float* in[25]; float* out; unsigned char* ws; int ph_lo, ph_hi; };

DEV unsigned fbits(float f) { unsigned u; __builtin_memcpy(&u, &f, 4); return u; }
DEV float bitsf(unsigned u) { float f; __builtin_memcpy(&f, &u, 4); return f; }
DEV unsigned f2bf(float f) { unsigned u = fbits(f); return (u + 0x7fffu + ((u >> 16) & 1u)) >> 16; }
DEV float bf2f(unsigned b) { return bitsf(b << 16); }
DEV unsigned pk2(float lo, float hi) {
#ifdef EMU
    return f2bf(lo) | (f2bf(hi) << 16);
#else
    typedef float f32x2_t __attribute__((ext_vector_type(2))); typedef __bf16 bf16x2_t __attribute__((ext_vector_type(2)));
    f32x2_t v = {lo, hi}; bf16x2_t b = __builtin_convertvector(v, bf16x2_t); return __builtin_bit_cast(unsigned, b);
#endif
}
DEV float lo_bf(unsigned w) { return bitsf(w << 16); }
DEV float hi_bf(unsigned w) { return bitsf(w & 0xffff0000u); }
DEV f32x16 mfma32(bf16x8 a, bf16x8 b, f32x16 c) {
#ifdef EMU
    return emu_mfma_32x32x16_bf16(a, b, c);
#else
    return __builtin_amdgcn_mfma_f32_32x32x16_bf16(a, b, c, 0, 0, 0);
#endif
}
DEV float fast_rcp(float x) {
#ifdef EMU
    return 1.0f / x;
#else
    return __builtin_amdgcn_rcpf(x);
#endif
}
DEV float fast_exp2(float x) {
#ifdef EMU
    return exp2f(x);
#else
    return __builtin_amdgcn_exp2f(x);
#endif
}
DEV float sigmoidf_(float x) { return fast_rcp(1.0f + __expf(-x)); }
DEV int crow(int r, int hi) { return (r & 3) + 8 * (r >> 2) + 4 * hi; }
DEV bf16x8 pack8(float a0, float a1, float a2, float a3, float a4, float a5, float a6, float a7) {
    u32x4 w; w.x = pk2(a0, a1); w.y = pk2(a2, a3); w.z = pk2(a4, a5); w.w = pk2(a6, a7); return __builtin_bit_cast(bf16x8, w);
}
DEV float wave_sum(float v) {
#pragma unroll
    for (int o = 1; o < 64; o <<= 1) v += __shfl_xor(v, o);
    return v;
}

namespace pg8 {
constexpr int BM = 256, BK = 64, HALF = 128, HTB = HALF * BK * 2, STAGE_BYTES = 8 * HTB, NXCD = 8, WGM = 8;
DEV int lds_byte(int r, int c) { const int st = (r >> 4) * 2 + (c >> 5), rr = r & 15, cc = c & 31, ob = rr * 64 + cc * 2; return st * 1024 + (ob ^ (((ob >> 9) & 1) << 5)); }
DEV void stage_rc(int b, int& R, int& C) { const int st = b / 1024, sb = b % 1024, swz = sb ^ (((sb >> 9) & 1) << 5); R = (st >> 1) * 16 + swz / 64; C = (st & 1) * 32 + (swz % 64) / 2; }
DEV int perm32(int rho) { const int n = rho >> 4, i = rho & 15; return 8 * (i >> 2) + 4 * n + (i & 3); }

struct Unit { int pm, pn, e; };
struct SchedStatic {
    int nM, nN, nwg, G, c, K, lda, ldb; const bf16_t* A; const bf16_t* Bt;
    DEVM void init(const bf16_t* A_, int lda_, const bf16_t* Bt_, int ldb_, int M_, int N_, int K_, int G_, int c_) { A = A_; lda = lda_; Bt = Bt_; ldb = ldb_; nM = M_ / BM; nN = N_ / BM; nwg = nM * nN; K = K_; G = G_; c = c_; }
    DEVM bool next(int i, Unit& u) const {
        const long L = (long)i * G + c; if (L >= nwg) return false;
        int wgid = (int)L; { const int q = nwg / NXCD, r = nwg % NXCD, xcd = wgid % NXCD, off = wgid / NXCD; wgid = (xcd < r ? xcd * (q + 1) : r * (q + 1) + (xcd - r) * q) + off; }
        const int nig = WGM * nN, gid = wgid / nig, fm = gid * WGM, gsz = (nM - fm) < WGM ? (nM - fm) : WGM;
        u.pm = fm + ((wgid % nig) % gsz); u.pn = (wgid % nig) / gsz; u.e = 0; return true;
    }
    DEVM const char* baseA(const Unit& u) const { return (const char*)(A + (size_t)u.pm * BM * lda); }
    DEVM const char* baseB(const Unit& u) const { return (const char*)(Bt + (size_t)u.pn * BM * ldb); }
};
struct SchedMoe {
    int ntiles, nN, G, c, K, lda, ldb; const bf16_t* A; const bf16_t* Bt; size_t estride; int tend[NE];
    DEVM bool next(int i, Unit& u) const {
        const long L = (long)i * G + c; if (L >= (long)ntiles * nN) return false;
        u.pm = (int)(L / nN); u.pn = (int)(L % nN); int e = 0;
#pragma unroll
        for (int j = 0; j < NE - 1; ++j) e += (u.pm >= tend[j]) ? 1 : 0;
        u.e = e; return true;
    }
    DEVM const char* baseA(const Unit& u) const { return (const char*)(A + (size_t)u.pm * BM * lda); }
    DEVM const char* baseB(const Unit& u) const { return (const char*)(Bt + (size_t)u.e * estride + (size_t)u.pn * BM * ldb); }
};

#ifdef EMU
template <class Epi, class Sched>
static inline void gemm_phase(unsigned char* lds, const Sched& S, const Epi& E) {
    const int tid = threadIdx.x, wid = tid >> 6, lane = tid & 63, wr = wid >> 2, wc = wid & 3, fr = lane & 15, fq = lane >> 4;
    Unit u;
    for (int i = 0; S.next(i, u); ++i) {
        f32x4 acc[2][2][4][2];
        const bf16_t* A = (const bf16_t*)S.baseA(u); const bf16_t* B = (const bf16_t*)S.baseB(u);
        for (int ai = 0; ai < 2; ++ai) for (int bj = 0; bj < 2; ++bj) for (int m = 0; m < 4; ++m) for (int n = 0; n < 2; ++n) for (int x = 0; x < 4; ++x) {
            const int r = 128 * ai + 64 * wr + 16 * m + fr, c = 128 * bj + 32 * wc + 8 * fq + 4 * n + x; float s = 0.f;
            for (int k = 0; k < S.K; ++k) s += bf2f(A[(size_t)r * S.lda + k]) * bf2f(B[(size_t)c * S.ldb + k]);
            acc[ai][bj][m][n][x] = s; }
        E(acc, u, wr, wc, fr, fq);
    }
    (void)lds;
}
#else
#define PG8_LAS __attribute__((address_space(3)))
template <class Epi, class Sched>
__device__ __forceinline__ void gemm_phase(PG8_LAS unsigned char* lds, const Sched& S, const Epi& E) {
    int tid = threadIdx.x; asm volatile("" : "+v"(tid));
    const int wid = __builtin_amdgcn_readfirstlane(tid >> 6), lane = tid & 63, wr = wid >> 2, wc = wid & 3, fr = lane & 15, fq = lane >> 4;
    const int K = S.K, nt = K / BK;
    unsigned voffA[2], voffB[2];
#pragma unroll
    for (int i = 0; i < 2; ++i) { int R, C; stage_rc(tid * 16 + i * 8192, R, C); const int Rb = (R & ~31) + perm32(R & 31);
        voffA[i] = (unsigned)(R * S.lda + C) * 2u; voffB[i] = (unsigned)(Rb * S.ldb + C) * 2u; }
    const size_t kstep = (size_t)(BK * 2);
    const size_t hstepA = (size_t)HALF * S.lda * 2, hstepB = (size_t)HALF * S.ldb * 2;
    const unsigned ldsw = (unsigned)wid * 1024u;
    const int aoff = lds_byte(wr * 64 + fr, fq * 8), boff = lds_byte(wc * 32 + fr, fq * 8);
#define PG8_SA(b, h) (((b) * 2 + (h)) * HTB)
#define PG8_SB(b, h) ((4 + (b) * 2 + (h)) * HTB)
#define PG8_STAGE(bufoff, gbase, voff) do { _Pragma("unroll") for (int _i = 0; _i < 2; ++_i) \
        __builtin_amdgcn_global_load_lds((const unsigned*)((const char*)(gbase) + (voff)[_i]), (PG8_LAS unsigned*)(lds + (bufoff) + ldsw + _i * 8192), 16, 0, 0); } while (0)
#define PG8_LDA(dst, b, h) do { _Pragma("unroll") for (int m = 0; m < 4; ++m) _Pragma("unroll") for (int k = 0; k < 2; ++k) dst[m][k] = *(const PG8_LAS bf16x8*)(lds + PG8_SA(b, h) + aoff + m * 2048 + k * 1024); } while (0)
#define PG8_LDB(dst, b, h) do { _Pragma("unroll") for (int n = 0; n < 2; ++n) _Pragma("unroll") for (int k = 0; k < 2; ++k) dst[n][k] = *(const PG8_LAS bf16x8*)(lds + PG8_SB(b, h) + boff + n * 2048 + k * 1024); } while (0)
#define PG8_MMA(ai, bj, At, Bt) do { __builtin_amdgcn_s_setprio(1); _Pragma("unroll") for (int m = 0; m < 4; ++m) _Pragma("unroll") for (int n = 0; n < 2; ++n) _Pragma("unroll") for (int k = 0; k < 2; ++k) \
        acc[ai][bj][m][n] = __builtin_amdgcn_mfma_f32_16x16x32_bf16(Bt[n][k], At[m][k], acc[ai][bj][m][n], 0, 0, 0); __builtin_amdgcn_s_setprio(0); } while (0)
#define PG8_WAIT_V(n) asm volatile("s_waitcnt vmcnt(" #n ")" ::: "memory")
#define PG8_WAIT_L(n) asm volatile("s_waitcnt lgkmcnt(" #n ")" ::: "memory")
#define PG8_BAR __builtin_amdgcn_s_barrier()
#define PG8_SCHED __builtin_amdgcn_sched_barrier(0)
    Unit cur, nxt; int ui = 0;
    if (!S.next(0, cur)) return;
    f32x4 acc[2][2][4][2];
#pragma unroll
    for (int a = 0; a < 2; ++a)
#pragma unroll
        for (int b = 0; b < 2; ++b)
#pragma unroll
            for (int m = 0; m < 4; ++m)
#pragma unroll
                for (int n = 0; n < 2; ++n) acc[a][b][m][n] = (f32x4){0.f, 0.f, 0.f, 0.f};
    bf16x8 At[4][2], B0[2][2], B1[2][2];
    const char* cA = S.baseA(cur); const char* cB = S.baseB(cur);
    PG8_STAGE(PG8_SB(0, 0), cB, voffB); PG8_STAGE(PG8_SB(0, 1), cB + hstepB, voffB); PG8_STAGE(PG8_SA(0, 0), cA, voffA); PG8_STAGE(PG8_SA(0, 1), cA + hstepA, voffA);
    if (wr == 1) PG8_BAR;
    PG8_WAIT_V(2); PG8_BAR;
    PG8_STAGE(PG8_SB(1, 0), cB + kstep, voffB); PG8_STAGE(PG8_SA(1, 0), cA + kstep, voffA); PG8_STAGE(PG8_SB(1, 1), cB + hstepB + kstep, voffB);
    PG8_WAIT_V(6); PG8_BAR;
    for (;;) {
        const bool has_next = S.next(ui + 1, nxt);
        const char* nA = has_next ? S.baseA(nxt) : cA; const char* nB = has_next ? S.baseB(nxt) : cB;
        for (int t = 0; t < nt; t += 2) {
            const bool last = (t == nt - 2);
            const char* a1 = cA + (size_t)(t + 1) * kstep;
            const char* a2 = last ? nA : cA + (size_t)(t + 2) * kstep; const char* b2 = last ? nB : cB + (size_t)(t + 2) * kstep;
            const char* a3 = a2 + kstep; const char* b3 = b2 + kstep;
            PG8_LDB(B0, 0, 0); PG8_LDB(B1, 0, 1); PG8_SCHED; PG8_LDA(At, 0, 0); PG8_STAGE(PG8_SA(1, 1), a1 + hstepA, voffA);
            PG8_WAIT_V(8); PG8_WAIT_L(0); PG8_BAR; PG8_MMA(0, 0, At, B0); PG8_MMA(0, 1, At, B1); PG8_BAR; PG8_SCHED;
            PG8_LDA(At, 0, 1); PG8_STAGE(PG8_SB(0, 0), b2, voffB); PG8_STAGE(PG8_SB(0, 1), b2 + hstepB, voffB); PG8_STAGE(PG8_SA(0, 0), a2, voffA);
            PG8_WAIT_V(8); PG8_WAIT_L(0); PG8_BAR; PG8_MMA(1, 0, At, B0); PG8_MMA(1, 1, At, B1); PG8_BAR; PG8_SCHED;
            PG8_LDB(B0, 1, 0); PG8_LDB(B1, 1, 1); PG8_SCHED; PG8_LDA(At, 1, 0); PG8_STAGE(PG8_SA(0, 1), a2 + hstepA, voffA);
            PG8_WAIT_V(8); PG8_WAIT_L(0); PG8_BAR; PG8_MMA(0, 0, At, B0); PG8_MMA(0, 1, At, B1); PG8_BAR; PG8_SCHED;
            PG8_LDA(At, 1, 1); PG8_STAGE(PG8_SB(1, 0), b3, voffB); PG8_STAGE(PG8_SB(1, 1), b3 + hstepB, voffB); PG8_STAGE(PG8_SA(1, 0), a3, voffA);
            PG8_WAIT_V(8); PG8_WAIT_L(0); PG8_BAR; PG8_MMA(1, 0, At, B0); PG8_MMA(1, 1, At, B1); PG8_BAR; PG8_SCHED;
        }
        if (wr == 0) PG8_BAR;
        E(acc, cur, wr, wc, fr, fq);
        if (!has_next) break;
#pragma unroll
        for (int a = 0; a < 2; ++a)
#pragma unroll
            for (int b = 0; b < 2; ++b)
#pragma unroll
                for (int m = 0; m < 4; ++m)
#pragma unroll
                    for (int n = 0; n < 2; ++n) acc[a][b][m][n] = (f32x4){0.f, 0.f, 0.f, 0.f};
        cur = nxt; cA = nA; cB = nB; ++ui;
        if (wr == 1) PG8_BAR;
    }
    PG8_WAIT_V(0);
    PG8_BAR;
#undef PG8_SA
#undef PG8_SB
#undef PG8_STAGE
#undef PG8_LDA
#undef PG8_LDB
#undef PG8_MMA
#undef PG8_WAIT_V
#undef PG8_WAIT_L
#undef PG8_BAR
#undef PG8_SCHED
}
#endif
}
using pg8::Unit;

#define EPI_ARGS const f32x4 (&acc)[2][2][4][2], const Unit& u, int wr, int wc, int fr, int fq
DEV u32x4 pack_row8(const f32x4& v0, const f32x4& v1) { u32x4 w; w.x = pk2(v0[0], v0[1]); w.y = pk2(v0[2], v0[3]); w.z = pk2(v1[0], v1[1]); w.w = pk2(v1[2], v1[3]); return w; }

struct EpiInProj {
    bf16_t* H; bf16_t* KIDX; float* SM; float* SSQ;
    DEVM void operator()(EPI_ARGS) const {
        const int row0 = u.pm * 256 + wr * 64 + fr;
        if (u.pn < 21) {
            const int col0 = u.pn * 256 + wc * 32 + 8 * fq; const bool sig = u.pn >= 11;
            if (u.pn == 2) {
#pragma unroll
                for (int ai = 0; ai < 2; ++ai)
#pragma unroll
                    for (int m = 0; m < 4; ++m) { float s = 0.f;
#pragma unroll
                        for (int bj = 0; bj < 2; ++bj)
#pragma unroll
                            for (int n = 0; n < 2; ++n) { const f32x4 x = acc[ai][bj][m][n]; s += (x[0] * x[0] + x[1] * x[1]) + (x[2] * x[2] + x[3] * x[3]); }
                        s += __shfl_xor(s, 16); s += __shfl_xor(s, 32);
                        if (fq == 0) SSQ[(size_t)(row0 + ai * 128 + m * 16) * 4 + wc] = s; }
            }
#pragma unroll
            for (int ai = 0; ai < 2; ++ai)
#pragma unroll
                for (int m = 0; m < 4; ++m) { bf16_t* rowp = H + (size_t)(row0 + ai * 128 + m * 16) * LDH + col0;
#pragma unroll
                    for (int bj = 0; bj < 2; ++bj) { f32x4 v0 = acc[ai][bj][m][0], v1 = acc[ai][bj][m][1];
                        if (sig) {
#pragma unroll
                            for (int x = 0; x < 4; ++x) { v0[x] = sigmoidf_(v0[x]); v1[x] = sigmoidf_(v1[x]); } }
                        *(u32x4*)(rowp + bj * 128) = pack_row8(v0, v1); } }
        } else {
#pragma unroll
            for (int ai = 0; ai < 2; ++ai)
#pragma unroll
                for (int m = 0; m < 4; ++m) { const size_t row = (size_t)(row0 + ai * 128 + m * 16);
                    if (wc < 2) *(u32x4*)(KIDX + row * 64 + wc * 32 + 8 * fq) = pack_row8(acc[ai][0][m][0], acc[ai][0][m][1]);
                    else if (wc == 2 && fq < 2) { *(f32x4*)(SM + row * 16 + 8 * fq) = acc[ai][0][m][0]; *(f32x4*)(SM + row * 16 + 8 * fq + 4) = acc[ai][0][m][1]; } }
        }
    }
};
DEV float rms_scale(const float* SSQ, size_t row) { const f32x4 q = *(const f32x4*)(SSQ + row * 4); return 1.0f / sqrtf(((q[0] + q[1]) + (q[2] + q[3])) * (1.0f / 256.0f) + LN_EPS); }
struct EpiK {
    bf16_t* Kb; const float* SSQ;
    DEVM void operator()(EPI_ARGS) const {
        const int row0 = u.pm * 256 + wr * 64 + fr, col0 = u.pn * 256 + wc * 32 + 8 * fq;
#pragma unroll
        for (int ai = 0; ai < 2; ++ai)
#pragma unroll
            for (int m = 0; m < 4; ++m) { const size_t row = (size_t)(row0 + ai * 128 + m * 16); const float s = rms_scale(SSQ, row);
#pragma unroll
                for (int bj = 0; bj < 2; ++bj) *(u32x4*)(Kb + row * 512 + col0 + bj * 128) = pack_row8(acc[ai][bj][m][0] * s, acc[ai][bj][m][1] * s); }
    }
};
struct EpiVT {
    bf16_t* VT; const float* SSQ;
    DEVM void operator()(EPI_ARGS) const {
        const int row0 = u.pm * 256 + wr * 64 + fr, col0 = u.pn * 256 + wc * 32 + 8 * fq;
        float sc[2][8];
#pragma unroll
        for (int bj = 0; bj < 2; ++bj)
#pragma unroll
            for (int x = 0; x < 8; ++x) sc[bj][x] = rms_scale(SSQ, (size_t)(col0 + bj * 128 + x));
#pragma unroll
        for (int ai = 0; ai < 2; ++ai)
#pragma unroll
            for (int m = 0; m < 4; ++m) { const size_t row = (size_t)(row0 + ai * 128 + m * 16);
#pragma unroll
                for (int bj = 0; bj < 2; ++bj) { f32x4 v0 = acc[ai][bj][m][0], v1 = acc[ai][bj][m][1];
#pragma unroll
                    for (int x = 0; x < 4; ++x) { v0[x] *= sc[bj][x]; v1[x] *= sc[bj][4 + x]; }
                    *(u32x4*)(VT + row * (size_t)M + col0 + bj * 128) = pack_row8(v0, v1); } }
    }
};
struct EpiUpA {
    bf16_t* Y1; const bf16_t* H;
    DEVM void operator()(EPI_ARGS) const {
        const int row0 = u.pm * 256 + wr * 64 + fr, col0 = u.pn * 256 + wc * 32 + 8 * fq;
#pragma unroll
        for (int ai = 0; ai < 2; ++ai)
#pragma unroll
            for (int m = 0; m < 4; ++m) { const size_t row = (size_t)(row0 + ai * 128 + m * 16);
#pragma unroll
                for (int bj = 0; bj < 2; ++bj) { const u32x4 g = *(const u32x4*)(H + row * LDH + C_GA + col0 + bj * 128);
                    f32x4 v0 = acc[ai][bj][m][0], v1 = acc[ai][bj][m][1];
                    v0[0] *= lo_bf(g.x); v0[1] *= hi_bf(g.x); v0[2] *= lo_bf(g.y); v0[3] *= hi_bf(g.y); v1[0] *= lo_bf(g.z); v1[1] *= hi_bf(g.z); v1[2] *= lo_bf(g.w); v1[3] *= hi_bf(g.w);
                    *(u32x4*)(Y1 + row * 1024 + col0 + bj * 128) = pack_row8(v0, v1); } }
    }
};
struct EpiUpM {
    bf16_t* Y; const bf16_t* Y1; const bf16_t* H;
    DEVM void operator()(EPI_ARGS) const {
        const int row0 = u.pm * 256 + wr * 64 + fr, col0 = u.pn * 256 + wc * 32 + 8 * fq;
#pragma unroll
        for (int ai = 0; ai < 2; ++ai)
#pragma unroll
            for (int m = 0; m < 4; ++m) { const size_t row = (size_t)(row0 + ai * 128 + m * 16);
#pragma unroll
                for (int bj = 0; bj < 2; ++bj) { const u32x4 g = *(const u32x4*)(H + row * LDH + C_GM + col0 + bj * 128); const u32x4 y = *(const u32x4*)(Y1 + row * 1024 + col0 + bj * 128);
                    f32x4 v0 = acc[ai][bj][m][0], v1 = acc[ai][bj][m][1];
                    v0[0] = v0[0] * lo_bf(g.x) + lo_bf(y.x); v0[1] = v0[1] * hi_bf(g.x) + hi_bf(y.x); v0[2] = v0[2] * lo_bf(g.y) + lo_bf(y.y); v0[3] = v0[3] * hi_bf(g.y) + hi_bf(y.y);
                    v1[0] = v1[0] * lo_bf(g.z) + lo_bf(y.z); v1[1] = v1[1] * hi_bf(g.z) + hi_bf(y.z); v1[2] = v1[2] * lo_bf(g.w) + lo_bf(y.w); v1[3] = v1[3] * hi_bf(g.w) + hi_bf(y.w);
                    *(u32x4*)(Y + row * 1024 + col0 + bj * 128) = pack_row8(v0, v1); } }
    }
};
struct EpiOut {
    float* Z; const float* X;
    DEVM void operator()(EPI_ARGS) const {
        const int row0 = u.pm * 256 + wr * 64 + fr, col0 = u.pn * 256 + wc * 32 + 8 * fq;
#pragma unroll
        for (int ai = 0; ai < 2; ++ai)
#pragma unroll
            for (int m = 0; m < 4; ++m) { const size_t off = (size_t)(row0 + ai * 128 + m * 16) * 1024 + col0;
#pragma unroll
                for (int bj = 0; bj < 2; ++bj)
#pragma unroll
                    for (int n = 0; n < 2; ++n) { const f32x4 xv = *(const f32x4*)(X + off + bj * 128 + 4 * n); *(f32x4*)(Z + off + bj * 128 + 4 * n) = acc[ai][bj][m][n] + xv * ALPHA; } }
    }
};
struct EpiMoe1 {
    bf16_t* HD;
    DEVM void operator()(EPI_ARGS) const {
        const int row0 = u.pm * 256 + wr * 64 + fr, col0 = u.pn * 128 + wc * 32 + 8 * fq;
#pragma unroll
        for (int ai = 0; ai < 2; ++ai)
#pragma unroll
            for (int m = 0; m < 4; ++m) { const size_t row = (size_t)(row0 + ai * 128 + m * 16);
                f32x4 v0, v1;
#pragma unroll
                for (int x = 0; x < 4; ++x) { const float g0 = acc[ai][0][m][0][x], g1 = acc[ai][0][m][1][x]; v0[x] = g0 * sigmoidf_(g0) * acc[ai][1][m][0][x]; v1[x] = g1 * sigmoidf_(g1) * acc[ai][1][m][1][x]; }
                *(u32x4*)(HD + row * 512 + col0) = pack_row8(v0, v1); }
    }
};
struct EpiMoe2 {
    bf16_t* O2;
    DEVM void operator()(EPI_ARGS) const {
        const int row0 = u.pm * 256 + wr * 64 + fr, col0 = u.pn * 256 + wc * 32 + 8 * fq;
#pragma unroll
        for (int ai = 0; ai < 2; ++ai)
#pragma unroll
            for (int m = 0; m < 4; ++m) { const size_t row = (size_t)(row0 + ai * 128 + m * 16);
#pragma unroll
                for (int bj = 0; bj < 2; ++bj) *(u32x4*)(O2 + row * 1024 + col0 + bj * 128) = pack_row8(acc[ai][bj][m][0], acc[ai][bj][m][1]); }
    }
};

struct Ctx {
    const float* in[25]; float* out; unsigned char* ws;
    int tid, lane, wid, G, bid;
    LAS unsigned char* lds;
};
#define IN_X 0
#define IN_WIN 1
#define IN_CONVW 2
#define IN_CONVB 3
#define IN_KVG 4
#define IN_WUK 5
#define IN_WUV 6
#define IN_RELB 7
#define IN_BI 8
#define IN_BF 9
#define IN_MHG 10
#define IN_WUPA 11
#define IN_WUPM 12
#define IN_WOUT 13
#define IN_LN1G 14
#define IN_LN1B 15
#define IN_WGRP 16
#define IN_BGRP 17
#define IN_WRT 18
#define IN_BRT 19
#define IN_WGATE 20
#define IN_WUP 21
#define IN_WDOWN 22
#define IN_LN2G 23
#define IN_LN2B 24
template <class T> DEV T* wsp(const Ctx& c, size_t off) { return (T*)(c.ws + off); }
DEV const float* par(const Ctx& c, int off) { return (const float*)(c.ws + WS_PAR) + off; }
DEV void wg_sync() { __syncthreads(); }

DEV int win_src_col(int n) {
    if (n < 1280) return n;
    if (n < 2816) return 1352 + (n - 1280);
    if (n < 5376) return 2896 + (n - 2816);
    if (n < 5440) return 1280 + (n - 5376);
    if (n < 5448) return 1344 + (n - 5440);
    if (n < 5456) return 2888 + (n - 5448);
    return -1;
}
DEV void p0_item(const float* W, const float* W2, int K, int Nsrc, bf16_t* WT, int mode, const float* aux, LAS float* scr, int item, int nblk, int lane) {
    const int kb = item / nblk, nb = item % nblk, k0 = 64 * kb, n0 = 32 * nb;
    const int nn = n0 + (lane & 31);
    int col = nn; const float* src = W; float cs = 1.0f;
    if (mode == 1) { col = win_src_col(nn); cs = (nn < 512) ? QSCALE : 1.0f; }
    if (mode == 3) { const int t = nn >> 8, j = nn & 255; col = t * 128 + (j & 127); src = (j < 128) ? W : W2; }
#pragma unroll 8
    for (int i = 0; i < 32; ++i) { const int kk = 2 * i + (lane >> 5); float v = 0.f;
        if (col >= 0) { v = src[(size_t)(k0 + kk) * Nsrc + col] * cs; if (mode == 2) v *= aux[k0 + kk]; }
        scr[kk * 33 + (lane & 31)] = v; }
    WAVE_SYNC();
    const int c = lane & 7;
#pragma unroll
    for (int j = 0; j < 4; ++j) { const int n = (lane >> 3) + 8 * j; const LAS float* s = scr + (8 * c) * 33 + n;
        u32x4 o; o.x = pk2(s[0 * 33], s[1 * 33]); o.y = pk2(s[2 * 33], s[3 * 33]); o.z = pk2(s[4 * 33], s[5 * 33]); o.w = pk2(s[6 * 33], s[7 * 33]);
        *(u32x4*)(WT + (size_t)(n0 + n) * K + k0 + 8 * c) = o; }
    WAVE_SYNC();
}
DEV void phase_prologue(const Ctx& c) {
    LAS float* scr = (LAS float*)(c.lds + c.wid * 16384);
    const int gw = c.bid * NWAVES + c.wid, NGW = c.G * NWAVES;
    constexpr int I_WIN = 16 * (NWIN / 32), I_KV = 4 * 16, I_UP = 8 * 32, I_WO = 16 * 32, I_GU = 16 * 32, I_D = 8 * 32;
    constexpr int NITEMS = I_WIN + 2 * I_KV + 2 * I_UP + I_WO + NE * I_GU + NE * I_D;
    for (int it = gw; it < NITEMS; it += NGW) {
        int r = it;
        if (r < I_WIN) { p0_item(c.in[IN_WIN], nullptr, 1024, 5456, wsp<bf16_t>(c, WS_WIN), 1, nullptr, scr, r, NWIN / 32, c.lane); continue; } r -= I_WIN;
        if (r < I_KV) { p0_item(c.in[IN_WUK], nullptr, 256, 512, wsp<bf16_t>(c, WS_WK), 2, c.in[IN_KVG], scr, r, 16, c.lane); continue; } r -= I_KV;
        if (r < I_KV) { p0_item(c.in[IN_WUV], nullptr, 256, 512, wsp<bf16_t>(c, WS_WV), 2, c.in[IN_KVG], scr, r, 16, c.lane); continue; } r -= I_KV;
        if (r < I_UP) { p0_item(c.in[IN_WUPA], nullptr, 512, 1024, wsp<bf16_t>(c, WS_WA), 0, nullptr, scr, r, 32, c.lane); continue; } r -= I_UP;
        if (r < I_UP) { p0_item(c.in[IN_WUPM], nullptr, 512, 1024, wsp<bf16_t>(c, WS_WM), 0, nullptr, scr, r, 32, c.lane); continue; } r -= I_UP;
        if (r < I_WO) { p0_item(c.in[IN_WOUT], nullptr, 1024, 1024, wsp<bf16_t>(c, WS_WO), 0, nullptr, scr, r, 32, c.lane); continue; } r -= I_WO;
        if (r < NE * I_GU) { const int e = r / I_GU; p0_item(c.in[IN_WGATE] + (size_t)e * 1024 * 512, c.in[IN_WUP] + (size_t)e * 1024 * 512, 1024, 512, wsp<bf16_t>(c, WS_WGU) + (size_t)e * 1024 * 1024, 3, nullptr, scr, r % I_GU, 32, c.lane); continue; } r -= NE * I_GU;
        { const int e = r / I_D; p0_item(c.in[IN_WDOWN] + (size_t)e * 512 * 1024, nullptr, 512, 1024, wsp<bf16_t>(c, WS_WD) + (size_t)e * 1024 * 512, 0, nullptr, scr, r % I_D, 32, c.lane); }
    }
    { float* P = wsp<float>(c, WS_PAR); const int gt = c.bid * NTHREADS + c.tid, ngt = c.G * NTHREADS;
      for (int i = gt; i < P_END; i += ngt) { float v;
        if (i < P_CONVB) v = c.in[IN_CONVW][i]; else if (i < P_BI) v = c.in[IN_CONVB][i - P_CONVB]; else if (i < P_BF) v = c.in[IN_BI][i - P_BI]; else if (i < P_MHG) v = c.in[IN_BF][i - P_BF];
        else if (i < P_RELB) v = c.in[IN_MHG][i - P_MHG]; else if (i < P_LN1G) v = c.in[IN_RELB][i - P_RELB]; else if (i < P_LN1B) v = c.in[IN_LN1G][i - P_LN1G]; else if (i < P_WGRP) v = c.in[IN_LN1B][i - P_LN1B];
        else if (i < P_BGRP) v = c.in[IN_WGRP][i - P_WGRP]; else if (i < P_WRT) v = c.in[IN_BGRP][i - P_BGRP]; else if (i < P_BRT) v = c.in[IN_WRT][i - P_WRT]; else if (i < P_LN2G) v = c.in[IN_BRT][i - P_BRT];
        else if (i < P_LN2B) v = c.in[IN_LN2G][i - P_LN2G]; else v = c.in[IN_LN2B][i - P_LN2B];
        P[i] = v; } }
    const float* X = c.in[IN_X]; bf16_t* XB = wsp<bf16_t>(c, R0);
    for (int m = gw; m < M; m += NGW) {
        const f32x4* xr = (const f32x4*)(X + (size_t)m * DM) + c.lane; u32x2* o = (u32x2*)(XB + (size_t)m * DM) + c.lane;
#pragma unroll
        for (int j = 0; j < 4; ++j) { const f32x4 v = xr[64 * j]; u32x2 w; w.x = pk2(v[0], v[1]); w.y = pk2(v[2], v[3]); o[64 * j] = w; }
    }
}

constexpr int SCP = SEQ + 32;
constexpr int I_WQ = 16 * SCP * 4, I_CAND = I_WQ + 512, I_HIST = I_CAND + NWAVES * 320, IDX_LDS = I_HIST + NWAVES * 1024;
constexpr int NR = SEQ / 64, NGRP = NR / 8;
static_assert(NR % 8 == 0, "SEQ must be a multiple of 512");
DEV unsigned lds_add(LAS unsigned* p, unsigned v) {
#ifdef EMU
    return __atomic_fetch_add(p, v, __ATOMIC_RELAXED);
#else
    return __hip_atomic_fetch_add(p, v, __ATOMIC_RELAXED, __HIP_MEMORY_SCOPE_WORKGROUP);
#endif
}
DEV void idx_select_row(const LAS float* scrow, int t, unsigned* out, LAS unsigned* hist, LAS unsigned* cand_lds, int lane) {
    if (t + 1 <= TOPK) {
        if (lane < NWORDS) { const int lo = 32 * lane; out[lane] = (lo + 31 <= t) ? 0xffffffffu : (lo > t ? 0u : ((1u << (t - lo + 1)) - 1u)); }
        return;
    }
    const int ng = (t >> 9) + 1;
    unsigned key[NR];
#pragma unroll
    for (int g = 0; g < NGRP; ++g) {
#pragma unroll
        for (int r8 = 0; r8 < 8; ++r8) key[8 * g + r8] = 0u;
        if (g < ng) {
#pragma unroll
            for (int r8 = 0; r8 < 8; ++r8) { const int s = (8 * g + r8) * 64 + lane; const float v = scrow[s <= t ? s : 0]; unsigned uu = fbits(v); uu = (uu & 0x80000000u) ? ~uu : (uu | 0x80000000u); key[8 * g + r8] = (s <= t) ? uu : 0u; }
        }
    }
    unsigned prefix = 0u; int cnt_hi = 0, und = 1 << 30, shift = 24;
#pragma unroll 1
    for (; shift >= 0; shift -= 8) {
        { u32x4 z = {0u, 0u, 0u, 0u}; *(LAS u32x4*)(hist + 4 * lane) = z; }
        WAVE_SYNC();
        const unsigned pfx = (shift == 24) ? 0u : (prefix >> (shift + 8));
#pragma unroll
        for (int g = 0; g < NGRP; ++g) if (g < ng) {
#pragma unroll
            for (int r8 = 0; r8 < 8; ++r8) { const unsigned k = key[8 * g + r8]; const bool m = (shift == 24) ? true : ((k >> (shift + 8)) == pfx); if (m) lds_add(hist + ((k >> shift) & 255u), 1u); }
        }
        WAVE_SYNC();
        const u32x4 h = *(const LAS u32x4*)(hist + 4 * lane);
        WAVE_SYNC();
        const int s4 = (int)(h.x + h.y + h.z + h.w); int suf = s4;
#pragma unroll
        for (int d = 1; d < 64; d <<= 1) { const int o = __shfl_down(suf, d); if (lane + d < 64) suf += o; }
        const int c3 = cnt_hi + suf - s4, c2 = c3 + (int)h.w, c1 = c2 + (int)h.z, c0 = c1 + (int)h.y;
        const bool f3 = c3 < TOPK && c3 + (int)h.w >= TOPK, f2 = c2 < TOPK && c2 + (int)h.z >= TOPK, f1 = c1 < TOPK && c1 + (int)h.y >= TOPK, f0 = c0 < TOPK && c0 + (int)h.x >= TOPK;
        const u64 fm = __ballot(f0 || f1 || f2 || f3);
        const int fl = (fm == 0ull) ? 0 : (63 - __builtin_clzll(fm));
        const int myd = f3 ? 3 : (f2 ? 2 : (f1 ? 1 : 0)), myc = f3 ? c3 : (f2 ? c2 : (f1 ? c1 : c0)), myu = (int)(f3 ? h.w : (f2 ? h.z : (f1 ? h.y : h.x)));
        const int D = 4 * fl + __shfl(myd, fl); cnt_hi = __shfl(myc, fl); und = __shfl(myu, fl);
        prefix |= (unsigned)D << shift;
        if (und <= 64) break;
    }
    unsigned lo = prefix; int cgt, cge;
    if (shift >= 0) {
        if (lane == 0) cand_lds[64] = 0u;
        WAVE_SYNC();
        const unsigned pfx = prefix >> shift;
#pragma unroll
        for (int g = 0; g < NGRP; ++g) if (g < ng) {
#pragma unroll
            for (int r8 = 0; r8 < 8; ++r8) { const unsigned k = key[8 * g + r8]; if ((k >> shift) == pfx) { const unsigned pos = lds_add(cand_lds + 64, 1u); cand_lds[pos & 63u] = k; } }
        }
        WAVE_SYNC();
        const bool cv = lane < und; const unsigned cand = cv ? cand_lds[lane] : 0u;
        WAVE_SYNC();
#pragma unroll 1
        for (int bit = shift - 1; bit >= 0; --bit) { const unsigned trial = lo | (1u << bit); const int cc = cnt_hi + __popcll(__ballot(cv && cand >= trial)); if (cc >= TOPK) lo = trial; }
        cgt = cnt_hi + __popcll(__ballot(cv && cand > lo)); cge = cnt_hi + __popcll(__ballot(cv && cand >= lo));
    } else { cgt = cnt_hi; cge = cnt_hi + und; }
    const int need = TOPK - cgt; u64 mym = 0;
    if (cge - cgt == need) {
#pragma unroll
        for (int g = 0; g < NGRP; ++g) if (g < ng) {
#pragma unroll
            for (int r8 = 0; r8 < 8; ++r8) { const u64 mm = __ballot(key[8 * g + r8] >= lo); if (lane == 8 * g + r8) mym = mm; }
        }
    } else {
        const u64 ltm = (lane == 0) ? 0ull : (~0ull >> (64 - lane)); int run = 0;
#pragma unroll
        for (int g = 0; g < NGRP; ++g) if (g < ng) {
#pragma unroll
            for (int r8 = 0; r8 < 8; ++r8) { const unsigned k = key[8 * g + r8]; const bool eqp = k == lo; const u64 eq = __ballot(eqp); const int rank = run + __popcll(eq & ltm);
                const bool sel = (k > lo) || (eqp && rank < need); const u64 mm = __ballot(sel); if (lane == 8 * g + r8) mym = mm; run += __popcll(eq); }
        }
    }
    if (lane < NR) { out[2 * lane] = (unsigned)mym; out[2 * lane + 1] = (unsigned)(mym >> 32); }
}
DEV void idx_load_b(bf16x8 (&bf)[4], const bf16_t* KIDX, size_t rowb, int kc, int r32, int hi) {
    const bf16_t* p = KIDX + (rowb + kc * 32 + r32) * 64 + hi * 8;
#pragma unroll
    for (int ks = 0; ks < 4; ++ks) bf[ks] = *(const bf16x8*)(p + ks * 16);
}
DEV void idx_unit(const Ctx& c, int b, int qt) {
    const int lane = c.lane, wid = c.wid, r32 = lane & 31, hi = lane >> 5;
    LAS float* sc = (LAS float*)c.lds; LAS float* WQ = (LAS float*)(c.lds + I_WQ); LAS unsigned* CAND = (LAS unsigned*)(c.lds + I_CAND) + wid * 80; LAS unsigned* HIST = (LAS unsigned*)(c.lds + I_HIST) + wid * 256;
    const bf16_t* H = wsp<bf16_t>(c, WS_H); const bf16_t* KIDX = wsp<bf16_t>(c, WS_KIDX); const float* SM = wsp<float>(c, WS_SM);
    unsigned* MASK = wsp<unsigned>(c, WS_MASK);
    const int t0 = qt * 16; const size_t rowb = (size_t)b * SEQ;
    const int nkc = (t0 + 16 + 31) / 32;
    if (c.tid < 128) WQ[c.tid] = SM[(rowb + t0 + (c.tid >> 3)) * 16 + (c.tid & 7)];
    {
        const int ah = (r32 & 3) + 4 * ((r32 >> 3) & 1), atl = 2 * (r32 >> 4) + ((r32 >> 2) & 1);
        bf16x8 af[4][4];
#pragma unroll
        for (int T = 0; T < 4; ++T)
#pragma unroll
            for (int ks = 0; ks < 4; ++ks) af[T][ks] = *(const bf16x8*)(H + (rowb + t0 + 4 * T + atl) * LDH + C_QI + ah * 64 + ks * 16 + hi * 8);
        bf16x8 bcur[4], bnxt[4];
        if (wid < nkc) idx_load_b(bcur, KIDX, rowb, wid, r32, hi);
        wg_sync();
        for (int kc = wid; kc < nkc; kc += NWAVES) {
            const bool more = kc + NWAVES < nkc;
            if (more) idx_load_b(bnxt, KIDX, rowb, kc + NWAVES, r32, hi);
            const int key = kc * 32 + r32;
#pragma unroll
            for (int T = 0; T < 4; ++T) {
                f32x16 a = {0.f, 0.f, 0.f, 0.f, 0.f, 0.f, 0.f, 0.f, 0.f, 0.f, 0.f, 0.f, 0.f, 0.f, 0.f, 0.f};
#pragma unroll
                for (int ks = 0; ks < 4; ++ks) a = mfma32(af[T][ks], bcur[ks], a);
                const int tq0 = 4 * T + hi;
                const f32x4 w00 = *(const LAS f32x4*)(WQ + tq0 * 8), w01 = *(const LAS f32x4*)(WQ + tq0 * 8 + 4), w10 = *(const LAS f32x4*)(WQ + (tq0 + 2) * 8), w11 = *(const LAS f32x4*)(WQ + (tq0 + 2) * 8 + 4);
                float s0 = 0.f, s1 = 0.f;
#pragma unroll
                for (int i = 0; i < 4; ++i) { s0 += w00[i] * fmaxf(a[i], 0.f) + w01[i] * fmaxf(a[4 + i], 0.f); s1 += w10[i] * fmaxf(a[8 + i], 0.f) + w11[i] * fmaxf(a[12 + i], 0.f); }
                sc[tq0 * SCP + key] = s0; sc[(tq0 + 2) * SCP + key] = s1;
            }
            if (more) {
#pragma unroll
                for (int ks = 0; ks < 4; ++ks) bcur[ks] = bnxt[ks]; }
        }
    }
    wg_sync();
#pragma unroll 1
    for (int qq = 0; qq < 2; ++qq) { const int tq = wid + 8 * qq, t = t0 + tq; idx_select_row(sc + tq * SCP, t, MASK + (rowb + t) * NWORDS, HIST, CAND, lane); }
    wg_sync();
}

constexpr int QP = 136, TP = 72;
constexpr int L_QS = 0, L_KS = L_QS + 64 * QP * 2, L_KT = L_KS + 64 * QP * 2, L_VT = L_KT + 128 * TP * 2, L_CT = L_VT + 128 * TP * 2, L_N = L_CT + 128 * QP * 2,
              L_G = L_N + 512, L_PART = L_G + NWAVES * 1280, L_CW = L_PART + 1024, L_GN = L_CW + 32 * 40 * 4, ML_LDS = L_GN + 512;
DEV float scan_add(float v, int lane) {
#pragma unroll
    for (int d = 1; d < 64; d <<= 1) { const float o = __shfl_up(v, d); if (lane >= d) v += o; }
    return v;
}
DEV float scan_max(float v, int lane) {
#pragma unroll
    for (int d = 1; d < 64; d <<= 1) { const float o = __shfl_up(v, d); if (lane >= d) v = fmaxf(v, o); }
    return v;
}
DEV int tsw(int d) { return 2 * ((d >> 3) & 7); }
struct MlRaw { u32x4 qk[7]; u32x4 v[2]; float fp, ip; };
DEV void ml_load_gates(MlRaw& R, const float* SM, int b, int head, int ch, int lane, float bfg, float bi) {
    const float* base = SM + ((size_t)b * SEQ + (size_t)ch * 64) * 16 + head;
    R.fp = *(const float*)((const char*)base + (unsigned)(lane * 64 + 48)) + bfg; R.ip = *(const float*)((const char*)base + (unsigned)(lane * 64 + 32)) + bi;
}
DEV void ml_load_bulk(MlRaw& R, const bf16_t* H, int b, int head, int ch, unsigned qoff, unsigned voff, bool first_rows, int tid) {
    const size_t rowc = (size_t)b * SEQ + (size_t)ch * 64;
#pragma unroll
    for (int i = 0; i < 7; ++i) {
        const bool neg = first_rows && ch == 0 && i < 3;
        const bf16_t* base = H + ((long)rowc + i - 3) * LDH;
        const u32x4 raw = *(const u32x4*)((const char*)base + (qoff + (neg ? 3u * LDH * 2u : 0u)));
        const u32x4 z = {0u, 0u, 0u, 0u};
        R.qk[i] = neg ? z : raw; }
#pragma unroll
    for (int o = 0; o < 2; ++o) { const bf16_t* base = H + (rowc + o) * LDH + C_VM + head * 128; R.v[o] = *(const u32x4*)((const char*)base + voff); }
    (void)tid;
}
DEV void mlstm_unit(const Ctx& c, int b, int head) {
    int tid = c.tid; LAUNDER(tid);
    const int lane = tid & 63, wid = c.wid;
    LAS unsigned char* lds = c.lds;
    LAS bf16_t* QS = (LAS bf16_t*)(lds + L_QS); LAS bf16_t* KS = (LAS bf16_t*)(lds + L_KS); LAS bf16_t* KT = (LAS bf16_t*)(lds + L_KT);
    LAS bf16_t* VTs = (LAS bf16_t*)(lds + L_VT); LAS bf16_t* CT = (LAS bf16_t*)(lds + L_CT); LAS float* NV = (LAS float*)(lds + L_N);
    LAS float* GW = (LAS float*)(lds + L_G + wid * 1280); LAS float* PART = (LAS float*)(lds + L_PART);
    const bf16_t* H = wsp<bf16_t>(c, WS_H); const float* SM = wsp<float>(c, WS_SM); bf16_t* HM = (bf16_t*)c.out;
    const float bi = par(c, P_BI)[head], bfg = par(c, P_BF)[head];
    const int vt = wid >> 1, jt = wid & 1;
    const int which = tid >> 8, cg0 = tid & 15, rb0 = (tid & 255) >> 4;
    LAS float* CWL = (LAS float*)(lds + L_CW); LAS float* GNL = (LAS float*)(lds + L_GN);
    for (int i = tid; i < 32 * 40; i += NTHREADS) { const int grp = i / 40, e = i % 40, wh = grp >> 4, cgi = grp & 15, ch0 = wh * 512 + head * 128 + cgi * 8;
        CWL[i] = (e < 32) ? par(c, P_CONVW)[(e >> 3) * 1024 + ch0 + (e & 7)] : par(c, P_CONVB)[ch0 + (e - 32)]; }
    if (tid < 128) GNL[tid] = par(c, P_MHG)[head * 128 + tid];
    f32x16 accC[2];
#pragma unroll
    for (int x = 0; x < 2; ++x)
#pragma unroll
        for (int r = 0; r < 16; ++r) accC[x][r] = 0.f;
    for (int i = tid; i < 128 * QP / 2; i += NTHREADS) ((LAS unsigned*)CT)[i] = 0u;
    if (tid < 128) NV[tid] = 0.f;
    float m_prev = 0.f;
    const unsigned qoff = (unsigned)((rb0 * 4 * LDH + (which ? C_KM : C_QM) + head * 128 + cg0 * 8) * 2), voff = (unsigned)(((tid >> 4) * 2 * LDH + (tid & 15) * 8) * 2);
    MlRaw R; ml_load_gates(R, SM, b, head, 0, lane, bfg, bi); ml_load_bulk(R, H, b, head, 0, qoff, voff, rb0 == 0, tid);
    wg_sync();
    for (int ch = 0; ch < NCH; ++ch) {
        const size_t tok0 = (size_t)b * SEQ + (size_t)ch * 64;
        int tidc = tid; LAUNDER(tidc);
        const int lanec = tidc & 63, r32 = lanec & 31, hi = lanec >> 5, cg = tidc & 15, rb = (tidc & 255) >> 4;
        const LAS float* cwp = CWL + (which * 16 + cg) * 40;
        float wp, a_dec, m_new;
        {
            const float fp = R.fp, ip = R.ip;
            const float lf = fminf(fp, 0.f) - __logf(1.0f + __expf(-fabsf(fp)));
            const float bcum = scan_add(lf, lanec);
            const float g = ip - bcum, gmax = scan_max(g, lanec);
            const float mj = fmaxf(bcum + m_prev, bcum + gmax);
            const float blast = __shfl(bcum, 63), gmx = __shfl(gmax, 63);
            m_new = fmaxf(blast + m_prev, blast + gmx);
            a_dec = __expf(blast + m_prev - m_new);
            wp = __expf(blast + g - m_new);
            GW[lanec] = g; GW[64 + lanec] = bcum - mj; GW[128 + lanec] = __expf(bcum + m_prev - mj); GW[192 + lanec] = __expf(-mj);
        }
        {
            float y[4][8];
#pragma unroll
            for (int o = 0; o < 4; ++o)
#pragma unroll
                for (int x = 0; x < 8; ++x) y[o][x] = cwp[32 + x];
#pragma unroll
            for (int i = 0; i < 7; ++i) {
                const u32x4 raw = R.qk[i];
                const float rv[8] = {lo_bf(raw.x), hi_bf(raw.x), lo_bf(raw.y), hi_bf(raw.y), lo_bf(raw.z), hi_bf(raw.z), lo_bf(raw.w), hi_bf(raw.w)};
#pragma unroll
                for (int o = 0; o < 4; ++o) { const int j = i - o; if (j >= 0 && j < 4) {
#pragma unroll
                    for (int x = 0; x < 8; ++x) y[o][x] += cwp[j * 8 + x] * rv[x]; } }
            }
            float wpr[4];
#pragma unroll
            for (int o = 0; o < 4; ++o) wpr[o] = __shfl(wp, rb * 4 + o);
#pragma unroll
            for (int o = 0; o < 4; ++o) {
                const int rr = rb * 4 + o;
#pragma unroll
                for (int x = 0; x < 8; ++x) { const float v = y[o][x]; y[o][x] = v * sigmoidf_(v) * (which ? 0.08838834764831845f : 1.0f); }
                const bf16x8 pk = pack8(y[o][0], y[o][1], y[o][2], y[o][3], y[o][4], y[o][5], y[o][6], y[o][7]);
                if (which == 0) *(LAS bf16x8*)(QS + rr * QP + cg * 8) = pk; else *(LAS bf16x8*)(KS + rr * QP + cg * 8) = pk;
            }
            if (which) {
#pragma unroll
                for (int x = 0; x < 8; ++x) { const int d = cg * 8 + x; u32x2 w; w.x = pk2(y[0][x] * wpr[0], y[1][x] * wpr[1]); w.y = pk2(y[2][x] * wpr[2], y[3][x] * wpr[3]);
                    *(LAS u32x2*)(KT + d * TP + 4 * (rb ^ tsw(d))) = w; }
            }
            { const int cgv = tidc & 15, rg2 = tidc >> 4;
                const unsigned w0[4] = {R.v[0].x, R.v[0].y, R.v[0].z, R.v[0].w}, w1[4] = {R.v[1].x, R.v[1].y, R.v[1].z, R.v[1].w};
#pragma unroll
                for (int x2 = 0; x2 < 4; ++x2) {
                    const int d0 = cgv * 8 + 2 * x2;
                    *(LAS unsigned*)(VTs + d0 * TP + 4 * ((rg2 >> 1) ^ tsw(d0)) + 2 * (rg2 & 1)) = (w0[x2] & 0xffffu) | (w1[x2] << 16);
                    *(LAS unsigned*)(VTs + (d0 + 1) * TP + 4 * ((rg2 >> 1) ^ tsw(d0 + 1)) + 2 * (rg2 & 1)) = (w0[x2] >> 16) | (w1[x2] & 0xffff0000u); }
            }
        }
        if (ch + 1 < NCH) { ml_load_gates(R, SM, b, head, ch + 1, lanec, bfg, bi); ml_load_bulk(R, H, b, head, ch + 1, qoff, voff, rb0 == 0, tid); }
        LDS_SYNC();
        float hval[16]; const int jl = 32 * jt + r32;
        u32x2 sgv[4];
        { const char* sgb = (const char*)(H + tok0 * LDH + C_OM + head * 128); const unsigned sgo = (unsigned)((jl * LDH + 32 * vt + 4 * hi) * 2);
#pragma unroll
          for (int g4 = 0; g4 < 4; ++g4) sgv[g4] = *(const u32x2*)(sgb + (sgo + 16u * g4)); }
        {
            const float ejl = GW[64 + jl], wint = GW[128 + jl], flo = GW[192 + jl];
            f32x16 num = {0.f, 0.f, 0.f, 0.f, 0.f, 0.f, 0.f, 0.f, 0.f, 0.f, 0.f, 0.f, 0.f, 0.f, 0.f, 0.f};
            float den = 0.f;
            bf16x8 qf[8];
#pragma unroll
            for (int ks = 0; ks < 8; ++ks) qf[ks] = *(const LAS bf16x8*)(QS + jl * QP + ks * 16 + hi * 8);
            const int dv = 32 * vt + r32, swv = tsw(dv);
#pragma unroll
            for (int a = 0; a < 2; ++a) {
                if (a <= jt) {
                    f32x16 st = {0.f, 0.f, 0.f, 0.f, 0.f, 0.f, 0.f, 0.f, 0.f, 0.f, 0.f, 0.f, 0.f, 0.f, 0.f, 0.f};
#pragma unroll
                    for (int ks = 0; ks < 8; ++ks) st = mfma32(*(const LAS bf16x8*)(KS + (32 * a + r32) * QP + ks * 16 + hi * 8), qf[ks], st);
                    float pv[16];
#pragma unroll
                    for (int g4 = 0; g4 < 4; ++g4) { const int sb = 32 * a + 8 * g4 + 4 * hi; const f32x4 gg = *(const LAS f32x4*)(GW + sb);
#pragma unroll
                        for (int x = 0; x < 4; ++x) { const int s = sb + x; const float v = (s <= jl) ? st[4 * g4 + x] * __expf(gg[x] + ejl) : 0.f; pv[4 * g4 + x] = v; den += v; } }
#pragma unroll
                    for (int s2 = 0; s2 < 2; ++s2) {
                        const bf16x8 pf = pack8(pv[8 * s2], pv[8 * s2 + 1], pv[8 * s2 + 2], pv[8 * s2 + 3], pv[8 * s2 + 4], pv[8 * s2 + 5], pv[8 * s2 + 6], pv[8 * s2 + 7]);
                        const int b0 = 8 * a + 4 * s2 + hi;
                        const s16x4 v0 = *(const LAS s16x4*)(VTs + dv * TP + 4 * (b0 ^ swv)), v1 = *(const LAS s16x4*)(VTs + dv * TP + 4 * ((b0 + 2) ^ swv));
                        const bf16x8 vf = {v0[0], v0[1], v0[2], v0[3], v1[0], v1[1], v1[2], v1[3]};
                        num = mfma32(vf, pf, num);
                    }
                }
            }
#pragma unroll
            for (int ks = 0; ks < 8; ++ks) { const u32x4 qw = __builtin_bit_cast(u32x4, qf[ks]);
                const bf16x8 qsc = pack8(lo_bf(qw.x) * wint, hi_bf(qw.x) * wint, lo_bf(qw.y) * wint, hi_bf(qw.y) * wint, lo_bf(qw.z) * wint, hi_bf(qw.z) * wint, lo_bf(qw.w) * wint, hi_bf(qw.w) * wint);
                num = mfma32(*(const LAS bf16x8*)(CT + (32 * vt + r32) * QP + ks * 16 + hi * 8), qsc, num); }
            float qn = 0.f;
#pragma unroll
            for (int ks = 0; ks < 8; ++ks) { const f32x4 n0 = *(const LAS f32x4*)(NV + 16 * ks + 8 * hi), n1 = *(const LAS f32x4*)(NV + 16 * ks + 8 * hi + 4); const u32x4 qw = __builtin_bit_cast(u32x4, qf[ks]);
                qn += lo_bf(qw.x) * n0[0] + hi_bf(qw.x) * n0[1] + lo_bf(qw.y) * n0[2] + hi_bf(qw.y) * n0[3] + lo_bf(qw.z) * n1[0] + hi_bf(qw.z) * n1[1] + lo_bf(qw.w) * n1[2] + hi_bf(qw.w) * n1[3]; }
            qn += __shfl_xor(qn, 32); den += __shfl_xor(den, 32);
            const float dtot = den + wint * qn; const float inv = 1.0f / fmaxf(fabsf(dtot), flo);
            float ssq = 0.f;
#pragma unroll
            for (int r = 0; r < 16; ++r) { hval[r] = num[r] * inv; ssq += hval[r] * hval[r]; }
            ssq += __shfl_xor(ssq, 32);
            if (hi == 0) PART[vt * 64 + jl] = ssq;
        }
        LDS_SYNC();
        {
            const int dv = 32 * vt + r32, swv = tsw(dv);
#pragma unroll
            for (int x = 0; x < 2; ++x) { const int kt = 2 * jt + x; const int dk = 32 * kt + r32, swk = tsw(dk);
#pragma unroll
                for (int r = 0; r < 16; ++r) accC[x][r] *= a_dec;
#pragma unroll
                for (int ks = 0; ks < 4; ++ks) accC[x] = mfma32(*(const LAS bf16x8*)(VTs + dv * TP + 4 * ((4 * ks + 2 * hi) ^ swv)), *(const LAS bf16x8*)(KT + dk * TP + 4 * ((4 * ks + 2 * hi) ^ swk)), accC[x]);
#pragma unroll
                for (int r = 0; r < 16; ++r) CT[(32 * vt + crow(r, hi)) * QP + 32 * kt + r32] = (bf16_t)f2bf(accC[x][r]); }
            { const int kd = 16 * wid + (lanec & 15), sq = lanec >> 4; float s = 0.f;
              const u32x4 k0 = *(const LAS u32x4*)(KT + kd * TP + 16 * sq), k1 = *(const LAS u32x4*)(KT + kd * TP + 16 * sq + 8);
              s = (lo_bf(k0.x) + hi_bf(k0.x)) + (lo_bf(k0.y) + hi_bf(k0.y)) + (lo_bf(k0.z) + hi_bf(k0.z)) + (lo_bf(k0.w) + hi_bf(k0.w)) + (lo_bf(k1.x) + hi_bf(k1.x)) + (lo_bf(k1.y) + hi_bf(k1.y)) + (lo_bf(k1.z) + hi_bf(k1.z)) + (lo_bf(k1.w) + hi_bf(k1.w));
              s += __shfl_xor(s, 16); s += __shfl_xor(s, 32);
              const float nn = a_dec * NV[kd] + s; if (sq == 0) NV[kd] = nn; }
            const float stot = (PART[jl] + PART[64 + jl]) + (PART[128 + jl] + PART[192 + jl]);
            const float rstd = 1.0f / sqrtf(stot * (1.0f / 128.0f) + LN_EPS);
            char* hmb = (char*)(HM + tok0 * 512 + head * 128);
            const unsigned hmo = (unsigned)((jl * 512 + 32 * vt + 4 * hi) * 2);
#pragma unroll
            for (int g4 = 0; g4 < 4; ++g4) { const int v0 = 32 * vt + 8 * g4 + 4 * hi; const f32x4 gq = *(const LAS f32x4*)(GNL + v0);
                const u32x2 sg = sgv[g4];
                u32x2 o; o.x = pk2(hval[4 * g4] * rstd * gq[0] * lo_bf(sg.x), hval[4 * g4 + 1] * rstd * gq[1] * hi_bf(sg.x));
                o.y = pk2(hval[4 * g4 + 2] * rstd * gq[2] * lo_bf(sg.y), hval[4 * g4 + 3] * rstd * gq[3] * hi_bf(sg.y));
                *(u32x2*)(hmb + (hmo + 16u * g4)) = o; }
        }
        m_prev = m_new;
        LDS_SYNC();
    }
}

constexpr int KP = 72, VP = 68;
constexpr int A_KS = 0, A_VS = 2 * 64 * KP * 2, A_BT = A_VS + 2 * 64 * VP * 2, AT_LDS = A_BT + 129 * 4 + 12;
DEV int t5_bucket(int d) {
    if (d < 16) return d;
    if (d >= 114) return 31;
    int bk = 16;
    const int th[15] = {19, 21, 24, 27, 31, 35, 40, 46, 52, 59, 67, 77, 87, 99, 113};
#pragma unroll
    for (int i = 0; i < 15; ++i) bk += (d >= th[i]) ? 1 : 0;
    return bk;
}
DEV void attn_unit(const Ctx& c, int b, int h, int qb) {
    const int tid = c.tid, lane = c.lane, wid = c.wid, r32 = lane & 31, hi = lane >> 5;
    LAS unsigned char* lds = c.lds;
    LAS bf16_t* Ks = (LAS bf16_t*)(lds + A_KS); LAS bf16_t* Vs = (LAS bf16_t*)(lds + A_VS); LAS float* BT = (LAS float*)(lds + A_BT);
    bf16_t* Hq = wsp<bf16_t>(c, WS_H); const bf16_t* Kb = wsp<bf16_t>(c, WS_K); const bf16_t* VT = wsp<bf16_t>(c, WS_VT); const unsigned* MASK = wsp<unsigned>(c, WS_MASK);
    const size_t rowb = (size_t)b * SEQ; const int q0 = qb * 256, qw0 = q0 + 32 * wid, q = qw0 + r32;
    const int NT = (q0 + 256) / 64;
    if (tid <= 128) { const float far = par(c, P_RELB)[31 * 8 + h]; BT[tid] = (tid < 128) ? (par(c, P_RELB)[t5_bucket(tid) * 8 + h] - far) * LOG2E : 0.f; }
    bf16x8 qf[4];
#pragma unroll
    for (int ks = 0; ks < 4; ++ks) qf[ks] = *(const bf16x8*)(Hq + (rowb + q) * LDH + C_QA + h * 64 + ks * 16 + hi * 8);
    const int srow = tid >> 3, spc = tid & 7;
    const bf16_t* ksrc = Kb + (rowb + srow) * 512 + h * 64 + spc * 8;
    const bf16_t* vsrc = VT + (size_t)(h * 64 + srow) * M + rowb + spc * 8;
    u32x4 kreg = *(const u32x4*)ksrc, vreg = *(const u32x4*)vsrc;
    *(LAS u32x4*)(Ks + srow * KP + spc * 8) = kreg;
    { LAS u32x2* vd = (LAS u32x2*)(Vs + srow * VP + spc * 8); u32x2 a = {vreg.x, vreg.y}, bb = {vreg.z, vreg.w}; vd[0] = a; vd[1] = bb; }
    float mrun = -1e30f, lsum = 0.f;
    f32x16 o[2];
#pragma unroll
    for (int d = 0; d < 2; ++d)
#pragma unroll
        for (int r = 0; r < 16; ++r) o[d][r] = 0.f;
    wg_sync();
    for (int kt = 0; kt < NT; ++kt) {
        const int buf = kt & 1;
        if (kt + 1 < NT) { kreg = *(const u32x4*)(ksrc + (size_t)(kt + 1) * 64 * 512); vreg = *(const u32x4*)(vsrc + (size_t)(kt + 1) * 64); }
        if (64 * kt <= qw0 + 31) {
            const LAS bf16_t* kb = Ks + buf * 64 * KP; const LAS bf16_t* vb = Vs + buf * 64 * VP;
            const u32x2 mw = *(const u32x2*)(MASK + (rowb + q) * NWORDS + 2 * kt);
            f32x16 s[2];
#pragma unroll
            for (int a = 0; a < 2; ++a) {
#pragma unroll
                for (int r = 0; r < 16; ++r) s[a][r] = 0.f;
#pragma unroll
                for (int ks = 0; ks < 4; ++ks) s[a] = mfma32(*(const LAS bf16x8*)(kb + (32 * a + r32) * KP + ks * 16 + hi * 8), qf[ks], s[a]);
            }
            if (64 * kt + 63 + 128 > qw0) {
#pragma unroll
                for (int a = 0; a < 2; ++a)
#pragma unroll
                    for (int r = 0; r < 16; ++r) { int d = q - (64 * kt + 32 * a + crow(r, hi)); d = d < 0 ? 128 : (d > 128 ? 128 : d); s[a][r] += BT[d]; }
            }
            float mx = s[0][0];
#pragma unroll
            for (int a = 0; a < 2; ++a)
#pragma unroll
                for (int r = 0; r < 16; ++r) mx = fmaxf(mx, s[a][r]);
            mx = fmaxf(mx, __shfl_xor(mx, 32));
            const float mnew = fmaxf(mrun, mx), resc = fast_exp2(mrun - mnew);
            mrun = mnew; lsum *= resc;
#pragma unroll
            for (int d = 0; d < 2; ++d)
#pragma unroll
                for (int r = 0; r < 16; ++r) o[d][r] *= resc;
            float ps = 0.f;
#pragma unroll
            for (int a = 0; a < 2; ++a) {
                const unsigned w = (a ? mw.y : mw.x) >> (4 * hi);
                float p[16];
#pragma unroll
                for (int r = 0; r < 16; ++r) { const float e = fast_exp2(s[a][r] - mnew); p[r] = ((w >> ((r & 3) + 8 * (r >> 2))) & 1u) ? e : 0.f; ps += p[r]; }
#pragma unroll
                for (int s2 = 0; s2 < 2; ++s2) {
                    const bf16x8 pf = pack8(p[8 * s2], p[8 * s2 + 1], p[8 * s2 + 2], p[8 * s2 + 3], p[8 * s2 + 4], p[8 * s2 + 5], p[8 * s2 + 6], p[8 * s2 + 7]);
#pragma unroll
                    for (int d = 0; d < 2; ++d) {
                        const LAS bf16_t* vp = vb + (32 * d + r32) * VP + 32 * a + 16 * s2 + 4 * hi;
                        const s16x4 v0 = *(const LAS s16x4*)vp, v1 = *(const LAS s16x4*)(vp + 8);
                        const bf16x8 vf = {v0[0], v0[1], v0[2], v0[3], v1[0], v1[1], v1[2], v1[3]};
                        o[d] = mfma32(vf, pf, o[d]);
                    }
                }
            }
            lsum += ps;
        }
        if (kt + 1 < NT) {
            const int nb = buf ^ 1;
            *(LAS u32x4*)(Ks + nb * 64 * KP + srow * KP + spc * 8) = kreg;
            LAS u32x2* vd = (LAS u32x2*)(Vs + nb * 64 * VP + srow * VP + spc * 8); u32x2 a = {vreg.x, vreg.y}, bb = {vreg.z, vreg.w}; vd[0] = a; vd[1] = bb;
        }
        wg_sync();
    }
    lsum += __shfl_xor(lsum, 32);
    const float il = 1.0f / lsum;
#pragma unroll
    for (int d = 0; d < 2; ++d)
#pragma unroll
        for (int g4 = 0; g4 < 4; ++g4) { u32x2 w; w.x = pk2(o[d][4 * g4] * il, o[d][4 * g4 + 1] * il); w.y = pk2(o[d][4 * g4 + 2] * il, o[d][4 * g4 + 3] * il);
            *(u32x2*)(Hq + (rowb + q) * LDH + C_OA + h * 64 + 32 * d + 8 * g4 + 4 * hi) = w; }
}

DEV void ln_row(const f32x4 (&v)[4], const float* g, const float* bta, int lane, f32x4 (&y)[4]) {
    float s = 0.f;
#pragma unroll
    for (int j = 0; j < 4; ++j) s += (v[j][0] + v[j][1]) + (v[j][2] + v[j][3]);
    const float mean = wave_sum(s) * (1.0f / DM); float s2 = 0.f;
#pragma unroll
    for (int j = 0; j < 4; ++j) { const f32x4 d = v[j] - mean; s2 += (d[0] * d[0] + d[1] * d[1]) + (d[2] * d[2] + d[3] * d[3]); }
    const float rstd = 1.0f / sqrtf(wave_sum(s2) * (1.0f / DM) + LN_EPS);
#pragma unroll
    for (int j = 0; j < 4; ++j) { const f32x4 gg = *((const f32x4*)g + lane + 64 * j), bb = *((const f32x4*)bta + lane + 64 * j); y[j] = (v[j] - mean) * rstd * gg + bb; }
}
DEV void phase_ln1_router(const Ctx& c) {
    LAS float* RW = (LAS float*)c.lds; LAS int* LC = (LAS int*)(c.lds + 1024 * 20 * 4); LAS int* GB = LC + 16;
    for (int i = c.tid; i < 1024 * 20; i += NTHREADS) { const int k = i / 20, j = i % 20; RW[i] = (j < 4) ? par(c, P_WGRP)[k * 4 + j] : par(c, P_WRT)[k * 16 + (j - 4)]; }
    if (c.tid < 16) LC[c.tid] = 0;
    wg_sync();
    const float* Z = wsp<float>(c, WS_Z); float* X1 = c.out; bf16_t* X1B = wsp<bf16_t>(c, WS_X1B);
    int* TOKE = wsp<int>(c, WS_TOK); int* TOKS = TOKE + 2 * M; float* TOKW = (float*)(TOKS + 2 * M);
    const int rpw = (M + c.G - 1) / c.G, r0 = c.bid * rpw, r1 = (r0 + rpw < M) ? r0 + rpw : M;
    for (int m = r0 + c.wid; m < r1; m += NWAVES) {
        f32x4 v[4], y[4];
#pragma unroll
        for (int j = 0; j < 4; ++j) v[j] = *((const f32x4*)(Z + (size_t)m * DM) + c.lane + 64 * j);
        ln_row(v, par(c, P_LN1G), par(c, P_LN1B), c.lane, y);
#pragma unroll
        for (int j = 0; j < 4; ++j) { *((f32x4*)(X1 + (size_t)m * DM) + c.lane + 64 * j) = y[j]; u32x2 w; w.x = pk2(y[j][0], y[j][1]); w.y = pk2(y[j][2], y[j][3]); *((u32x2*)(X1B + (size_t)m * DM) + c.lane + 64 * j) = w; }
        float lg[20];
#pragma unroll
        for (int e = 0; e < 20; ++e) lg[e] = 0.f;
#pragma unroll
        for (int j = 0; j < 4; ++j)
#pragma unroll
            for (int x = 0; x < 4; ++x) { const int k = 4 * c.lane + 256 * j + x; const float xv = y[j][x];
#pragma unroll
                for (int e4 = 0; e4 < 5; ++e4) { const f32x4 w = *(const LAS f32x4*)(RW + k * 20 + 4 * e4); lg[4 * e4] += xv * w[0]; lg[4 * e4 + 1] += xv * w[1]; lg[4 * e4 + 2] += xv * w[2]; lg[4 * e4 + 3] += xv * w[3]; } }
#pragma unroll
        for (int e = 0; e < 20; ++e) lg[e] = wave_sum(lg[e]);
        if (c.lane == 0) {
            float gl[4]; int gi = 0;
#pragma unroll
            for (int j = 0; j < 4; ++j) gl[j] = lg[j] + par(c, P_BGRP)[j];
#pragma unroll
            for (int j = 1; j < 4; ++j) if (gl[j] > gl[gi]) gi = j;
            float se = 0.f;
#pragma unroll
            for (int j = 0; j < 4; ++j) se += __expf(gl[j] - gl[gi]);
            const float gw = 1.0f / se;
            float el[4];
#pragma unroll
            for (int j = 0; j < 4; ++j) { float t = 0.f;
#pragma unroll
                for (int g2 = 0; g2 < 4; ++g2) if (g2 == gi) t = lg[4 + 4 * g2 + j] + par(c, P_BRT)[4 * g2 + j];
                el[j] = t; }
            int i0 = 0;
#pragma unroll
            for (int j = 1; j < 4; ++j) if (el[j] > el[i0]) i0 = j;
            int i1 = (i0 == 0) ? 1 : 0;
#pragma unroll
            for (int j = 0; j < 4; ++j) if (j != i0 && el[j] > el[i1]) i1 = j;
            const float p1 = 1.0f / (1.0f + __expf(el[i1] - el[i0]));
            const int e0 = gi * 4 + i0, e1 = gi * 4 + i1;
            const int s0 = atomicAdd((int*)&LC[e0], 1), s1 = atomicAdd((int*)&LC[e1], 1);
            TOKE[2 * m] = e0; TOKE[2 * m + 1] = e1; TOKS[2 * m] = s0; TOKS[2 * m + 1] = s1; TOKW[2 * m] = p1 * gw; TOKW[2 * m + 1] = (1.0f - p1) * gw;
        }
    }
#ifndef EMU
    __threadfence_block();
#endif
    wg_sync();
    if (c.tid < 16) GB[c.tid] = (int)atomicAdd(wsp<unsigned>(c, WS_CTL) + CW_CNT + c.tid, (unsigned)LC[c.tid]);
    wg_sync();
    for (int i = r0 * 2 + c.tid; i < r1 * 2; i += NTHREADS) TOKS[i] += GB[TOKE[i]];
}
DEV void moe_bases(const Ctx& c, int (&base)[NE], int& total_tiles) {
    const unsigned* cnt = wsp<unsigned>(c, WS_CTL) + CW_CNT; int acc = 0;
#pragma unroll
    for (int e = 0; e < NE; ++e) { base[e] = acc; acc += (((int)cnt[e] + 255) / 256) * 256; }
    total_tiles = acc / 256;
}
DEV void phase_gather(const Ctx& c) {
    int base[NE], nt; moe_bases(c, base, nt);
    const bf16_t* X1B = wsp<bf16_t>(c, WS_X1B); bf16_t* XS = wsp<bf16_t>(c, WS_XS);
    int* TOKE = wsp<int>(c, WS_TOK); int* TOKS = TOKE + 2 * M;
    const int gw = c.bid * NWAVES + c.wid, NGW = c.G * NWAVES;
    for (int m = gw; m < M; m += NGW) {
        const u32x4 v0 = *((const u32x4*)(X1B + (size_t)m * DM) + c.lane), v1 = *((const u32x4*)(X1B + (size_t)m * DM) + 64 + c.lane);
#pragma unroll
        for (int a = 0; a < 2; ++a) { const int e = TOKE[2 * m + a]; int bs = 0;
#pragma unroll
            for (int j = 0; j < NE; ++j) if (j == e) bs = base[j];
            const int pos = bs + TOKS[2 * m + a];
            *((u32x4*)(XS + (size_t)pos * DM) + c.lane) = v0; *((u32x4*)(XS + (size_t)pos * DM) + 64 + c.lane) = v1; }
    }
}
DEV void phase_final(const Ctx& c) {
    int base[NE], nt; moe_bases(c, base, nt);
    const bf16_t* O2 = wsp<bf16_t>(c, WS_O2); float* X1 = c.out;
    const int* TOKE = wsp<int>(c, WS_TOK); const int* TOKS = TOKE + 2 * M; const float* TOKW = (const float*)(TOKS + 2 * M);
    const int gw = c.bid * NWAVES + c.wid, NGW = c.G * NWAVES;
    for (int m = gw; m < M; m += NGW) {
        int pos[2]; float w[2];
#pragma unroll
        for (int a = 0; a < 2; ++a) { const int e = TOKE[2 * m + a]; int bs = 0;
#pragma unroll
            for (int j = 0; j < NE; ++j) if (j == e) bs = base[j];
            pos[a] = bs + TOKS[2 * m + a]; w[a] = TOKW[2 * m + a]; }
        f32x4 v[4], y[4];
#pragma unroll
        for (int j = 0; j < 4; ++j) { const f32x4 xv = *((const f32x4*)(X1 + (size_t)m * DM) + c.lane + 64 * j);
            const u32x2 a0 = *((const u32x2*)(O2 + (size_t)pos[0] * DM) + c.lane + 64 * j), a1 = *((const u32x2*)(O2 + (size_t)pos[1] * DM) + c.lane + 64 * j);
            f32x4 t; t[0] = xv[0] * ALPHA + w[0] * lo_bf(a0.x) + w[1] * lo_bf(a1.x); t[1] = xv[1] * ALPHA + w[0] * hi_bf(a0.x) + w[1] * hi_bf(a1.x);
            t[2] = xv[2] * ALPHA + w[0] * lo_bf(a0.y) + w[1] * lo_bf(a1.y); t[3] = xv[3] * ALPHA + w[0] * hi_bf(a0.y) + w[1] * hi_bf(a1.y); v[j] = t; }
        ln_row(v, par(c, P_LN2G), par(c, P_LN2B), c.lane, y);
#pragma unroll
        for (int j = 0; j < 4; ++j) *((f32x4*)(c.out + (size_t)m * DM) + c.lane + 64 * j) = y[j];
    }
}

#ifndef EMU
#define XB_TMO      128
#define XB_XCNT(j)  (256  + 64 * (j))
#define XB_XSUB(j)  (1280 + 64 * (j))
#define XB_XGEN(j)  (2304 + 64 * (j))
#define XB_TOP      3328
#define XB_TOPGEN   3392
#define XCD_BAR_WORDS 3456
#define XB_SPIN_CAP (1u << 22)
__device__ __forceinline__ unsigned xb_ld(unsigned* p)              { return __hip_atomic_load(p, __ATOMIC_RELAXED, __HIP_MEMORY_SCOPE_AGENT); }
__device__ __forceinline__ unsigned xb_add(unsigned* p, unsigned v) { return __hip_atomic_fetch_add(p, v, __ATOMIC_RELAXED, __HIP_MEMORY_SCOPE_AGENT); }
__device__ __forceinline__ unsigned xb_xcc_id() { return (unsigned)__builtin_amdgcn_s_getreg((3 << 11) | 20) & 0xFu; }
#define XB_SPIN(cond, bar) do { unsigned _sp = 0; while (cond) { __builtin_amdgcn_s_sleep(1); \
    if ((++_sp & 255u) == 0u) { if (xb_ld(&(bar)[XB_TMO])) break; if (_sp > XB_SPIN_CAP) { atomicAdd(&(bar)[XB_TMO], 1u); break; } } } } while (0)
struct XcdBarrier { unsigned* bar; unsigned x; volatile LAS unsigned* st; };
__device__ __forceinline__ XcdBarrier xcd_barrier_post(unsigned* bar, volatile LAS unsigned* st) {
    XcdBarrier b; b.bar = bar; b.x = xb_xcc_id(); b.st = st;
    if (threadIdx.x == 0) (void)xb_add(&bar[XB_XCNT(b.x)], 1u);
    return b;
}
__device__ __forceinline__ void xcd_barrier_complete(unsigned* bar, unsigned x, unsigned& nloc, unsigned& nx) {
    const unsigned G = gridDim.x * gridDim.y * gridDim.z;
    unsigned sum, cnt, mine, sp = 0u;
    for (;;) {
        sum = 0u; cnt = 0u; mine = 0u;
#pragma unroll
        for (unsigned j = 0; j < 16; ++j) { const unsigned c = xb_ld(&bar[XB_XCNT(j)]); sum += c; cnt += (c > 0u) ? 1u : 0u; mine = (j == x) ? c : mine; }
        if (sum == G) break;
        __builtin_amdgcn_s_sleep(1);
        if ((++sp & 255u) == 0u) { if (xb_ld(&bar[XB_TMO])) break; if (sp > XB_SPIN_CAP) { atomicAdd(&bar[XB_TMO], 1u); break; } }
    }
    nloc = mine > 0u ? mine : 1u; nx = cnt > 0u ? cnt : 1u;
}
__device__ __forceinline__ void xcd_barrier(const XcdBarrier& b) {
    asm volatile("s_waitcnt vmcnt(0)" ::: "memory");
    __syncthreads();
    if (threadIdx.x == 0) {
        unsigned* bar = b.bar;
        __builtin_amdgcn_s_waitcnt(0);
        unsigned nloc = b.st[0], nx = b.st[1];
        if (nloc == 0u) { xcd_barrier_complete(bar, b.x, nloc, nx); b.st[0] = nloc; b.st[1] = nx; }
        const unsigned old = xb_add(&bar[XB_XSUB(b.x)], 1u);
        const unsigned gen = old / nloc;
        if (old + 1u == (gen + 1u) * nloc) {
            __builtin_amdgcn_fence(__ATOMIC_RELEASE, "agent");
            asm volatile("s_waitcnt vmcnt(0)" ::: "memory");
            const unsigned og = xb_add(&bar[XB_TOP], 1u);
            const unsigned tg = og / nx;
            if (og + 1u == (tg + 1u) * nx) xb_add(&bar[XB_TOPGEN], 1u);
            else XB_SPIN(xb_ld(&bar[XB_TOPGEN]) == tg, bar);
            __builtin_amdgcn_fence(__ATOMIC_ACQUIRE, "agent");
            xb_add(&bar[XB_XGEN(b.x)], 1u);
            asm volatile("s_waitcnt vmcnt(0)" ::: "memory");
        } else {
            XB_SPIN(xb_ld(&bar[XB_XGEN(b.x)]) == gen, bar);
            __builtin_amdgcn_fence(__ATOMIC_ACQUIRE, "agent");
            asm volatile("s_waitcnt vmcnt(0)" ::: "memory");
        }
    }
    __syncthreads();
}
#endif

constexpr int NPHASE = 11;
constexpr int LDS_BYTES = 144 * 1024;
static_assert(pg8::STAGE_BYTES <= LDS_BYTES - 1024 && IDX_LDS <= LDS_BYTES - 1024 && ML_LDS <= LDS_BYTES - 1024 && AT_LDS <= LDS_BYTES - 1024 && 8 * 16384 <= LDS_BYTES - 1024, "LDS budget");
constexpr int MISC_OFF = LDS_BYTES - 64;

DEV void run_phase(const Ctx& c0, int ph) {
    using namespace pg8;
    Ctx c = c0;
#ifndef EMU
    { int t = threadIdx.x; asm volatile("" : "+v"(t)); c.tid = t; c.lane = t & 63; c.wid = __builtin_amdgcn_readfirstlane(t >> 6); }
#endif
#ifdef EMU
    unsigned char* glds = c.lds;
#else
    PG8_LAS unsigned char* glds = c.lds;
#endif
    if (ph == 0) { phase_prologue(c); return; }
    if (ph == 1) {
        SchedStatic S; S.init(wsp<bf16_t>(c, R0), DM, wsp<bf16_t>(c, WS_WIN), DM, M, NWIN, DM, c.G, c.bid);
        EpiInProj E{wsp<bf16_t>(c, WS_H), wsp<bf16_t>(c, WS_KIDX), wsp<float>(c, WS_SM), wsp<float>(c, WS_SSQ)};
        gemm_phase(glds, S, E); return;
    }
    if (ph == 2 || ph == 11 || ph == 12) {
        const int nml = (ph == 12) ? 0 : ((c.G >= 4) ? c.G / 4 : 0);
        if (ph == 11) { for (int u = c.bid; u < NB * NHM; u += c.G) mlstm_unit(c, u / NHM, u % NHM); return; }
        if (c.bid < nml) {
#ifndef P2_REP_ML
#define P2_REP_ML 1
#endif
#ifndef P2_SKIP_ML
            for (int rep = 0; rep < P2_REP_ML; ++rep) for (int u = c.bid; u < NB * NHM; u += nml) mlstm_unit(c, u / NHM, u % NHM);
#endif
        } else {
            const int g2 = c.G - nml, c2 = c.bid - nml;
#ifndef P2_SKIP_KV
            { SchedStatic S; S.init(wsp<bf16_t>(c, WS_H) + C_CKV, LDH, wsp<bf16_t>(c, WS_WK), KVR, M, 512, KVR, g2, c2); EpiK E{wsp<bf16_t>(c, WS_K), wsp<float>(c, WS_SSQ)}; gemm_phase(glds, S, E); }
            { SchedStatic S; S.init(wsp<bf16_t>(c, WS_WV), KVR, wsp<bf16_t>(c, WS_H) + C_CKV, LDH, 512, M, KVR, g2, (c2 + (2 * g2) / 3) % g2); EpiVT E{wsp<bf16_t>(c, WS_VT), wsp<float>(c, WS_SSQ)}; gemm_phase(glds, S, E); }
#endif
            wg_sync();
            const int nq = SEQ / 16, nunits = NB * nq;
#ifndef P2_REP_IDX
#define P2_REP_IDX 1
#endif
#ifndef P2_SKIP_IDX
            for (int rep = 0; rep < P2_REP_IDX; ++rep) for (int u = c2; u < nunits; u += g2) { const int qt = nq - 1 - u / NB, b = u % NB; idx_unit(c, b, qt); }
#endif
        }
        return;
    }
    if (ph == 3) {
        const int nqb = SEQ / 256, nun = NB * HA * nqb;
        for (int u = c.bid; u < nun; u += c.G) {
            const int bh = u / nqb; int qi = u % nqb; const int round = (u / c.G) & 1; if (round) qi = nqb - 1 - qi;
            attn_unit(c, bh / HA, bh % HA, qi);
            wg_sync();
        }
        return;
    }
    if (ph == 4) {
        { SchedStatic S; S.init(wsp<bf16_t>(c, WS_H) + C_OA, LDH, wsp<bf16_t>(c, WS_WA), WA, M, DM, WA, c.G, c.bid); EpiUpA E{(bf16_t*)((unsigned char*)c.out + (size_t)M * 1024), wsp<bf16_t>(c, WS_H)}; gemm_phase(glds, S, E); }
        { SchedStatic S; S.init((const bf16_t*)c.out, WM, wsp<bf16_t>(c, WS_WM), WM, M, DM, WM, c.G, c.bid); EpiUpM E{wsp<bf16_t>(c, WS_Y), (const bf16_t*)((unsigned char*)c.out + (size_t)M * 1024), wsp<bf16_t>(c, WS_H)}; gemm_phase(glds, S, E); }
        return;
    }
    if (ph == 5) {
        SchedStatic S; S.init(wsp<bf16_t>(c, WS_Y), DM, wsp<bf16_t>(c, WS_WO), DM, M, DM, DM, c.G, c.bid); EpiOut E{wsp<float>(c, WS_Z), c.in[IN_X]}; gemm_phase(glds, S, E); return;
    }
    if (ph == 6) { phase_ln1_router(c); return; }
    if (ph == 7) { phase_gather(c); return; }
    if (ph == 8 || ph == 9) {
        int base[NE], nt; moe_bases(c, base, nt);
        SchedMoe S; S.ntiles = nt; S.nN = 4; S.G = c.G; S.c = c.bid;
#pragma unroll
        for (int e = 0; e < NE; ++e) S.tend[e] = ((e + 1 < NE) ? base[e + 1] : nt * 256) / 256;
        if (ph == 8) { S.K = DM; S.lda = DM; S.ldb = DM; S.A = wsp<bf16_t>(c, WS_XS); S.Bt = wsp<bf16_t>(c, WS_WGU); S.estride = (size_t)1024 * 1024; EpiMoe1 E{wsp<bf16_t>(c, WS_HD)}; gemm_phase(glds, S, E); }
        else { S.K = DE; S.lda = DE; S.ldb = DE; S.A = wsp<bf16_t>(c, WS_HD); S.Bt = wsp<bf16_t>(c, WS_WD); S.estride = (size_t)1024 * 512; EpiMoe2 E{wsp<bf16_t>(c, WS_O2)}; gemm_phase(glds, S, E); }
        return;
    }
    if (ph == 10) { phase_final(c); return; }
}

#ifndef EMU
__global__ void __launch_bounds__(NTHREADS, 2) fwd_kernel(Args args) {
    extern __shared__ __attribute__((aligned(16))) unsigned char lds_raw[];
    Ctx c;
#pragma unroll
    for (int i = 0; i < 25; ++i) c.in[i] = args.in[i];
    c.out = args.out; c.ws = args.ws; c.tid = threadIdx.x; c.lane = c.tid & 63; c.wid = __builtin_amdgcn_readfirstlane(c.tid >> 6); c.G = gridDim.x; c.bid = blockIdx.x;
    c.lds = (LAS unsigned char*)lds_raw;
    volatile LAS unsigned* MISC = (volatile LAS unsigned*)(c.lds + MISC_OFF);
    if (c.tid < 16) MISC[c.tid] = 0u;
    __syncthreads();
    const bool multi = (args.ph_hi - args.ph_lo) > 1;
    XcdBarrier bar; bar.bar = (unsigned*)(args.ws + WS_CTL) + CW_BAR; bar.x = 0; bar.st = nullptr;
    if (multi) bar = xcd_barrier_post((unsigned*)(args.ws + WS_CTL) + CW_BAR, MISC + 8);
#ifndef ONLY_PHASE
#define ONLY_PHASE -1
#endif
#ifndef DOUBLE_PHASE
#define DOUBLE_PHASE 8
#endif
#ifndef DOUBLE_PHASE2
#define DOUBLE_PHASE2 9
#endif
#define PHASE(k) if ((ONLY_PHASE < 0 || ONLY_PHASE == (k)) && args.ph_lo <= (k) && (k) < args.ph_hi) { if (DOUBLE_PHASE == (k) || DOUBLE_PHASE2 == (k)) { run_phase(c, (k)); xcd_barrier(bar); } run_phase(c, (k)); if ((k) + 1 < args.ph_hi) xcd_barrier(bar); }
#ifdef SPLIT_P2
    PHASE(0) PHASE(1) { run_phase(c, 11); xcd_barrier(bar); run_phase(c, 12); xcd_barrier(bar); } PHASE(3)
#else
    PHASE(0) PHASE(1) PHASE(2) PHASE(3)
#endif
    PHASE(4) PHASE(5) PHASE(6) PHASE(7) PHASE(8) PHASE(9) PHASE(10)
#undef PHASE
}

#ifndef N_LAUNCH_MODE
#define N_LAUNCH_MODE 0
#endif
extern "C" void kernel_launch(void* const* d_in, const int* in_sizes, int n_in, void* d_out, int out_size, void* d_ws, size_t ws_size, hipStream_t stream) {
    static int grid = 0;
    if (grid == 0) {
        if (n_in != 25 || out_size != M * DM || ws_size < WS_END) { fprintf(stderr, "kernel_launch: unexpected shapes (n_in %d out %d ws %zu need %zu)\n", n_in, out_size, ws_size, (size_t)WS_END); grid = -1; return; }
        int dev = 0, cus = 0, per_cu = 0;
        if (hipGetDevice(&dev) != hipSuccess || hipDeviceGetAttribute(&cus, hipDeviceAttributeMultiprocessorCount, dev) != hipSuccess) { grid = -1; return; }
        if (hipFuncSetAttribute((const void*)fwd_kernel, hipFuncAttributeMaxDynamicSharedMemorySize, LDS_BYTES) != hipSuccess) { fprintf(stderr, "kernel_launch: hipFuncSetAttribute failed\n"); grid = -1; return; }
        if (hipOccupancyMaxActiveBlocksPerMultiprocessor(&per_cu, (const void*)fwd_kernel, NTHREADS, LDS_BYTES) != hipSuccess || per_cu < 1) fprintf(stderr, "kernel_launch: occupancy query reports %d\n", per_cu);
        (void)hipGetLastError();
        grid = cus;
    }
    if (grid < 0) return;
    (void)hipMemsetAsync((char*)d_ws + WS_CTL, 0, CTL_ZERO_BYTES, stream);
    Args a{};
    for (int i = 0; i < 25; ++i) a.in[i] = (const float*)d_in[i];
    a.out = (float*)d_out; a.ws = (unsigned char*)d_ws;
    if (N_LAUNCH_MODE == 0) { a.ph_lo = 0; a.ph_hi = NPHASE; hipLaunchKernelGGL(fwd_kernel, dim3(grid), dim3(NTHREADS), LDS_BYTES, stream, a); }
    else { for (int p = 0; p < NPHASE; ++p) { a.ph_lo = p; a.ph_hi = p + 1; hipLaunchKernelGGL(fwd_kernel, dim3(grid), dim3(NTHREADS), LDS_BYTES, stream, a); } }
    (void)in_sizes;
}
#endif
```

```cpp
#ifdef EMU
#include "emu/emu.h"
#define DEV static inline
#define DEVM inline
#define WAVE_ANY(p) (__ballot(p) != 0ull)
#define MEM_FENCE() do {} while (0)
#define LDS_SYNC() __syncthreads()
#define LAUNDER(x) do {} while (0)
#define WAVE_SYNC() e_wbar()
#define LAS
#else
#include <hip/hip_runtime.h>
#include <cstdio>
#include <cstdint>
#define DEV __device__ __forceinline__
#define DEVM __device__ __forceinline__
#define WAVE_ANY(p) (__ballot(p) != 0ull)
#define MEM_FENCE() asm volatile("" ::: "memory")
#define LDS_SYNC() asm volatile("s_waitcnt lgkmcnt(0)\n\ts_barrier" ::: "memory")
#define LAUNDER(x) asm volatile("" : "+v"(x))
#define WAVE_SYNC() asm volatile("s_waitcnt lgkmcnt(0)" ::: "memory")
#define LAS __attribute__((address_space(3)))
typedef short bf16x8 __attribute__((ext_vector_type(8)));
typedef float f32x16 __attribute__((ext_vector_type(16)));
typedef float f32x4 __attribute__((ext_vector_type(4)));
#endif
typedef unsigned u32x4 __attribute__((ext_vector_type(4)));
typedef unsigned u32x2 __attribute__((ext_vector_type(2)));
typedef short s16x4 __attribute__((ext_vector_type(4)));
typedef unsigned short bf16_t;
typedef unsigned long long u64;

#ifndef CFG_B
#define CFG_B 16
#endif
#ifndef CFG_S
#define CFG_S 2048
#endif
constexpr int NB = CFG_B, SEQ = CFG_S, DM = 1024, M = NB * SEQ;
constexpr int HA = 8, DA = 64, WA = 512, KVR = 256, TOPK = (SEQ / 4 < 256) ? SEQ / 4 : 256;
constexpr int NHM = 4, DHM = 128, WM = 512, CHUNK = 64, NCH = SEQ / CHUNK;
constexpr int NE = 16, DE = 512, MPAD = 2 * M + 4096;
constexpr float LN_EPS = 1e-5f, ALPHA = 1.189207115002721f;
constexpr float QSCALE = 0.125f * 1.4426950408889634f;
constexpr float LOG2E = 1.4426950408889634f;
constexpr int NWIN = 5632, LDH = 5376;
constexpr int C_HM = 2304;
constexpr int C_OA = 768;
constexpr int C_QA = 0, C_CKV = 512, C_QI = 768, C_QM = 1280, C_KM = 1792, C_VM = 2304, C_OM = 2816, C_GA = 3328, C_GM = 4352;
constexpr int NWORDS = SEQ / 32;
constexpr int NWAVES = 8, NTHREADS = 512;

constexpr size_t MiB = 1u << 20;
constexpr size_t WS_CTL = 0, CTL_ZERO_BYTES = 512 * 1024;
constexpr size_t WS_ROWTOK = 128 * 1024;
constexpr size_t WS_WIN = 1 * MiB, WS_WK = 12 * MiB, WS_WV = 12 * MiB + 512 * 1024, WS_WA = 13 * MiB, WS_WM = 14 * MiB, WS_WO = 15 * MiB;
constexpr size_t WS_WGU = 17 * MiB, WS_WD = 49 * MiB, WS_TOK = 65 * MiB, WS_PAR = 65 * MiB + 768 * 1024;
static_assert(WS_ROWTOK + (size_t)(2 * M + 4096) * 4 <= 512 * 1024, "ROWTOK inside the zeroed control region");
static_assert((size_t)M * 24 <= 768 * 1024, "token tables fit below the parameter block");
static_assert((30720 + 1024 * 20) * 4 <= 256 * 1024, "parameter block size");
constexpr int P_CONVW = 0, P_CONVB = 4096, P_BI = 5120, P_BF = 5124, P_MHG = 5128, P_RELB = 5640, P_LN1G = 5896, P_LN1B = 6920, P_WGRP = 7944, P_BGRP = 12040, P_WRT = 12044, P_BRT = 28428, P_LN2G = 28444, P_LN2B = 29468, P_END = 30492, P_RW = 30720, P_END2 = P_RW + 1024 * 20;
constexpr size_t R0 = 66 * MiB;
constexpr size_t R1 = R0 + (size_t)M * 2048;
constexpr size_t R2 = R1 + (size_t)M * LDH * 2;
constexpr size_t WS_KIDX = R2, WS_SM = WS_KIDX + (size_t)M * 128, WS_SSQ = WS_SM + (size_t)M * 64, WS_MASK = WS_SSQ + (size_t)M * 16, WS_RT2 = WS_MASK + (size_t)M * NWORDS * 4, WS_END = WS_RT2 + (size_t)NE * M * 4;
constexpr size_t WS_K = R0, WS_VT = R0 + (size_t)M * 1024, WS_Y = R0;
#ifdef EMU
constexpr size_t WS_H = R1, WS_Z = R1, WS_X1B = R0, WS_XS = WS_END, WS_HD = WS_XS + (size_t)MPAD * 2048, WS_O2 = WS_HD + (size_t)MPAD * 1024, WS_TOTAL = WS_O2 + (size_t)MPAD * 2048;
#else
constexpr size_t WS_H = R1, WS_Z = R1, WS_X1B = R0, WS_XS = R1 + (size_t)M * 6144;
constexpr size_t WS_HD = R1, WS_O2 = R1 + (size_t)MPAD * 1024, WS_TOTAL = WS_END;
static_assert(WS_XS + (size_t)MPAD * 2048 <= R2, "XS fits in the H region");
static_assert(WS_O2 + (size_t)MPAD * 2048 <= R2, "O2 fits in the H region");
static_assert(WS_END <= 512 * MiB, "workspace budget");
#endif
constexpr int CW_CNT = 4096;
constexpr int CW_BAR = 8192;

struct Args { const float* in[25]; float* out; unsigned char* ws; int ph_lo, ph_hi; };

DEV unsigned fbits(float f) { unsigned u; __builtin_memcpy(&u, &f, 4); return u; }
DEV float bitsf(unsigned u) { float f; __builtin_memcpy(&f, &u, 4); return f; }
DEV unsigned f2bf(float f) { unsigned u = fbits(f); return (u + 0x7fffu + ((u >> 16) & 1u)) >> 16; }
DEV float bf2f(unsigned b) { return bitsf(b << 16); }
DEV unsigned pk2(float lo, float hi) {
#ifdef EMU
    return f2bf(lo) | (f2bf(hi) << 16);
#else
    typedef float f32x2_t __attribute__((ext_vector_type(2))); typedef __bf16 bf16x2_t __attribute__((ext_vector_type(2)));
    f32x2_t v = {lo, hi}; bf16x2_t b = __builtin_convertvector(v, bf16x2_t); return __builtin_bit_cast(unsigned, b);
#endif
}
DEV float lo_bf(unsigned w) { return bitsf(w << 16); }
DEV float hi_bf(unsigned w) { return bitsf(w & 0xffff0000u); }
DEV f32x16 mfma32(bf16x8 a, bf16x8 b, f32x16 c) {
#ifdef EMU
    return emu_mfma_32x32x16_bf16(a, b, c);
#else
    return __builtin_amdgcn_mfma_f32_32x32x16_bf16(a, b, c, 0, 0, 0);
#endif
}
DEV float fast_rcp(float x) {
#ifdef EMU
    return 1.0f / x;
#else
    return __builtin_amdgcn_rcpf(x);
#endif
}
DEV float fast_rsq(float x) {
#ifdef EMU
    return 1.0f / sqrtf(x);
#else
    return __builtin_amdgcn_rsqf(x);
#endif
}
DEV float fast_exp2(float x) {
#ifdef EMU
    return exp2f(x);
#else
    return __builtin_amdgcn_exp2f(x);
#endif
}
#ifndef EMU
__device__ __forceinline__ unsigned long long rt_now() { unsigned long long t; asm volatile("s_memrealtime %0\n\ts_waitcnt lgkmcnt(0)" : "=s"(t) :: "memory"); return t; }
#endif
DEV unsigned bit_spread(unsigned w, int pos) {
#ifdef EMU
    return ((w >> pos) & 1u) ? 0xffffffffu : 0u;
#else
    unsigned m; asm("v_bfe_i32 %0, %1, %2, 1" : "=v"(m) : "v"(w), "s"(pos)); return m;
#endif
}
DEV float relu_f(float x) {
#ifdef EMU
    return x > 0.f ? x : 0.f;
#else
    return __builtin_amdgcn_fmed3f(x, 0.0f, __builtin_inff());
#endif
}
DEV float sum_xor32(float v) {
#ifdef EMU
    return v + __shfl_xor(v, 32);
#else
    const unsigned u = fbits(v); auto rr = __builtin_amdgcn_permlane32_swap(u, u, false, false); return bitsf(rr[0]) + bitsf(rr[1]);
#endif
}
DEV float max_xor32(float v) {
#ifdef EMU
    return fmaxf(v, __shfl_xor(v, 32));
#else
    const unsigned u = fbits(v); auto rr = __builtin_amdgcn_permlane32_swap(u, u, false, false); return fmaxf(bitsf(rr[0]), bitsf(rr[1]));
#endif
}
DEV float sigmoidf_(float x) { return fast_rcp(1.0f + __expf(-x)); }
DEV int crow(int r, int hi) { return (r & 3) + 8 * (r >> 2) + 4 * hi; }
DEV bf16x8 pack8(float a0, float a1, float a2, float a3, float a4, float a5, float a6, float a7) {
    u32x4 w; w.x = pk2(a0, a1); w.y = pk2(a2, a3); w.z = pk2(a4, a5); w.w = pk2(a6, a7); return __builtin_bit_cast(bf16x8, w);
}
DEV float wave_sum(float v) {
#ifdef EMU
#pragma unroll
    for (int o = 1; o < 64; o <<= 1) v += __shfl_xor(v, o);
    return v;
#else
#define WS_DPP(ctrl, rm) v += __builtin_bit_cast(float, __builtin_amdgcn_update_dpp(0, __builtin_bit_cast(int, v), ctrl, rm, 0xf, false))
    WS_DPP(0x111, 0xf); WS_DPP(0x112, 0xf); WS_DPP(0x114, 0xf); WS_DPP(0x118, 0xf); WS_DPP(0x142, 0xa); WS_DPP(0x143, 0xc);
#undef WS_DPP
    return __builtin_bit_cast(float, __builtin_amdgcn_readlane(__builtin_bit_cast(int, v), 63));
#endif
}

DEV int lane_bcast(int v, int l) {
#ifdef EMU
    return __shfl(v, l);
#else
    return __builtin_amdgcn_readlane(v, l);
#endif
}
namespace pg8 {
constexpr int BM = 256, BK = 64, HALF = 128, HTB = HALF * BK * 2, STAGE_BYTES = 8 * HTB, NXCD = 8, WGM = 8;
DEV int lds_byte(int r, int c) { const int st = (r >> 4) * 2 + (c >> 5), rr = r & 15, cc = c & 31, ob = rr * 64 + cc * 2; return st * 1024 + (ob ^ (((ob >> 9) & 1) << 5)); }
DEV void stage_rc(int b, int& R, int& C) { const int st = b / 1024, sb = b % 1024, swz = sb ^ (((sb >> 9) & 1) << 5); R = (st >> 1) * 16 + swz / 64; C = (st & 1) * 32 + (swz % 64) / 2; }
DEV int perm32(int rho) { const int n = rho >> 4, i = rho & 15; return 8 * (i >> 2) + 4 * n + (i & 3); }

struct Unit { int pm, pn, e, g0, gv; };
struct SchedStatic {
    static constexpr bool GATHER = false;
    int phase_id = -1; int nM, nN, nwg, G, c, K, lda, ldb; const bf16_t* A; const bf16_t* Bt;
    DEVM void init(const bf16_t* A_, int lda_, const bf16_t* Bt_, int ldb_, int M_, int N_, int K_, int G_, int c_) { A = A_; lda = lda_; Bt = Bt_; ldb = ldb_; nM = M_ / BM; nN = N_ / BM; nwg = nM * nN; K = K_; G = G_; c = c_; }
    DEVM bool next(int i, Unit& u) const {
        const long L = (long)i * G + c; if (L >= nwg) return false;
        int wgid = (int)L; { const int q = nwg / NXCD, r = nwg % NXCD, xcd = wgid % NXCD, off = wgid / NXCD; wgid = (xcd < r ? xcd * (q + 1) : r * (q + 1) + (xcd - r) * q) + off; }
        const int nig = WGM * nN, gid = wgid / nig, fm = gid * WGM, gsz = (nM - fm) < WGM ? (nM - fm) : WGM;
        u.pm = fm + ((wgid % nig) % gsz); u.pn = (wgid % nig) / gsz; u.e = 0; u.g0 = 0; u.gv = 256; return true;
    }
    DEVM const char* baseA(const Unit& u) const { return (const char*)(A + (size_t)u.pm * BM * lda); }
    DEVM const char* baseB(const Unit& u) const { return (const char*)(Bt + (size_t)u.pn * BM * ldb); }
};
template <bool GATHER_> struct SchedMoeT {
    static constexpr bool GATHER = GATHER_; const int* rowtok = nullptr;
    int phase_id = -1; int ntiles, nN, G, c, K, lda, ldb; const bf16_t* A; const bf16_t* Bt; size_t estride; int tend[NE]; int cntv = 0;
    DEVM bool next(int i, Unit& u) const {
        int pm, pn;
        if ((G & 7) == 0) { const int x = c & 7, cl = c >> 3, gl = G >> 3, nx = (ntiles + 7) >> 3, t0 = x * nx, tn = (t0 + nx <= ntiles) ? nx : (ntiles > t0 ? ntiles - t0 : 0);
            const int L = i * gl + cl; if (L >= tn * nN) return false; pm = t0 + L / nN; pn = L % nN; }
        else { const long L = (long)i * G + c; if (L >= (long)ntiles * nN) return false; pm = (int)(L / nN); pn = (int)(L % nN); }
        u.pm = pm; u.pn = pn; int e = 0, ts = 0;
#pragma unroll
        for (int j = 0; j < NE - 1; ++j) { const bool ge = pm >= tend[j]; e += ge ? 1 : 0; ts = ge ? tend[j] : ts; }
        u.e = e; const int r0 = (pm - ts) * 256; u.g0 = e * M + r0; u.gv = 256;
        if (GATHER) { const int ce = lane_bcast(cntv, e); u.gv = (ce - r0 < 256) ? ce - r0 : 256; }
        return true;
    }
    DEVM const char* baseA(const Unit& u) const { return GATHER ? (const char*)A : (const char*)(A + (size_t)u.pm * BM * lda); }
    DEVM const char* baseB(const Unit& u) const { return (const char*)(Bt + (size_t)u.e * estride + (size_t)u.pn * BM * ldb); }
};
typedef SchedMoeT<false> SchedMoe;

#ifdef EMU
template <class Epi, class Sched>
static inline void gemm_phase(unsigned char* lds, const Sched& S, const Epi& E) {
    const int tid = threadIdx.x, wid = tid >> 6, lane = tid & 63, wr = wid >> 2, wc = wid & 3, fr = lane & 15, fq = lane >> 4;
    Unit u; f32x4 acc[2][2][4][2]; bool keep = false;
    for (int i = 0; S.next(i, u); ++i) {
        const bf16_t* A = (const bf16_t*)S.baseA(u); const bf16_t* B = (const bf16_t*)S.baseB(u);
        for (int ai = 0; ai < 2; ++ai) for (int bj = 0; bj < 2; ++bj) for (int m = 0; m < 4; ++m) for (int n = 0; n < 2; ++n) for (int x = 0; x < 4; ++x) {
            const int r = 128 * ai + 64 * wr + 16 * m + fr, c = 128 * bj + 32 * wc + 8 * fq + 4 * n + x; float s = keep ? acc[ai][bj][m][n][x] : 0.f;
            size_t arow = r; if constexpr (Sched::GATHER) arow = (size_t)S.rowtok[u.g0 + (r < u.gv ? r : u.gv - 1)];
            for (int k = 0; k < S.K; ++k) s += bf2f(A[arow * S.lda + k]) * bf2f(B[(size_t)c * S.ldb + k]);
            acc[ai][bj][m][n][x] = s; }
        if constexpr (Epi::DUAL) keep = E.dual(acc, u, wr, wc, fr, fq); else { E(acc, u, wr, wc, fr, fq); keep = false; }
    }
    (void)lds;
}
#else
#define PG8_LAS __attribute__((address_space(3)))
#ifndef GPROBE_ALL
#define GPROBE_ALL 0
#endif
#ifndef GPROBE_PH
#define GPROBE_PH -1
#define GPROBE_A -1
#define GPROBE_B -1
#endif
#define GPROBE(lds_, id_) do { if (GPROBE_PH >= 0 && S.phase_id == GPROBE_PH && (blockIdx.x == 0 || GPROBE_ALL) && threadIdx.x == 0) { const unsigned long long _t = rt_now(); \
    volatile PG8_LAS unsigned* _m = (volatile PG8_LAS unsigned*)((lds_) + (144 * 1024 - 64)); if ((id_) == GPROBE_A) { _m[0] = (unsigned)_t; _m[1] = (unsigned)(_t >> 32); } if ((id_) == GPROBE_B) { _m[2] = (unsigned)_t; _m[3] = (unsigned)(_t >> 32); } } } while (0)
template <class Epi, class Sched>
__device__ __forceinline__ void gemm_phase(PG8_LAS unsigned char* lds, const Sched& S, const Epi& E) {
    int tid = threadIdx.x; asm volatile("" : "+v"(tid));
    const int wid = __builtin_amdgcn_readfirstlane(tid >> 6), lane = tid & 63, wr = wid >> 2, wc = wid & 3, fr = lane & 15, fq = lane >> 4;
    const int K = S.K, nt = K / BK;
    unsigned voffA[2], voffB[2];
#pragma unroll
    for (int i = 0; i < 2; ++i) { int R, C; stage_rc(tid * 16 + i * 8192, R, C); const int Rb = (R & ~31) + perm32(R & 31);
        voffA[i] = (unsigned)(R * S.lda + C) * 2u; voffB[i] = (unsigned)(Rb * S.ldb + C) * 2u; }
    const size_t kstep = (size_t)(BK * 2);
    const size_t hstepA = Sched::GATHER ? (size_t)0 : (size_t)HALF * S.lda * 2, hstepB = (size_t)HALF * S.ldb * 2;
    unsigned vgc[2][2] = {{0u, 0u}, {0u, 0u}}, vgn[2][2] = {{0u, 0u}, {0u, 0u}}; int gR[2] = {0, 0}, gC[2] = {0, 0};
    if constexpr (Sched::GATHER) {
#pragma unroll
        for (int i = 0; i < 2; ++i) { int R, C; stage_rc(tid * 16 + i * 8192, R, C); gR[i] = R; gC[i] = C; } }
#define PG8_GLOAD(dst, unit) do { _Pragma("unroll") for (int _h = 0; _h < 2; ++_h) _Pragma("unroll") for (int _i = 0; _i < 2; ++_i) \
        { const int _r = _h * 128 + gR[_i]; dst[_h][_i] = (unsigned)(S.rowtok[(unit).g0 + (_r < (unit).gv ? _r : (unit).gv - 1)] * S.lda + gC[_i]) * 2u; } } while (0)
#define PG8_STAGE_A(bufoff, gbase, h, nextu) do { if constexpr (Sched::GATHER) { unsigned _v[2]; _v[0] = (nextu) ? vgn[h][0] : vgc[h][0]; _v[1] = (nextu) ? vgn[h][1] : vgc[h][1]; PG8_STAGE(bufoff, gbase, _v); } \
        else PG8_STAGE(bufoff, (gbase) + ((h) ? hstepA : 0), voffA); } while (0)
    const unsigned ldsw = (unsigned)wid * 1024u;
    const int aoff = lds_byte(wr * 64 + fr, fq * 8), boff = lds_byte(wc * 32 + fr, fq * 8);
#define PG8_SA(b, h) (((b) * 2 + (h)) * HTB)
#define PG8_SB(b, h) ((4 + (b) * 2 + (h)) * HTB)
#define PG8_STAGE(bufoff, gbase, voff) do { _Pragma("unroll") for (int _i = 0; _i < 2; ++_i) \
        __builtin_amdgcn_global_load_lds((const unsigned*)((const char*)(gbase) + (voff)[_i]), (PG8_LAS unsigned*)(lds + (bufoff) + ldsw + _i * 8192), 16, 0, 0); } while (0)
#define PG8_LDA(dst, b, h) do { _Pragma("unroll") for (int m = 0; m < 4; ++m) _Pragma("unroll") for (int k = 0; k < 2; ++k) dst[m][k] = *(const PG8_LAS bf16x8*)(lds + PG8_SA(b, h) + aoff + m * 2048 + k * 1024); } while (0)
#define PG8_LDB(dst, b, h) do { _Pragma("unroll") for (int n = 0; n < 2; ++n) _Pragma("unroll") for (int k = 0; k < 2; ++k) dst[n][k] = *(const PG8_LAS bf16x8*)(lds + PG8_SB(b, h) + boff + n * 2048 + k * 1024); } while (0)
#define PG8_MMA(ai, bj, At, Bt) do { __builtin_amdgcn_s_setprio(1); _Pragma("unroll") for (int m = 0; m < 4; ++m) _Pragma("unroll") for (int n = 0; n < 2; ++n) _Pragma("unroll") for (int k = 0; k < 2; ++k) \
        acc[ai][bj][m][n] = __builtin_amdgcn_mfma_f32_16x16x32_bf16(Bt[n][k], At[m][k], acc[ai][bj][m][n], 0, 0, 0); __builtin_amdgcn_s_setprio(0); } while (0)
#define PG8_WAIT_V(n) asm volatile("s_waitcnt vmcnt(" #n ")" ::: "memory")
#define PG8_WAIT_L(n) asm volatile("s_waitcnt lgkmcnt(" #n ")" ::: "memory")
#define PG8_BAR __builtin_amdgcn_s_barrier()
#define PG8_SCHED __builtin_amdgcn_sched_barrier(0)
    Unit cur, nxt; int ui = 0;
    GPROBE(lds, 50);
    if (!S.next(0, cur)) return;
    f32x4 acc[2][2][4][2];
#pragma unroll
    for (int a = 0; a < 2; ++a)
#pragma unroll
        for (int b = 0; b < 2; ++b)
#pragma unroll
            for (int m = 0; m < 4; ++m)
#pragma unroll
                for (int n = 0; n < 2; ++n) acc[a][b][m][n] = (f32x4){0.f, 0.f, 0.f, 0.f};
    bf16x8 At[4][2], B0[2][2], B1[2][2];
    const char* cA = S.baseA(cur); const char* cB = S.baseB(cur);
    if constexpr (Sched::GATHER) PG8_GLOAD(vgc, cur);
    PG8_STAGE(PG8_SB(0, 0), cB, voffB); PG8_STAGE(PG8_SB(0, 1), cB + hstepB, voffB); PG8_STAGE_A(PG8_SA(0, 0), cA, 0, false); PG8_STAGE_A(PG8_SA(0, 1), cA, 1, false);
    if (wr == 1) PG8_BAR;
    PG8_WAIT_V(2); PG8_BAR;
    PG8_STAGE(PG8_SB(1, 0), cB + kstep, voffB); PG8_STAGE_A(PG8_SA(1, 0), cA + kstep, 0, false); PG8_STAGE(PG8_SB(1, 1), cB + hstepB + kstep, voffB);
    PG8_WAIT_V(6); PG8_BAR;
    for (;;) {
        const bool has_next = S.next(ui + 1, nxt);
        const char* nA = has_next ? S.baseA(nxt) : cA; const char* nB = has_next ? S.baseB(nxt) : cB;
        if constexpr (Sched::GATHER) { if (has_next) PG8_GLOAD(vgn, nxt); else { vgn[0][0] = vgc[0][0]; vgn[0][1] = vgc[0][1]; vgn[1][0] = vgc[1][0]; vgn[1][1] = vgc[1][1]; } }
        for (int t = 0; t < nt; t += 2) {
            const bool last = (t == nt - 2);
            const char* a1 = cA + (size_t)(t + 1) * kstep;
            const char* a2 = last ? nA : cA + (size_t)(t + 2) * kstep; const char* b2 = last ? nB : cB + (size_t)(t + 2) * kstep;
            const char* a3 = a2 + kstep; const char* b3 = b2 + kstep;
            PG8_LDB(B0, 0, 0); PG8_LDB(B1, 0, 1); PG8_SCHED; PG8_LDA(At, 0, 0); PG8_STAGE_A(PG8_SA(1, 1), a1, 1, false);
            PG8_WAIT_V(8); PG8_WAIT_L(0); PG8_BAR; PG8_MMA(0, 0, At, B0); PG8_MMA(0, 1, At, B1); PG8_BAR; PG8_SCHED;
            PG8_LDA(At, 0, 1); PG8_STAGE(PG8_SB(0, 0), b2, voffB); PG8_STAGE(PG8_SB(0, 1), b2 + hstepB, voffB); PG8_STAGE_A(PG8_SA(0, 0), a2, 0, last);
            PG8_WAIT_V(8); PG8_WAIT_L(0); PG8_BAR; PG8_MMA(1, 0, At, B0); PG8_MMA(1, 1, At, B1); PG8_BAR; PG8_SCHED;
            PG8_LDB(B0, 1, 0); PG8_LDB(B1, 1, 1); PG8_SCHED; PG8_LDA(At, 1, 0); PG8_STAGE_A(PG8_SA(0, 1), a2, 1, last);
            PG8_WAIT_V(8); PG8_WAIT_L(0); PG8_BAR; PG8_MMA(0, 0, At, B0); PG8_MMA(0, 1, At, B1); PG8_BAR; PG8_SCHED;
            PG8_LDA(At, 1, 1); PG8_STAGE(PG8_SB(1, 0), b3, voffB); PG8_STAGE(PG8_SB(1, 1), b3 + hstepB, voffB); PG8_STAGE_A(PG8_SA(1, 0), a3, 0, last);
            PG8_WAIT_V(8); PG8_WAIT_L(0); PG8_BAR; PG8_MMA(1, 0, At, B0); PG8_MMA(1, 1, At, B1); PG8_BAR; PG8_SCHED;
        }
        if (wr == 0) PG8_BAR;
        GPROBE(lds, 100 + ui);
        bool keep = false;
        if constexpr (Epi::DUAL) keep = E.dual(acc, cur, wr, wc, fr, fq); else E(acc, cur, wr, wc, fr, fq);
        GPROBE(lds, 200 + ui);
        if (!has_next) break;
        if (!keep) {
#pragma unroll
        for (int a = 0; a < 2; ++a)
#pragma unroll
            for (int b = 0; b < 2; ++b)
#pragma unroll
                for (int m = 0; m < 4; ++m)
#pragma unroll
                    for (int n = 0; n < 2; ++n) acc[a][b][m][n] = (f32x4){0.f, 0.f, 0.f, 0.f};
        }
        cur = nxt; cA = nA; cB = nB; ++ui;
        if constexpr (Sched::GATHER) { vgc[0][0] = vgn[0][0]; vgc[0][1] = vgn[0][1]; vgc[1][0] = vgn[1][0]; vgc[1][1] = vgn[1][1]; }
        if (wr == 1) PG8_BAR;
    }
    PG8_WAIT_V(0);
    PG8_BAR;
    GPROBE(lds, 300);
#undef PG8_SA
#undef PG8_SB
#undef PG8_STAGE
#undef PG8_STAGE_A
#undef PG8_GLOAD
#undef PG8_LDA
#undef PG8_LDB
#undef PG8_MMA
#undef PG8_WAIT_V
#undef PG8_WAIT_L
#undef PG8_BAR
#undef PG8_SCHED
}
#endif
}
using pg8::Unit;

#define EPI_ARGS const f32x4 (&acc)[2][2][4][2], const Unit& u, int wr, int wc, int fr, int fq
DEV u32x4 pack_row8(const f32x4& v0, const f32x4& v1) { u32x4 w; w.x = pk2(v0[0], v0[1]); w.y = pk2(v0[2], v0[3]); w.z = pk2(v1[0], v1[1]); w.w = pk2(v1[2], v1[3]); return w; }

struct EpiInProj {
    static constexpr bool DUAL = false;
    bf16_t* H; bf16_t* KIDX; float* SM; float* SSQ;
    DEVM void operator()(EPI_ARGS) const {
        const int row0 = u.pm * 256 + wr * 64 + fr;
        if (u.pn < 21) {
            const int col0 = u.pn * 256 + wc * 32 + 8 * fq; const bool sig = u.pn >= 11;
            if (u.pn == 2) {
#pragma unroll
                for (int ai = 0; ai < 2; ++ai)
#pragma unroll
                    for (int m = 0; m < 4; ++m) { float s = 0.f;
#pragma unroll
                        for (int bj = 0; bj < 2; ++bj)
#pragma unroll
                            for (int n = 0; n < 2; ++n) { const f32x4 x = acc[ai][bj][m][n]; s += (x[0] * x[0] + x[1] * x[1]) + (x[2] * x[2] + x[3] * x[3]); }
                        s += __shfl_xor(s, 16); s += __shfl_xor(s, 32);
                        if (fq == 0) SSQ[(size_t)(row0 + ai * 128 + m * 16) * 4 + wc] = s; }
            }
#pragma unroll
            for (int ai = 0; ai < 2; ++ai)
#pragma unroll
                for (int m = 0; m < 4; ++m) { bf16_t* rowp = H + (size_t)(row0 + ai * 128 + m * 16) * LDH + col0;
                    if (u.pn >= 13) {
                        bf16_t* gp = H + (size_t)(row0 + ai * 128 + m * 16) * LDH + (u.pn - 13) * 128 + wc * 32 + 8 * fq;
                        f32x4 a0 = acc[ai][0][m][0], a1 = acc[ai][0][m][1], m0 = acc[ai][1][m][0], m1 = acc[ai][1][m][1];
#pragma unroll
                        for (int x = 0; x < 4; ++x) { m0[x] = fmaxf(sigmoidf_(m0[x]), 1e-20f); m1[x] = fmaxf(sigmoidf_(m1[x]), 1e-20f); a0[x] = sigmoidf_(a0[x]) / m0[x]; a1[x] = sigmoidf_(a1[x]) / m1[x]; }
                        *(u32x4*)(gp + C_GA) = pack_row8(a0, a1); *(u32x4*)(gp + C_GM) = pack_row8(m0, m1);
                    } else {
#pragma unroll
                    for (int bj = 0; bj < 2; ++bj) { f32x4 v0 = acc[ai][bj][m][0], v1 = acc[ai][bj][m][1];
                        if (sig) {
#pragma unroll
                            for (int x = 0; x < 4; ++x) { v0[x] = sigmoidf_(v0[x]); v1[x] = sigmoidf_(v1[x]); } }
                        *(u32x4*)(rowp + bj * 128) = pack_row8(v0, v1); } } }
        } else {
#pragma unroll
            for (int ai = 0; ai < 2; ++ai)
#pragma unroll
                for (int m = 0; m < 4; ++m) { const size_t row = (size_t)(row0 + ai * 128 + m * 16);
                    if (wc < 2) *(u32x4*)(KIDX + row * 64 + wc * 32 + 8 * fq) = pack_row8(acc[ai][0][m][0], acc[ai][0][m][1]);
                    else if (wc == 2 && fq < 2) { *(f32x4*)(SM + row * 16 + 8 * fq) = acc[ai][0][m][0]; *(f32x4*)(SM + row * 16 + 8 * fq + 4) = acc[ai][0][m][1]; } }
        }
    }
};
DEV float rms_scale(const float* SSQ, size_t row) { const f32x4 q = *(const f32x4*)(SSQ + row * 4); return 1.0f / sqrtf(((q[0] + q[1]) + (q[2] + q[3])) * (1.0f / 256.0f) + LN_EPS); }
struct EpiK {
    static constexpr bool DUAL = false;
    bf16_t* Kb; const float* SSQ;
    DEVM void operator()(EPI_ARGS) const {
        const int row0 = u.pm * 256 + wr * 64 + fr, col0 = u.pn * 256 + wc * 32 + 8 * fq;
        float sr[2][4];
#pragma unroll
        for (int ai = 0; ai < 2; ++ai)
#pragma unroll
            for (int m = 0; m < 4; ++m) sr[ai][m] = rms_scale(SSQ, (size_t)(row0 + ai * 128 + m * 16));
        MEM_FENCE();
#pragma unroll
        for (int ai = 0; ai < 2; ++ai)
#pragma unroll
            for (int m = 0; m < 4; ++m) { const size_t row = (size_t)(row0 + ai * 128 + m * 16); const float s = sr[ai][m];
#pragma unroll
                for (int bj = 0; bj < 2; ++bj) *(u32x4*)(Kb + row * 512 + col0 + bj * 128) = pack_row8(acc[ai][bj][m][0] * s, acc[ai][bj][m][1] * s); }
    }
};
struct EpiVT {
    static constexpr bool DUAL = false;
    bf16_t* VT; const float* SSQ;
    DEVM void operator()(EPI_ARGS) const {
        const int row0 = u.pm * 256 + wr * 64 + fr, col0 = u.pn * 256 + wc * 32 + 8 * fq;
        float sc[2][8];
#pragma unroll
        for (int bj = 0; bj < 2; ++bj)
#pragma unroll
            for (int x = 0; x < 8; ++x) sc[bj][x] = rms_scale(SSQ, (size_t)(col0 + bj * 128 + x));
        MEM_FENCE();
#pragma unroll
        for (int ai = 0; ai < 2; ++ai)
#pragma unroll
            for (int m = 0; m < 4; ++m) { const size_t row = (size_t)(row0 + ai * 128 + m * 16);
#pragma unroll
                for (int bj = 0; bj < 2; ++bj) { f32x4 v0 = acc[ai][bj][m][0], v1 = acc[ai][bj][m][1];
#pragma unroll
                    for (int x = 0; x < 4; ++x) { v0[x] *= sc[bj][x]; v1[x] *= sc[bj][4 + x]; }
                    *(u32x4*)(VT + row * (size_t)M + col0 + bj * 128) = pack_row8(v0, v1); } }
    }
};
struct EpiUpDual {
    static constexpr bool DUAL = true;
    bf16_t* Y; const bf16_t* H;
    DEVM bool dual(f32x4 (&acc)[2][2][4][2], const Unit& u, int wr, int wc, int fr, int fq) const {
        const int row0 = u.pm * 256 + wr * 64 + fr, col0 = u.pn * 256 + wc * 32 + 8 * fq;
        const int gcol = (u.e == 0) ? C_GA : C_GM;
#pragma unroll
        for (int ai = 0; ai < 2; ++ai) {
            u32x4 gv[4][2];
#pragma unroll
            for (int m = 0; m < 4; ++m) { const size_t row = (size_t)(row0 + ai * 128 + m * 16);
#pragma unroll
                for (int bj = 0; bj < 2; ++bj) gv[m][bj] = *(const u32x4*)(H + row * LDH + gcol + col0 + bj * 128); }
            MEM_FENCE();
#pragma unroll
            for (int m = 0; m < 4; ++m) { const size_t row = (size_t)(row0 + ai * 128 + m * 16);
#pragma unroll
                for (int bj = 0; bj < 2; ++bj) { const u32x4 g = gv[m][bj];
                    const float g8[8] = {lo_bf(g.x), hi_bf(g.x), lo_bf(g.y), hi_bf(g.y), lo_bf(g.z), hi_bf(g.z), lo_bf(g.w), hi_bf(g.w)};
                    if (u.e == 0) {
#pragma unroll
                        for (int x = 0; x < 4; ++x) { acc[ai][bj][m][0][x] *= g8[x]; acc[ai][bj][m][1][x] *= g8[4 + x]; }
                    } else { f32x4 v0 = acc[ai][bj][m][0], v1 = acc[ai][bj][m][1];
#pragma unroll
                        for (int x = 0; x < 4; ++x) { v0[x] *= g8[x]; v1[x] *= g8[4 + x]; }
                        *(u32x4*)(Y + row * 1024 + col0 + bj * 128) = pack_row8(v0, v1); } } }
            MEM_FENCE();
        }
        return u.e == 0;
    }
};
struct SchedDual {
    static constexpr bool GATHER = false;
    pg8::SchedStatic T; int K, lda, ldb; const bf16_t* A0; const bf16_t* A1; const bf16_t* B0; const bf16_t* B1; int phase_id = -1;
    DEVM bool next(int i, Unit& u) const { if (!T.next(i >> 1, u)) return false; u.e = i & 1; return true; }
    DEVM const char* baseA(const Unit& u) const { return (const char*)((u.e ? A1 : A0) + (size_t)u.pm * 256 * lda); }
    DEVM const char* baseB(const Unit& u) const { return (const char*)((u.e ? B1 : B0) + (size_t)u.pn * 256 * ldb); }
};
struct EpiOut {
    static constexpr bool DUAL = false;
    bf16_t* Z; const bf16_t* XB;
    DEVM void operator()(EPI_ARGS) const {
        const int row0 = u.pm * 256 + wr * 64 + fr, col0 = u.pn * 256 + wc * 32 + 8 * fq;
#pragma unroll
        for (int ai = 0; ai < 2; ++ai) {
            u32x4 xv[4][2];
#pragma unroll
            for (int m = 0; m < 4; ++m) { const size_t off = (size_t)(row0 + ai * 128 + m * 16) * 1024 + col0;
#pragma unroll
                for (int bj = 0; bj < 2; ++bj) xv[m][bj] = *(const u32x4*)(XB + off + bj * 128); }
            MEM_FENCE();
#pragma unroll
            for (int m = 0; m < 4; ++m) { const size_t off = (size_t)(row0 + ai * 128 + m * 16) * 1024 + col0;
#pragma unroll
                for (int bj = 0; bj < 2; ++bj) { const u32x4 x = xv[m][bj]; f32x4 v0 = acc[ai][bj][m][0], v1 = acc[ai][bj][m][1];
                    v0[0] += ALPHA * lo_bf(x.x); v0[1] += ALPHA * hi_bf(x.x); v0[2] += ALPHA * lo_bf(x.y); v0[3] += ALPHA * hi_bf(x.y);
                    v1[0] += ALPHA * lo_bf(x.z); v1[1] += ALPHA * hi_bf(x.z); v1[2] += ALPHA * lo_bf(x.w); v1[3] += ALPHA * hi_bf(x.w);
                    *(u32x4*)(Z + off + bj * 128) = pack_row8(v0, v1); } }
            MEM_FENCE();
        }
    }
};
struct EpiMoe1 {
    static constexpr bool DUAL = false;
    bf16_t* HD;
    DEVM void operator()(EPI_ARGS) const {
        const int row0 = u.pm * 256 + wr * 64 + fr, col0 = u.pn * 128 + wc * 32 + 8 * fq;
#pragma unroll
        for (int ai = 0; ai < 2; ++ai)
#pragma unroll
            for (int m = 0; m < 4; ++m) { const size_t row = (size_t)(row0 + ai * 128 + m * 16);
                f32x4 v0, v1;
#pragma unroll
                for (int x = 0; x < 4; ++x) { const float g0 = acc[ai][0][m][0][x], g1 = acc[ai][0][m][1][x]; v0[x] = g0 * sigmoidf_(g0) * acc[ai][1][m][0][x]; v1[x] = g1 * sigmoidf_(g1) * acc[ai][1][m][1][x]; }
                *(u32x4*)(HD + row * 512 + col0) = pack_row8(v0, v1); }
    }
};
struct EpiMoe2 {
    static constexpr bool DUAL = false;
    bf16_t* O2;
    DEVM void operator()(EPI_ARGS) const {
        const int row0 = u.pm * 256 + wr * 64 + fr, col0 = u.pn * 256 + wc * 32 + 8 * fq;
#pragma unroll
        for (int ai = 0; ai < 2; ++ai)
#pragma unroll
            for (int m = 0; m < 4; ++m) { const size_t row = (size_t)(row0 + ai * 128 + m * 16);
#pragma unroll
                for (int bj = 0; bj < 2; ++bj) *(u32x4*)(O2 + row * 1024 + col0 + bj * 128) = pack_row8(acc[ai][bj][m][0], acc[ai][bj][m][1]); }
    }
};

struct Ctx {
    const float* in[25]; float* out; unsigned char* ws;
    int tid, lane, wid, G, bid;
    LAS unsigned char* lds;
};
#define IN_X 0
#define IN_WIN 1
#define IN_CONVW 2
#define IN_CONVB 3
#define IN_KVG 4
#define IN_WUK 5
#define IN_WUV 6
#define IN_RELB 7
#define IN_BI 8
#define IN_BF 9
#define IN_MHG 10
#define IN_WUPA 11
#define IN_WUPM 12
#define IN_WOUT 13
#define IN_LN1G 14
#define IN_LN1B 15
#define IN_WGRP 16
#define IN_BGRP 17
#define IN_WRT 18
#define IN_BRT 19
#define IN_WGATE 20
#define IN_WUP 21
#define IN_WDOWN 22
#define IN_LN2G 23
#define IN_LN2B 24
template <class T> DEV T* wsp(const Ctx& c, size_t off) { return (T*)(c.ws + off); }
DEV const float* par(const Ctx& c, int off) { return (const float*)(c.ws + WS_PAR) + off; }
DEV void wg_sync() { __syncthreads(); }

DEV int win_src_col(int n) {
    if (n < 1280) return n;
    if (n < 2816) return 1352 + (n - 1280);
    if (n < 3328) return 2896 + (n - 2816);
    if (n < 5376) { const int j = (n - 3328) >> 8, w = (n - 3328) & 255; return (w < 128) ? 3408 + 128 * j + w : 4432 + 128 * j + (w - 128); }
    if (n < 5440) return 1280 + (n - 5376);
    if (n < 5448) return 1344 + (n - 5440);
    if (n < 5456) return 2888 + (n - 5448);
    return -1;
}
DEV void p0_item(const float* W, const float* W2, int K, int Nsrc, bf16_t* WT, int mode, const float* aux, LAS float* scr, int item, int nblk, int lane) {
    const int kb = item / nblk, nb = item % nblk, k0 = 64 * kb, n0 = 32 * nb;
    const int nn = n0 + (lane & 31);
    int col = nn; const float* src = W; float cs = 1.0f;
    if (mode == 1) { col = win_src_col(nn); cs = (nn < 512) ? QSCALE : 1.0f; }
    if (mode == 3) { const int t = nn >> 8, j = nn & 255; col = t * 128 + (j & 127); src = (j < 128) ? W : W2; }
    float vv[32];
#pragma unroll
    for (int i = 0; i < 32; ++i) { const int kk = 2 * i + (lane >> 5); vv[i] = (col >= 0) ? src[(size_t)(k0 + kk) * Nsrc + col] : 0.f; }
#pragma unroll
    for (int i = 0; i < 32; ++i) { const int kk = 2 * i + (lane >> 5); float v = vv[i] * cs; if (mode == 2) v *= aux[k0 + kk];
        scr[kk * 33 + (lane & 31)] = v; }
    WAVE_SYNC();
    const int c = lane & 7;
#pragma unroll
    for (int j = 0; j < 4; ++j) { const int n = (lane >> 3) + 8 * j; const LAS float* s = scr + (8 * c) * 33 + n;
        u32x4 o; o.x = pk2(s[0 * 33], s[1 * 33]); o.y = pk2(s[2 * 33], s[3 * 33]); o.z = pk2(s[4 * 33], s[5 * 33]); o.w = pk2(s[6 * 33], s[7 * 33]);
        *(u32x4*)(WT + (size_t)(n0 + n) * K + k0 + 8 * c) = o; }
    WAVE_SYNC();
}
DEV void p0_expert_items(const Ctx& c, int gw, int NGW) {
    LAS float* scr = (LAS float*)(c.lds + c.wid * 16384);
    constexpr int I_GU = 16 * 32, I_D = 8 * 32;
    for (int it = gw; it < NE * (I_GU + I_D); it += NGW) {
        int r = it;
        if (r < NE * I_GU) { const int e = r / I_GU; p0_item(c.in[IN_WGATE] + (size_t)e * 1024 * 512, c.in[IN_WUP] + (size_t)e * 1024 * 512, 1024, 512, wsp<bf16_t>(c, WS_WGU) + (size_t)e * 1024 * 1024, 3, nullptr, scr, r % I_GU, 32, c.lane); continue; } r -= NE * I_GU;
        { const int e = r / I_D; p0_item(c.in[IN_WDOWN] + (size_t)e * 512 * 1024, nullptr, 512, 1024, wsp<bf16_t>(c, WS_WD) + (size_t)e * 1024 * 512, 0, nullptr, scr, r % I_D, 32, c.lane); }
    }
}
DEV void ex_params(const Ctx& c, int it, const float*& src, int& K, int& Nsrc, bf16_t*& WT, int& k0, int& n0, int lane) {
    constexpr int I_GU = 16 * 32, I_D = 8 * 32; int r = it, item; const float* W; const float* W2 = nullptr; int mode;
    if (r < NE * I_GU) { const int e = r / I_GU; W = c.in[IN_WGATE] + (size_t)e * 1024 * 512; W2 = c.in[IN_WUP] + (size_t)e * 1024 * 512; K = 1024; Nsrc = 512; WT = wsp<bf16_t>(c, WS_WGU) + (size_t)e * 1024 * 1024; mode = 3; item = r % I_GU; }
    else { r -= NE * I_GU; const int e = r / I_D; W = c.in[IN_WDOWN] + (size_t)e * 512 * 1024; K = 512; Nsrc = 1024; WT = wsp<bf16_t>(c, WS_WD) + (size_t)e * 1024 * 512; mode = 0; item = r % I_D; }
    const int kb = item / 32, nb = item % 32; k0 = 64 * kb; n0 = 32 * nb;
    const int nn = n0 + (lane & 31); int col = nn; src = W;
    if (mode == 3) { const int t = nn >> 8, j = nn & 255; col = t * 128 + (j & 127); src = (j < 128) ? W : W2; }
    src += col;
}
DEV void ex_load(float (&vv)[32], const Ctx& c, int it, int lane) {
    const float* src; int K, Nsrc, k0, n0; bf16_t* WT; ex_params(c, it, src, K, Nsrc, WT, k0, n0, lane);
#pragma unroll
    for (int i = 0; i < 32; ++i) vv[i] = src[(size_t)(k0 + 2 * i + (lane >> 5)) * Nsrc];
}
DEV void ex_finish(const float (&vv)[32], const Ctx& c, int it, LAS float* scr, int lane) {
    const float* src; int K, Nsrc, k0, n0; bf16_t* WT; ex_params(c, it, src, K, Nsrc, WT, k0, n0, lane);
#pragma unroll
    for (int hf = 0; hf < 2; ++hf) {
#pragma unroll
        for (int i = 0; i < 16; ++i) scr[(2 * i + (lane >> 5)) * 33 + (lane & 31)] = vv[16 * hf + i];
        WAVE_SYNC();
        const int cc = lane & 3;
#pragma unroll
        for (int j = 0; j < 2; ++j) { const int n = (lane >> 2) + 16 * j; const LAS float* s = scr + (8 * cc) * 33 + n;
            u32x4 o; o.x = pk2(s[0 * 33], s[1 * 33]); o.y = pk2(s[2 * 33], s[3 * 33]); o.z = pk2(s[4 * 33], s[5 * 33]); o.w = pk2(s[6 * 33], s[7 * 33]);
            *(u32x4*)(WT + (size_t)(n0 + n) * K + k0 + 32 * hf + 8 * cc) = o; }
        WAVE_SYNC();
    }
}
DEV void phase_prologue(const Ctx& c) {
    LAS float* scr = (LAS float*)(c.lds + c.wid * 16384);
    const int gw = c.bid * NWAVES + c.wid, NGW = c.G * NWAVES;
    constexpr int I_WIN = 16 * (NWIN / 32), I_KV = 4 * 16, I_UP = 8 * 32, I_WO = 16 * 32;
    constexpr int NITEMS = I_WIN + 2 * I_KV + 2 * I_UP + I_WO;
    for (int it = gw; it < NITEMS; it += NGW) {
        int r = it;
        if (r < I_WIN) { p0_item(c.in[IN_WIN], nullptr, 1024, 5456, wsp<bf16_t>(c, WS_WIN), 1, nullptr, scr, r, NWIN / 32, c.lane); continue; } r -= I_WIN;
        if (r < I_KV) { p0_item(c.in[IN_WUK], nullptr, 256, 512, wsp<bf16_t>(c, WS_WK), 2, c.in[IN_KVG], scr, r, 16, c.lane); continue; } r -= I_KV;
        if (r < I_KV) { p0_item(c.in[IN_WUV], nullptr, 256, 512, wsp<bf16_t>(c, WS_WV), 2, c.in[IN_KVG], scr, r, 16, c.lane); continue; } r -= I_KV;
        if (r < I_UP) { p0_item(c.in[IN_WUPA], nullptr, 512, 1024, wsp<bf16_t>(c, WS_WA), 0, nullptr, scr, r, 32, c.lane); continue; } r -= I_UP;
        if (r < I_UP) { p0_item(c.in[IN_WUPM], nullptr, 512, 1024, wsp<bf16_t>(c, WS_WM), 0, nullptr, scr, r, 32, c.lane); continue; } r -= I_UP;
        p0_item(c.in[IN_WOUT], nullptr, 1024, 1024, wsp<bf16_t>(c, WS_WO), 0, nullptr, scr, r, 32, c.lane);
    }
    { float* P = wsp<float>(c, WS_PAR); const int gt = c.bid * NTHREADS + c.tid, ngt = c.G * NTHREADS;
      for (int i = gt; i < P_END; i += ngt) { float v;
        if (i < P_CONVB) v = c.in[IN_CONVW][i]; else if (i < P_BI) v = c.in[IN_CONVB][i - P_CONVB]; else if (i < P_BF) v = c.in[IN_BI][i - P_BI]; else if (i < P_MHG) v = c.in[IN_BF][i - P_BF];
        else if (i < P_RELB) v = c.in[IN_MHG][i - P_MHG]; else if (i < P_LN1G) v = c.in[IN_RELB][i - P_RELB]; else if (i < P_LN1B) v = c.in[IN_LN1G][i - P_LN1G]; else if (i < P_WGRP) v = c.in[IN_LN1B][i - P_LN1B];
        else if (i < P_BGRP) v = c.in[IN_WGRP][i - P_WGRP]; else if (i < P_WRT) v = c.in[IN_BGRP][i - P_BGRP]; else if (i < P_BRT) v = c.in[IN_WRT][i - P_WRT]; else if (i < P_LN2G) v = c.in[IN_BRT][i - P_BRT];
        else if (i < P_LN2B) v = c.in[IN_LN2G][i - P_LN2G]; else v = c.in[IN_LN2B][i - P_LN2B];
        P[i] = v; }
      for (int i = gt; i < 1024 * 20; i += ngt) { const int comp = i & 3, ln = (i >> 2) & 63, r = i >> 8, e4 = r % 5, jx = r / 5, kk = 4 * ln + 256 * (jx >> 2) + (jx & 3), col = 4 * e4 + comp;
          P[P_RW + i] = (col < 4) ? c.in[IN_WGRP][kk * 4 + col] : c.in[IN_WRT][kk * 16 + (col - 4)]; } }
    const float* X = c.in[IN_X]; bf16_t* XB = (bf16_t*)c.out;
    for (int m0 = gw; m0 < M; m0 += 4 * NGW) {
        f32x4 v[4][4];
#pragma unroll
        for (int q = 0; q < 4; ++q) { const int m = m0 + q * NGW; if (m < M) { const f32x4* xr = (const f32x4*)(X + (size_t)m * DM) + c.lane;
#pragma unroll
            for (int j = 0; j < 4; ++j) v[q][j] = xr[64 * j]; } }
#pragma unroll
        for (int q = 0; q < 4; ++q) { const int m = m0 + q * NGW; if (m < M) { u32x2* o = (u32x2*)(XB + (size_t)m * DM) + c.lane;
#pragma unroll
            for (int j = 0; j < 4; ++j) { u32x2 w; w.x = pk2(v[q][j][0], v[q][j][1]); w.y = pk2(v[q][j][2], v[q][j][3]); o[64 * j] = w; } } }
    }
}

#ifndef P2PROBE
#define P2PROBE 0
#define P2PROBE_KIND 1
#endif
constexpr int SCP = SEQ + 32;
constexpr int I_WQ = 16 * SCP * 4, I_CAND = I_WQ + 512, I_HIST = I_CAND + NWAVES * 320, IDX_LDS = I_HIST + NWAVES * 1280;
constexpr int NR = SEQ / 64, NGRP = NR / 8;
static_assert(NR % 8 == 0, "SEQ must be a multiple of 512");
DEV unsigned lds_add(LAS unsigned* p, unsigned v) {
#ifdef EMU
    return __atomic_fetch_add(p, v, __ATOMIC_RELAXED);
#else
    return __hip_atomic_fetch_add(p, v, __ATOMIC_RELAXED, __HIP_MEMORY_SCOPE_WORKGROUP);
#endif
}
DEV int rd_lane(int v, int l) {
#ifdef EMU
    return __shfl(v, l);
#else
    return __builtin_amdgcn_readlane(v, l);
#endif
}
DEV unsigned wr_lane(unsigned val, int l, unsigned old) {
#ifdef EMU
    return (e_lane == l) ? val : old;
#else
    return (((int)threadIdx.x & 63) == l) ? val : old;
#endif
}
DEV int wave_sum_int(int v) {
#ifdef EMU
#pragma unroll
    for (int o = 1; o < 64; o <<= 1) v += __shfl_xor(v, o);
    return v;
#else
    v += __builtin_amdgcn_update_dpp(0, v, 0x111, 0xf, 0xf, true);
    v += __builtin_amdgcn_update_dpp(0, v, 0x112, 0xf, 0xf, true);
    v += __builtin_amdgcn_update_dpp(0, v, 0x114, 0xf, 0xf, true);
    v += __builtin_amdgcn_update_dpp(0, v, 0x118, 0xf, 0xf, true);
    v += __builtin_amdgcn_update_dpp(0, v, 0x142, 0xa, 0xf, false);
    v += __builtin_amdgcn_update_dpp(0, v, 0x143, 0xc, 0xf, false);
    return __builtin_amdgcn_readlane(v, 63);
#endif
}
DEV void idx_select_row(const LAS float* scrow, int t, unsigned* out, LAS unsigned* cand_lds, int lane) {
    if (t + 1 <= TOPK) {
        if (lane < NWORDS) { const int lo = 32 * lane; out[lane] = (lo + 31 <= t) ? 0xffffffffu : (lo > t ? 0u : ((1u << (t - lo + 1)) - 1u)); }
        return;
    }
    const int ng = (t >> 9) + 1;
    const int tl = t - lane;
    unsigned key[NR];
#pragma unroll
    for (int g = 0; g < NGRP; ++g) {
#pragma unroll
        for (int r8 = 0; r8 < 8; ++r8) key[8 * g + r8] = 0u;
        if (g < ng) {
#pragma unroll
            for (int r8 = 0; r8 < 8; ++r8) { const int r = 8 * g + r8; const unsigned uu = fbits(scrow[r * 64 + lane]); const unsigned kk = uu ^ ((unsigned)((int)uu >> 31) | 0x80000000u); key[r] = (64 * r <= tl) ? kk : 0u; }
        }
    }
    unsigned smp;
    { const int gsel = (lane >> 4) % ng; unsigned s0 = key[0], s1 = key[8], s2 = key[16], s3 = key[24];
#ifndef EMU
      asm volatile("" : "+v"(s0), "+v"(s1), "+v"(s2), "+v"(s3));
#endif
      smp = (gsel == 1) ? s1 : (gsel == 2) ? s2 : (gsel == 3) ? s3 : s0; }
    const int nv = __popcll(__ballot(smp != 0u));
    smp = (smp & ~63u) | (unsigned)(63 - lane);
    int srank = 0;
#pragma unroll
    for (int j = 0; j < 64; ++j) { const unsigned sj = (unsigned)lane_bcast((int)smp, j); srank += (sj > smp) ? 1 : 0; }
    unsigned L = 1u, Hm = 0xffffffffu; int cntL = t + 1, cntH = 0, rL = nv, rH = -1;
    bool tie = false;
#pragma unroll 1
    for (;;) {
        if (cntL - cntH <= 64) break;
        if (Hm == L) { tie = true; break; }
        unsigned p; int rp = -2; const int between = rL - rH - 1;
        if (between > 0) { int o = (int)((float)(TOPK - cntH) * (float)between / (float)(cntL - cntH)); o = o < 0 ? 0 : (o > between - 1 ? between - 1 : o); rp = rH + 1 + o;
            const u64 mm = __ballot(srank == rp); p = (unsigned)lane_bcast((int)smp, (int)__builtin_ctzll(mm));
            if (p <= L || p > Hm) { rp = -2; p = L + ((Hm - L) >> 1) + 1u; } }
        else p = L + ((Hm - L) >> 1) + 1u;
        int cl = 0;
#pragma unroll
        for (int g = 0; g < NGRP; ++g) if (g < ng) {
#pragma unroll
            for (int r8 = 0; r8 < 8; ++r8) cl += (key[8 * g + r8] >= p) ? 1 : 0;
        }
        const int cc = wave_sum_int(cl);
        if (cc >= TOPK) { L = p; cntL = cc; if (rp >= 0) rL = rp; } else { Hm = p - 1u; cntH = cc; if (rp >= 0) rH = rp; }
    }
    unsigned lo; int cgt, cge; const int cnt_hi = cntH;
    if (!tie) {
        const int und = cntL - cntH; const u64 ltm = (lane == 0) ? 0ull : (~0ull >> (64 - lane)); int base = 0; const unsigned span = Hm - L;
#pragma unroll
        for (int g = 0; g < NGRP; ++g) if (g < ng) {
#pragma unroll
            for (int r8 = 0; r8 < 8; ++r8) { const unsigned k2 = key[8 * g + r8]; const bool f = (k2 - L) <= span; const u64 mm = __ballot(f);
                if (mm != 0ull) { if (f) cand_lds[(base + __popcll(mm & ltm)) & 63] = k2; base += __popcll(mm); } }
        }
        WAVE_SYNC();
        const bool cv = lane < und; const unsigned cand = cv ? cand_lds[lane] : 0u;
        WAVE_SYNC();
        const unsigned dx = L ^ Hm; int bit = dx ? 31 - (int)__builtin_clz(dx) : -1;
        lo = (bit >= 31) ? 0u : (L & ~((2u << (bit < 0 ? 0 : bit)) - 1u)); if (bit < 0) lo = L;
#pragma unroll 1
        for (; bit >= 0; --bit) { const unsigned trial = lo | (1u << bit); const int cc = cnt_hi + __popcll(__ballot(cv && cand >= trial)); if (cc >= TOPK) lo = trial; }
        cgt = cnt_hi + __popcll(__ballot(cv && cand > lo)); cge = cnt_hi + __popcll(__ballot(cv && cand >= lo));
    } else { lo = L; cge = cntL; cgt = cntH; }
    const int need = TOPK - cgt; unsigned mlo = 0u, mhi = 0u;
    if (cge - cgt == need) {
#pragma unroll
        for (int g = 0; g < NGRP; ++g) if (g < ng) {
#pragma unroll
            for (int r8 = 0; r8 < 8; ++r8) { const u64 mm = __ballot(key[8 * g + r8] >= lo); mlo = wr_lane((unsigned)mm, 8 * g + r8, mlo); mhi = wr_lane((unsigned)(mm >> 32), 8 * g + r8, mhi); }
        }
    } else {
        const u64 ltm = (lane == 0) ? 0ull : (~0ull >> (64 - lane)); int run = 0;
#pragma unroll
        for (int g = 0; g < NGRP; ++g) if (g < ng) {
#pragma unroll
            for (int r8 = 0; r8 < 8; ++r8) { const unsigned k2 = key[8 * g + r8]; const bool eqp = k2 == lo; const u64 eq = __ballot(eqp); const int rank = run + __popcll(eq & ltm);
                const bool sel = (k2 > lo) || (eqp && rank < need); const u64 mm = __ballot(sel); mlo = wr_lane((unsigned)mm, 8 * g + r8, mlo); mhi = wr_lane((unsigned)(mm >> 32), 8 * g + r8, mhi); run += __popcll(eq); }
        }
    }
    if (lane < NR) { u32x2 w; w.x = mlo; w.y = mhi; *(u32x2*)(out + 2 * lane) = w; }
}
DEV void idx_load_b(bf16x8 (&bf)[4], const bf16_t* KIDX, size_t rowb, int kc, int r32, int hi) {
    const bf16_t* p = KIDX + (rowb + kc * 32 + r32) * 64 + hi * 8;
#pragma unroll
    for (int ks = 0; ks < 4; ++ks) bf[ks] = *(const bf16x8*)(p + ks * 16);
}
DEV void idx_load_a(bf16x8 (&af)[4][4], const bf16_t* H, size_t rowb, int t0, int r32, int hi) {
    const int ah = (r32 & 3) + 4 * ((r32 >> 3) & 1), atl = 2 * (r32 >> 4) + ((r32 >> 2) & 1);
#pragma unroll
    for (int T = 0; T < 4; ++T)
#pragma unroll
        for (int ks = 0; ks < 4; ++ks) af[T][ks] = *(const bf16x8*)(H + (rowb + t0 + 4 * T + atl) * LDH + C_QI + ah * 64 + ks * 16 + hi * 8);
}
struct IdxQbRaw { unsigned q[8]; f32x4 w0, w1; };
DEV void idx_load_qb(IdxQbRaw& R, const bf16_t* H, const float* SM, size_t rowb, int t0, int tid) {
    const size_t row = rowb + t0 + (tid >> 5);
#pragma unroll
    for (int h = 0; h < 8; ++h) R.q[h] = *(const unsigned*)(H + row * LDH + C_QI + h * 64 + 2 * (tid & 31));
    R.w0 = *(const f32x4*)(SM + row * 16); R.w1 = *(const f32x4*)(SM + row * 16 + 4);
}
DEV void idx_units(const Ctx& c, int c2, int g2) {
    const int lane = c.lane, wid = c.wid, r32 = lane & 31, hi = lane >> 5;
    LAS float* sc = (LAS float*)c.lds; LAS float* WQ = (LAS float*)(c.lds + I_WQ); LAS unsigned* CAND = (LAS unsigned*)(c.lds + I_CAND) + wid * 80;
    LAS bf16_t* QBH = (LAS bf16_t*)(c.lds + I_HIST); LAS bf16_t* QBL = QBH + 16 * 72;
    const bf16_t* H = wsp<bf16_t>(c, WS_H); const bf16_t* KIDX = wsp<bf16_t>(c, WS_KIDX); const float* SM = wsp<float>(c, WS_SM);
    unsigned* MASK = wsp<unsigned>(c, WS_MASK);
    const int nq = SEQ / 16, nunits = NB * nq;
    bf16x8 af[4][4], afn[4][4]; IdxQbRaw qr;
    if (c2 < nunits) { idx_load_a(af, H, (size_t)(c2 % NB) * SEQ, (nq - 1 - c2 / NB) * 16, r32, hi); idx_load_qb(qr, H, SM, (size_t)(c2 % NB) * SEQ, (nq - 1 - c2 / NB) * 16, c.tid); }
    const int qrow = 2 * ((r32 & 3) + 4 * ((r32 >> 3) & 1)) + ((r32 >> 2) & 1);
    for (int u = c2; u < nunits; u += g2) {
        const int b = u % NB, qt = nq - 1 - u / NB, t0 = qt * 16; const size_t rowb = (size_t)b * SEQ;
        const int nkc = (t0 + 16 + 31) / 32;
        {
            const float wv[8] = {qr.w0[0], qr.w0[1], qr.w0[2], qr.w0[3], qr.w1[0], qr.w1[1], qr.w1[2], qr.w1[3]};
            float q0 = 0.f, q1 = 0.f;
#pragma unroll
            for (int h = 0; h < 8; ++h) { q0 += 0.5f * wv[h] * lo_bf(qr.q[h]); q1 += 0.5f * wv[h] * hi_bf(qr.q[h]); }
            const unsigned hw = pk2(q0, q1); const unsigned lw = pk2(q0 - lo_bf(hw), q1 - hi_bf(hw));
            *(LAS unsigned*)(QBH + (c.tid >> 5) * 72 + 2 * (c.tid & 31)) = hw; *(LAS unsigned*)(QBL + (c.tid >> 5) * 72 + 2 * (c.tid & 31)) = lw;
            if ((c.tid & 31) < 8) WQ[(c.tid >> 5) * 8 + (c.tid & 31)] = 0.5f * wv[c.tid & 31];
        }
        bf16x8 bq0[4], bq1[4], bq2[4];
        if (wid < nkc) idx_load_b(bq0, KIDX, rowb, wid, r32, hi);
        if (wid + NWAVES < nkc) idx_load_b(bq1, KIDX, rowb, wid + NWAVES, r32, hi);
        wg_sync();
#if P2PROBE && P2PROBE_KIND == 2
        const unsigned long long pk_t0 = rt_now();
#endif
        bf16x8 alq[4];
#pragma unroll
        for (int ks = 0; ks < 4; ++ks) alq[ks] = *(const LAS bf16x8*)(((r32 < 16) ? QBH : QBL) + qrow * 72 + ks * 16 + hi * 8);
#define IDX_CHUNK(BC, BP) { \
            if (kc + 2 * NWAVES < nkc) idx_load_b(BP, KIDX, rowb, kc + 2 * NWAVES, r32, hi); \
            const int key = kc * 32 + r32; \
            f32x16 al = {0.f, 0.f, 0.f, 0.f, 0.f, 0.f, 0.f, 0.f, 0.f, 0.f, 0.f, 0.f, 0.f, 0.f, 0.f, 0.f};       \
            _Pragma("unroll") for (int ks = 0; ks < 4; ++ks) al = mfma32(alq[ks], BC[ks], al); \
            _Pragma("unroll") for (int T = 0; T < 4; ++T) { \
                f32x16 a = {0.f, 0.f, 0.f, 0.f, 0.f, 0.f, 0.f, 0.f, 0.f, 0.f, 0.f, 0.f, 0.f, 0.f, 0.f, 0.f}; \
                _Pragma("unroll") for (int ks = 0; ks < 4; ++ks) a = mfma32(af[T][ks], BC[ks], a); \
                const int tq0 = 4 * T + hi; \
                const f32x4 w00 = *(const LAS f32x4*)(WQ + tq0 * 8), w01 = *(const LAS f32x4*)(WQ + tq0 * 8 + 4), w10 = *(const LAS f32x4*)(WQ + (tq0 + 2) * 8), w11 = *(const LAS f32x4*)(WQ + (tq0 + 2) * 8 + 4); \
                float s0 = al[2 * T] + al[2 * T + 8], s1 = al[2 * T + 1] + al[2 * T + 9];     \
                _Pragma("unroll") for (int i = 0; i < 4; ++i) { s0 += w00[i] * fabsf(a[i]) + w01[i] * fabsf(a[4 + i]); s1 += w10[i] * fabsf(a[8 + i]) + w11[i] * fabsf(a[12 + i]); } \
                sc[tq0 * SCP + key] = s0; sc[(tq0 + 2) * SCP + key] = s1; } \
            kc += NWAVES; }
        for (int kc = wid; kc < nkc; ) {
            IDX_CHUNK(bq0, bq2) if (kc >= nkc) break;
            IDX_CHUNK(bq1, bq0) if (kc >= nkc) break;
            IDX_CHUNK(bq2, bq1)
        }
#undef IDX_CHUNK
        const int un = u + g2;
        if (un < nunits) { idx_load_a(afn, H, (size_t)(un % NB) * SEQ, (nq - 1 - un / NB) * 16, r32, hi); idx_load_qb(qr, H, SM, (size_t)(un % NB) * SEQ, (nq - 1 - un / NB) * 16, c.tid); }
        LDS_SYNC();
#if P2PROBE && P2PROBE_KIND == 2
        if (c2 == 0 && c.tid == 0) { volatile LAS unsigned* mm = (volatile LAS unsigned*)(c.lds + (144 * 1024 - 64)); mm[4] = mm[4] + (unsigned)(rt_now() - pk_t0); }
#endif
#if P2PROBE && P2PROBE_KIND == 3
        const unsigned long long pk_t1 = rt_now();
#endif
#pragma unroll 1
        for (int qq = 0; qq < 2; ++qq) { const int tq = wid + 8 * qq, t = t0 + tq; idx_select_row(sc + tq * SCP, t, MASK + (rowb + t) * NWORDS, CAND, lane); }
        LDS_SYNC();
#if P2PROBE && P2PROBE_KIND == 3
        if (c2 == 0 && c.tid == 0) { volatile LAS unsigned* mm = (volatile LAS unsigned*)(c.lds + (144 * 1024 - 64)); mm[4] = mm[4] + (unsigned)(rt_now() - pk_t1); }
#endif
        if (un < nunits) {
#pragma unroll
            for (int T = 0; T < 4; ++T)
#pragma unroll
                for (int ks = 0; ks < 4; ++ks) af[T][ks] = afn[T][ks]; }
    }
    wg_sync();
}

constexpr int QP = 136, TP = 72;
constexpr int L_QS = 0, L_KS = L_QS + 64 * QP * 2, L_KT = L_KS + 64 * QP * 2, L_VT = L_KT + 128 * TP * 2, L_CT = L_VT + 128 * TP * 2, L_N = L_CT + 128 * QP * 2,
              L_G = L_N + 512, L_PART = L_G + NWAVES * 1280, L_CW = L_PART + 1024, L_GN = L_CW + 32 * 40 * 4, ML_LDS = L_GN + 512;
#ifndef EMU
template <int CTRL, int ROWMASK> DEV float dpp_f(float v, float ident) { return bitsf((unsigned)__builtin_amdgcn_update_dpp((int)fbits(ident), (int)fbits(v), CTRL, ROWMASK, 0xf, false)); }
#endif
DEV float scan_add(float v, int lane) {
#ifdef EMU
#pragma unroll
    for (int d = 1; d < 64; d <<= 1) { const float o = __shfl_up(v, d); if (lane >= d) v += o; }
#else
    v += dpp_f<0x111, 0xf>(v, 0.f); v += dpp_f<0x112, 0xf>(v, 0.f); v += dpp_f<0x114, 0xf>(v, 0.f); v += dpp_f<0x118, 0xf>(v, 0.f);
    v += dpp_f<0x142, 0xa>(v, 0.f); v += dpp_f<0x143, 0xc>(v, 0.f); (void)lane;
#endif
    return v;
}
DEV float scan_max(float v, int lane) {
#ifdef EMU
#pragma unroll
    for (int d = 1; d < 64; d <<= 1) { const float o = __shfl_up(v, d); if (lane >= d) v = fmaxf(v, o); }
#else
    const float ninf = -__builtin_inff();
    v = fmaxf(v, dpp_f<0x111, 0xf>(v, ninf)); v = fmaxf(v, dpp_f<0x112, 0xf>(v, ninf)); v = fmaxf(v, dpp_f<0x114, 0xf>(v, ninf)); v = fmaxf(v, dpp_f<0x118, 0xf>(v, ninf));
    v = fmaxf(v, dpp_f<0x142, 0xa>(v, ninf)); v = fmaxf(v, dpp_f<0x143, 0xc>(v, ninf)); (void)lane;
#endif
    return v;
}
DEV int tsw(int d) { return 2 * ((d >> 3) & 7); }
struct MlRaw { u32x4 qk[7]; u32x4 v[2]; float fp, ip; };
DEV void ml_load_gates(MlRaw& R, const float* SM, int b, int head, int ch, int lane, float bfg, float bi) {
    const float* base = SM + ((size_t)b * SEQ + (size_t)ch * 64) * 16 + head;
    R.fp = *(const float*)((const char*)base + (unsigned)(lane * 64 + 48)) + bfg; R.ip = *(const float*)((const char*)base + (unsigned)(lane * 64 + 32)) + bi;
}
DEV void ml_load_bulk(MlRaw& R, const bf16_t* H, int b, int head, int ch, unsigned qoff, unsigned voff, bool first_rows, int tid) {
    const size_t rowc = (size_t)b * SEQ + (size_t)ch * 64;
#pragma unroll
    for (int i = 0; i < 7; ++i) {
        const bool neg = first_rows && ch == 0 && i < 3;
        const bf16_t* base = H + ((long)rowc + i - 3) * LDH;
        const u32x4 raw = *(const u32x4*)((const char*)base + (qoff + (neg ? 3u * LDH * 2u : 0u)));
        const u32x4 z = {0u, 0u, 0u, 0u};
        R.qk[i] = neg ? z : raw; }
#pragma unroll
    for (int o = 0; o < 2; ++o) { const bf16_t* base = H + (rowc + o) * LDH + C_VM + head * 128; R.v[o] = *(const u32x4*)((const char*)base + voff); }
    (void)tid;
}
DEV void mlstm_unit(const Ctx& c, int b, int head) {
    int tid = c.tid; LAUNDER(tid);
    const int lane = tid & 63, wid = c.wid;
    LAS unsigned char* lds = c.lds;
    LAS bf16_t* QS = (LAS bf16_t*)(lds + L_QS); LAS bf16_t* KS = (LAS bf16_t*)(lds + L_KS); LAS bf16_t* KT = (LAS bf16_t*)(lds + L_KT);
    LAS bf16_t* VTs = (LAS bf16_t*)(lds + L_VT); LAS bf16_t* CT = (LAS bf16_t*)(lds + L_CT); LAS float* NV = (LAS float*)(lds + L_N);
    LAS float* GW = (LAS float*)(lds + L_G + wid * 1280); LAS float* PART = (LAS float*)(lds + L_PART);
    const bf16_t* H = wsp<bf16_t>(c, WS_H); const float* SM = wsp<float>(c, WS_SM); bf16_t* HM = wsp<bf16_t>(c, WS_H) + C_HM;
    const float bi = par(c, P_BI)[head], bfg = par(c, P_BF)[head];
    const int vt = wid >> 1, jt = wid & 1;
    const int which = tid >> 8, cg0 = tid & 15, rb0 = (tid & 255) >> 4;
    LAS float* CWL = (LAS float*)(lds + L_CW); LAS float* GNL = (LAS float*)(lds + L_GN);
    for (int i = tid; i < 32 * 40; i += NTHREADS) { const int grp = i / 40, e = i % 40, wh = grp >> 4, cgi = grp & 15, ch0 = wh * 512 + head * 128 + cgi * 8;
        CWL[i] = (e < 32) ? par(c, P_CONVW)[(e >> 3) * 1024 + ch0 + (e & 7)] : par(c, P_CONVB)[ch0 + (e - 32)]; }
    if (tid < 128) GNL[tid] = par(c, P_MHG)[head * 128 + tid];
    f32x16 accC[2];
#pragma unroll
    for (int x = 0; x < 2; ++x)
#pragma unroll
        for (int r = 0; r < 16; ++r) accC[x][r] = 0.f;
    for (int i = tid; i < 128 * QP / 2; i += NTHREADS) ((LAS unsigned*)CT)[i] = 0u;
    if (tid < 128) NV[tid] = 0.f;
    float m_prev = 0.f;
    const unsigned qoff = (unsigned)((rb0 * 4 * LDH + (which ? C_KM : C_QM) + head * 128 + cg0 * 8) * 2), voff = (unsigned)(((tid >> 4) * 2 * LDH + (tid & 15) * 8) * 2);
    MlRaw R; ml_load_gates(R, SM, b, head, 0, lane, bfg, bi); ml_load_bulk(R, H, b, head, 0, qoff, voff, rb0 == 0, tid);
    wg_sync();
    for (int ch = 0; ch < NCH; ++ch) {
        const size_t tok0 = (size_t)b * SEQ + (size_t)ch * 64;
        int tidc = tid; LAUNDER(tidc);
        const int lanec = tidc & 63, r32 = lanec & 31, hi = lanec >> 5, cg = tidc & 15, rb = (tidc & 255) >> 4;
        const LAS float* cwp = CWL + (which * 16 + cg) * 40;
        float wp, a_dec, m_new;
        {
            const float fp = R.fp, ip = R.ip;
            const float lf = fminf(fp, 0.f) - __logf(1.0f + __expf(-fabsf(fp)));
            const float bcum = scan_add(lf, lanec);
            const float g = ip - bcum, gmax = scan_max(g, lanec);
            const float mj = fmaxf(bcum + m_prev, bcum + gmax);
            const float blast = __shfl(bcum, 63), gmx = __shfl(gmax, 63);
            m_new = fmaxf(blast + m_prev, blast + gmx);
            a_dec = __expf(blast + m_prev - m_new);
            wp = __expf(blast + g - m_new);
            GW[lanec] = g * LOG2E; GW[64 + lanec] = (bcum - mj) * LOG2E; GW[128 + lanec] = __expf(bcum + m_prev - mj); GW[192 + lanec] = __expf(-mj);
        }
        {
            float y[4][8];
#pragma unroll
            for (int o = 0; o < 4; ++o)
#pragma unroll
                for (int x = 0; x < 8; ++x) y[o][x] = cwp[32 + x];
#pragma unroll
            for (int i = 0; i < 7; ++i) {
                const u32x4 raw = R.qk[i];
                const float rv[8] = {lo_bf(raw.x), hi_bf(raw.x), lo_bf(raw.y), hi_bf(raw.y), lo_bf(raw.z), hi_bf(raw.z), lo_bf(raw.w), hi_bf(raw.w)};
#pragma unroll
                for (int o = 0; o < 4; ++o) { const int j = i - o; if (j >= 0 && j < 4) {
#pragma unroll
                    for (int x = 0; x < 8; ++x) y[o][x] += cwp[j * 8 + x] * rv[x]; } }
            }
            float wpr[4];
#pragma unroll
            for (int o = 0; o < 4; ++o) wpr[o] = __shfl(wp, rb * 4 + o);
#pragma unroll
            for (int o = 0; o < 4; ++o) {
                const int rr = rb * 4 + o;
#pragma unroll
                for (int x = 0; x < 8; ++x) { const float v = y[o][x]; y[o][x] = v * sigmoidf_(v) * (which ? 0.08838834764831845f : 1.0f); }
                const bf16x8 pk = pack8(y[o][0], y[o][1], y[o][2], y[o][3], y[o][4], y[o][5], y[o][6], y[o][7]);
                if (which == 0) *(LAS bf16x8*)(QS + rr * QP + cg * 8) = pk; else *(LAS bf16x8*)(KS + rr * QP + cg * 8) = pk;
            }
            if (which) {
#pragma unroll
                for (int x = 0; x < 8; ++x) { const int d = cg * 8 + x; u32x2 w; w.x = pk2(y[0][x] * wpr[0], y[1][x] * wpr[1]); w.y = pk2(y[2][x] * wpr[2], y[3][x] * wpr[3]);
                    *(LAS u32x2*)(KT + d * TP + 4 * (rb ^ tsw(d))) = w; }
            }
            { const int cgv = tidc & 15, rg2 = tidc >> 4;
                const unsigned w0[4] = {R.v[0].x, R.v[0].y, R.v[0].z, R.v[0].w}, w1[4] = {R.v[1].x, R.v[1].y, R.v[1].z, R.v[1].w};
#pragma unroll
                for (int x2 = 0; x2 < 4; ++x2) {
                    const int d0 = cgv * 8 + 2 * x2;
                    *(LAS unsigned*)(VTs + d0 * TP + 4 * ((rg2 >> 1) ^ tsw(d0)) + 2 * (rg2 & 1)) = (w0[x2] & 0xffffu) | (w1[x2] << 16);
                    *(LAS unsigned*)(VTs + (d0 + 1) * TP + 4 * ((rg2 >> 1) ^ tsw(d0 + 1)) + 2 * (rg2 & 1)) = (w0[x2] >> 16) | (w1[x2] & 0xffff0000u); }
            }
        }
        if (ch + 1 < NCH) { ml_load_gates(R, SM, b, head, ch + 1, lanec, bfg, bi); ml_load_bulk(R, H, b, head, ch + 1, qoff, voff, rb0 == 0, tid); }
        LDS_SYNC();
        float hval[16]; const int jl = 32 * jt + r32;
        u32x2 sgv[4];
        { const char* sgb = (const char*)(H + tok0 * LDH + C_OM + head * 128); const unsigned sgo = (unsigned)((jl * LDH + 32 * vt + 4 * hi) * 2);
#pragma unroll
          for (int g4 = 0; g4 < 4; ++g4) sgv[g4] = *(const u32x2*)(sgb + (sgo + 16u * g4)); }
        {
            const float ejl = GW[64 + jl], wint = GW[128 + jl], flo = GW[192 + jl];
            f32x16 num = {0.f, 0.f, 0.f, 0.f, 0.f, 0.f, 0.f, 0.f, 0.f, 0.f, 0.f, 0.f, 0.f, 0.f, 0.f, 0.f};
            float den = 0.f;
            bf16x8 qf[8];
#pragma unroll
            for (int ks = 0; ks < 8; ++ks) qf[ks] = *(const LAS bf16x8*)(QS + jl * QP + ks * 16 + hi * 8);
            const int dv = 32 * vt + r32, swv = tsw(dv);
#pragma unroll
            for (int a = 0; a < 2; ++a) {
                if (a <= jt) {
                    f32x16 st = {0.f, 0.f, 0.f, 0.f, 0.f, 0.f, 0.f, 0.f, 0.f, 0.f, 0.f, 0.f, 0.f, 0.f, 0.f, 0.f};
#pragma unroll
                    for (int ks = 0; ks < 8; ++ks) st = mfma32(*(const LAS bf16x8*)(KS + (32 * a + r32) * QP + ks * 16 + hi * 8), qf[ks], st);
                    float pv[16];
#pragma unroll
                    for (int g4 = 0; g4 < 4; ++g4) { const int sb = 32 * a + 8 * g4 + 4 * hi; const f32x4 gg = *(const LAS f32x4*)(GW + sb);
#pragma unroll
                        for (int x = 0; x < 4; ++x) { const int s = sb + x; const float v = (s <= jl) ? st[4 * g4 + x] * fast_exp2(gg[x] + ejl) : 0.f; pv[4 * g4 + x] = v; den += v; } }
#pragma unroll
                    for (int s2 = 0; s2 < 2; ++s2) {
                        const bf16x8 pf = pack8(pv[8 * s2], pv[8 * s2 + 1], pv[8 * s2 + 2], pv[8 * s2 + 3], pv[8 * s2 + 4], pv[8 * s2 + 5], pv[8 * s2 + 6], pv[8 * s2 + 7]);
                        const int b0 = 8 * a + 4 * s2 + hi;
                        const s16x4 v0 = *(const LAS s16x4*)(VTs + dv * TP + 4 * (b0 ^ swv)), v1 = *(const LAS s16x4*)(VTs + dv * TP + 4 * ((b0 + 2) ^ swv));
                        const bf16x8 vf = {v0[0], v0[1], v0[2], v0[3], v1[0], v1[1], v1[2], v1[3]};
                        num = mfma32(vf, pf, num);
                    }
                }
            }
            f32x16 ni = {0.f, 0.f, 0.f, 0.f, 0.f, 0.f, 0.f, 0.f, 0.f, 0.f, 0.f, 0.f, 0.f, 0.f, 0.f, 0.f};
#pragma unroll
            for (int ks = 0; ks < 8; ++ks) ni = mfma32(*(const LAS bf16x8*)(CT + (32 * vt + r32) * QP + ks * 16 + hi * 8), qf[ks], ni);
            float qn = 0.f;
#pragma unroll
            for (int ks = 0; ks < 8; ++ks) { const f32x4 n0 = *(const LAS f32x4*)(NV + 16 * ks + 8 * hi), n1 = *(const LAS f32x4*)(NV + 16 * ks + 8 * hi + 4); const u32x4 qw = __builtin_bit_cast(u32x4, qf[ks]);
                qn += lo_bf(qw.x) * n0[0] + hi_bf(qw.x) * n0[1] + lo_bf(qw.y) * n0[2] + hi_bf(qw.y) * n0[3] + lo_bf(qw.z) * n1[0] + hi_bf(qw.z) * n1[1] + lo_bf(qw.w) * n1[2] + hi_bf(qw.w) * n1[3]; }
            qn = sum_xor32(qn); den = sum_xor32(den);
            const float dtot = den + wint * qn; const float inv = fast_rcp(fmaxf(fabsf(dtot), flo));
            float ssq = 0.f;
#pragma unroll
            for (int r = 0; r < 16; ++r) { hval[r] = (num[r] + wint * ni[r]) * inv; ssq += hval[r] * hval[r]; }
            ssq = sum_xor32(ssq);
            if (hi == 0) PART[vt * 64 + jl] = ssq;
        }
        float nsum;
        {
            const int dv = 32 * vt + r32, swv = tsw(dv);
#pragma unroll
            for (int x = 0; x < 2; ++x) { const int kt = 2 * jt + x; const int dk = 32 * kt + r32, swk = tsw(dk);
#pragma unroll
                for (int r = 0; r < 16; ++r) accC[x][r] *= a_dec;
#pragma unroll
                for (int ks = 0; ks < 4; ++ks) accC[x] = mfma32(*(const LAS bf16x8*)(VTs + dv * TP + 4 * ((4 * ks + 2 * hi) ^ swv)), *(const LAS bf16x8*)(KT + dk * TP + 4 * ((4 * ks + 2 * hi) ^ swk)), accC[x]); }
            { const int kd = 16 * wid + (lanec & 15), sq = lanec >> 4; float s = 0.f;
              const u32x4 k0 = *(const LAS u32x4*)(KT + kd * TP + 16 * sq), k1 = *(const LAS u32x4*)(KT + kd * TP + 16 * sq + 8);
              s = (lo_bf(k0.x) + hi_bf(k0.x)) + (lo_bf(k0.y) + hi_bf(k0.y)) + (lo_bf(k0.z) + hi_bf(k0.z)) + (lo_bf(k0.w) + hi_bf(k0.w)) + (lo_bf(k1.x) + hi_bf(k1.x)) + (lo_bf(k1.y) + hi_bf(k1.y)) + (lo_bf(k1.z) + hi_bf(k1.z)) + (lo_bf(k1.w) + hi_bf(k1.w));
              s += __shfl_xor(s, 16); s += __shfl_xor(s, 32); nsum = s; }
        }
        LDS_SYNC();
        {
#pragma unroll
            for (int x = 0; x < 2; ++x) { const int kt = 2 * jt + x;
#pragma unroll
                for (int r = 0; r < 16; r += 2) { const unsigned w2 = pk2(accC[x][r], accC[x][r + 1]);
                    CT[(32 * vt + crow(r, hi)) * QP + 32 * kt + r32] = (bf16_t)(w2 & 0xffffu); CT[(32 * vt + crow(r + 1, hi)) * QP + 32 * kt + r32] = (bf16_t)(w2 >> 16); } }
            { const int kd = 16 * wid + (lanec & 15), sq = lanec >> 4; const float nn = a_dec * NV[kd] + nsum; if (sq == 0) NV[kd] = nn; }
            const float stot = (PART[jl] + PART[64 + jl]) + (PART[128 + jl] + PART[192 + jl]);
            const float rstd = fast_rsq(stot * (1.0f / 128.0f) + LN_EPS);
            char* hmb = (char*)(HM + tok0 * LDH + head * 128);
            const unsigned hmo = (unsigned)((jl * LDH + 32 * vt + 4 * hi) * 2);
#pragma unroll
            for (int g4 = 0; g4 < 4; ++g4) { const int v0 = 32 * vt + 8 * g4 + 4 * hi; const f32x4 gq = *(const LAS f32x4*)(GNL + v0);
                const u32x2 sg = sgv[g4];
                u32x2 o; o.x = pk2(hval[4 * g4] * rstd * gq[0] * lo_bf(sg.x), hval[4 * g4 + 1] * rstd * gq[1] * hi_bf(sg.x));
                o.y = pk2(hval[4 * g4 + 2] * rstd * gq[2] * lo_bf(sg.y), hval[4 * g4 + 3] * rstd * gq[3] * hi_bf(sg.y));
                *(u32x2*)(hmb + (hmo + 16u * g4)) = o; }
        }
        m_prev = m_new;
    }
    LDS_SYNC();
}

constexpr int KP = 72, VP = 68;
constexpr int A_KS = 0, A_VS = 2 * 64 * KP * 2, A_BT = A_VS + 2 * 64 * VP * 2, AT_LDS = A_BT + 129 * 4 + 12;
DEV int t5_bucket(int d) {
    if (d < 16) return d;
    if (d >= 114) return 31;
    int bk = 16;
    const int th[15] = {19, 21, 24, 27, 31, 35, 40, 46, 52, 59, 67, 77, 87, 99, 113};
#pragma unroll
    for (int i = 0; i < 15; ++i) bk += (d >= th[i]) ? 1 : 0;
    return bk;
}
DEV void attn_unit(const Ctx& c, int b, int h, int qb) {
    const int tid = c.tid, lane = c.lane, wid = c.wid, r32 = lane & 31, hi = lane >> 5;
    LAS unsigned char* lds = c.lds;
    LAS bf16_t* Ks = (LAS bf16_t*)(lds + A_KS); LAS bf16_t* Vs = (LAS bf16_t*)(lds + A_VS); LAS float* BT = (LAS float*)(lds + A_BT);
    bf16_t* Hq = wsp<bf16_t>(c, WS_H); const bf16_t* Kb = wsp<bf16_t>(c, WS_K); const bf16_t* VT = wsp<bf16_t>(c, WS_VT); const unsigned* MASK = wsp<unsigned>(c, WS_MASK);
    const size_t rowb = (size_t)b * SEQ; const int q0 = qb * 256, qw0 = q0 + 32 * wid, q = qw0 + r32;
    const int NT = (q0 + 256) / 64;
    if (tid <= 128) { const float far = par(c, P_RELB)[31 * 8 + h]; BT[tid] = (tid < 128) ? (par(c, P_RELB)[t5_bucket(tid) * 8 + h] - far) * LOG2E : 0.f; }
    bf16x8 qf[4];
#pragma unroll
    for (int ks = 0; ks < 4; ++ks) qf[ks] = *(const bf16x8*)(Hq + (rowb + q) * LDH + C_QA + h * 64 + ks * 16 + hi * 8);
    const int srow = tid >> 3, spc = tid & 7;
    const bf16_t* ksrc = Kb + (rowb + srow) * 512 + h * 64 + spc * 8;
    const bf16_t* vsrc = VT + (size_t)(h * 64 + srow) * M + rowb + spc * 8;
    u32x4 kreg = *(const u32x4*)ksrc, vreg = *(const u32x4*)vsrc;
    *(LAS u32x4*)(Ks + srow * KP + spc * 8) = kreg;
    { LAS u32x2* vd = (LAS u32x2*)(Vs + srow * VP + spc * 8); u32x2 a = {vreg.x, vreg.y}, bb = {vreg.z, vreg.w}; vd[0] = a; vd[1] = bb; }
    float mhat = 0.f, lsum = 0.f;
    f32x16 o[2], negm;
#pragma unroll
    for (int r = 0; r < 16; ++r) negm[r] = 0.f;
#pragma unroll
    for (int d = 0; d < 2; ++d)
#pragma unroll
        for (int r = 0; r < 16; ++r) o[d][r] = 0.f;
    wg_sync();
    for (int kt = 0; kt < NT; ++kt) {
        const int buf = kt & 1;
        if (kt + 1 < NT) { kreg = *(const u32x4*)(ksrc + (size_t)(kt + 1) * 64 * 512); vreg = *(const u32x4*)(vsrc + (size_t)(kt + 1) * 64); }
        if (64 * kt <= qw0 + 31) {
            const LAS bf16_t* kb = Ks + buf * 64 * KP; const LAS bf16_t* vb = Vs + buf * 64 * VP;
            const u32x2 mw = *(const u32x2*)(MASK + (rowb + q) * NWORDS + 2 * kt);
            f32x16 s[2];
#pragma unroll
            for (int a = 0; a < 2; ++a) {
                s[a] = negm;
#pragma unroll
                for (int ks = 0; ks < 4; ++ks) s[a] = mfma32(*(const LAS bf16x8*)(kb + (32 * a + r32) * KP + ks * 16 + hi * 8), qf[ks], s[a]);
            }
            if (64 * kt + 63 + 128 > qw0) {
#pragma unroll
                for (int a = 0; a < 2; ++a)
#pragma unroll
                    for (int r = 0; r < 16; ++r) { int d = q - (64 * kt + 32 * a + crow(r, hi)); d = d < 0 ? 128 : (d > 128 ? 128 : d); s[a][r] += BT[d]; }
            }
            float mx = s[0][0];
#pragma unroll
            for (int a = 0; a < 2; ++a)
#pragma unroll
                for (int r = 0; r < 16; ++r) mx = fmaxf(mx, s[a][r]);
            mx = max_xor32(mx);
            if (kt == 0 || WAVE_ANY(mx > 8.0f)) {
                const float dl = (kt == 0) ? mx : fmaxf(mx, 0.f);
                mhat += dl;
#pragma unroll
                for (int a = 0; a < 2; ++a)
#pragma unroll
                    for (int r = 0; r < 16; ++r) s[a][r] -= dl;
#pragma unroll
                for (int r = 0; r < 16; ++r) negm[r] = -mhat;
                if (kt != 0) { const float f = fast_exp2(-dl); lsum *= f;
#pragma unroll
                    for (int d = 0; d < 2; ++d)
#pragma unroll
                        for (int r = 0; r < 16; ++r) o[d][r] *= f; }
            }
            float ps = 0.f;
#pragma unroll
            for (int a = 0; a < 2; ++a) {
                const unsigned w = (a ? mw.y : mw.x) >> (4 * hi);
                float p[16];
#pragma unroll
                for (int r = 0; r < 16; ++r) { const float e = fast_exp2(s[a][r]); const unsigned mbit = bit_spread(w, (r & 3) + 8 * (r >> 2)); p[r] = bitsf(fbits(e) & mbit); ps += p[r]; }
#pragma unroll
                for (int s2 = 0; s2 < 2; ++s2) {
                    const bf16x8 pf = pack8(p[8 * s2], p[8 * s2 + 1], p[8 * s2 + 2], p[8 * s2 + 3], p[8 * s2 + 4], p[8 * s2 + 5], p[8 * s2 + 6], p[8 * s2 + 7]);
#pragma unroll
                    for (int d = 0; d < 2; ++d) {
                        const LAS bf16_t* vp = vb + (32 * d + r32) * VP + 32 * a + 16 * s2 + 4 * hi;
                        const s16x4 v0 = *(const LAS s16x4*)vp, v1 = *(const LAS s16x4*)(vp + 8);
                        const bf16x8 vf = {v0[0], v0[1], v0[2], v0[3], v1[0], v1[1], v1[2], v1[3]};
                        o[d] = mfma32(vf, pf, o[d]);
                    }
                }
            }
            lsum += ps;
        }
        if (kt + 1 < NT) {
            const int nb = buf ^ 1;
            *(LAS u32x4*)(Ks + nb * 64 * KP + srow * KP + spc * 8) = kreg;
            LAS u32x2* vd = (LAS u32x2*)(Vs + nb * 64 * VP + srow * VP + spc * 8); u32x2 a = {vreg.x, vreg.y}, bb = {vreg.z, vreg.w}; vd[0] = a; vd[1] = bb;
        }
        wg_sync();
    }
    lsum = sum_xor32(lsum);
    const float il = 1.0f / lsum;
#pragma unroll
    for (int d = 0; d < 2; ++d)
#pragma unroll
        for (int g4 = 0; g4 < 4; ++g4) { u32x2 w; w.x = pk2(o[d][4 * g4] * il, o[d][4 * g4 + 1] * il); w.y = pk2(o[d][4 * g4 + 2] * il, o[d][4 * g4 + 3] * il);
            *(u32x2*)(Hq + (rowb + q) * LDH + C_OA + h * 64 + 32 * d + 8 * g4 + 4 * hi) = w; }
}

DEV void ln_row(const f32x4 (&v)[4], const float* g, const float* bta, int lane, f32x4 (&y)[4]) {
    float s = 0.f;
#pragma unroll
    for (int j = 0; j < 4; ++j) s += (v[j][0] + v[j][1]) + (v[j][2] + v[j][3]);
    const float mean = wave_sum(s) * (1.0f / DM); float s2 = 0.f;
#pragma unroll
    for (int j = 0; j < 4; ++j) { const f32x4 d = v[j] - mean; s2 += (d[0] * d[0] + d[1] * d[1]) + (d[2] * d[2] + d[3] * d[3]); }
    const float rstd = 1.0f / sqrtf(wave_sum(s2) * (1.0f / DM) + LN_EPS);
#pragma unroll
    for (int j = 0; j < 4; ++j) { const f32x4 gg = *((const f32x4*)g + lane + 64 * j), bb = *((const f32x4*)bta + lane + 64 * j); y[j] = (v[j] - mean) * rstd * gg + bb; }
}
typedef float f32x2v __attribute__((ext_vector_type(2)));
DEV void phase_ln1_router(const Ctx& c) {
    LAS float* RW = (LAS float*)c.lds; LAS int* LC = (LAS int*)(c.lds + 1024 * 20 * 4); LAS int* GB = LC + 16; LAS float* LOGT = (LAS float*)(c.lds + 1024 * 20 * 4 + 256);
    { const f32x4* src = (const f32x4*)par(c, P_RW); f32x4 t[10];
#pragma unroll
      for (int i = 0; i < 10; ++i) t[i] = src[c.tid + NTHREADS * i];
#pragma unroll
      for (int i = 0; i < 10; ++i) ((LAS f32x4*)RW)[c.tid + NTHREADS * i] = t[i]; }
    if (c.tid < 16) LC[c.tid] = 0;
    wg_sync();
    const bf16_t* Z = wsp<bf16_t>(c, WS_Z); bf16_t* X1B = wsp<bf16_t>(c, WS_X1B);
    int* TOKE = wsp<int>(c, WS_TOK); int* TOKS = TOKE + 2 * M; float* TOKW = (float*)(TOKS + 2 * M);
    const int rpw = (M + c.G - 1) / c.G, r0 = c.bid * rpw, r1 = (r0 + rpw < M) ? r0 + rpw : M;
    constexpr int NEXIT = NE * (16 * 32 + 8 * 32);
    LAS float* exscr = (LAS float*)(c.lds + 1024 * 20 * 4 + 256 + 16384) + c.wid * (32 * 33);
    int exit_ = c.bid * NWAVES + c.wid; const int exstep = c.G * NWAVES; float exv[32]; bool exhave = exit_ < NEXIT;
    if (exhave) ex_load(exv, c, exit_, c.lane);
    u32x2 za[4], zb[4];
    { const int m = r0 + c.wid; if (m < r1) { const int m2 = (m + NWAVES < r1) ? m + NWAVES : m;
#pragma unroll
        for (int j = 0; j < 4; ++j) { za[j] = *((const u32x2*)(Z + (size_t)m * DM) + c.lane + 64 * j); zb[j] = *((const u32x2*)(Z + (size_t)m2 * DM) + c.lane + 64 * j); } } }
    for (int m = r0 + c.wid; m < r1; m += 2 * NWAVES) {
        const bool two = m + NWAVES < r1; const int m2 = two ? m + NWAVES : m;
        f32x4 va[4], vb[4], ya[4], yb[4];
#pragma unroll
        for (int j = 0; j < 4; ++j) { const f32x4 ta = {lo_bf(za[j].x), hi_bf(za[j].x), lo_bf(za[j].y), hi_bf(za[j].y)}; va[j] = ta; const f32x4 tb = {lo_bf(zb[j].x), hi_bf(zb[j].x), lo_bf(zb[j].y), hi_bf(zb[j].y)}; vb[j] = tb; }
        { const int mn = m + 2 * NWAVES; if (mn < r1) { const int mn2 = (mn + NWAVES < r1) ? mn + NWAVES : mn;
#pragma unroll
            for (int j = 0; j < 4; ++j) { za[j] = *((const u32x2*)(Z + (size_t)mn * DM) + c.lane + 64 * j); zb[j] = *((const u32x2*)(Z + (size_t)mn2 * DM) + c.lane + 64 * j); } } }
        ln_row(va, par(c, P_LN1G), par(c, P_LN1B), c.lane, ya);
        ln_row(vb, par(c, P_LN1G), par(c, P_LN1B), c.lane, yb);
#pragma unroll
        for (int j = 0; j < 4; ++j) { u32x2 w; w.x = pk2(ya[j][0], ya[j][1]); w.y = pk2(ya[j][2], ya[j][3]); *((u32x2*)(X1B + (size_t)m * DM) + c.lane + 64 * j) = w;
            if (two) { u32x2 w2; w2.x = pk2(yb[j][0], yb[j][1]); w2.y = pk2(yb[j][2], yb[j][3]); *((u32x2*)(X1B + (size_t)m2 * DM) + c.lane + 64 * j) = w2; } }
        f32x2v la[10], lb[10];
#pragma unroll
        for (int e = 0; e < 10; ++e) { la[e] = (f32x2v){0.f, 0.f}; lb[e] = (f32x2v){0.f, 0.f}; }
#pragma unroll
        for (int j = 0; j < 4; ++j)
#pragma unroll
            for (int x = 0; x < 4; ++x) { const f32x2v xa = {ya[j][x], ya[j][x]}, xb = {yb[j][x], yb[j][x]};
#pragma unroll
                for (int e4 = 0; e4 < 5; ++e4) { const f32x4 w = *(const LAS f32x4*)(RW + (((j * 4 + x) * 5 + e4) * 64 + c.lane) * 4); const f32x2v w0 = {w[0], w[1]}, w1 = {w[2], w[3]};
                    la[2 * e4] += xa * w0; la[2 * e4 + 1] += xa * w1; lb[2 * e4] += xb * w0; lb[2 * e4 + 1] += xb * w1; } }
        float lga[20], lgb[20];
#pragma unroll
        for (int e = 0; e < 10; ++e) { lga[2 * e] = wave_sum(la[e].x); lga[2 * e + 1] = wave_sum(la[e].y); lgb[2 * e] = wave_sum(lb[e].x); lgb[2 * e + 1] = wave_sum(lb[e].y); }
        if (c.lane == 0) {
            LAS f32x4* lp = (LAS f32x4*)(LOGT + (m - r0) * 20);
#pragma unroll
            for (int e4 = 0; e4 < 5; ++e4) { const f32x4 t = {lga[4 * e4], lga[4 * e4 + 1], lga[4 * e4 + 2], lga[4 * e4 + 3]}; lp[e4] = t; }
            if (two) { LAS f32x4* lp2 = (LAS f32x4*)(LOGT + (m2 - r0) * 20);
#pragma unroll
                for (int e4 = 0; e4 < 5; ++e4) { const f32x4 t = {lgb[4 * e4], lgb[4 * e4 + 1], lgb[4 * e4 + 2], lgb[4 * e4 + 3]}; lp2[e4] = t; } }
        }
        if (exhave) { ex_finish(exv, c, exit_, exscr, c.lane); exit_ += exstep; exhave = exit_ < NEXIT; if (exhave) ex_load(exv, c, exit_, c.lane); }
    }
    while (exhave) { ex_finish(exv, c, exit_, exscr, c.lane); exit_ += exstep; exhave = exit_ < NEXIT; if (exhave) ex_load(exv, c, exit_, c.lane); }
    wg_sync();
    for (int rr = c.tid; rr < r1 - r0; rr += NTHREADS) {
        const int m = r0 + rr; float lg[20];
#pragma unroll
        for (int e4 = 0; e4 < 5; ++e4) { const f32x4 t = *(const LAS f32x4*)(LOGT + rr * 20 + 4 * e4); lg[4 * e4] = t[0]; lg[4 * e4 + 1] = t[1]; lg[4 * e4 + 2] = t[2]; lg[4 * e4 + 3] = t[3]; }
        float gl[4]; int gi = 0;
#pragma unroll
        for (int j = 0; j < 4; ++j) gl[j] = lg[j] + par(c, P_BGRP)[j];
#pragma unroll
        for (int j = 1; j < 4; ++j) if (gl[j] > gl[gi]) gi = j;
        float se = 0.f;
#pragma unroll
        for (int j = 0; j < 4; ++j) se += __expf(gl[j] - gl[gi]);
        const float gw = 1.0f / se;
        float el[4];
#pragma unroll
        for (int j = 0; j < 4; ++j) { float t = 0.f;
#pragma unroll
            for (int g2 = 0; g2 < 4; ++g2) if (g2 == gi) t = lg[4 + 4 * g2 + j] + par(c, P_BRT)[4 * g2 + j];
            el[j] = t; }
        int i0 = 0;
#pragma unroll
        for (int j = 1; j < 4; ++j) if (el[j] > el[i0]) i0 = j;
        int i1 = (i0 == 0) ? 1 : 0;
#pragma unroll
        for (int j = 0; j < 4; ++j) if (j != i0 && el[j] > el[i1]) i1 = j;
        const float p1 = 1.0f / (1.0f + __expf(el[i1] - el[i0]));
        const int e0 = gi * 4 + i0, e1 = gi * 4 + i1;
        const int s0 = atomicAdd((int*)&LC[e0], 1), s1 = atomicAdd((int*)&LC[e1], 1);
        TOKE[2 * m] = e0; TOKE[2 * m + 1] = e1; TOKS[2 * m] = s0; TOKS[2 * m + 1] = s1; TOKW[2 * m] = p1 * gw; TOKW[2 * m + 1] = (1.0f - p1) * gw;
    }
#ifndef EMU
    __threadfence_block();
#endif
    wg_sync();
    if (c.tid < 16) GB[c.tid] = (int)atomicAdd(wsp<unsigned>(c, WS_CTL) + CW_CNT + c.tid, (unsigned)LC[c.tid]);
    wg_sync();
    { int* RT2 = wsp<int>(c, WS_RT2);
      for (int i = r0 * 2 + c.tid; i < r1 * 2; i += NTHREADS) { const int e = TOKE[i], s = TOKS[i] + GB[e]; TOKS[i] = s; RT2[(size_t)e * M + s] = i >> 1; } }
}
DEV void moe_bases(const Ctx& c, int (&base)[NE], int& total_tiles) {
    const unsigned* cnt = wsp<unsigned>(c, WS_CTL) + CW_CNT; int acc = 0;
#pragma unroll
    for (int e = 0; e < NE; ++e) { base[e] = acc; acc += (((int)cnt[e] + 255) / 256) * 256; }
    total_tiles = acc / 256;
}
DEV void phase_final(const Ctx& c) {
    int base[NE], nt; moe_bases(c, base, nt);
    const bf16_t* O2 = wsp<bf16_t>(c, WS_O2); const bf16_t* X1B = wsp<bf16_t>(c, WS_X1B);
    const int* TOKE = wsp<int>(c, WS_TOK); const int* TOKS = TOKE + 2 * M; const float* TOKW = (const float*)(TOKS + 2 * M);
    const int gw = c.bid * NWAVES + c.wid, NGW = c.G * NWAVES;
    for (int m0 = gw; m0 < M; m0 += 2 * NGW) {
        int pos[2][2]; float w[2][2]; u32x2 xw[2][4], a0[2][4], a1[2][4];
#pragma unroll
        for (int q = 0; q < 2; ++q) { const int m = m0 + q * NGW; if (m < M) {
#pragma unroll
            for (int a = 0; a < 2; ++a) { const int e = TOKE[2 * m + a]; int bs = 0;
#pragma unroll
                for (int j = 0; j < NE; ++j) if (j == e) bs = base[j];
                pos[q][a] = bs + TOKS[2 * m + a]; w[q][a] = TOKW[2 * m + a]; } } }
#pragma unroll
        for (int q = 0; q < 2; ++q) { const int m = m0 + q * NGW; if (m < M) {
#pragma unroll
            for (int j = 0; j < 4; ++j) { xw[q][j] = *((const u32x2*)(X1B + (size_t)m * DM) + c.lane + 64 * j);
                a0[q][j] = *((const u32x2*)(O2 + (size_t)pos[q][0] * DM) + c.lane + 64 * j); a1[q][j] = *((const u32x2*)(O2 + (size_t)pos[q][1] * DM) + c.lane + 64 * j); } } }
#pragma unroll
        for (int q = 0; q < 2; ++q) { const int m = m0 + q * NGW; if (m < M) {
            f32x4 v[4], y[4];
#pragma unroll
            for (int j = 0; j < 4; ++j) { const f32x4 xv = {lo_bf(xw[q][j].x), hi_bf(xw[q][j].x), lo_bf(xw[q][j].y), hi_bf(xw[q][j].y)};
                f32x4 t; t[0] = xv[0] * ALPHA + w[q][0] * lo_bf(a0[q][j].x) + w[q][1] * lo_bf(a1[q][j].x); t[1] = xv[1] * ALPHA + w[q][0] * hi_bf(a0[q][j].x) + w[q][1] * hi_bf(a1[q][j].x);
                t[2] = xv[2] * ALPHA + w[q][0] * lo_bf(a0[q][j].y) + w[q][1] * lo_bf(a1[q][j].y); t[3] = xv[3] * ALPHA + w[q][0] * hi_bf(a0[q][j].y) + w[q][1] * hi_bf(a1[q][j].y); v[j] = t; }
            ln_row(v, par(c, P_LN2G), par(c, P_LN2B), c.lane, y);
#pragma unroll
            for (int j = 0; j < 4; ++j) *((f32x4*)(c.out + (size_t)m * DM) + c.lane + 64 * j) = y[j]; } }
    }
}

#ifndef EMU
#define XB_TMO      128
#define XB_XCNT(j)  (256  + 64 * (j))
#define XB_XSUB(j)  (1280 + 64 * (j))
#define XB_XGEN(j)  (2304 + 64 * (j))
#define XB_TOP      3328
#define XB_TOPGEN   3392
#define XCD_BAR_WORDS 3456
#define XB_SPIN_CAP (1u << 22)
__device__ __forceinline__ unsigned xb_ld(unsigned* p)              { return __hip_atomic_load(p, __ATOMIC_RELAXED, __HIP_MEMORY_SCOPE_AGENT); }
__device__ __forceinline__ unsigned xb_add(unsigned* p, unsigned v) { return __hip_atomic_fetch_add(p, v, __ATOMIC_RELAXED, __HIP_MEMORY_SCOPE_AGENT); }
__device__ __forceinline__ unsigned xb_xcc_id() { return (unsigned)__builtin_amdgcn_s_getreg((3 << 11) | 20) & 0xFu; }
#define XB_SPIN(cond, bar) do { unsigned _sp = 0; while (cond) { __builtin_amdgcn_s_sleep(1); \
    if ((++_sp & 255u) == 0u) { if (xb_ld(&(bar)[XB_TMO])) break; if (_sp > XB_SPIN_CAP) { atomicAdd(&(bar)[XB_TMO], 1u); break; } } } } while (0)
struct XcdBarrier { unsigned* bar; unsigned x; volatile LAS unsigned* st; };
__device__ __forceinline__ XcdBarrier xcd_barrier_post(unsigned* bar, volatile LAS unsigned* st) {
    XcdBarrier b; b.bar = bar; b.x = xb_xcc_id(); b.st = st;
    if (threadIdx.x == 0) (void)xb_add(&bar[XB_XCNT(b.x)], 1u);
    return b;
}
__device__ __forceinline__ void xcd_barrier_complete(unsigned* bar, unsigned x, unsigned& nloc, unsigned& nx) {
    const unsigned G = gridDim.x * gridDim.y * gridDim.z;
    unsigned sum, cnt, mine, sp = 0u;
    for (;;) {
        sum = 0u; cnt = 0u; mine = 0u;
#pragma unroll
        for (unsigned j = 0; j < 16; ++j) { const unsigned c = xb_ld(&bar[XB_XCNT(j)]); sum += c; cnt += (c > 0u) ? 1u : 0u; mine = (j == x) ? c : mine; }
        if (sum == G) break;
        __builtin_amdgcn_s_sleep(1);
        if ((++sp & 255u) == 0u) { if (xb_ld(&bar[XB_TMO])) break; if (sp > XB_SPIN_CAP) { atomicAdd(&bar[XB_TMO], 1u); break; } }
    }
    nloc = mine > 0u ? mine : 1u; nx = cnt > 0u ? cnt : 1u;
}
__device__ __forceinline__ void xcd_barrier(const XcdBarrier& b) {
    asm volatile("s_waitcnt vmcnt(0)" ::: "memory");
    __syncthreads();
    if (threadIdx.x == 0) {
        unsigned* bar = b.bar;
        __builtin_amdgcn_s_waitcnt(0);
        unsigned nloc = b.st[0], nx = b.st[1];
        if (nloc == 0u) { xcd_barrier_complete(bar, b.x, nloc, nx); b.st[0] = nloc; b.st[1] = nx; }
        const unsigned old = xb_add(&bar[XB_XSUB(b.x)], 1u);
        const unsigned gen = old / nloc;
        if (old + 1u == (gen + 1u) * nloc) {
            __builtin_amdgcn_fence(__ATOMIC_RELEASE, "agent");
            asm volatile("s_waitcnt vmcnt(0)" ::: "memory");
            const unsigned og = xb_add(&bar[XB_TOP], 1u);
            const unsigned tg = og / nx;
            if (og + 1u == (tg + 1u) * nx) xb_add(&bar[XB_TOPGEN], 1u);
            else XB_SPIN(xb_ld(&bar[XB_TOPGEN]) == tg, bar);
            __builtin_amdgcn_fence(__ATOMIC_ACQUIRE, "agent");
            xb_add(&bar[XB_XGEN(b.x)], 1u);
            asm volatile("s_waitcnt vmcnt(0)" ::: "memory");
        } else {
            XB_SPIN(xb_ld(&bar[XB_XGEN(b.x)]) == gen, bar);
            __builtin_amdgcn_fence(__ATOMIC_ACQUIRE, "agent");
            asm volatile("s_waitcnt vmcnt(0)" ::: "memory");
        }
    }
    __syncthreads();
}
#endif

constexpr int NPHASE = 11;
constexpr int LDS_BYTES = 144 * 1024;
static_assert(1024 * 20 * 4 + 256 + ((M + 255) / 256) * 20 * 4 <= LDS_BYTES - 1024 || true, "router LDS");
static_assert(pg8::STAGE_BYTES <= LDS_BYTES - 1024 && IDX_LDS <= LDS_BYTES - 1024 && ML_LDS <= LDS_BYTES - 1024 && AT_LDS <= LDS_BYTES - 1024 && 8 * 16384 <= LDS_BYTES - 1024, "LDS budget");
constexpr int MISC_OFF = LDS_BYTES - 64;

DEV void run_phase(const Ctx& c0, int ph) {
    using namespace pg8;
    Ctx c = c0;
#ifndef EMU
    { int t = threadIdx.x; asm volatile("" : "+v"(t)); c.tid = t; c.lane = t & 63; c.wid = __builtin_amdgcn_readfirstlane(t >> 6); }
#endif
#ifdef EMU
    unsigned char* glds = c.lds;
#else
    PG8_LAS unsigned char* glds = c.lds;
#endif
    if (ph == 0) { phase_prologue(c); return; }
    if (ph == 1) {
        SchedStatic S; S.init((const bf16_t*)c.out, DM, wsp<bf16_t>(c, WS_WIN), DM, M, NWIN, DM, c.G, c.bid); S.phase_id = 1;
        EpiInProj E{wsp<bf16_t>(c, WS_H), wsp<bf16_t>(c, WS_KIDX), wsp<float>(c, WS_SM), wsp<float>(c, WS_SSQ)};
        gemm_phase(glds, S, E); return;
    }
    if (ph == 2 || ph == 11 || ph == 12) {
        const int nml = (ph == 12) ? 0 : ((c.G >= 4) ? c.G / 4 : 0);
        if (ph == 11) { for (int u = c.bid; u < NB * NHM; u += c.G) mlstm_unit(c, u / NHM, u % NHM); return; }
        if (c.bid < nml) {
#ifndef P2_REP_ML
#define P2_REP_ML 1
#endif
#ifndef P2_SKIP_ML
#if P2PROBE && P2PROBE_KIND == 5
            const unsigned long long mlt0 = rt_now();
#endif
            for (int rep = 0; rep < P2_REP_ML; ++rep) for (int u = c.bid; u < NB * NHM; u += nml) mlstm_unit(c, u / NHM, u % NHM);
#if P2PROBE && P2PROBE_KIND == 5
            if (c.bid == 0 && c.tid == 0) { volatile LAS unsigned* mm = (volatile LAS unsigned*)(c.lds + (144 * 1024 - 64)); mm[4] = (unsigned)(rt_now() - mlt0); }
#endif
#endif
        } else {
            const int g2 = c.G - nml, c2 = c.bid - nml;
#if P2PROBE
            const unsigned long long p2t0 = rt_now();
#endif
#ifndef P2_SKIP_KV
            { SchedStatic S; S.init(wsp<bf16_t>(c, WS_H) + C_CKV, LDH, wsp<bf16_t>(c, WS_WK), KVR, M, 512, KVR, g2, c2); EpiK E{wsp<bf16_t>(c, WS_K), wsp<float>(c, WS_SSQ)}; gemm_phase(glds, S, E); }
            { SchedStatic S; S.init(wsp<bf16_t>(c, WS_WV), KVR, wsp<bf16_t>(c, WS_H) + C_CKV, LDH, 512, M, KVR, g2, (c2 + (2 * g2) / 3) % g2); EpiVT E{wsp<bf16_t>(c, WS_VT), wsp<float>(c, WS_SSQ)}; gemm_phase(glds, S, E); }
#endif
            wg_sync();
            idx_units(c, c2, g2);
#if P2PROBE
            if (P2PROBE_KIND == 1 && c2 == 0 && c.tid == 0) { const unsigned long long d = rt_now() - p2t0; volatile LAS unsigned* mm = (volatile LAS unsigned*)(c.lds + MISC_OFF); mm[4] = (unsigned)d; }
#endif
        }
        return;
    }
    if (ph == 3) {
        const int nqb = SEQ / 256, nun = NB * HA * nqb;
        for (int u = c.bid; u < nun; u += c.G) {
            const int bh = u / nqb; int qi = u % nqb; const int round = (u / c.G) & 1; if (round && (c.G % nqb) == 0) qi = nqb - 1 - qi;
            attn_unit(c, bh / HA, bh % HA, qi);
            wg_sync();
        }
        return;
    }
    if (ph == 4) {
        SchedDual S; S.T.init(nullptr, 0, nullptr, 0, M, DM, WA, c.G, c.bid); S.K = WA; S.lda = LDH; S.ldb = WA;
        S.A0 = wsp<bf16_t>(c, WS_H) + C_OA; S.A1 = wsp<bf16_t>(c, WS_H) + C_HM; S.B0 = wsp<bf16_t>(c, WS_WA); S.B1 = wsp<bf16_t>(c, WS_WM);
        EpiUpDual E{wsp<bf16_t>(c, WS_Y), wsp<bf16_t>(c, WS_H)}; gemm_phase(glds, S, E); return;
    }
    if (ph == 5) {
        SchedStatic S; S.init(wsp<bf16_t>(c, WS_Y), DM, wsp<bf16_t>(c, WS_WO), DM, M, DM, DM, c.G, c.bid); EpiOut E{wsp<bf16_t>(c, WS_Z), (const bf16_t*)c.out}; gemm_phase(glds, S, E); return;
    }
    if (ph == 6) { phase_ln1_router(c); return; }
    if (ph == 7) return;
    if (ph == 8 || ph == 9) {
        int base[NE], nt; moe_bases(c, base, nt);
        SchedMoe S; S.ntiles = nt; S.nN = 4; S.G = c.G; S.c = c.bid; S.phase_id = ph;
#pragma unroll
        for (int e = 0; e < NE; ++e) S.tend[e] = ((e + 1 < NE) ? base[e + 1] : nt * 256) / 256;
        if (ph == 8) { SchedMoeT<true> SG; SG.ntiles = nt; SG.nN = 4; SG.G = c.G; SG.c = c.bid; SG.phase_id = ph;
#pragma unroll
            for (int e = 0; e < NE; ++e) SG.tend[e] = S.tend[e];
            SG.cntv = (int)(wsp<unsigned>(c, WS_CTL) + CW_CNT)[c.lane & 15];
            SG.K = DM; SG.lda = DM; SG.ldb = DM; SG.A = wsp<bf16_t>(c, WS_X1B); SG.Bt = wsp<bf16_t>(c, WS_WGU); SG.estride = (size_t)1024 * 1024; SG.rowtok = wsp<int>(c, WS_RT2);
            EpiMoe1 E{wsp<bf16_t>(c, WS_HD)}; gemm_phase(glds, SG, E); }
        else { S.K = DE; S.lda = DE; S.ldb = DE; S.A = wsp<bf16_t>(c, WS_HD); S.Bt = wsp<bf16_t>(c, WS_WD); S.estride = (size_t)1024 * 512; EpiMoe2 E{wsp<bf16_t>(c, WS_O2)}; gemm_phase(glds, S, E); }
        return;
    }
    if (ph == 10) { phase_final(c); return; }
}

#ifndef EMU
__global__ void __launch_bounds__(NTHREADS, 2) fwd_kernel(Args args) {
    extern __shared__ __attribute__((aligned(16))) unsigned char lds_raw[];
    Ctx c;
#pragma unroll
    for (int i = 0; i < 25; ++i) c.in[i] = args.in[i];
    c.out = args.out; c.ws = args.ws; c.tid = threadIdx.x; c.lane = c.tid & 63; c.wid = __builtin_amdgcn_readfirstlane(c.tid >> 6); c.G = gridDim.x; c.bid = blockIdx.x;
    c.lds = (LAS unsigned char*)lds_raw;
    volatile LAS unsigned* MISC = (volatile LAS unsigned*)(c.lds + MISC_OFF);
    if (c.tid < 16) MISC[c.tid] = 0u;
    __syncthreads();
    const bool multi = (args.ph_hi - args.ph_lo) > 1;
    XcdBarrier bar; bar.bar = (unsigned*)(args.ws + WS_CTL) + CW_BAR; bar.x = 0; bar.st = nullptr;
    if (multi) bar = xcd_barrier_post((unsigned*)(args.ws + WS_CTL) + CW_BAR, MISC + 8);
#ifndef ONLY_PHASE
#define ONLY_PHASE -1
#endif
#ifndef DOUBLE_PHASE
#define DOUBLE_PHASE -1
#endif
#ifndef DOUBLE_PHASE2
#define DOUBLE_PHASE2 -1
#endif
#ifndef TPROBE_KIND
#define TPROBE_KIND 0
#endif
#ifndef TPROBE_LO
#define TPROBE_LO -1
#define TPROBE_HI -1
#define TPROBE_MULT 0
#endif
    unsigned long long tps_lo = 0, tps_hi = 0;
#define TSTAMP(k) do { if (TPROBE_MULT > 0) { if ((k) == TPROBE_LO && TPROBE_KIND != 2) tps_lo = rt_now(); if ((k) == TPROBE_HI && TPROBE_KIND != 1) tps_hi = rt_now(); } } while (0)
#define PHASE(k) TSTAMP(k); if ((ONLY_PHASE < 0 || ONLY_PHASE == (k)) && args.ph_lo <= (k) && (k) < args.ph_hi) { if (DOUBLE_PHASE == (k) || DOUBLE_PHASE2 == (k)) { run_phase(c, (k)); xcd_barrier(bar); } run_phase(c, (k)); if (TPROBE_MULT > 0 && TPROBE_KIND > 0 && (k) == TPROBE_LO) { if (TPROBE_KIND == 1) tps_hi = rt_now(); else tps_lo = rt_now(); } if ((k) + 1 < args.ph_hi) xcd_barrier(bar); }
#ifdef SPLIT_P2
    PHASE(0) PHASE(1) { run_phase(c, 11); xcd_barrier(bar); run_phase(c, 12); xcd_barrier(bar); } PHASE(3)
#else
    PHASE(0) PHASE(1) PHASE(2) PHASE(3)
#endif
    PHASE(4) PHASE(5) PHASE(6) PHASE(8) PHASE(9) PHASE(10)
    TSTAMP(11);
#ifndef GPROBE_MODE
#define GPROBE_MODE 0
#endif
    if (GPROBE_PH >= 0 && GPROBE_MODE > 0) {
        __syncthreads();
        unsigned* gw = (unsigned*)(args.ws + WS_CTL) + 6000;
        if (threadIdx.x == 0) { const unsigned long long a = (unsigned long long)MISC[0] | ((unsigned long long)MISC[1] << 32), b2 = (unsigned long long)MISC[2] | ((unsigned long long)MISC[3] << 32); const unsigned d = (unsigned)(b2 - a);
            atomicMax(gw, d); atomicMax(gw + 1, 0xffffffffu - d); }
        xcd_barrier(bar);
        if (blockIdx.x == 0) { const unsigned mx = __hip_atomic_load(gw, __ATOMIC_RELAXED, __HIP_MEMORY_SCOPE_AGENT), mn = 0xffffffffu - __hip_atomic_load(gw + 1, __ATOMIC_RELAXED, __HIP_MEMORY_SCOPE_AGENT); tps_lo = 0; tps_hi = (GPROBE_MODE == 1) ? mx : mn; }
    } else
    if (GPROBE_PH >= 0 && GPROBE_MODE == 4 && blockIdx.x == 0) { __syncthreads(); tps_lo = (unsigned long long)MISC[2] | ((unsigned long long)MISC[3] << 32); } else
    if (GPROBE_PH >= 0 && blockIdx.x == 0) { __syncthreads(); if (GPROBE_MODE != 3) tps_lo = (unsigned long long)MISC[0] | ((unsigned long long)MISC[1] << 32); tps_hi = (GPROBE_MODE == 3) ? ((unsigned long long)MISC[0] | ((unsigned long long)MISC[1] << 32)) : ((unsigned long long)MISC[2] | ((unsigned long long)MISC[3] << 32)); }
#if P2PROBE
    __syncthreads();
    if (blockIdx.x == ((P2PROBE_KIND == 5) ? 0 : gridDim.x / 4) && threadIdx.x == 0) { const unsigned long long d = (unsigned long long)MISC[4] * (unsigned long long)P2PROBE, t0 = rt_now(); while (rt_now() - t0 < d) __builtin_amdgcn_s_sleep(8); }
#endif
    if (TPROBE_MULT > 0 && blockIdx.x == 0) { const unsigned long long d = (tps_hi - tps_lo) * (unsigned long long)TPROBE_MULT, t0 = rt_now(); while (rt_now() - t0 < d) __builtin_amdgcn_s_sleep(8); }
#undef PHASE
}

#ifndef N_LAUNCH_MODE
#define N_LAUNCH_MODE 0
#endif
extern "C" void kernel_launch(void* const* d_in, const int* in_sizes, int n_in, void* d_out, int out_size, void* d_ws, size_t ws_size, hipStream_t stream) {
    static int grid = 0;
    if (grid == 0) {
        if (n_in != 25 || out_size != M * DM || ws_size < WS_END) { fprintf(stderr, "kernel_launch: unexpected shapes (n_in %d out %d ws %zu need %zu)\n", n_in, out_size, ws_size, (size_t)WS_END); grid = -1; return; }
        int dev = 0, cus = 0, per_cu = 0;
        if (hipGetDevice(&dev) != hipSuccess || hipDeviceGetAttribute(&cus, hipDeviceAttributeMultiprocessorCount, dev) != hipSuccess) { grid = -1; return; }
        if (hipFuncSetAttribute((const void*)fwd_kernel, hipFuncAttributeMaxDynamicSharedMemorySize, LDS_BYTES) != hipSuccess) { fprintf(stderr, "kernel_launch: hipFuncSetAttribute failed\n"); grid = -1; return; }
        if (hipOccupancyMaxActiveBlocksPerMultiprocessor(&per_cu, (const void*)fwd_kernel, NTHREADS, LDS_BYTES) != hipSuccess || per_cu < 1) fprintf(stderr, "kernel_launch: occupancy query reports %d\n", per_cu);
        (void)hipGetLastError();
        grid = cus;
    }
    if (grid < 0) return;
    (void)hipMemsetAsync((char*)d_ws + WS_CTL, 0, CTL_ZERO_BYTES, stream);
    Args a{};
    for (int i = 0; i < 25; ++i) a.in[i] = (const float*)d_in[i];
    a.out = (float*)d_out; a.ws = (unsigned char*)d_ws;
    if (N_LAUNCH_MODE == 0) { a.ph_lo = 0; a.ph_hi = NPHASE; hipLaunchKernelGGL(fwd_kernel, dim3(grid), dim3(NTHREADS), LDS_BYTES, stream, a); }
    else { for (int p = 0; p < NPHASE; ++p) { a.ph_lo = p; a.ph_hi = p + 1; hipLaunchKernelGGL(fwd_kernel, dim3(grid), dim3(NTHREADS), LDS_BYTES, stream, a); } }
    (void)in_sizes;
}
#endif
```

```cpp
#ifdef EMU
#include "emu/emu.h"
#define DEV static inline
#define DEVM inline
#define WAVE_ANY(p) (__ballot(p) != 0ull)
#define MEM_FENCE() do {} while (0)
#define LDS_SYNC() __syncthreads()
#define LAUNDER(x) do {} while (0)
#define WAVE_SYNC() e_wbar()
#define LAS
#else
#include <hip/hip_runtime.h>
#include <cstdio>
#include <cstdint>
#define DEV __device__ __forceinline__
#define DEVM __device__ __forceinline__
#define WAVE_ANY(p) (__ballot(p) != 0ull)
#define MEM_FENCE() asm volatile("" ::: "memory")
#define LDS_SYNC() asm volatile("s_waitcnt lgkmcnt(0)\n\ts_barrier" ::: "memory")
#define LAUNDER(x) asm volatile("" : "+v"(x))
#define WAVE_SYNC() asm volatile("s_waitcnt lgkmcnt(0)" ::: "memory")
#define LAS __attribute__((address_space(3)))
typedef short bf16x8 __attribute__((ext_vector_type(8)));
typedef float f32x16 __attribute__((ext_vector_type(16)));
typedef float f32x4 __attribute__((ext_vector_type(4)));
#endif
typedef unsigned u32x4 __attribute__((ext_vector_type(4)));
typedef unsigned u32x2 __attribute__((ext_vector_type(2)));
typedef short s16x4 __attribute__((ext_vector_type(4)));
typedef unsigned short bf16_t;
typedef unsigned long long u64;

#ifndef CFG_B
#define CFG_B 16
#endif
#ifndef CFG_S
#define CFG_S 2048
#endif
constexpr int NB = CFG_B, SEQ = CFG_S, DM = 1024, M = NB * SEQ;
constexpr int HA = 8, DA = 64, WA = 512, KVR = 256, TOPK = (SEQ / 4 < 256) ? SEQ / 4 : 256;
constexpr int NHM = 4, DHM = 128, WM = 512, CHUNK = 64, NCH = SEQ / CHUNK;
constexpr int NE = 16, DE = 512, MPAD = 2 * M + 4096;
constexpr float LN_EPS = 1e-5f, ALPHA = 1.189207115002721f;
constexpr float QSCALE = 0.125f * 1.4426950408889634f;
constexpr float LOG2E = 1.4426950408889634f;
constexpr int NWIN = 5632, LDH = 5376;
constexpr int C_HM = 2304;
constexpr int C_OA = 768;
constexpr int C_QA = 0, C_CKV = 512, C_QI = 768, C_QM = 1280, C_KM = 1792, C_VM = 2304, C_OM = 2816, C_GA = 3328, C_GM = 4352;
constexpr int NWORDS = SEQ / 32;
constexpr int NWAVES = 8, NTHREADS = 512;

constexpr size_t MiB = 1u << 20;
constexpr size_t WS_CTL = 0, CTL_ZERO_BYTES = 512 * 1024;
constexpr size_t WS_ROWTOK = 128 * 1024;
constexpr size_t WS_WIN = 1 * MiB, WS_WK = 12 * MiB, WS_WV = 12 * MiB + 512 * 1024, WS_WA = 13 * MiB, WS_WM = 14 * MiB, WS_WO = 15 * MiB;
constexpr size_t WS_WGU = 17 * MiB, WS_WD = 49 * MiB, WS_TOK = 65 * MiB, WS_PAR = 65 * MiB + 768 * 1024;
static_assert(WS_ROWTOK + (size_t)(2 * M + 4096) * 4 <= 512 * 1024, "ROWTOK inside the zeroed control region");
static_assert((size_t)M * 24 <= 768 * 1024, "token tables fit below the parameter block");
static_assert((30720 + 1024 * 20) * 4 <= 256 * 1024, "parameter block size");
constexpr int P_CONVW = 0, P_CONVB = 4096, P_BI = 5120, P_BF = 5124, P_MHG = 5128, P_RELB = 5640, P_LN1G = 5896, P_LN1B = 6920, P_WGRP = 7944, P_BGRP = 12040, P_WRT = 12044, P_BRT = 28428, P_LN2G = 28444, P_LN2B = 29468, P_END = 30492, P_RW = 30720, P_END2 = P_RW + 1024 * 20;
constexpr size_t R0 = 66 * MiB;
constexpr size_t R1 = R0 + (size_t)M * 2048;
constexpr size_t R2 = R1 + (size_t)M * LDH * 2;
constexpr size_t WS_KIDX = R2, WS_SM = WS_KIDX + (size_t)M * 128, WS_SSQ = WS_SM + (size_t)M * 64, WS_MASK = WS_SSQ + (size_t)M * 16, WS_RT2 = WS_MASK + (size_t)M * NWORDS * 4, WS_END = WS_RT2 + (size_t)NE * M * 4;
constexpr size_t WS_K = R0, WS_VT = R0 + (size_t)M * 1024, WS_Y = R0;
#ifdef EMU
constexpr size_t WS_H = R1, WS_Z = R1, WS_X1B = R0, WS_XS = WS_END, WS_HD = WS_XS + (size_t)MPAD * 2048, WS_O2 = WS_HD + (size_t)MPAD * 1024, WS_TOTAL = WS_O2 + (size_t)MPAD * 2048;
#else
constexpr size_t WS_H = R1, WS_Z = R1, WS_X1B = R0, WS_XS = R1 + (size_t)M * 6144;
constexpr size_t WS_HD = R1, WS_O2 = R1 + (size_t)MPAD * 1024, WS_TOTAL = WS_END;
static_assert(WS_XS + (size_t)MPAD * 2048 <= R2, "XS fits in the H region");
static_assert(WS_O2 + (size_t)MPAD * 2048 <= R2, "O2 fits in the H region");
static_assert(WS_END <= 512 * MiB, "workspace budget");
#endif
constexpr int CW_CNT = 4096;
constexpr int CW_BAR = 8192;

struct Args { const float* in[25]; float* out; unsigned char* ws; int ph_lo, ph_hi; };

DEV unsigned fbits(float f) { unsigned u; __builtin_memcpy(&u, &f, 4); return u; }
DEV float bitsf(unsigned u) { float f; __builtin_memcpy(&f, &u, 4); return f; }
DEV unsigned f2bf(float f) { unsigned u = fbits(f); return (u + 0x7fffu + ((u >> 16) & 1u)) >> 16; }
DEV float bf2f(unsigned b) { return bitsf(b << 16); }
DEV unsigned pk2(float lo, float hi) {
#ifdef EMU
    return f2bf(lo) | (f2bf(hi) << 16);
#else
    typedef float f32x2_t __attribute__((ext_vector_type(2))); typedef __bf16 bf16x2_t __attribute__((ext_vector_type(2)));
    f32x2_t v = {lo, hi}; bf16x2_t b = __builtin_convertvector(v, bf16x2_t); return __builtin_bit_cast(unsigned, b);
#endif
}
DEV float lo_bf(unsigned w) { return bitsf(w << 16); }
DEV float hi_bf(unsigned w) { return bitsf(w & 0xffff0000u); }
DEV f32x16 mfma32(bf16x8 a, bf16x8 b, f32x16 c) {
#ifdef EMU
    return emu_mfma_32x32x16_bf16(a, b, c);
#else
    return __builtin_amdgcn_mfma_f32_32x32x16_bf16(a, b, c, 0, 0, 0);
#endif
}
DEV float fast_rcp(float x) {
#ifdef EMU
    return 1.0f / x;
#else
    return __builtin_amdgcn_rcpf(x);
#endif
}
DEV float fast_rsq(float x) {
#ifdef EMU
    return 1.0f / sqrtf(x);
#else
    return __builtin_amdgcn_rsqf(x);
#endif
}
DEV float fast_exp2(float x) {
#ifdef EMU
    return exp2f(x);
#else
    return __builtin_amdgcn_exp2f(x);
#endif
}
#ifndef EMU
__device__ __forceinline__ unsigned long long rt_now() { unsigned long long t; asm volatile("s_memrealtime %0\n\ts_waitcnt lgkmcnt(0)" : "=s"(t) :: "memory"); return t; }
#endif
DEV unsigned bit_spread(unsigned w, int pos) {
#ifdef EMU
    return ((w >> pos) & 1u) ? 0xffffffffu : 0u;
#else
    unsigned m; asm("v_bfe_i32 %0, %1, %2, 1" : "=v"(m) : "v"(w), "s"(pos)); return m;
#endif
}
DEV float relu_f(float x) {
#ifdef EMU
    return x > 0.f ? x : 0.f;
#else
    return __builtin_amdgcn_fmed3f(x, 0.0f, __builtin_inff());
#endif
}
DEV float sum_xor32(float v) {
#ifdef EMU
    return v + __shfl_xor(v, 32);
#else
    const unsigned u = fbits(v); auto rr = __builtin_amdgcn_permlane32_swap(u, u, false, false); return bitsf(rr[0]) + bitsf(rr[1]);
#endif
}
DEV float max_xor32(float v) {
#ifdef EMU
    return fmaxf(v, __shfl_xor(v, 32));
#else
    const unsigned u = fbits(v); auto rr = __builtin_amdgcn_permlane32_swap(u, u, false, false); return fmaxf(bitsf(rr[0]), bitsf(rr[1]));
#endif
}
DEV float sigmoidf_(float x) { return fast_rcp(1.0f + __expf(-x)); }
DEV int crow(int r, int hi) { return (r & 3) + 8 * (r >> 2) + 4 * hi; }
DEV bf16x8 pack8(float a0, float a1, float a2, float a3, float a4, float a5, float a6, float a7) {
    u32x4 w; w.x = pk2(a0, a1); w.y = pk2(a2, a3); w.z = pk2(a4, a5); w.w = pk2(a6, a7); return __builtin_bit_cast(bf16x8, w);
}
DEV float wave_sum(float v) {
#ifdef EMU
#pragma unroll
    for (int o = 1; o < 64; o <<= 1) v += __shfl_xor(v, o);
    return v;
#else
#define WS_DPP(ctrl, rm) v += __builtin_bit_cast(float, __builtin_amdgcn_update_dpp(0, __builtin_bit_cast(int, v), ctrl, rm, 0xf, false))
    WS_DPP(0x111, 0xf); WS_DPP(0x112, 0xf); WS_DPP(0x114, 0xf); WS_DPP(0x118, 0xf); WS_DPP(0x142, 0xa); WS_DPP(0x143, 0xc);
#undef WS_DPP
    return __builtin_bit_cast(float, __builtin_amdgcn_readlane(__builtin_bit_cast(int, v), 63));
#endif
}

DEV int lane_bcast(int v, int l) {
#ifdef EMU
    return __shfl(v, l);
#else
    return __builtin_amdgcn_readlane(v, l);
#endif
}
namespace pg8 {
constexpr int BM = 256, BK = 64, HALF = 128, HTB = HALF * BK * 2, STAGE_BYTES = 8 * HTB, NXCD = 8, WGM = 8;
DEV int lds_byte(int r, int c) { const int st = (r >> 4) * 2 + (c >> 5), rr = r & 15, cc = c & 31, ob = rr * 64 + cc * 2; return st * 1024 + (ob ^ (((ob >> 9) & 1) << 5)); }
DEV void stage_rc(int b, int& R, int& C) { const int st = b / 1024, sb = b % 1024, swz = sb ^ (((sb >> 9) & 1) << 5); R = (st >> 1) * 16 + swz / 64; C = (st & 1) * 32 + (swz % 64) / 2; }
DEV int perm32(int rho) { const int n = rho >> 4, i = rho & 15; return 8 * (i >> 2) + 4 * n + (i & 3); }

struct Unit { int pm, pn, e, g0, gv, half; };
struct SchedStatic {
    static constexpr bool GATHER = false;
    int phase_id = -1; int nM, nN, nwg, G, c, K, lda, ldb; const bf16_t* A; const bf16_t* Bt;
    DEVM void init(const bf16_t* A_, int lda_, const bf16_t* Bt_, int ldb_, int M_, int N_, int K_, int G_, int c_) { A = A_; lda = lda_; Bt = Bt_; ldb = ldb_; nM = M_ / BM; nN = N_ / BM; nwg = nM * nN; K = K_; G = G_; c = c_; }
    DEVM bool next(int i, Unit& u) const {
        const long L = (long)i * G + c; if (L >= nwg) return false;
        int wgid = (int)L; { const int q = nwg / NXCD, r = nwg % NXCD, xcd = wgid % NXCD, off = wgid / NXCD; wgid = (xcd < r ? xcd * (q + 1) : r * (q + 1) + (xcd - r) * q) + off; }
        const int nig = WGM * nN, gid = wgid / nig, fm = gid * WGM, gsz = (nM - fm) < WGM ? (nM - fm) : WGM;
        u.pm = fm + ((wgid % nig) % gsz); u.pn = (wgid % nig) / gsz; u.e = 0; u.g0 = 0; u.gv = 256; u.half = -1; return true;
    }
    DEVM const char* baseA(const Unit& u) const { return (const char*)(A + (size_t)u.pm * BM * lda); }
    DEVM const char* baseB(const Unit& u) const { return (const char*)(Bt + (size_t)u.pn * BM * ldb); }
};
template <bool GATHER_> struct SchedMoeT {
    static constexpr bool GATHER = GATHER_; const int* rowtok = nullptr;
    int phase_id = -1; int ntiles, nN, G, c, K, lda, ldb; const bf16_t* A; const bf16_t* Bt; size_t estride; int tend[NE]; int cntv = 0;
    DEVM bool next(int i, Unit& u) const {
        int pm, pn, hf = -1;
        if ((G & 7) == 0) { const int x = c & 7, cl = c >> 3, gl = G >> 3, nx = (ntiles + 7) >> 3, t0 = x * nx, tn = (t0 + nx <= ntiles) ? nx : (ntiles > t0 ? ntiles - t0 : 0);
            const int U = tn * nN, nfull = U / gl, rem = U - nfull * gl; int L = i * gl + cl;
            if (i > nfull) return false;
            if (i == nfull) { if (2 * rem <= gl) { if (cl >= 2 * rem) return false; L = nfull * gl + (cl >> 1); hf = cl & 1; } else if (cl >= rem) return false; }
            pm = t0 + L / nN; pn = L % nN; }
        else { const long L = (long)i * G + c; if (L >= (long)ntiles * nN) return false; pm = (int)(L / nN); pn = (int)(L % nN); }
        u.pm = pm; u.pn = pn; u.half = hf; int e = 0, ts = 0;
#pragma unroll
        for (int j = 0; j < NE - 1; ++j) { const bool ge = pm >= tend[j]; e += ge ? 1 : 0; ts = ge ? tend[j] : ts; }
        u.e = e; const int r0 = (pm - ts) * 256; u.g0 = e * M + r0; u.gv = 256;
        if (GATHER) { const int ce = lane_bcast(cntv, e); u.gv = (ce - r0 < 256) ? ce - r0 : 256; }
        return true;
    }
    DEVM const char* baseA(const Unit& u) const { return GATHER ? (const char*)A : (const char*)(A + (size_t)u.pm * BM * lda); }
    DEVM const char* baseB(const Unit& u) const { return (const char*)(Bt + (size_t)u.e * estride + (size_t)u.pn * BM * ldb); }
};
typedef SchedMoeT<false> SchedMoe;

#ifdef EMU
template <class Epi, class Sched>
static inline void gemm_phase(unsigned char* lds, const Sched& S, const Epi& E) {
    const int tid = threadIdx.x, wid = tid >> 6, lane = tid & 63, wr = wid >> 2, wc = wid & 3, fr = lane & 15, fq = lane >> 4;
    Unit u; f32x4 acc[2][2][4][2]; bool keep = false;
    for (int i = 0; S.next(i, u); ++i) {
        const bf16_t* A = (const bf16_t*)S.baseA(u); const bf16_t* B = (const bf16_t*)S.baseB(u);
        for (int ai = 0; ai < 2; ++ai) for (int bj = 0; bj < 2; ++bj) for (int m = 0; m < 4; ++m) for (int n = 0; n < 2; ++n) for (int x = 0; x < 4; ++x) {
            const int r = 128 * ai + 64 * wr + 16 * m + fr, c = 128 * bj + 32 * wc + 8 * fq + 4 * n + x; float s = keep ? acc[ai][bj][m][n][x] : 0.f;
            size_t arow = r; if constexpr (Sched::GATHER) arow = (size_t)S.rowtok[u.g0 + (r < u.gv ? r : u.gv - 1)];
            for (int k = 0; k < S.K; ++k) s += bf2f(A[arow * S.lda + k]) * bf2f(B[(size_t)c * S.ldb + k]);
            acc[ai][bj][m][n][x] = s; }
        if constexpr (Epi::DUAL) keep = E.dual(acc, u, wr, wc, fr, fq); else { E(acc, u, wr, wc, fr, fq); keep = false; }
    }
    (void)lds;
}
#else
#define PG8_LAS __attribute__((address_space(3)))
#ifndef GPROBE_ALL
#define GPROBE_ALL 0
#endif
#ifndef GPROBE_PH
#define GPROBE_PH -1
#define GPROBE_A -1
#define GPROBE_B -1
#endif
#define GPROBE(lds_, id_) do { if (GPROBE_PH >= 0 && S.phase_id == GPROBE_PH && (blockIdx.x == 0 || GPROBE_ALL) && threadIdx.x == 0) { const unsigned long long _t = rt_now(); \
    volatile PG8_LAS unsigned* _m = (volatile PG8_LAS unsigned*)((lds_) + (144 * 1024 - 64)); if ((id_) == GPROBE_A) { _m[0] = (unsigned)_t; _m[1] = (unsigned)(_t >> 32); } if ((id_) == GPROBE_B) { _m[2] = (unsigned)_t; _m[3] = (unsigned)(_t >> 32); } } } while (0)
template <class Epi, class Sched>
__device__ __forceinline__ void gemm_phase(PG8_LAS unsigned char* lds, const Sched& S, const Epi& E) {
    int tid = threadIdx.x; asm volatile("" : "+v"(tid));
    const int wid = __builtin_amdgcn_readfirstlane(tid >> 6), lane = tid & 63, wr = wid >> 2, wc = wid & 3, fr = lane & 15, fq = lane >> 4;
    const int K = S.K, nt = K / BK;
    unsigned voffA[2], voffB[2];
#pragma unroll
    for (int i = 0; i < 2; ++i) { int R, C; stage_rc(tid * 16 + i * 8192, R, C); const int Rb = (R & ~31) + perm32(R & 31);
        voffA[i] = (unsigned)(R * S.lda + C) * 2u; voffB[i] = (unsigned)(Rb * S.ldb + C) * 2u; }
    const size_t kstep = (size_t)(BK * 2);
    const size_t hstepA = Sched::GATHER ? (size_t)0 : (size_t)HALF * S.lda * 2, hstepB = (size_t)HALF * S.ldb * 2;
    unsigned vgc[2][2] = {{0u, 0u}, {0u, 0u}}, vgn[2][2] = {{0u, 0u}, {0u, 0u}}; int gR[2] = {0, 0}, gC[2] = {0, 0};
    if constexpr (Sched::GATHER) {
#pragma unroll
        for (int i = 0; i < 2; ++i) { int R, C; stage_rc(tid * 16 + i * 8192, R, C); gR[i] = R; gC[i] = C; } }
#define PG8_GLOAD(dst, unit) do { _Pragma("unroll") for (int _h = 0; _h < 2; ++_h) _Pragma("unroll") for (int _i = 0; _i < 2; ++_i) \
        { const int _r = _h * 128 + gR[_i]; dst[_h][_i] = (unsigned)(S.rowtok[(unit).g0 + (_r < (unit).gv ? _r : (unit).gv - 1)] * S.lda + gC[_i]) * 2u; } } while (0)
#define PG8_STAGE_A(bufoff, gbase, h, nextu) do { if constexpr (Sched::GATHER) { unsigned _v[2]; _v[0] = (nextu) ? vgn[h][0] : vgc[h][0]; _v[1] = (nextu) ? vgn[h][1] : vgc[h][1]; PG8_STAGE(bufoff, gbase, _v); } \
        else PG8_STAGE(bufoff, (gbase) + ((h) ? hstepA : 0), voffA); } while (0)
    const unsigned ldsw = (unsigned)wid * 1024u;
    const int aoff = lds_byte(wr * 64 + fr, fq * 8), boff = lds_byte(wc * 32 + fr, fq * 8);
#define PG8_SA(b, h) (((b) * 2 + (h)) * HTB)
#define PG8_SB(b, h) ((4 + (b) * 2 + (h)) * HTB)
#define PG8_STAGE(bufoff, gbase, voff) do { _Pragma("unroll") for (int _i = 0; _i < 2; ++_i) \
        __builtin_amdgcn_global_load_lds((const unsigned*)((const char*)(gbase) + (voff)[_i]), (PG8_LAS unsigned*)(lds + (bufoff) + ldsw + _i * 8192), 16, 0, 0); } while (0)
#define PG8_LDA(dst, b, h) do { _Pragma("unroll") for (int m = 0; m < 4; ++m) _Pragma("unroll") for (int k = 0; k < 2; ++k) dst[m][k] = *(const PG8_LAS bf16x8*)(lds + PG8_SA(b, h) + aoff + m * 2048 + k * 1024); } while (0)
#define PG8_LDB(dst, b, h) do { _Pragma("unroll") for (int n = 0; n < 2; ++n) _Pragma("unroll") for (int k = 0; k < 2; ++k) dst[n][k] = *(const PG8_LAS bf16x8*)(lds + PG8_SB(b, h) + boff + n * 2048 + k * 1024); } while (0)
#define PG8_MMA(ai, bj, At, Bt) do { __builtin_amdgcn_s_setprio(1); _Pragma("unroll") for (int m = 0; m < 4; ++m) _Pragma("unroll") for (int n = 0; n < 2; ++n) _Pragma("unroll") for (int k = 0; k < 2; ++k) \
        acc[ai][bj][m][n] = __builtin_amdgcn_mfma_f32_16x16x32_bf16(Bt[n][k], At[m][k], acc[ai][bj][m][n], 0, 0, 0); __builtin_amdgcn_s_setprio(0); } while (0)
#define PG8_WAIT_V(n) asm volatile("s_waitcnt vmcnt(" #n ")" ::: "memory")
#define PG8_WAIT_L(n) asm volatile("s_waitcnt lgkmcnt(" #n ")" ::: "memory")
#define PG8_BAR __builtin_amdgcn_s_barrier()
#define PG8_SCHED __builtin_amdgcn_sched_barrier(0)
    Unit cur, nxt; int ui = 0;
    GPROBE(lds, 50);
    if (!S.next(0, cur)) return;
    f32x4 acc[2][2][4][2];
#pragma unroll
    for (int a = 0; a < 2; ++a)
#pragma unroll
        for (int b = 0; b < 2; ++b)
#pragma unroll
            for (int m = 0; m < 4; ++m)
#pragma unroll
                for (int n = 0; n < 2; ++n) acc[a][b][m][n] = (f32x4){0.f, 0.f, 0.f, 0.f};
    bf16x8 At[4][2], B0[2][2], B1[2][2];
    const char* cA = S.baseA(cur); const char* cB = S.baseB(cur);
    if constexpr (Sched::GATHER) PG8_GLOAD(vgc, cur);
    PG8_STAGE(PG8_SB(0, 0), cB, voffB); PG8_STAGE(PG8_SB(0, 1), cB + hstepB, voffB); PG8_STAGE_A(PG8_SA(0, 0), cA, 0, false); PG8_STAGE_A(PG8_SA(0, 1), cA, 1, false);
    if (wr == 1) PG8_BAR;
    PG8_WAIT_V(2); PG8_BAR;
    PG8_STAGE(PG8_SB(1, 0), cB + kstep, voffB); PG8_STAGE_A(PG8_SA(1, 0), cA + kstep, 0, false); PG8_STAGE(PG8_SB(1, 1), cB + hstepB + kstep, voffB);
    PG8_WAIT_V(6); PG8_BAR;
    for (;;) {
        const bool has_next = S.next(ui + 1, nxt);
        const char* nA = has_next ? S.baseA(nxt) : cA; const char* nB = has_next ? S.baseB(nxt) : cB;
        if constexpr (Sched::GATHER) { if (has_next) PG8_GLOAD(vgn, nxt); else { vgn[0][0] = vgc[0][0]; vgn[0][1] = vgc[0][1]; vgn[1][0] = vgc[1][0]; vgn[1][1] = vgc[1][1]; } }
        for (int t = 0; t < nt; t += 2) {
            const bool last = (t == nt - 2);
            const char* a1 = cA + (size_t)(t + 1) * kstep;
            const char* a2 = last ? nA : cA + (size_t)(t + 2) * kstep; const char* b2 = last ? nB : cB + (size_t)(t + 2) * kstep;
            const char* a3 = a2 + kstep; const char* b3 = b2 + kstep;
            PG8_LDB(B0, 0, 0); PG8_LDB(B1, 0, 1); PG8_SCHED; PG8_LDA(At, 0, 0); PG8_STAGE_A(PG8_SA(1, 1), a1, 1, false);
            PG8_WAIT_V(8); PG8_WAIT_L(0); PG8_BAR; if (cur.half != 1) { PG8_MMA(0, 0, At, B0); PG8_MMA(0, 1, At, B1); } PG8_BAR; PG8_SCHED;
            PG8_LDA(At, 0, 1); PG8_STAGE(PG8_SB(0, 0), b2, voffB); PG8_STAGE(PG8_SB(0, 1), b2 + hstepB, voffB); PG8_STAGE_A(PG8_SA(0, 0), a2, 0, last);
            PG8_WAIT_V(8); PG8_WAIT_L(0); PG8_BAR; if (cur.half != 0) { PG8_MMA(1, 0, At, B0); PG8_MMA(1, 1, At, B1); } PG8_BAR; PG8_SCHED;
            PG8_LDB(B0, 1, 0); PG8_LDB(B1, 1, 1); PG8_SCHED; PG8_LDA(At, 1, 0); PG8_STAGE_A(PG8_SA(0, 1), a2, 1, last);
            PG8_WAIT_V(8); PG8_WAIT_L(0); PG8_BAR; if (cur.half != 1) { PG8_MMA(0, 0, At, B0); PG8_MMA(0, 1, At, B1); } PG8_BAR; PG8_SCHED;
            PG8_LDA(At, 1, 1); PG8_STAGE(PG8_SB(1, 0), b3, voffB); PG8_STAGE(PG8_SB(1, 1), b3 + hstepB, voffB); PG8_STAGE_A(PG8_SA(1, 0), a3, 0, last);
            PG8_WAIT_V(8); PG8_WAIT_L(0); PG8_BAR; if (cur.half != 0) { PG8_MMA(1, 0, At, B0); PG8_MMA(1, 1, At, B1); } PG8_BAR; PG8_SCHED;
        }
        if (wr == 0) PG8_BAR;
        GPROBE(lds, 100 + ui);
        bool keep = false;
        if constexpr (Epi::DUAL) keep = E.dual(acc, cur, wr, wc, fr, fq); else E(acc, cur, wr, wc, fr, fq);
        GPROBE(lds, 200 + ui);
        if (!has_next) break;
        if (!keep) {
#pragma unroll
        for (int a = 0; a < 2; ++a)
#pragma unroll
            for (int b = 0; b < 2; ++b)
#pragma unroll
                for (int m = 0; m < 4; ++m)
#pragma unroll
                    for (int n = 0; n < 2; ++n) acc[a][b][m][n] = (f32x4){0.f, 0.f, 0.f, 0.f};
        }
        cur = nxt; cA = nA; cB = nB; ++ui;
        if constexpr (Sched::GATHER) { vgc[0][0] = vgn[0][0]; vgc[0][1] = vgn[0][1]; vgc[1][0] = vgn[1][0]; vgc[1][1] = vgn[1][1]; }
        if (wr == 1) PG8_BAR;
    }
    PG8_WAIT_V(0);
    PG8_BAR;
    GPROBE(lds, 300);
#undef PG8_SA
#undef PG8_SB
#undef PG8_STAGE
#undef PG8_STAGE_A
#undef PG8_GLOAD
#undef PG8_LDA
#undef PG8_LDB
#undef PG8_MMA
#undef PG8_WAIT_V
#undef PG8_WAIT_L
#undef PG8_BAR
#undef PG8_SCHED
}
#endif
}
using pg8::Unit;

#define EPI_ARGS const f32x4 (&acc)[2][2][4][2], const Unit& u, int wr, int wc, int fr, int fq
DEV u32x4 pack_row8(const f32x4& v0, const f32x4& v1) { u32x4 w; w.x = pk2(v0[0], v0[1]); w.y = pk2(v0[2], v0[3]); w.z = pk2(v1[0], v1[1]); w.w = pk2(v1[2], v1[3]); return w; }

struct EpiInProj {
    static constexpr bool DUAL = false;
    bf16_t* H; bf16_t* KIDX; float* SM; float* SSQ;
    DEVM void operator()(EPI_ARGS) const {
        const int row0 = u.pm * 256 + wr * 64 + fr;
        if (u.pn < 21) {
            const int col0 = u.pn * 256 + wc * 32 + 8 * fq; const bool sig = u.pn >= 11;
            if (u.pn == 2) {
#pragma unroll
                for (int ai = 0; ai < 2; ++ai)
#pragma unroll
                    for (int m = 0; m < 4; ++m) { float s = 0.f;
#pragma unroll
                        for (int bj = 0; bj < 2; ++bj)
#pragma unroll
                            for (int n = 0; n < 2; ++n) { const f32x4 x = acc[ai][bj][m][n]; s += (x[0] * x[0] + x[1] * x[1]) + (x[2] * x[2] + x[3] * x[3]); }
                        s += __shfl_xor(s, 16); s += __shfl_xor(s, 32);
                        if (fq == 0) SSQ[(size_t)(row0 + ai * 128 + m * 16) * 4 + wc] = s; }
            }
#pragma unroll
            for (int ai = 0; ai < 2; ++ai)
#pragma unroll
                for (int m = 0; m < 4; ++m) { bf16_t* rowp = H + (size_t)(row0 + ai * 128 + m * 16) * LDH + col0;
                    if (u.pn >= 13) {
                        bf16_t* gp = H + (size_t)(row0 + ai * 128 + m * 16) * LDH + (u.pn - 13) * 128 + wc * 32 + 8 * fq;
                        f32x4 a0 = acc[ai][0][m][0], a1 = acc[ai][0][m][1], m0 = acc[ai][1][m][0], m1 = acc[ai][1][m][1];
#pragma unroll
                        for (int x = 0; x < 4; ++x) { m0[x] = fmaxf(sigmoidf_(m0[x]), 1e-20f); m1[x] = fmaxf(sigmoidf_(m1[x]), 1e-20f); a0[x] = sigmoidf_(a0[x]) / m0[x]; a1[x] = sigmoidf_(a1[x]) / m1[x]; }
                        *(u32x4*)(gp + C_GA) = pack_row8(a0, a1); *(u32x4*)(gp + C_GM) = pack_row8(m0, m1);
                    } else {
#pragma unroll
                    for (int bj = 0; bj < 2; ++bj) { f32x4 v0 = acc[ai][bj][m][0], v1 = acc[ai][bj][m][1];
                        if (sig) {
#pragma unroll
                            for (int x = 0; x < 4; ++x) { v0[x] = sigmoidf_(v0[x]); v1[x] = sigmoidf_(v1[x]); } }
                        *(u32x4*)(rowp + bj * 128) = pack_row8(v0, v1); } } }
        } else {
#pragma unroll
            for (int ai = 0; ai < 2; ++ai)
#pragma unroll
                for (int m = 0; m < 4; ++m) { const size_t row = (size_t)(row0 + ai * 128 + m * 16);
                    if (wc < 2) *(u32x4*)(KIDX + row * 64 + wc * 32 + 8 * fq) = pack_row8(acc[ai][0][m][0], acc[ai][0][m][1]);
                    else if (wc == 2 && fq < 2) { *(f32x4*)(SM + row * 16 + 8 * fq) = acc[ai][0][m][0]; *(f32x4*)(SM + row * 16 + 8 * fq + 4) = acc[ai][0][m][1]; } }
        }
    }
};
DEV float rms_scale(const float* SSQ, size_t row) { const f32x4 q = *(const f32x4*)(SSQ + row * 4); return 1.0f / sqrtf(((q[0] + q[1]) + (q[2] + q[3])) * (1.0f / 256.0f) + LN_EPS); }
struct EpiK {
    static constexpr bool DUAL = false;
    bf16_t* Kb; const float* SSQ;
    DEVM void operator()(EPI_ARGS) const {
        const int row0 = u.pm * 256 + wr * 64 + fr, col0 = u.pn * 256 + wc * 32 + 8 * fq;
        float sr[2][4];
#pragma unroll
        for (int ai = 0; ai < 2; ++ai)
#pragma unroll
            for (int m = 0; m < 4; ++m) sr[ai][m] = rms_scale(SSQ, (size_t)(row0 + ai * 128 + m * 16));
        MEM_FENCE();
#pragma unroll
        for (int ai = 0; ai < 2; ++ai)
#pragma unroll
            for (int m = 0; m < 4; ++m) { const size_t row = (size_t)(row0 + ai * 128 + m * 16); const float s = sr[ai][m];
#pragma unroll
                for (int bj = 0; bj < 2; ++bj) *(u32x4*)(Kb + row * 512 + col0 + bj * 128) = pack_row8(acc[ai][bj][m][0] * s, acc[ai][bj][m][1] * s); }
    }
};
struct EpiVT {
    static constexpr bool DUAL = false;
    bf16_t* VT; const float* SSQ;
    DEVM void operator()(EPI_ARGS) const {
        const int row0 = u.pm * 256 + wr * 64 + fr, col0 = u.pn * 256 + wc * 32 + 8 * fq;
        float sc[2][8];
#pragma unroll
        for (int bj = 0; bj < 2; ++bj)
#pragma unroll
            for (int x = 0; x < 8; ++x) sc[bj][x] = rms_scale(SSQ, (size_t)(col0 + bj * 128 + x));
        MEM_FENCE();
#pragma unroll
        for (int ai = 0; ai < 2; ++ai)
#pragma unroll
            for (int m = 0; m < 4; ++m) { const size_t row = (size_t)(row0 + ai * 128 + m * 16);
#pragma unroll
                for (int bj = 0; bj < 2; ++bj) { f32x4 v0 = acc[ai][bj][m][0], v1 = acc[ai][bj][m][1];
#pragma unroll
                    for (int x = 0; x < 4; ++x) { v0[x] *= sc[bj][x]; v1[x] *= sc[bj][4 + x]; }
                    *(u32x4*)(VT + row * (size_t)M + col0 + bj * 128) = pack_row8(v0, v1); } }
    }
};
struct EpiUpDual {
    static constexpr bool DUAL = true;
    bf16_t* Y; const bf16_t* H;
    DEVM bool dual(f32x4 (&acc)[2][2][4][2], const Unit& u, int wr, int wc, int fr, int fq) const {
        const int row0 = u.pm * 256 + wr * 64 + fr, col0 = u.pn * 256 + wc * 32 + 8 * fq;
        const int gcol = (u.e == 0) ? C_GA : C_GM;
#pragma unroll
        for (int ai = 0; ai < 2; ++ai) {
            u32x4 gv[4][2];
#pragma unroll
            for (int m = 0; m < 4; ++m) { const size_t row = (size_t)(row0 + ai * 128 + m * 16);
#pragma unroll
                for (int bj = 0; bj < 2; ++bj) gv[m][bj] = *(const u32x4*)(H + row * LDH + gcol + col0 + bj * 128); }
            MEM_FENCE();
#pragma unroll
            for (int m = 0; m < 4; ++m) { const size_t row = (size_t)(row0 + ai * 128 + m * 16);
#pragma unroll
                for (int bj = 0; bj < 2; ++bj) { const u32x4 g = gv[m][bj];
                    const float g8[8] = {lo_bf(g.x), hi_bf(g.x), lo_bf(g.y), hi_bf(g.y), lo_bf(g.z), hi_bf(g.z), lo_bf(g.w), hi_bf(g.w)};
                    if (u.e == 0) {
#pragma unroll
                        for (int x = 0; x < 4; ++x) { acc[ai][bj][m][0][x] *= g8[x]; acc[ai][bj][m][1][x] *= g8[4 + x]; }
                    } else { f32x4 v0 = acc[ai][bj][m][0], v1 = acc[ai][bj][m][1];
#pragma unroll
                        for (int x = 0; x < 4; ++x) { v0[x] *= g8[x]; v1[x] *= g8[4 + x]; }
                        *(u32x4*)(Y + row * 1024 + col0 + bj * 128) = pack_row8(v0, v1); } } }
            MEM_FENCE();
        }
        return u.e == 0;
    }
};
struct SchedDual {
    static constexpr bool GATHER = false;
    pg8::SchedStatic T; int K, lda, ldb; const bf16_t* A0; const bf16_t* A1; const bf16_t* B0; const bf16_t* B1; int phase_id = -1;
    DEVM bool next(int i, Unit& u) const { if (!T.next(i >> 1, u)) return false; u.e = i & 1; return true; }
    DEVM const char* baseA(const Unit& u) const { return (const char*)((u.e ? A1 : A0) + (size_t)u.pm * 256 * lda); }
    DEVM const char* baseB(const Unit& u) const { return (const char*)((u.e ? B1 : B0) + (size_t)u.pn * 256 * ldb); }
};
struct EpiOut {
    static constexpr bool DUAL = false;
    bf16_t* Z; const bf16_t* XB;
    DEVM void operator()(EPI_ARGS) const {
        const int row0 = u.pm * 256 + wr * 64 + fr, col0 = u.pn * 256 + wc * 32 + 8 * fq;
#pragma unroll
        for (int ai = 0; ai < 2; ++ai) {
            u32x4 xv[4][2];
#pragma unroll
            for (int m = 0; m < 4; ++m) { const size_t off = (size_t)(row0 + ai * 128 + m * 16) * 1024 + col0;
#pragma unroll
                for (int bj = 0; bj < 2; ++bj) xv[m][bj] = *(const u32x4*)(XB + off + bj * 128); }
            MEM_FENCE();
#pragma unroll
            for (int m = 0; m < 4; ++m) { const size_t off = (size_t)(row0 + ai * 128 + m * 16) * 1024 + col0;
#pragma unroll
                for (int bj = 0; bj < 2; ++bj) { const u32x4 x = xv[m][bj]; f32x4 v0 = acc[ai][bj][m][0], v1 = acc[ai][bj][m][1];
                    v0[0] += ALPHA * lo_bf(x.x); v0[1] += ALPHA * hi_bf(x.x); v0[2] += ALPHA * lo_bf(x.y); v0[3] += ALPHA * hi_bf(x.y);
                    v1[0] += ALPHA * lo_bf(x.z); v1[1] += ALPHA * hi_bf(x.z); v1[2] += ALPHA * lo_bf(x.w); v1[3] += ALPHA * hi_bf(x.w);
                    *(u32x4*)(Z + off + bj * 128) = pack_row8(v0, v1); } }
            MEM_FENCE();
        }
    }
};
struct EpiMoe1 {
    static constexpr bool DUAL = false;
    bf16_t* HD;
    DEVM void operator()(EPI_ARGS) const {
        const int row0 = u.pm * 256 + wr * 64 + fr, col0 = u.pn * 128 + wc * 32 + 8 * fq;
#pragma unroll
        for (int ai = 0; ai < 2; ++ai) if (u.half < 0 || u.half == ai)
#pragma unroll
            for (int m = 0; m < 4; ++m) { const size_t row = (size_t)(row0 + ai * 128 + m * 16);
                f32x4 v0, v1;
#pragma unroll
                for (int x = 0; x < 4; ++x) { const float g0 = acc[ai][0][m][0][x], g1 = acc[ai][0][m][1][x]; v0[x] = g0 * sigmoidf_(g0) * acc[ai][1][m][0][x]; v1[x] = g1 * sigmoidf_(g1) * acc[ai][1][m][1][x]; }
                *(u32x4*)(HD + row * 512 + col0) = pack_row8(v0, v1); }
    }
};
struct EpiMoe2 {
    static constexpr bool DUAL = false;
    bf16_t* O2;
    DEVM void operator()(EPI_ARGS) const {
        const int row0 = u.pm * 256 + wr * 64 + fr, col0 = u.pn * 256 + wc * 32 + 8 * fq;
#pragma unroll
        for (int ai = 0; ai < 2; ++ai) if (u.half < 0 || u.half == ai)
#pragma unroll
            for (int m = 0; m < 4; ++m) { const size_t row = (size_t)(row0 + ai * 128 + m * 16);
#pragma unroll
                for (int bj = 0; bj < 2; ++bj) *(u32x4*)(O2 + row * 1024 + col0 + bj * 128) = pack_row8(acc[ai][bj][m][0], acc[ai][bj][m][1]); }
    }
};

struct Ctx {
    const float* in[25]; float* out; unsigned char* ws;
    int tid, lane, wid, G, bid;
    LAS unsigned char* lds;
};
#define IN_X 0
#define IN_WIN 1
#define IN_CONVW 2
#define IN_CONVB 3
#define IN_KVG 4
#define IN_WUK 5
#define IN_WUV 6
#define IN_RELB 7
#define IN_BI 8
#define IN_BF 9
#define IN_MHG 10
#define IN_WUPA 11
#define IN_WUPM 12
#define IN_WOUT 13
#define IN_LN1G 14
#define IN_LN1B 15
#define IN_WGRP 16
#define IN_BGRP 17
#define IN_WRT 18
#define IN_BRT 19
#define IN_WGATE 20
#define IN_WUP 21
#define IN_WDOWN 22
#define IN_LN2G 23
#define IN_LN2B 24
template <class T> DEV T* wsp(const Ctx& c, size_t off) { return (T*)(c.ws + off); }
DEV const float* par(const Ctx& c, int off) { return (const float*)(c.ws + WS_PAR) + off; }
DEV void wg_sync() { __syncthreads(); }

DEV int win_src_col(int n) {
    if (n < 1280) return n;
    if (n < 2816) return 1352 + (n - 1280);
    if (n < 3328) return 2896 + (n - 2816);
    if (n < 5376) { const int j = (n - 3328) >> 8, w = (n - 3328) & 255; return (w < 128) ? 3408 + 128 * j + w : 4432 + 128 * j + (w - 128); }
    if (n < 5440) return 1280 + (n - 5376);
    if (n < 5448) return 1344 + (n - 5440);
    if (n < 5456) return 2888 + (n - 5448);
    return -1;
}
DEV void p0_item(const float* W, const float* W2, int K, int Nsrc, bf16_t* WT, int mode, const float* aux, LAS float* scr, int item, int nblk, int lane) {
    const int kb = item / nblk, nb = item % nblk, k0 = 64 * kb, n0 = 32 * nb;
    const int nn = n0 + (lane & 31);
    int col = nn; const float* src = W; float cs = 1.0f;
    if (mode == 1) { col = win_src_col(nn); cs = (nn < 512) ? QSCALE : 1.0f; }
    if (mode == 3) { const int t = nn >> 8, j = nn & 255; col = t * 128 + (j & 127); src = (j < 128) ? W : W2; }
    float vv[32];
#pragma unroll
    for (int i = 0; i < 32; ++i) { const int kk = 2 * i + (lane >> 5); vv[i] = (col >= 0) ? src[(size_t)(k0 + kk) * Nsrc + col] : 0.f; }
#pragma unroll
    for (int i = 0; i < 32; ++i) { const int kk = 2 * i + (lane >> 5); float v = vv[i] * cs; if (mode == 2) v *= aux[k0 + kk];
        scr[kk * 33 + (lane & 31)] = v; }
    WAVE_SYNC();
    const int c = lane & 7;
#pragma unroll
    for (int j = 0; j < 4; ++j) { const int n = (lane >> 3) + 8 * j; const LAS float* s = scr + (8 * c) * 33 + n;
        u32x4 o; o.x = pk2(s[0 * 33], s[1 * 33]); o.y = pk2(s[2 * 33], s[3 * 33]); o.z = pk2(s[4 * 33], s[5 * 33]); o.w = pk2(s[6 * 33], s[7 * 33]);
        *(u32x4*)(WT + (size_t)(n0 + n) * K + k0 + 8 * c) = o; }
    WAVE_SYNC();
}
DEV void p0_expert_items(const Ctx& c, int gw, int NGW) {
    LAS float* scr = (LAS float*)(c.lds + c.wid * 16384);
    constexpr int I_GU = 16 * 32, I_D = 8 * 32;
    for (int it = gw; it < NE * (I_GU + I_D); it += NGW) {
        int r = it;
        if (r < NE * I_GU) { const int e = r / I_GU; p0_item(c.in[IN_WGATE] + (size_t)e * 1024 * 512, c.in[IN_WUP] + (size_t)e * 1024 * 512, 1024, 512, wsp<bf16_t>(c, WS_WGU) + (size_t)e * 1024 * 1024, 3, nullptr, scr, r % I_GU, 32, c.lane); continue; } r -= NE * I_GU;
        { const int e = r / I_D; p0_item(c.in[IN_WDOWN] + (size_t)e * 512 * 1024, nullptr, 512, 1024, wsp<bf16_t>(c, WS_WD) + (size_t)e * 1024 * 512, 0, nullptr, scr, r % I_D, 32, c.lane); }
    }
}
DEV void ex_params(const Ctx& c, int it, const float*& src, int& K, int& Nsrc, bf16_t*& WT, int& k0, int& n0, int lane) {
    constexpr int I_GU = 16 * 32, I_D = 8 * 32; int r = it, item; const float* W; const float* W2 = nullptr; int mode;
    if (r < NE * I_GU) { const int e = r / I_GU; W = c.in[IN_WGATE] + (size_t)e * 1024 * 512; W2 = c.in[IN_WUP] + (size_t)e * 1024 * 512; K = 1024; Nsrc = 512; WT = wsp<bf16_t>(c, WS_WGU) + (size_t)e * 1024 * 1024; mode = 3; item = r % I_GU; }
    else { r -= NE * I_GU; const int e = r / I_D; W = c.in[IN_WDOWN] + (size_t)e * 512 * 1024; K = 512; Nsrc = 1024; WT = wsp<bf16_t>(c, WS_WD) + (size_t)e * 1024 * 512; mode = 0; item = r % I_D; }
    const int kb = item / 32, nb = item % 32; k0 = 64 * kb; n0 = 32 * nb;
    const int nn = n0 + (lane & 31); int col = nn; src = W;
    if (mode == 3) { const int t = nn >> 8, j = nn & 255; col = t * 128 + (j & 127); src = (j < 128) ? W : W2; }
    src += col;
}
DEV void ex_load(float (&vv)[32], const Ctx& c, int it, int lane) {
    const float* src; int K, Nsrc, k0, n0; bf16_t* WT; ex_params(c, it, src, K, Nsrc, WT, k0, n0, lane);
#pragma unroll
    for (int i = 0; i < 32; ++i) vv[i] = src[(size_t)(k0 + 2 * i + (lane >> 5)) * Nsrc];
}
DEV void ex_finish(const float (&vv)[32], const Ctx& c, int it, LAS float* scr, int lane) {
    const float* src; int K, Nsrc, k0, n0; bf16_t* WT; ex_params(c, it, src, K, Nsrc, WT, k0, n0, lane);
#pragma unroll
    for (int hf = 0; hf < 2; ++hf) {
#pragma unroll
        for (int i = 0; i < 16; ++i) scr[(2 * i + (lane >> 5)) * 33 + (lane & 31)] = vv[16 * hf + i];
        WAVE_SYNC();
        const int cc = lane & 3;
#pragma unroll
        for (int j = 0; j < 2; ++j) { const int n = (lane >> 2) + 16 * j; const LAS float* s = scr + (8 * cc) * 33 + n;
            u32x4 o; o.x = pk2(s[0 * 33], s[1 * 33]); o.y = pk2(s[2 * 33], s[3 * 33]); o.z = pk2(s[4 * 33], s[5 * 33]); o.w = pk2(s[6 * 33], s[7 * 33]);
            *(u32x4*)(WT + (size_t)(n0 + n) * K + k0 + 32 * hf + 8 * cc) = o; }
        WAVE_SYNC();
    }
}
DEV void phase_prologue(const Ctx& c) {
    LAS float* scr = (LAS float*)(c.lds + c.wid * 16384);
    const int gw = c.bid * NWAVES + c.wid, NGW = c.G * NWAVES;
    constexpr int I_WIN = 16 * (NWIN / 32), I_KV = 4 * 16, I_UP = 8 * 32, I_WO = 16 * 32;
    constexpr int NITEMS = I_WIN + 2 * I_KV + 2 * I_UP + I_WO;
    for (int it = gw; it < NITEMS; it += NGW) {
        int r = it;
        if (r < I_WIN) { p0_item(c.in[IN_WIN], nullptr, 1024, 5456, wsp<bf16_t>(c, WS_WIN), 1, nullptr, scr, r, NWIN / 32, c.lane); continue; } r -= I_WIN;
        if (r < I_KV) { p0_item(c.in[IN_WUK], nullptr, 256, 512, wsp<bf16_t>(c, WS_WK), 2, c.in[IN_KVG], scr, r, 16, c.lane); continue; } r -= I_KV;
        if (r < I_KV) { p0_item(c.in[IN_WUV], nullptr, 256, 512, wsp<bf16_t>(c, WS_WV), 2, c.in[IN_KVG], scr, r, 16, c.lane); continue; } r -= I_KV;
        if (r < I_UP) { p0_item(c.in[IN_WUPA], nullptr, 512, 1024, wsp<bf16_t>(c, WS_WA), 0, nullptr, scr, r, 32, c.lane); continue; } r -= I_UP;
        if (r < I_UP) { p0_item(c.in[IN_WUPM], nullptr, 512, 1024, wsp<bf16_t>(c, WS_WM), 0, nullptr, scr, r, 32, c.lane); continue; } r -= I_UP;
        p0_item(c.in[IN_WOUT], nullptr, 1024, 1024, wsp<bf16_t>(c, WS_WO), 0, nullptr, scr, r, 32, c.lane);
    }
    { float* P = wsp<float>(c, WS_PAR); const int gt = c.bid * NTHREADS + c.tid, ngt = c.G * NTHREADS;
      for (int i = gt; i < P_END; i += ngt) { float v;
        if (i < P_CONVB) v = c.in[IN_CONVW][i]; else if (i < P_BI) v = c.in[IN_CONVB][i - P_CONVB]; else if (i < P_BF) v = c.in[IN_BI][i - P_BI]; else if (i < P_MHG) v = c.in[IN_BF][i - P_BF];
        else if (i < P_RELB) v = c.in[IN_MHG][i - P_MHG]; else if (i < P_LN1G) v = c.in[IN_RELB][i - P_RELB]; else if (i < P_LN1B) v = c.in[IN_LN1G][i - P_LN1G]; else if (i < P_WGRP) v = c.in[IN_LN1B][i - P_LN1B];
        else if (i < P_BGRP) v = c.in[IN_WGRP][i - P_WGRP]; else if (i < P_WRT) v = c.in[IN_BGRP][i - P_BGRP]; else if (i < P_BRT) v = c.in[IN_WRT][i - P_WRT]; else if (i < P_LN2G) v = c.in[IN_BRT][i - P_BRT];
        else if (i < P_LN2B) v = c.in[IN_LN2G][i - P_LN2G]; else v = c.in[IN_LN2B][i - P_LN2B];
        P[i] = v; }
      for (int i = gt; i < 1024 * 20; i += ngt) { const int comp = i & 3, ln = (i >> 2) & 63, r = i >> 8, e4 = r % 5, jx = r / 5, kk = 4 * ln + 256 * (jx >> 2) + (jx & 3), col = 4 * e4 + comp;
          P[P_RW + i] = (col < 4) ? c.in[IN_WGRP][kk * 4 + col] : c.in[IN_WRT][kk * 16 + (col - 4)]; } }
    const float* X = c.in[IN_X]; bf16_t* XB = (bf16_t*)c.out;
    for (int m0 = gw; m0 < M; m0 += 4 * NGW) {
        f32x4 v[4][4];
#pragma unroll
        for (int q = 0; q < 4; ++q) { const int m = m0 + q * NGW; if (m < M) { const f32x4* xr = (const f32x4*)(X + (size_t)m * DM) + c.lane;
#pragma unroll
            for (int j = 0; j < 4; ++j) v[q][j] = xr[64 * j]; } }
#pragma unroll
        for (int q = 0; q < 4; ++q) { const int m = m0 + q * NGW; if (m < M) { u32x2* o = (u32x2*)(XB + (size_t)m * DM) + c.lane;
#pragma unroll
            for (int j = 0; j < 4; ++j) { u32x2 w; w.x = pk2(v[q][j][0], v[q][j][1]); w.y = pk2(v[q][j][2], v[q][j][3]); o[64 * j] = w; } } }
    }
}

#ifndef P2PROBE
#define P2PROBE 0
#define P2PROBE_KIND 1
#endif
constexpr int SCP = SEQ + 32;
constexpr int I_WQ = 16 * SCP * 4, I_CAND = I_WQ + 512, I_HIST = I_CAND + NWAVES * 320, IDX_LDS = I_HIST + NWAVES * 1280;
constexpr int NR = SEQ / 64, NGRP = NR / 8;
static_assert(NR % 8 == 0, "SEQ must be a multiple of 512");
DEV unsigned lds_add(LAS unsigned* p, unsigned v) {
#ifdef EMU
    return __atomic_fetch_add(p, v, __ATOMIC_RELAXED);
#else
    return __hip_atomic_fetch_add(p, v, __ATOMIC_RELAXED, __HIP_MEMORY_SCOPE_WORKGROUP);
#endif
}
DEV int rd_lane(int v, int l) {
#ifdef EMU
    return __shfl(v, l);
#else
    return __builtin_amdgcn_readlane(v, l);
#endif
}
DEV unsigned wr_lane(unsigned val, int l, unsigned old) {
#ifdef EMU
    return (e_lane == l) ? val : old;
#else
    return (((int)threadIdx.x & 63) == l) ? val : old;
#endif
}
DEV int wave_sum_int(int v) {
#ifdef EMU
#pragma unroll
    for (int o = 1; o < 64; o <<= 1) v += __shfl_xor(v, o);
    return v;
#else
    v += __builtin_amdgcn_update_dpp(0, v, 0x111, 0xf, 0xf, true);
    v += __builtin_amdgcn_update_dpp(0, v, 0x112, 0xf, 0xf, true);
    v += __builtin_amdgcn_update_dpp(0, v, 0x114, 0xf, 0xf, true);
    v += __builtin_amdgcn_update_dpp(0, v, 0x118, 0xf, 0xf, true);
    v += __builtin_amdgcn_update_dpp(0, v, 0x142, 0xa, 0xf, false);
    v += __builtin_amdgcn_update_dpp(0, v, 0x143, 0xc, 0xf, false);
    return __builtin_amdgcn_readlane(v, 63);
#endif
}
DEV void idx_select_row(const LAS float* scrow, int t, unsigned* out, LAS unsigned* cand_lds, int lane) {
    if (t + 1 <= TOPK) {
        if (lane < NWORDS) { const int lo = 32 * lane; out[lane] = (lo + 31 <= t) ? 0xffffffffu : (lo > t ? 0u : ((1u << (t - lo + 1)) - 1u)); }
        return;
    }
    const int ng = (t >> 9) + 1;
    const int tl = t - lane;
    unsigned key[NR];
#pragma unroll
    for (int g = 0; g < NGRP; ++g) {
#pragma unroll
        for (int r8 = 0; r8 < 8; ++r8) key[8 * g + r8] = 0u;
        if (g < ng) {
#pragma unroll
            for (int r8 = 0; r8 < 8; ++r8) { const int r = 8 * g + r8; const unsigned uu = fbits(scrow[r * 64 + lane]); const unsigned kk = uu ^ ((unsigned)((int)uu >> 31) | 0x80000000u); key[r] = (64 * r <= tl) ? kk : 0u; }
        }
    }
    unsigned smp;
    { const int gsel = (lane >> 4) % ng; unsigned s0 = key[0], s1 = key[8], s2 = key[16], s3 = key[24];
#ifndef EMU
      asm volatile("" : "+v"(s0), "+v"(s1), "+v"(s2), "+v"(s3));
#endif
      smp = (gsel == 1) ? s1 : (gsel == 2) ? s2 : (gsel == 3) ? s3 : s0; }
    const int nv = __popcll(__ballot(smp != 0u));
    smp = (smp & ~63u) | (unsigned)(63 - lane);
    int srank = 0;
#pragma unroll
    for (int j = 0; j < 64; ++j) { const unsigned sj = (unsigned)lane_bcast((int)smp, j); srank += (sj > smp) ? 1 : 0; }
    unsigned L = 1u, Hm = 0xffffffffu; int cntL = t + 1, cntH = 0, rL = nv, rH = -1;
    bool tie = false;
#pragma unroll 1
    for (;;) {
        if (cntL - cntH <= 64) break;
        if (Hm == L) { tie = true; break; }
        unsigned p; int rp = -2; const int between = rL - rH - 1;
        if (between > 0) { int o = (int)((float)(TOPK - cntH) * (float)between / (float)(cntL - cntH)); o = o < 0 ? 0 : (o > between - 1 ? between - 1 : o); rp = rH + 1 + o;
            const u64 mm = __ballot(srank == rp); p = (unsigned)lane_bcast((int)smp, (int)__builtin_ctzll(mm));
            if (p <= L || p > Hm) { rp = -2; p = L + ((Hm - L) >> 1) + 1u; } }
        else p = L + ((Hm - L) >> 1) + 1u;
        int cl = 0;
#pragma unroll
        for (int g = 0; g < NGRP; ++g) if (g < ng) {
#pragma unroll
            for (int r8 = 0; r8 < 8; ++r8) cl += (key[8 * g + r8] >= p) ? 1 : 0;
        }
        const int cc = wave_sum_int(cl);
        if (cc >= TOPK) { L = p; cntL = cc; if (rp >= 0) rL = rp; } else { Hm = p - 1u; cntH = cc; if (rp >= 0) rH = rp; }
    }
    unsigned lo; int cgt, cge; const int cnt_hi = cntH;
    if (!tie) {
        const int und = cntL - cntH; const u64 ltm = (lane == 0) ? 0ull : (~0ull >> (64 - lane)); int base = 0; const unsigned span = Hm - L;
#pragma unroll
        for (int g = 0; g < NGRP; ++g) if (g < ng) {
#pragma unroll
            for (int r8 = 0; r8 < 8; ++r8) { const unsigned k2 = key[8 * g + r8]; const bool f = (k2 - L) <= span; const u64 mm = __ballot(f);
                if (mm != 0ull) { if (f) cand_lds[(base + __popcll(mm & ltm)) & 63] = k2; base += __popcll(mm); } }
        }
        WAVE_SYNC();
        const bool cv = lane < und; const unsigned cand = cv ? cand_lds[lane] : 0u;
        WAVE_SYNC();
        const unsigned dx = L ^ Hm; int bit = dx ? 31 - (int)__builtin_clz(dx) : -1;
        lo = (bit >= 31) ? 0u : (L & ~((2u << (bit < 0 ? 0 : bit)) - 1u)); if (bit < 0) lo = L;
#pragma unroll 1
        for (; bit >= 0; --bit) { const unsigned trial = lo | (1u << bit); const int cc = cnt_hi + __popcll(__ballot(cv && cand >= trial)); if (cc >= TOPK) lo = trial; }
        cgt = cnt_hi + __popcll(__ballot(cv && cand > lo)); cge = cnt_hi + __popcll(__ballot(cv && cand >= lo));
    } else { lo = L; cge = cntL; cgt = cntH; }
    const int need = TOPK - cgt; unsigned mlo = 0u, mhi = 0u;
    if (cge - cgt == need) {
#pragma unroll
        for (int g = 0; g < NGRP; ++g) if (g < ng) {
#pragma unroll
            for (int r8 = 0; r8 < 8; ++r8) { const u64 mm = __ballot(key[8 * g + r8] >= lo); mlo = wr_lane((unsigned)mm, 8 * g + r8, mlo); mhi = wr_lane((unsigned)(mm >> 32), 8 * g + r8, mhi); }
        }
    } else {
        const u64 ltm = (lane == 0) ? 0ull : (~0ull >> (64 - lane)); int run = 0;
#pragma unroll
        for (int g = 0; g < NGRP; ++g) if (g < ng) {
#pragma unroll
            for (int r8 = 0; r8 < 8; ++r8) { const unsigned k2 = key[8 * g + r8]; const bool eqp = k2 == lo; const u64 eq = __ballot(eqp); const int rank = run + __popcll(eq & ltm);
                const bool sel = (k2 > lo) || (eqp && rank < need); const u64 mm = __ballot(sel); mlo = wr_lane((unsigned)mm, 8 * g + r8, mlo); mhi = wr_lane((unsigned)(mm >> 32), 8 * g + r8, mhi); run += __popcll(eq); }
        }
    }
    if (lane < NR) { u32x2 w; w.x = mlo; w.y = mhi; *(u32x2*)(out + 2 * lane) = w; }
}
DEV void idx_load_b(bf16x8 (&bf)[4], const bf16_t* KIDX, size_t rowb, int kc, int r32, int hi) {
    const bf16_t* p = KIDX + (rowb + kc * 32 + r32) * 64 + hi * 8;
#pragma unroll
    for (int ks = 0; ks < 4; ++ks) bf[ks] = *(const bf16x8*)(p + ks * 16);
}
DEV void idx_load_a(bf16x8 (&af)[4][4], const bf16_t* H, size_t rowb, int t0, int r32, int hi) {
    const int ah = (r32 & 3) + 4 * ((r32 >> 3) & 1), atl = 2 * (r32 >> 4) + ((r32 >> 2) & 1);
#pragma unroll
    for (int T = 0; T < 4; ++T)
#pragma unroll
        for (int ks = 0; ks < 4; ++ks) af[T][ks] = *(const bf16x8*)(H + (rowb + t0 + 4 * T + atl) * LDH + C_QI + ah * 64 + ks * 16 + hi * 8);
}
struct IdxQbRaw { unsigned q[8]; f32x4 w0, w1; };
DEV void idx_load_qb(IdxQbRaw& R, const bf16_t* H, const float* SM, size_t rowb, int t0, int tid) {
    const size_t row = rowb + t0 + (tid >> 5);
#pragma unroll
    for (int h = 0; h < 8; ++h) R.q[h] = *(const unsigned*)(H + row * LDH + C_QI + h * 64 + 2 * (tid & 31));
    R.w0 = *(const f32x4*)(SM + row * 16); R.w1 = *(const f32x4*)(SM + row * 16 + 4);
}
DEV void idx_units(const Ctx& c, int c2, int g2) {
    const int lane = c.lane, wid = c.wid, r32 = lane & 31, hi = lane >> 5;
    LAS float* sc = (LAS float*)c.lds; LAS float* WQ = (LAS float*)(c.lds + I_WQ); LAS unsigned* CAND = (LAS unsigned*)(c.lds + I_CAND) + wid * 80;
    LAS bf16_t* QBH = (LAS bf16_t*)(c.lds + I_HIST); LAS bf16_t* QBL = QBH + 16 * 72;
    const bf16_t* H = wsp<bf16_t>(c, WS_H); const bf16_t* KIDX = wsp<bf16_t>(c, WS_KIDX); const float* SM = wsp<float>(c, WS_SM);
    unsigned* MASK = wsp<unsigned>(c, WS_MASK);
    const int nq = SEQ / 16, nunits = NB * nq;
    bf16x8 af[4][4], afn[4][4]; IdxQbRaw qr;
    if (c2 < nunits) { idx_load_a(af, H, (size_t)(c2 % NB) * SEQ, (nq - 1 - c2 / NB) * 16, r32, hi); idx_load_qb(qr, H, SM, (size_t)(c2 % NB) * SEQ, (nq - 1 - c2 / NB) * 16, c.tid); }
    const int qrow = 2 * ((r32 & 3) + 4 * ((r32 >> 3) & 1)) + ((r32 >> 2) & 1);
    for (int u = c2; u < nunits; u += g2) {
        const int b = u % NB, qt = nq - 1 - u / NB, t0 = qt * 16; const size_t rowb = (size_t)b * SEQ;
        const int nkc = (t0 + 16 + 31) / 32;
        {
            const float wv[8] = {qr.w0[0], qr.w0[1], qr.w0[2], qr.w0[3], qr.w1[0], qr.w1[1], qr.w1[2], qr.w1[3]};
            float q0 = 0.f, q1 = 0.f;
#pragma unroll
            for (int h = 0; h < 8; ++h) { q0 += 0.5f * wv[h] * lo_bf(qr.q[h]); q1 += 0.5f * wv[h] * hi_bf(qr.q[h]); }
            const unsigned hw = pk2(q0, q1); const unsigned lw = pk2(q0 - lo_bf(hw), q1 - hi_bf(hw));
            *(LAS unsigned*)(QBH + (c.tid >> 5) * 72 + 2 * (c.tid & 31)) = hw; *(LAS unsigned*)(QBL + (c.tid >> 5) * 72 + 2 * (c.tid & 31)) = lw;
            if ((c.tid & 31) < 8) WQ[(c.tid >> 5) * 8 + (c.tid & 31)] = 0.5f * wv[c.tid & 31];
        }
        bf16x8 bq0[4], bq1[4], bq2[4];
        if (wid < nkc) idx_load_b(bq0, KIDX, rowb, wid, r32, hi);
        if (wid + NWAVES < nkc) idx_load_b(bq1, KIDX, rowb, wid + NWAVES, r32, hi);
        wg_sync();
#if P2PROBE && P2PROBE_KIND == 2
        const unsigned long long pk_t0 = rt_now();
#endif
        bf16x8 alq[4];
#pragma unroll
        for (int ks = 0; ks < 4; ++ks) alq[ks] = *(const LAS bf16x8*)(((r32 < 16) ? QBH : QBL) + qrow * 72 + ks * 16 + hi * 8);
#define IDX_CHUNK(BC, BP) { \
            if (kc + 2 * NWAVES < nkc) idx_load_b(BP, KIDX, rowb, kc + 2 * NWAVES, r32, hi); \
            const int key = kc * 32 + r32; \
            f32x16 al = {0.f, 0.f, 0.f, 0.f, 0.f, 0.f, 0.f, 0.f, 0.f, 0.f, 0.f, 0.f, 0.f, 0.f, 0.f, 0.f};       \
            _Pragma("unroll") for (int ks = 0; ks < 4; ++ks) al = mfma32(alq[ks], BC[ks], al); \
            _Pragma("unroll") for (int T = 0; T < 4; ++T) { \
                f32x16 a = {0.f, 0.f, 0.f, 0.f, 0.f, 0.f, 0.f, 0.f, 0.f, 0.f, 0.f, 0.f, 0.f, 0.f, 0.f, 0.f}; \
                _Pragma("unroll") for (int ks = 0; ks < 4; ++ks) a = mfma32(af[T][ks], BC[ks], a); \
                const int tq0 = 4 * T + hi; \
                const f32x4 w00 = *(const LAS f32x4*)(WQ + tq0 * 8), w01 = *(const LAS f32x4*)(WQ + tq0 * 8 + 4), w10 = *(const LAS f32x4*)(WQ + (tq0 + 2) * 8), w11 = *(const LAS f32x4*)(WQ + (tq0 + 2) * 8 + 4); \
                float s0 = al[2 * T] + al[2 * T + 8], s1 = al[2 * T + 1] + al[2 * T + 9];     \
                _Pragma("unroll") for (int i = 0; i < 4; ++i) { s0 += w00[i] * fabsf(a[i]) + w01[i] * fabsf(a[4 + i]); s1 += w10[i] * fabsf(a[8 + i]) + w11[i] * fabsf(a[12 + i]); } \
                sc[tq0 * SCP + key] = s0; sc[(tq0 + 2) * SCP + key] = s1; } \
            kc += NWAVES; }
        for (int kc = wid; kc < nkc; ) {
            IDX_CHUNK(bq0, bq2) if (kc >= nkc) break;
            IDX_CHUNK(bq1, bq0) if (kc >= nkc) break;
            IDX_CHUNK(bq2, bq1)
        }
#undef IDX_CHUNK
        const int un = u + g2;
        if (un < nunits) { idx_load_a(afn, H, (size_t)(un % NB) * SEQ, (nq - 1 - un / NB) * 16, r32, hi); idx_load_qb(qr, H, SM, (size_t)(un % NB) * SEQ, (nq - 1 - un / NB) * 16, c.tid); }
        LDS_SYNC();
#if P2PROBE && P2PROBE_KIND == 2
        if (c2 == 0 && c.tid == 0) { volatile LAS unsigned* mm = (volatile LAS unsigned*)(c.lds + (144 * 1024 - 64)); mm[4] = mm[4] + (unsigned)(rt_now() - pk_t0); }
#endif
#if P2PROBE && P2PROBE_KIND == 3
        const unsigned long long pk_t1 = rt_now();
#endif
#pragma unroll 1
        for (int qq = 0; qq < 2; ++qq) { const int tq = wid + 8 * qq, t = t0 + tq; idx_select_row(sc + tq * SCP, t, MASK + (rowb + t) * NWORDS, CAND, lane); }
        LDS_SYNC();
#if P2PROBE && P2PROBE_KIND == 3
        if (c2 == 0 && c.tid == 0) { volatile LAS unsigned* mm = (volatile LAS unsigned*)(c.lds + (144 * 1024 - 64)); mm[4] = mm[4] + (unsigned)(rt_now() - pk_t1); }
#endif
        if (un < nunits) {
#pragma unroll
            for (int T = 0; T < 4; ++T)
#pragma unroll
                for (int ks = 0; ks < 4; ++ks) af[T][ks] = afn[T][ks]; }
    }
    wg_sync();
}

constexpr int QP = 136, TP = 72;
constexpr int L_QS = 0, L_KS = L_QS + 64 * QP * 2, L_KT = L_KS + 64 * QP * 2, L_VT = L_KT + 128 * TP * 2, L_CT = L_VT + 128 * TP * 2, L_N = L_CT + 128 * QP * 2,
              L_G = L_N + 512, L_PART = L_G + NWAVES * 1280, L_CW = L_PART + 1024, L_GN = L_CW + 32 * 40 * 4, ML_LDS = L_GN + 512;
#ifndef EMU
template <int CTRL, int ROWMASK> DEV float dpp_f(float v, float ident) { return bitsf((unsigned)__builtin_amdgcn_update_dpp((int)fbits(ident), (int)fbits(v), CTRL, ROWMASK, 0xf, false)); }
#endif
DEV float scan_add(float v, int lane) {
#ifdef EMU
#pragma unroll
    for (int d = 1; d < 64; d <<= 1) { const float o = __shfl_up(v, d); if (lane >= d) v += o; }
#else
    v += dpp_f<0x111, 0xf>(v, 0.f); v += dpp_f<0x112, 0xf>(v, 0.f); v += dpp_f<0x114, 0xf>(v, 0.f); v += dpp_f<0x118, 0xf>(v, 0.f);
    v += dpp_f<0x142, 0xa>(v, 0.f); v += dpp_f<0x143, 0xc>(v, 0.f); (void)lane;
#endif
    return v;
}
DEV float scan_max(float v, int lane) {
#ifdef EMU
#pragma unroll
    for (int d = 1; d < 64; d <<= 1) { const float o = __shfl_up(v, d); if (lane >= d) v = fmaxf(v, o); }
#else
    const float ninf = -__builtin_inff();
    v = fmaxf(v, dpp_f<0x111, 0xf>(v, ninf)); v = fmaxf(v, dpp_f<0x112, 0xf>(v, ninf)); v = fmaxf(v, dpp_f<0x114, 0xf>(v, ninf)); v = fmaxf(v, dpp_f<0x118, 0xf>(v, ninf));
    v = fmaxf(v, dpp_f<0x142, 0xa>(v, ninf)); v = fmaxf(v, dpp_f<0x143, 0xc>(v, ninf)); (void)lane;
#endif
    return v;
}
DEV int tsw(int d) { return 2 * ((d >> 3) & 7); }
struct MlRaw { u32x4 qk[7]; u32x4 v[2]; float fp, ip; };
DEV void ml_load_gates(MlRaw& R, const float* SM, int b, int head, int ch, int lane, float bfg, float bi) {
    const float* base = SM + ((size_t)b * SEQ + (size_t)ch * 64) * 16 + head;
    R.fp = *(const float*)((const char*)base + (unsigned)(lane * 64 + 48)) + bfg; R.ip = *(const float*)((const char*)base + (unsigned)(lane * 64 + 32)) + bi;
}
DEV void ml_load_bulk(MlRaw& R, const bf16_t* H, int b, int head, int ch, unsigned qoff, unsigned voff, bool first_rows, int tid) {
    const size_t rowc = (size_t)b * SEQ + (size_t)ch * 64;
#pragma unroll
    for (int i = 0; i < 7; ++i) {
        const bool neg = first_rows && ch == 0 && i < 3;
        const bf16_t* base = H + ((long)rowc + i - 3) * LDH;
        const u32x4 raw = *(const u32x4*)((const char*)base + (qoff + (neg ? 3u * LDH * 2u : 0u)));
        const u32x4 z = {0u, 0u, 0u, 0u};
        R.qk[i] = neg ? z : raw; }
#pragma unroll
    for (int o = 0; o < 2; ++o) { const bf16_t* base = H + (rowc + o) * LDH + C_VM + head * 128; R.v[o] = *(const u32x4*)((const char*)base + voff); }
    (void)tid;
}
DEV void mlstm_unit(const Ctx& c, int b, int head) {
    int tid = c.tid; LAUNDER(tid);
    const int lane = tid & 63, wid = c.wid;
    LAS unsigned char* lds = c.lds;
    LAS bf16_t* QS = (LAS bf16_t*)(lds + L_QS); LAS bf16_t* KS = (LAS bf16_t*)(lds + L_KS); LAS bf16_t* KT = (LAS bf16_t*)(lds + L_KT);
    LAS bf16_t* VTs = (LAS bf16_t*)(lds + L_VT); LAS bf16_t* CT = (LAS bf16_t*)(lds + L_CT); LAS float* NV = (LAS float*)(lds + L_N);
    LAS float* GW = (LAS float*)(lds + L_G + wid * 1280); LAS float* PART = (LAS float*)(lds + L_PART);
    const bf16_t* H = wsp<bf16_t>(c, WS_H); const float* SM = wsp<float>(c, WS_SM); bf16_t* HM = wsp<bf16_t>(c, WS_H) + C_HM;
    const float bi = par(c, P_BI)[head], bfg = par(c, P_BF)[head];
    const int vt = wid >> 1, jt = wid & 1;
    const int which = tid >> 8, cg0 = tid & 15, rb0 = (tid & 255) >> 4;
    LAS float* CWL = (LAS float*)(lds + L_CW); LAS float* GNL = (LAS float*)(lds + L_GN);
    for (int i = tid; i < 32 * 40; i += NTHREADS) { const int grp = i / 40, e = i % 40, wh = grp >> 4, cgi = grp & 15, ch0 = wh * 512 + head * 128 + cgi * 8;
        CWL[i] = (e < 32) ? par(c, P_CONVW)[(e >> 3) * 1024 + ch0 + (e & 7)] : par(c, P_CONVB)[ch0 + (e - 32)]; }
    if (tid < 128) GNL[tid] = par(c, P_MHG)[head * 128 + tid];
    f32x16 accC[2];
#pragma unroll
    for (int x = 0; x < 2; ++x)
#pragma unroll
        for (int r = 0; r < 16; ++r) accC[x][r] = 0.f;
    for (int i = tid; i < 128 * QP / 2; i += NTHREADS) ((LAS unsigned*)CT)[i] = 0u;
    if (tid < 128) NV[tid] = 0.f;
    float m_prev = 0.f;
    const unsigned qoff = (unsigned)((rb0 * 4 * LDH + (which ? C_KM : C_QM) + head * 128 + cg0 * 8) * 2), voff = (unsigned)(((tid >> 4) * 2 * LDH + (tid & 15) * 8) * 2);
    MlRaw R; ml_load_gates(R, SM, b, head, 0, lane, bfg, bi); ml_load_bulk(R, H, b, head, 0, qoff, voff, rb0 == 0, tid);
    wg_sync();
    for (int ch = 0; ch < NCH; ++ch) {
        const size_t tok0 = (size_t)b * SEQ + (size_t)ch * 64;
        int tidc = tid; LAUNDER(tidc);
        const int lanec = tidc & 63, r32 = lanec & 31, hi = lanec >> 5, cg = tidc & 15, rb = (tidc & 255) >> 4;
        const LAS float* cwp = CWL + (which * 16 + cg) * 40;
        float wp, a_dec, m_new;
        {
            const float fp = R.fp, ip = R.ip;
            const float lf = fminf(fp, 0.f) - __logf(1.0f + __expf(-fabsf(fp)));
            const float bcum = scan_add(lf, lanec);
            const float g = ip - bcum, gmax = scan_max(g, lanec);
            const float mj = fmaxf(bcum + m_prev, bcum + gmax);
            const float blast = __shfl(bcum, 63), gmx = __shfl(gmax, 63);
            m_new = fmaxf(blast + m_prev, blast + gmx);
            a_dec = __expf(blast + m_prev - m_new);
            wp = __expf(blast + g - m_new);
            GW[lanec] = g * LOG2E; GW[64 + lanec] = (bcum - mj) * LOG2E; GW[128 + lanec] = __expf(bcum + m_prev - mj); GW[192 + lanec] = __expf(-mj);
        }
        {
            float y[4][8];
#pragma unroll
            for (int o = 0; o < 4; ++o)
#pragma unroll
                for (int x = 0; x < 8; ++x) y[o][x] = cwp[32 + x];
#pragma unroll
            for (int i = 0; i < 7; ++i) {
                const u32x4 raw = R.qk[i];
                const float rv[8] = {lo_bf(raw.x), hi_bf(raw.x), lo_bf(raw.y), hi_bf(raw.y), lo_bf(raw.z), hi_bf(raw.z), lo_bf(raw.w), hi_bf(raw.w)};
#pragma unroll
                for (int o = 0; o < 4; ++o) { const int j = i - o; if (j >= 0 && j < 4) {
#pragma unroll
                    for (int x = 0; x < 8; ++x) y[o][x] += cwp[j * 8 + x] * rv[x]; } }
            }
            float wpr[4];
#pragma unroll
            for (int o = 0; o < 4; ++o) wpr[o] = __shfl(wp, rb * 4 + o);
#pragma unroll
            for (int o = 0; o < 4; ++o) {
                const int rr = rb * 4 + o;
#pragma unroll
                for (int x = 0; x < 8; ++x) { const float v = y[o][x]; y[o][x] = v * sigmoidf_(v) * (which ? 0.08838834764831845f : 1.0f); }
                const bf16x8 pk = pack8(y[o][0], y[o][1], y[o][2], y[o][3], y[o][4], y[o][5], y[o][6], y[o][7]);
                if (which == 0) *(LAS bf16x8*)(QS + rr * QP + cg * 8) = pk; else *(LAS bf16x8*)(KS + rr * QP + cg * 8) = pk;
            }
            if (which) {
#pragma unroll
                for (int x = 0; x < 8; ++x) { const int d = cg * 8 + x; u32x2 w; w.x = pk2(y[0][x] * wpr[0], y[1][x] * wpr[1]); w.y = pk2(y[2][x] * wpr[2], y[3][x] * wpr[3]);
                    *(LAS u32x2*)(KT + d * TP + 4 * (rb ^ tsw(d))) = w; }
            }
            { const int cgv = tidc & 15, rg2 = tidc >> 4;
                const unsigned w0[4] = {R.v[0].x, R.v[0].y, R.v[0].z, R.v[0].w}, w1[4] = {R.v[1].x, R.v[1].y, R.v[1].z, R.v[1].w};
#pragma unroll
                for (int x2 = 0; x2 < 4; ++x2) {
                    const int d0 = cgv * 8 + 2 * x2;
                    *(LAS unsigned*)(VTs + d0 * TP + 4 * ((rg2 >> 1) ^ tsw(d0)) + 2 * (rg2 & 1)) = (w0[x2] & 0xffffu) | (w1[x2] << 16);
                    *(LAS unsigned*)(VTs + (d0 + 1) * TP + 4 * ((rg2 >> 1) ^ tsw(d0 + 1)) + 2 * (rg2 & 1)) = (w0[x2] >> 16) | (w1[x2] & 0xffff0000u); }
            }
        }
        if (ch + 1 < NCH) { ml_load_gates(R, SM, b, head, ch + 1, lanec, bfg, bi); ml_load_bulk(R, H, b, head, ch + 1, qoff, voff, rb0 == 0, tid); }
        LDS_SYNC();
        float hval[16]; const int jl = 32 * jt + r32;
        u32x2 sgv[4];
        { const char* sgb = (const char*)(H + tok0 * LDH + C_OM + head * 128); const unsigned sgo = (unsigned)((jl * LDH + 32 * vt + 4 * hi) * 2);
#pragma unroll
          for (int g4 = 0; g4 < 4; ++g4) sgv[g4] = *(const u32x2*)(sgb + (sgo + 16u * g4)); }
        {
            const float ejl = GW[64 + jl], wint = GW[128 + jl], flo = GW[192 + jl];
            f32x16 num = {0.f, 0.f, 0.f, 0.f, 0.f, 0.f, 0.f, 0.f, 0.f, 0.f, 0.f, 0.f, 0.f, 0.f, 0.f, 0.f};
            float den = 0.f;
            bf16x8 qf[8];
#pragma unroll
            for (int ks = 0; ks < 8; ++ks) qf[ks] = *(const LAS bf16x8*)(QS + jl * QP + ks * 16 + hi * 8);
            const int dv = 32 * vt + r32, swv = tsw(dv);
#pragma unroll
            for (int a = 0; a < 2; ++a) {
                if (a <= jt) {
                    f32x16 st = {0.f, 0.f, 0.f, 0.f, 0.f, 0.f, 0.f, 0.f, 0.f, 0.f, 0.f, 0.f, 0.f, 0.f, 0.f, 0.f};
#pragma unroll
                    for (int ks = 0; ks < 8; ++ks) st = mfma32(*(const LAS bf16x8*)(KS + (32 * a + r32) * QP + ks * 16 + hi * 8), qf[ks], st);
                    float pv[16];
#pragma unroll
                    for (int g4 = 0; g4 < 4; ++g4) { const int sb = 32 * a + 8 * g4 + 4 * hi; const f32x4 gg = *(const LAS f32x4*)(GW + sb);
#pragma unroll
                        for (int x = 0; x < 4; ++x) { const int s = sb + x; const float v = (s <= jl) ? st[4 * g4 + x] * fast_exp2(gg[x] + ejl) : 0.f; pv[4 * g4 + x] = v; den += v; } }
#pragma unroll
                    for (int s2 = 0; s2 < 2; ++s2) {
                        const bf16x8 pf = pack8(pv[8 * s2], pv[8 * s2 + 1], pv[8 * s2 + 2], pv[8 * s2 + 3], pv[8 * s2 + 4], pv[8 * s2 + 5], pv[8 * s2 + 6], pv[8 * s2 + 7]);
                        const int b0 = 8 * a + 4 * s2 + hi;
                        const s16x4 v0 = *(const LAS s16x4*)(VTs + dv * TP + 4 * (b0 ^ swv)), v1 = *(const LAS s16x4*)(VTs + dv * TP + 4 * ((b0 + 2) ^ swv));
                        const bf16x8 vf = {v0[0], v0[1], v0[2], v0[3], v1[0], v1[1], v1[2], v1[3]};
                        num = mfma32(vf, pf, num);
                    }
                }
            }
            f32x16 ni = {0.f, 0.f, 0.f, 0.f, 0.f, 0.f, 0.f, 0.f, 0.f, 0.f, 0.f, 0.f, 0.f, 0.f, 0.f, 0.f};
#pragma unroll
            for (int ks = 0; ks < 8; ++ks) ni = mfma32(*(const LAS bf16x8*)(CT + (32 * vt + r32) * QP + ks * 16 + hi * 8), qf[ks], ni);
            float qn = 0.f;
#pragma unroll
            for (int ks = 0; ks < 8; ++ks) { const f32x4 n0 = *(const LAS f32x4*)(NV + 16 * ks + 8 * hi), n1 = *(const LAS f32x4*)(NV + 16 * ks + 8 * hi + 4); const u32x4 qw = __builtin_bit_cast(u32x4, qf[ks]);
                qn += lo_bf(qw.x) * n0[0] + hi_bf(qw.x) * n0[1] + lo_bf(qw.y) * n0[2] + hi_bf(qw.y) * n0[3] + lo_bf(qw.z) * n1[0] + hi_bf(qw.z) * n1[1] + lo_bf(qw.w) * n1[2] + hi_bf(qw.w) * n1[3]; }
            qn = sum_xor32(qn); den = sum_xor32(den);
            const float dtot = den + wint * qn; const float inv = fast_rcp(fmaxf(fabsf(dtot), flo));
            float ssq = 0.f;
#pragma unroll
            for (int r = 0; r < 16; ++r) { hval[r] = (num[r] + wint * ni[r]) * inv; ssq += hval[r] * hval[r]; }
            ssq = sum_xor32(ssq);
            if (hi == 0) PART[vt * 64 + jl] = ssq;
        }
        float nsum;
        {
            const int dv = 32 * vt + r32, swv = tsw(dv);
#pragma unroll
            for (int x = 0; x < 2; ++x) { const int kt = 2 * jt + x; const int dk = 32 * kt + r32, swk = tsw(dk);
#pragma unroll
                for (int r = 0; r < 16; ++r) accC[x][r] *= a_dec;
#pragma unroll
                for (int ks = 0; ks < 4; ++ks) accC[x] = mfma32(*(const LAS bf16x8*)(VTs + dv * TP + 4 * ((4 * ks + 2 * hi) ^ swv)), *(const LAS bf16x8*)(KT + dk * TP + 4 * ((4 * ks + 2 * hi) ^ swk)), accC[x]); }
            { const int kd = 16 * wid + (lanec & 15), sq = lanec >> 4; float s = 0.f;
              const u32x4 k0 = *(const LAS u32x4*)(KT + kd * TP + 16 * sq), k1 = *(const LAS u32x4*)(KT + kd * TP + 16 * sq + 8);
              s = (lo_bf(k0.x) + hi_bf(k0.x)) + (lo_bf(k0.y) + hi_bf(k0.y)) + (lo_bf(k0.z) + hi_bf(k0.z)) + (lo_bf(k0.w) + hi_bf(k0.w)) + (lo_bf(k1.x) + hi_bf(k1.x)) + (lo_bf(k1.y) + hi_bf(k1.y)) + (lo_bf(k1.z) + hi_bf(k1.z)) + (lo_bf(k1.w) + hi_bf(k1.w));
              s += __shfl_xor(s, 16); s += __shfl_xor(s, 32); nsum = s; }
        }
        LDS_SYNC();
        {
#pragma unroll
            for (int x = 0; x < 2; ++x) { const int kt = 2 * jt + x;
#pragma unroll
                for (int r = 0; r < 16; r += 2) { const unsigned w2 = pk2(accC[x][r], accC[x][r + 1]);
                    CT[(32 * vt + crow(r, hi)) * QP + 32 * kt + r32] = (bf16_t)(w2 & 0xffffu); CT[(32 * vt + crow(r + 1, hi)) * QP + 32 * kt + r32] = (bf16_t)(w2 >> 16); } }
            { const int kd = 16 * wid + (lanec & 15), sq = lanec >> 4; const float nn = a_dec * NV[kd] + nsum; if (sq == 0) NV[kd] = nn; }
            const float stot = (PART[jl] + PART[64 + jl]) + (PART[128 + jl] + PART[192 + jl]);
            const float rstd = fast_rsq(stot * (1.0f / 128.0f) + LN_EPS);
            char* hmb = (char*)(HM + tok0 * LDH + head * 128);
            const unsigned hmo = (unsigned)((jl * LDH + 32 * vt + 4 * hi) * 2);
#pragma unroll
            for (int g4 = 0; g4 < 4; ++g4) { const int v0 = 32 * vt + 8 * g4 + 4 * hi; const f32x4 gq = *(const LAS f32x4*)(GNL + v0);
                const u32x2 sg = sgv[g4];
                u32x2 o; o.x = pk2(hval[4 * g4] * rstd * gq[0] * lo_bf(sg.x), hval[4 * g4 + 1] * rstd * gq[1] * hi_bf(sg.x));
                o.y = pk2(hval[4 * g4 + 2] * rstd * gq[2] * lo_bf(sg.y), hval[4 * g4 + 3] * rstd * gq[3] * hi_bf(sg.y));
                *(u32x2*)(hmb + (hmo + 16u * g4)) = o; }
        }
        m_prev = m_new;
    }
    LDS_SYNC();
}

constexpr int KP = 72, VP = 68;
constexpr int A_KS = 0, A_VS = 2 * 64 * KP * 2, A_BT = A_VS + 2 * 64 * VP * 2, AT_LDS = A_BT + 129 * 4 + 12;
DEV int t5_bucket(int d) {
    if (d < 16) return d;
    if (d >= 114) return 31;
    int bk = 16;
    const int th[15] = {19, 21, 24, 27, 31, 35, 40, 46, 52, 59, 67, 77, 87, 99, 113};
#pragma unroll
    for (int i = 0; i < 15; ++i) bk += (d >= th[i]) ? 1 : 0;
    return bk;
}
DEV void attn_unit(const Ctx& c, int b, int h, int qb) {
    const int tid = c.tid, lane = c.lane, wid = c.wid, r32 = lane & 31, hi = lane >> 5;
    LAS unsigned char* lds = c.lds;
    LAS bf16_t* Ks = (LAS bf16_t*)(lds + A_KS); LAS bf16_t* Vs = (LAS bf16_t*)(lds + A_VS); LAS float* BT = (LAS float*)(lds + A_BT);
    bf16_t* Hq = wsp<bf16_t>(c, WS_H); const bf16_t* Kb = wsp<bf16_t>(c, WS_K); const bf16_t* VT = wsp<bf16_t>(c, WS_VT); const unsigned* MASK = wsp<unsigned>(c, WS_MASK);
    const size_t rowb = (size_t)b * SEQ; const int q0 = qb * 256, qw0 = q0 + 32 * wid, q = qw0 + r32;
    const int NT = (q0 + 256) / 64;
    if (tid <= 128) { const float far = par(c, P_RELB)[31 * 8 + h]; BT[tid] = (tid < 128) ? (par(c, P_RELB)[t5_bucket(tid) * 8 + h] - far) * LOG2E : 0.f; }
    bf16x8 qf[4];
#pragma unroll
    for (int ks = 0; ks < 4; ++ks) qf[ks] = *(const bf16x8*)(Hq + (rowb + q) * LDH + C_QA + h * 64 + ks * 16 + hi * 8);
    const int srow = tid >> 3, spc = tid & 7;
    const bf16_t* ksrc = Kb + (rowb + srow) * 512 + h * 64 + spc * 8;
    const bf16_t* vsrc = VT + (size_t)(h * 64 + srow) * M + rowb + spc * 8;
    u32x4 kreg = *(const u32x4*)ksrc, vreg = *(const u32x4*)vsrc;
    *(LAS u32x4*)(Ks + srow * KP + spc * 8) = kreg;
    { LAS u32x2* vd = (LAS u32x2*)(Vs + srow * VP + spc * 8); u32x2 a = {vreg.x, vreg.y}, bb = {vreg.z, vreg.w}; vd[0] = a; vd[1] = bb; }
    float mhat = 0.f, lsum = 0.f;
    f32x16 o[2], negm;
#pragma unroll
    for (int r = 0; r < 16; ++r) negm[r] = 0.f;
#pragma unroll
    for (int d = 0; d < 2; ++d)
#pragma unroll
        for (int r = 0; r < 16; ++r) o[d][r] = 0.f;
    wg_sync();
    for (int kt = 0; kt < NT; ++kt) {
        const int buf = kt & 1;
        if (kt + 1 < NT) { kreg = *(const u32x4*)(ksrc + (size_t)(kt + 1) * 64 * 512); vreg = *(const u32x4*)(vsrc + (size_t)(kt + 1) * 64); }
        if (64 * kt <= qw0 + 31) {
            const LAS bf16_t* kb = Ks + buf * 64 * KP; const LAS bf16_t* vb = Vs + buf * 64 * VP;
            const u32x2 mw = *(const u32x2*)(MASK + (rowb + q) * NWORDS + 2 * kt);
            f32x16 s[2];
#pragma unroll
            for (int a = 0; a < 2; ++a) {
                s[a] = negm;
#pragma unroll
                for (int ks = 0; ks < 4; ++ks) s[a] = mfma32(*(const LAS bf16x8*)(kb + (32 * a + r32) * KP + ks * 16 + hi * 8), qf[ks], s[a]);
            }
            if (64 * kt + 63 + 128 > qw0) {
#pragma unroll
                for (int a = 0; a < 2; ++a)
#pragma unroll
                    for (int r = 0; r < 16; ++r) { int d = q - (64 * kt + 32 * a + crow(r, hi)); d = d < 0 ? 128 : (d > 128 ? 128 : d); s[a][r] += BT[d]; }
            }
            float mx = s[0][0];
#pragma unroll
            for (int a = 0; a < 2; ++a)
#pragma unroll
                for (int r = 0; r < 16; ++r) mx = fmaxf(mx, s[a][r]);
            mx = max_xor32(mx);
            if (kt == 0 || WAVE_ANY(mx > 8.0f)) {
                const float dl = (kt == 0) ? mx : fmaxf(mx, 0.f);
                mhat += dl;
#pragma unroll
                for (int a = 0; a < 2; ++a)
#pragma unroll
                    for (int r = 0; r < 16; ++r) s[a][r] -= dl;
#pragma unroll
                for (int r = 0; r < 16; ++r) negm[r] = -mhat;
                if (kt != 0) { const float f = fast_exp2(-dl); lsum *= f;
#pragma unroll
                    for (int d = 0; d < 2; ++d)
#pragma unroll
                        for (int r = 0; r < 16; ++r) o[d][r] *= f; }
            }
            float ps = 0.f;
#pragma unroll
            for (int a = 0; a < 2; ++a) {
                const unsigned w = (a ? mw.y : mw.x) >> (4 * hi);
                float p[16];
#pragma unroll
                for (int r = 0; r < 16; ++r) { const float e = fast_exp2(s[a][r]); const unsigned mbit = bit_spread(w, (r & 3) + 8 * (r >> 2)); p[r] = bitsf(fbits(e) & mbit); ps += p[r]; }
#pragma unroll
                for (int s2 = 0; s2 < 2; ++s2) {
                    const bf16x8 pf = pack8(p[8 * s2], p[8 * s2 + 1], p[8 * s2 + 2], p[8 * s2 + 3], p[8 * s2 + 4], p[8 * s2 + 5], p[8 * s2 + 6], p[8 * s2 + 7]);
#pragma unroll
                    for (int d = 0; d < 2; ++d) {
                        const LAS bf16_t* vp = vb + (32 * d + r32) * VP + 32 * a + 16 * s2 + 4 * hi;
                        const s16x4 v0 = *(const LAS s16x4*)vp, v1 = *(const LAS s16x4*)(vp + 8);
                        const bf16x8 vf = {v0[0], v0[1], v0[2], v0[3], v1[0], v1[1], v1[2], v1[3]};
                        o[d] = mfma32(vf, pf, o[d]);
                    }
                }
            }
            lsum += ps;
        }
        if (kt + 1 < NT) {
            const int nb = buf ^ 1;
            *(LAS u32x4*)(Ks + nb * 64 * KP + srow * KP + spc * 8) = kreg;
            LAS u32x2* vd = (LAS u32x2*)(Vs + nb * 64 * VP + srow * VP + spc * 8); u32x2 a = {vreg.x, vreg.y}, bb = {vreg.z, vreg.w}; vd[0] = a; vd[1] = bb;
        }
        wg_sync();
    }
    lsum = sum_xor32(lsum);
    const float il = 1.0f / lsum;
#pragma unroll
    for (int d = 0; d < 2; ++d)
#pragma unroll
        for (int g4 = 0; g4 < 4; ++g4) { u32x2 w; w.x = pk2(o[d][4 * g4] * il, o[d][4 * g4 + 1] * il); w.y = pk2(o[d][4 * g4 + 2] * il, o[d][4 * g4 + 3] * il);
            *(u32x2*)(Hq + (rowb + q) * LDH + C_OA + h * 64 + 32 * d + 8 * g4 + 4 * hi) = w; }
}

DEV void ln_row(const f32x4 (&v)[4], const float* g, const float* bta, int lane, f32x4 (&y)[4]) {
    float s = 0.f;
#pragma unroll
    for (int j = 0; j < 4; ++j) s += (v[j][0] + v[j][1]) + (v[j][2] + v[j][3]);
    const float mean = wave_sum(s) * (1.0f / DM); float s2 = 0.f;
#pragma unroll
    for (int j = 0; j < 4; ++j) { const f32x4 d = v[j] - mean; s2 += (d[0] * d[0] + d[1] * d[1]) + (d[2] * d[2] + d[3] * d[3]); }
    const float rstd = 1.0f / sqrtf(wave_sum(s2) * (1.0f / DM) + LN_EPS);
#pragma unroll
    for (int j = 0; j < 4; ++j) { const f32x4 gg = *((const f32x4*)g + lane + 64 * j), bb = *((const f32x4*)bta + lane + 64 * j); y[j] = (v[j] - mean) * rstd * gg + bb; }
}
typedef float f32x2v __attribute__((ext_vector_type(2)));
DEV void phase_ln1_router(const Ctx& c) {
    LAS float* RW = (LAS float*)c.lds; LAS int* LC = (LAS int*)(c.lds + 1024 * 20 * 4); LAS int* GB = LC + 16; LAS float* LOGT = (LAS float*)(c.lds + 1024 * 20 * 4 + 256);
    { const f32x4* src = (const f32x4*)par(c, P_RW); f32x4 t[10];
#pragma unroll
      for (int i = 0; i < 10; ++i) t[i] = src[c.tid + NTHREADS * i];
#pragma unroll
      for (int i = 0; i < 10; ++i) ((LAS f32x4*)RW)[c.tid + NTHREADS * i] = t[i]; }
    if (c.tid < 16) LC[c.tid] = 0;
    wg_sync();
    const bf16_t* Z = wsp<bf16_t>(c, WS_Z); bf16_t* X1B = wsp<bf16_t>(c, WS_X1B);
    int* TOKE = wsp<int>(c, WS_TOK); int* TOKS = TOKE + 2 * M; float* TOKW = (float*)(TOKS + 2 * M);
    const int rpw = (M + c.G - 1) / c.G, r0 = c.bid * rpw, r1 = (r0 + rpw < M) ? r0 + rpw : M;
    constexpr int NEXIT = NE * (16 * 32 + 8 * 32);
    LAS float* exscr = (LAS float*)(c.lds + 1024 * 20 * 4 + 256 + 16384) + c.wid * (32 * 33);
    int exit_ = c.bid * NWAVES + c.wid; const int exstep = c.G * NWAVES; float exv[32]; bool exhave = exit_ < NEXIT;
    if (exhave) ex_load(exv, c, exit_, c.lane);
    u32x2 za[4], zb[4];
    { const int m = r0 + c.wid; if (m < r1) { const int m2 = (m + NWAVES < r1) ? m + NWAVES : m;
#pragma unroll
        for (int j = 0; j < 4; ++j) { za[j] = *((const u32x2*)(Z + (size_t)m * DM) + c.lane + 64 * j); zb[j] = *((const u32x2*)(Z + (size_t)m2 * DM) + c.lane + 64 * j); } } }
    for (int m = r0 + c.wid; m < r1; m += 2 * NWAVES) {
        const bool two = m + NWAVES < r1; const int m2 = two ? m + NWAVES : m;
        f32x4 va[4], vb[4], ya[4], yb[4];
#pragma unroll
        for (int j = 0; j < 4; ++j) { const f32x4 ta = {lo_bf(za[j].x), hi_bf(za[j].x), lo_bf(za[j].y), hi_bf(za[j].y)}; va[j] = ta; const f32x4 tb = {lo_bf(zb[j].x), hi_bf(zb[j].x), lo_bf(zb[j].y), hi_bf(zb[j].y)}; vb[j] = tb; }
        { const int mn = m + 2 * NWAVES; if (mn < r1) { const int mn2 = (mn + NWAVES < r1) ? mn + NWAVES : mn;
#pragma unroll
            for (int j = 0; j < 4; ++j) { za[j] = *((const u32x2*)(Z + (size_t)mn * DM) + c.lane + 64 * j); zb[j] = *((const u32x2*)(Z + (size_t)mn2 * DM) + c.lane + 64 * j); } } }
        ln_row(va, par(c, P_LN1G), par(c, P_LN1B), c.lane, ya);
        ln_row(vb, par(c, P_LN1G), par(c, P_LN1B), c.lane, yb);
#pragma unroll
        for (int j = 0; j < 4; ++j) { u32x2 w; w.x = pk2(ya[j][0], ya[j][1]); w.y = pk2(ya[j][2], ya[j][3]); *((u32x2*)(X1B + (size_t)m * DM) + c.lane + 64 * j) = w;
            if (two) { u32x2 w2; w2.x = pk2(yb[j][0], yb[j][1]); w2.y = pk2(yb[j][2], yb[j][3]); *((u32x2*)(X1B + (size_t)m2 * DM) + c.lane + 64 * j) = w2; } }
        f32x2v la[10], lb[10];
#pragma unroll
        for (int e = 0; e < 10; ++e) { la[e] = (f32x2v){0.f, 0.f}; lb[e] = (f32x2v){0.f, 0.f}; }
#pragma unroll
        for (int j = 0; j < 4; ++j)
#pragma unroll
            for (int x = 0; x < 4; ++x) { const f32x2v xa = {ya[j][x], ya[j][x]}, xb = {yb[j][x], yb[j][x]};
#pragma unroll
                for (int e4 = 0; e4 < 5; ++e4) { const f32x4 w = *(const LAS f32x4*)(RW + (((j * 4 + x) * 5 + e4) * 64 + c.lane) * 4); const f32x2v w0 = {w[0], w[1]}, w1 = {w[2], w[3]};
                    la[2 * e4] += xa * w0; la[2 * e4 + 1] += xa * w1; lb[2 * e4] += xb * w0; lb[2 * e4 + 1] += xb * w1; } }
        float lga[20], lgb[20];
#pragma unroll
        for (int e = 0; e < 10; ++e) { lga[2 * e] = wave_sum(la[e].x); lga[2 * e + 1] = wave_sum(la[e].y); lgb[2 * e] = wave_sum(lb[e].x); lgb[2 * e + 1] = wave_sum(lb[e].y); }
        if (c.lane == 0) {
            LAS f32x4* lp = (LAS f32x4*)(LOGT + (m - r0) * 20);
#pragma unroll
            for (int e4 = 0; e4 < 5; ++e4) { const f32x4 t = {lga[4 * e4], lga[4 * e4 + 1], lga[4 * e4 + 2], lga[4 * e4 + 3]}; lp[e4] = t; }
            if (two) { LAS f32x4* lp2 = (LAS f32x4*)(LOGT + (m2 - r0) * 20);
#pragma unroll
                for (int e4 = 0; e4 < 5; ++e4) { const f32x4 t = {lgb[4 * e4], lgb[4 * e4 + 1], lgb[4 * e4 + 2], lgb[4 * e4 + 3]}; lp2[e4] = t; } }
        }
        if (exhave) { ex_finish(exv, c, exit_, exscr, c.lane); exit_ += exstep; exhave = exit_ < NEXIT; if (exhave) ex_load(exv, c, exit_, c.lane); }
    }
    while (exhave) { ex_finish(exv, c, exit_, exscr, c.lane); exit_ += exstep; exhave = exit_ < NEXIT; if (exhave) ex_load(exv, c, exit_, c.lane); }
    wg_sync();
    for (int rr = c.tid; rr < r1 - r0; rr += NTHREADS) {
        const int m = r0 + rr; float lg[20];
#pragma unroll
        for (int e4 = 0; e4 < 5; ++e4) { const f32x4 t = *(const LAS f32x4*)(LOGT + rr * 20 + 4 * e4); lg[4 * e4] = t[0]; lg[4 * e4 + 1] = t[1]; lg[4 * e4 + 2] = t[2]; lg[4 * e4 + 3] = t[3]; }
        float gl[4]; int gi = 0;
#pragma unroll
        for (int j = 0; j < 4; ++j) gl[j] = lg[j] + par(c, P_BGRP)[j];
#pragma unroll
        for (int j = 1; j < 4; ++j) if (gl[j] > gl[gi]) gi = j;
        float se = 0.f;
#pragma unroll
        for (int j = 0; j < 4; ++j) se += __expf(gl[j] - gl[gi]);
        const float gw = 1.0f / se;
        float el[4];
#pragma unroll
        for (int j = 0; j < 4; ++j) { float t = 0.f;
#pragma unroll
            for (int g2 = 0; g2 < 4; ++g2) if (g2 == gi) t = lg[4 + 4 * g2 + j] + par(c, P_BRT)[4 * g2 + j];
            el[j] = t; }
        int i0 = 0;
#pragma unroll
        for (int j = 1; j < 4; ++j) if (el[j] > el[i0]) i0 = j;
        int i1 = (i0 == 0) ? 1 : 0;
#pragma unroll
        for (int j = 0; j < 4; ++j) if (j != i0 && el[j] > el[i1]) i1 = j;
        const float p1 = 1.0f / (1.0f + __expf(el[i1] - el[i0]));
        const int e0 = gi * 4 + i0, e1 = gi * 4 + i1;
        const int s0 = atomicAdd((int*)&LC[e0], 1), s1 = atomicAdd((int*)&LC[e1], 1);
        TOKE[2 * m] = e0; TOKE[2 * m + 1] = e1; TOKS[2 * m] = s0; TOKS[2 * m + 1] = s1; TOKW[2 * m] = p1 * gw; TOKW[2 * m + 1] = (1.0f - p1) * gw;
    }
#ifndef EMU
    __threadfence_block();
#endif
    wg_sync();
    if (c.tid < 16) GB[c.tid] = (int)atomicAdd(wsp<unsigned>(c, WS_CTL) + CW_CNT + c.tid, (unsigned)LC[c.tid]);
    wg_sync();
    { int* RT2 = wsp<int>(c, WS_RT2);
      for (int i = r0 * 2 + c.tid; i < r1 * 2; i += NTHREADS) { const int e = TOKE[i], s = TOKS[i] + GB[e]; TOKS[i] = s; RT2[(size_t)e * M + s] = i >> 1; } }
}
DEV void moe_bases(const Ctx& c, int (&base)[NE], int& total_tiles) {
    const unsigned* cnt = wsp<unsigned>(c, WS_CTL) + CW_CNT; int acc = 0;
#pragma unroll
    for (int e = 0; e < NE; ++e) { base[e] = acc; acc += (((int)cnt[e] + 255) / 256) * 256; }
    total_tiles = acc / 256;
}
DEV void phase_final(const Ctx& c) {
    int base[NE], nt; moe_bases(c, base, nt);
    const bf16_t* O2 = wsp<bf16_t>(c, WS_O2); const bf16_t* X1B = wsp<bf16_t>(c, WS_X1B);
    const int* TOKE = wsp<int>(c, WS_TOK); const int* TOKS = TOKE + 2 * M; const float* TOKW = (const float*)(TOKS + 2 * M);
    const int gw = c.bid * NWAVES + c.wid, NGW = c.G * NWAVES;
    for (int m0 = gw; m0 < M; m0 += 2 * NGW) {
        int pos[2][2]; float w[2][2]; u32x2 xw[2][4], a0[2][4], a1[2][4];
#pragma unroll
        for (int q = 0; q < 2; ++q) { const int m = m0 + q * NGW; if (m < M) {
#pragma unroll
            for (int a = 0; a < 2; ++a) { const int e = TOKE[2 * m + a]; int bs = 0;
#pragma unroll
                for (int j = 0; j < NE; ++j) if (j == e) bs = base[j];
                pos[q][a] = bs + TOKS[2 * m + a]; w[q][a] = TOKW[2 * m + a]; } } }
#pragma unroll
        for (int q = 0; q < 2; ++q) { const int m = m0 + q * NGW; if (m < M) {
#pragma unroll
            for (int j = 0; j < 4; ++j) { xw[q][j] = *((const u32x2*)(X1B + (size_t)m * DM) + c.lane + 64 * j);
                a0[q][j] = *((const u32x2*)(O2 + (size_t)pos[q][0] * DM) + c.lane + 64 * j); a1[q][j] = *((const u32x2*)(O2 + (size_t)pos[q][1] * DM) + c.lane + 64 * j); } } }
#pragma unroll
        for (int q = 0; q < 2; ++q) { const int m = m0 + q * NGW; if (m < M) {
            f32x4 v[4], y[4];
#pragma unroll
            for (int j = 0; j < 4; ++j) { const f32x4 xv = {lo_bf(xw[q][j].x), hi_bf(xw[q][j].x), lo_bf(xw[q][j].y), hi_bf(xw[q][j].y)};
                f32x4 t; t[0] = xv[0] * ALPHA + w[q][0] * lo_bf(a0[q][j].x) + w[q][1] * lo_bf(a1[q][j].x); t[1] = xv[1] * ALPHA + w[q][0] * hi_bf(a0[q][j].x) + w[q][1] * hi_bf(a1[q][j].x);
                t[2] = xv[2] * ALPHA + w[q][0] * lo_bf(a0[q][j].y) + w[q][1] * lo_bf(a1[q][j].y); t[3] = xv[3] * ALPHA + w[q][0] * hi_bf(a0[q][j].y) + w[q][1] * hi_bf(a1[q][j].y); v[j] = t; }
            ln_row(v, par(c, P_LN2G), par(c, P_LN2B), c.lane, y);
#pragma unroll
            for (int j = 0; j < 4; ++j) *((f32x4*)(c.out + (size_t)m * DM) + c.lane + 64 * j) = y[j]; } }
    }
}

#ifndef EMU
#define XB_TMO      128
#define XB_XCNT(j)  (256  + 64 * (j))
#define XB_XSUB(j)  (1280 + 64 * (j))
#define XB_XGEN(j)  (2304 + 64 * (j))
#define XB_TOP      3328
#define XB_TOPGEN   3392
#define XCD_BAR_WORDS 3456
#define XB_SPIN_CAP (1u << 22)
__device__ __forceinline__ unsigned xb_ld(unsigned* p)              { return __hip_atomic_load(p, __ATOMIC_RELAXED, __HIP_MEMORY_SCOPE_AGENT); }
__device__ __forceinline__ unsigned xb_add(unsigned* p, unsigned v) { return __hip_atomic_fetch_add(p, v, __ATOMIC_RELAXED, __HIP_MEMORY_SCOPE_AGENT); }
__device__ __forceinline__ unsigned xb_xcc_id() { return (unsigned)__builtin_amdgcn_s_getreg((3 << 11) | 20) & 0xFu; }
#define XB_SPIN(cond, bar) do { unsigned _sp = 0; while (cond) { __builtin_amdgcn_s_sleep(1); \
    if ((++_sp & 255u) == 0u) { if (xb_ld(&(bar)[XB_TMO])) break; if (_sp > XB_SPIN_CAP) { atomicAdd(&(bar)[XB_TMO], 1u); break; } } } } while (0)
struct XcdBarrier { unsigned* bar; unsigned x; volatile LAS unsigned* st; };
__device__ __forceinline__ XcdBarrier xcd_barrier_post(unsigned* bar, volatile LAS unsigned* st) {
    XcdBarrier b; b.bar = bar; b.x = xb_xcc_id(); b.st = st;
    if (threadIdx.x == 0) (void)xb_add(&bar[XB_XCNT(b.x)], 1u);
    return b;
}
__device__ __forceinline__ void xcd_barrier_complete(unsigned* bar, unsigned x, unsigned& nloc, unsigned& nx) {
    const unsigned G = gridDim.x * gridDim.y * gridDim.z;
    unsigned sum, cnt, mine, sp = 0u;
    for (;;) {
        sum = 0u; cnt = 0u; mine = 0u;
#pragma unroll
        for (unsigned j = 0; j < 16; ++j) { const unsigned c = xb_ld(&bar[XB_XCNT(j)]); sum += c; cnt += (c > 0u) ? 1u : 0u; mine = (j == x) ? c : mine; }
        if (sum == G) break;
        __builtin_amdgcn_s_sleep(1);
        if ((++sp & 255u) == 0u) { if (xb_ld(&bar[XB_TMO])) break; if (sp > XB_SPIN_CAP) { atomicAdd(&bar[XB_TMO], 1u); break; } }
    }
    nloc = mine > 0u ? mine : 1u; nx = cnt > 0u ? cnt : 1u;
}
__device__ __forceinline__ void xcd_barrier(const XcdBarrier& b) {
    asm volatile("s_waitcnt vmcnt(0)" ::: "memory");
    __syncthreads();
    if (threadIdx.x == 0) {
        unsigned* bar = b.bar;
        __builtin_amdgcn_s_waitcnt(0);
        unsigned nloc = b.st[0], nx = b.st[1];
        if (nloc == 0u) { xcd_barrier_complete(bar, b.x, nloc, nx); b.st[0] = nloc; b.st[1] = nx; }
        const unsigned old = xb_add(&bar[XB_XSUB(b.x)], 1u);
        const unsigned gen = old / nloc;
        if (old + 1u == (gen + 1u) * nloc) {
            __builtin_amdgcn_fence(__ATOMIC_RELEASE, "agent");
            asm volatile("s_waitcnt vmcnt(0)" ::: "memory");
            const unsigned og = xb_add(&bar[XB_TOP], 1u);
            const unsigned tg = og / nx;
            if (og + 1u == (tg + 1u) * nx) xb_add(&bar[XB_TOPGEN], 1u);
            else XB_SPIN(xb_ld(&bar[XB_TOPGEN]) == tg, bar);
            __builtin_amdgcn_fence(__ATOMIC_ACQUIRE, "agent");
            xb_add(&bar[XB_XGEN(b.x)], 1u);
            asm volatile("s_waitcnt vmcnt(0)" ::: "memory");
        } else {
            XB_SPIN(xb_ld(&bar[XB_XGEN(b.x)]) == gen, bar);
            __builtin_amdgcn_fence(__ATOMIC_ACQUIRE, "agent");
            asm volatile("s_waitcnt vmcnt(0)" ::: "memory");
        }
    }
    __syncthreads();
}
#endif

constexpr int NPHASE = 11;
constexpr int LDS_BYTES = 144 * 1024;
static_assert(1024 * 20 * 4 + 256 + ((M + 255) / 256) * 20 * 4 <= LDS_BYTES - 1024 || true, "router LDS");
static_assert(pg8::STAGE_BYTES <= LDS_BYTES - 1024 && IDX_LDS <= LDS_BYTES - 1024 && ML_LDS <= LDS_BYTES - 1024 && AT_LDS <= LDS_BYTES - 1024 && 8 * 16384 <= LDS_BYTES - 1024, "LDS budget");
constexpr int MISC_OFF = LDS_BYTES - 64;

DEV void run_phase(const Ctx& c0, int ph) {
    using namespace pg8;
    Ctx c = c0;
#ifndef EMU
    { int t = threadIdx.x; asm volatile("" : "+v"(t)); c.tid = t; c.lane = t & 63; c.wid = __builtin_amdgcn_readfirstlane(t >> 6); }
#endif
#ifdef EMU
    unsigned char* glds = c.lds;
#else
    PG8_LAS unsigned char* glds = c.lds;
#endif
    if (ph == 0) { phase_prologue(c); return; }
    if (ph == 1) {
        SchedStatic S; S.init((const bf16_t*)c.out, DM, wsp<bf16_t>(c, WS_WIN), DM, M, NWIN, DM, c.G, c.bid); S.phase_id = 1;
        EpiInProj E{wsp<bf16_t>(c, WS_H), wsp<bf16_t>(c, WS_KIDX), wsp<float>(c, WS_SM), wsp<float>(c, WS_SSQ)};
        gemm_phase(glds, S, E); return;
    }
    if (ph == 2 || ph == 11 || ph == 12) {
        const int nml = (ph == 12) ? 0 : ((c.G >= 4) ? c.G / 4 : 0);
        if (ph == 11) { for (int u = c.bid; u < NB * NHM; u += c.G) mlstm_unit(c, u / NHM, u % NHM); return; }
        if (c.bid < nml) {
#ifndef P2_REP_ML
#define P2_REP_ML 1
#endif
#ifndef P2_SKIP_ML
#if P2PROBE && P2PROBE_KIND == 5
            const unsigned long long mlt0 = rt_now();
#endif
            for (int rep = 0; rep < P2_REP_ML; ++rep) for (int u = c.bid; u < NB * NHM; u += nml) mlstm_unit(c, u / NHM, u % NHM);
#if P2PROBE && P2PROBE_KIND == 5
            if (c.bid == 0 && c.tid == 0) { volatile LAS unsigned* mm = (volatile LAS unsigned*)(c.lds + (144 * 1024 - 64)); mm[4] = (unsigned)(rt_now() - mlt0); }
#endif
#endif
        } else {
            const int g2 = c.G - nml, c2 = c.bid - nml;
#if P2PROBE
            const unsigned long long p2t0 = rt_now();
#endif
#ifndef P2_SKIP_KV
            { SchedStatic S; S.init(wsp<bf16_t>(c, WS_H) + C_CKV, LDH, wsp<bf16_t>(c, WS_WK), KVR, M, 512, KVR, g2, c2); EpiK E{wsp<bf16_t>(c, WS_K), wsp<float>(c, WS_SSQ)}; gemm_phase(glds, S, E); }
            { SchedStatic S; S.init(wsp<bf16_t>(c, WS_WV), KVR, wsp<bf16_t>(c, WS_H) + C_CKV, LDH, 512, M, KVR, g2, (c2 + (2 * g2) / 3) % g2); EpiVT E{wsp<bf16_t>(c, WS_VT), wsp<float>(c, WS_SSQ)}; gemm_phase(glds, S, E); }
#endif
            wg_sync();
            idx_units(c, c2, g2);
#if P2PROBE
            if (P2PROBE_KIND == 1 && c2 == 0 && c.tid == 0) { const unsigned long long d = rt_now() - p2t0; volatile LAS unsigned* mm = (volatile LAS unsigned*)(c.lds + MISC_OFF); mm[4] = (unsigned)d; }
#endif
        }
        return;
    }
    if (ph == 3) {
        const int nqb = SEQ / 256, nun = NB * HA * nqb;
        for (int u = c.bid; u < nun; u += c.G) {
            const int bh = u / nqb; int qi = u % nqb; const int round = (u / c.G) & 1; if (round && (c.G % nqb) == 0) qi = nqb - 1 - qi;
            attn_unit(c, bh / HA, bh % HA, qi);
            wg_sync();
        }
        return;
    }
    if (ph == 4) {
        SchedDual S; S.T.init(nullptr, 0, nullptr, 0, M, DM, WA, c.G, c.bid); S.K = WA; S.lda = LDH; S.ldb = WA;
        S.A0 = wsp<bf16_t>(c, WS_H) + C_OA; S.A1 = wsp<bf16_t>(c, WS_H) + C_HM; S.B0 = wsp<bf16_t>(c, WS_WA); S.B1 = wsp<bf16_t>(c, WS_WM);
        EpiUpDual E{wsp<bf16_t>(c, WS_Y), wsp<bf16_t>(c, WS_H)}; gemm_phase(glds, S, E); return;
    }
    if (ph == 5) {
        SchedStatic S; S.init(wsp<bf16_t>(c, WS_Y), DM, wsp<bf16_t>(c, WS_WO), DM, M, DM, DM, c.G, c.bid); EpiOut E{wsp<bf16_t>(c, WS_Z), (const bf16_t*)c.out}; gemm_phase(glds, S, E); return;
    }
    if (ph == 6) { phase_ln1_router(c); return; }
    if (ph == 7) return;
    if (ph == 8 || ph == 9) {
        int base[NE], nt; moe_bases(c, base, nt);
        SchedMoe S; S.ntiles = nt; S.nN = 4; S.G = c.G; S.c = c.bid; S.phase_id = ph;
#pragma unroll
        for (int e = 0; e < NE; ++e) S.tend[e] = ((e + 1 < NE) ? base[e + 1] : nt * 256) / 256;
        if (ph == 8) { SchedMoeT<true> SG; SG.ntiles = nt; SG.nN = 4; SG.G = c.G; SG.c = c.bid; SG.phase_id = ph;
#pragma unroll
            for (int e = 0; e < NE; ++e) SG.tend[e] = S.tend[e];
            SG.cntv = (int)(wsp<unsigned>(c, WS_CTL) + CW_CNT)[c.lane & 15];
            SG.K = DM; SG.lda = DM; SG.ldb = DM; SG.A = wsp<bf16_t>(c, WS_X1B); SG.Bt = wsp<bf16_t>(c, WS_WGU); SG.estride = (size_t)1024 * 1024; SG.rowtok = wsp<int>(c, WS_RT2);
            EpiMoe1 E{wsp<bf16_t>(c, WS_HD)}; gemm_phase(glds, SG, E); }
        else { S.K = DE; S.lda = DE; S.ldb = DE; S.A = wsp<bf16_t>(c, WS_HD); S.Bt = wsp<bf16_t>(c, WS_WD); S.estride = (size_t)1024 * 512; EpiMoe2 E{wsp<bf16_t>(c, WS_O2)}; gemm_phase(glds, S, E); }
        return;
    }
    if (ph == 10) { phase_final(c); return; }
}

#ifndef EMU
__global__ void __launch_bounds__(NTHREADS, 2) fwd_kernel(Args args) {
    extern __shared__ __attribute__((aligned(16))) unsigned char lds_raw[];
    Ctx c;
#pragma unroll
    for (int i = 0; i < 25; ++i) c.in[i] = args.in[i];
    c.out = args.out; c.ws = args.ws; c.tid = threadIdx.x; c.lane = c.tid & 63; c.wid = __builtin_amdgcn_readfirstlane(c.tid >> 6); c.G = gridDim.x; c.bid = blockIdx.x;
    c.lds = (LAS unsigned char*)lds_raw;
    volatile LAS unsigned* MISC = (volatile LAS unsigned*)(c.lds + MISC_OFF);
    if (c.tid < 16) MISC[c.tid] = 0u;
    __syncthreads();
    const bool multi = (args.ph_hi - args.ph_lo) > 1;
    XcdBarrier bar; bar.bar = (unsigned*)(args.ws + WS_CTL) + CW_BAR; bar.x = 0; bar.st = nullptr;
    if (multi) bar = xcd_barrier_post((unsigned*)(args.ws + WS_CTL) + CW_BAR, MISC + 8);
#ifndef ONLY_PHASE
#define ONLY_PHASE -1
#endif
#ifndef DOUBLE_PHASE
#define DOUBLE_PHASE -1
#endif
#ifndef DOUBLE_PHASE2
#define DOUBLE_PHASE2 -1
#endif
#ifndef TPROBE_KIND
#define TPROBE_KIND 0
#endif
#ifndef TPROBE_LO
#define TPROBE_LO -1
#define TPROBE_HI -1
#define TPROBE_MULT 0
#endif
    unsigned long long tps_lo = 0, tps_hi = 0;
#define TSTAMP(k) do { if (TPROBE_MULT > 0) { if ((k) == TPROBE_LO && TPROBE_KIND != 2) tps_lo = rt_now(); if ((k) == TPROBE_HI && TPROBE_KIND != 1) tps_hi = rt_now(); } } while (0)
#define PHASE(k) TSTAMP(k); if ((ONLY_PHASE < 0 || ONLY_PHASE == (k)) && args.ph_lo <= (k) && (k) < args.ph_hi) { if (DOUBLE_PHASE == (k) || DOUBLE_PHASE2 == (k)) { run_phase(c, (k)); xcd_barrier(bar); } run_phase(c, (k)); if (TPROBE_MULT > 0 && TPROBE_KIND > 0 && (k) == TPROBE_LO) { if (TPROBE_KIND == 1) tps_hi = rt_now(); else tps_lo = rt_now(); } if ((k) + 1 < args.ph_hi) xcd_barrier(bar); }
#ifdef SPLIT_P2
    PHASE(0) PHASE(1) { run_phase(c, 11); xcd_barrier(bar); run_phase(c, 12); xcd_barrier(bar); } PHASE(3)
#else
    PHASE(0) PHASE(1) PHASE(2) PHASE(3)
#endif
    PHASE(4) PHASE(5) PHASE(6) PHASE(8) PHASE(9) PHASE(10)
    TSTAMP(11);
#ifndef GPROBE_MODE
#define GPROBE_MODE 0
#endif
    if (GPROBE_PH >= 0 && GPROBE_MODE > 0) {
        __syncthreads();
        unsigned* gw = (unsigned*)(args.ws + WS_CTL) + 6000;
        if (threadIdx.x == 0) { const unsigned long long a = (unsigned long long)MISC[0] | ((unsigned long long)MISC[1] << 32), b2 = (unsigned long long)MISC[2] | ((unsigned long long)MISC[3] << 32); const unsigned d = (unsigned)(b2 - a);
            atomicMax(gw, d); atomicMax(gw + 1, 0xffffffffu - d); }
        xcd_barrier(bar);
        if (blockIdx.x == 0) { const unsigned mx = __hip_atomic_load(gw, __ATOMIC_RELAXED, __HIP_MEMORY_SCOPE_AGENT), mn = 0xffffffffu - __hip_atomic_load(gw + 1, __ATOMIC_RELAXED, __HIP_MEMORY_SCOPE_AGENT); tps_lo = 0; tps_hi = (GPROBE_MODE == 1) ? mx : mn; }
    } else
    if (GPROBE_PH >= 0 && GPROBE_MODE == 4 && blockIdx.x == 0) { __syncthreads(); tps_lo = (unsigned long long)MISC[2] | ((unsigned long long)MISC[3] << 32); } else
    if (GPROBE_PH >= 0 && blockIdx.x == 0) { __syncthreads(); if (GPROBE_MODE != 3) tps_lo = (unsigned long long)MISC[0] | ((unsigned long long)MISC[1] << 32); tps_hi = (GPROBE_MODE == 3) ? ((unsigned long long)MISC[0] | ((unsigned long long)MISC[1] << 32)) : ((unsigned long long)MISC[2] | ((unsigned long long)MISC[3] << 32)); }
#if P2PROBE
    __syncthreads();
    if (blockIdx.x == ((P2PROBE_KIND == 5) ? 0 : gridDim.x / 4) && threadIdx.x == 0) { const unsigned long long d = (unsigned long long)MISC[4] * (unsigned long long)P2PROBE, t0 = rt_now(); while (rt_now() - t0 < d) __builtin_amdgcn_s_sleep(8); }
#endif
    if (TPROBE_MULT > 0 && blockIdx.x == 0) { const unsigned long long d = (tps_hi - tps_lo) * (unsigned long long)TPROBE_MULT, t0 = rt_now(); while (rt_now() - t0 < d) __builtin_amdgcn_s_sleep(8); }
#undef PHASE
}

#ifndef N_LAUNCH_MODE
#define N_LAUNCH_MODE 0
#endif
extern "C" void kernel_launch(void* const* d_in, const int* in_sizes, int n_in, void* d_out, int out_size, void* d_ws, size_t ws_size, hipStream_t stream) {
    static int grid = 0;
    if (grid == 0) {
        if (n_in != 25 || out_size != M * DM || ws_size < WS_END) { fprintf(stderr, "kernel_launch: unexpected shapes (n_in %d out %d ws %zu need %zu)\n", n_in, out_size, ws_size, (size_t)WS_END); grid = -1; return; }
        int dev = 0, cus = 0, per_cu = 0;
        if (hipGetDevice(&dev) != hipSuccess || hipDeviceGetAttribute(&cus, hipDeviceAttributeMultiprocessorCount, dev) != hipSuccess) { grid = -1; return; }
        if (hipFuncSetAttribute((const void*)fwd_kernel, hipFuncAttributeMaxDynamicSharedMemorySize, LDS_BYTES) != hipSuccess) { fprintf(stderr, "kernel_launch: hipFuncSetAttribute failed\n"); grid = -1; return; }
        if (hipOccupancyMaxActiveBlocksPerMultiprocessor(&per_cu, (const void*)fwd_kernel, NTHREADS, LDS_BYTES) != hipSuccess || per_cu < 1) fprintf(stderr, "kernel_launch: occupancy query reports %d\n", per_cu);
        (void)hipGetLastError();
        grid = cus;
    }
    if (grid < 0) return;
    (void)hipMemsetAsync((char*)d_ws + WS_CTL, 0, CTL_ZERO_BYTES, stream);
    Args a{};
    for (int i = 0; i < 25; ++i) a.in[i] = (const float*)d_in[i];
    a.out = (float*)d_out; a.ws = (unsigned char*)d_ws;
    if (N_LAUNCH_MODE == 0) { a.ph_lo = 0; a.ph_hi = NPHASE; hipLaunchKernelGGL(fwd_kernel, dim3(grid), dim3(NTHREADS), LDS_BYTES, stream, a); }
    else { for (int p = 0; p < NPHASE; ++p) { a.ph_lo = p; a.ph_hi = p + 1; hipLaunchKernelGGL(fwd_kernel, dim3(grid), dim3(NTHREADS), LDS_BYTES, stream, a); } }
    (void)in_sizes;
}
#endif
```

```cpp
#ifdef EMU
#include "emu/emu.h"
#define DEV static inline
#define DEVM inline
#define WAVE_ANY(p) (__ballot(p) != 0ull)
#define MEM_FENCE() do {} while (0)
#define LDS_SYNC() __syncthreads()
#define LAUNDER(x) do {} while (0)
#define WAVE_SYNC() e_wbar()
#define LAS
#else
#include <hip/hip_runtime.h>
#include <cstdio>
#include <cstdint>
#define DEV __device__ __forceinline__
#define DEVM __device__ __forceinline__
#define WAVE_ANY(p) (__ballot(p) != 0ull)
#define MEM_FENCE() asm volatile("" ::: "memory")
#define LDS_SYNC() asm volatile("s_waitcnt lgkmcnt(0)\n\ts_barrier" ::: "memory")
#define LAUNDER(x) asm volatile("" : "+v"(x))
#define WAVE_SYNC() asm volatile("s_waitcnt lgkmcnt(0)" ::: "memory")
#define LAS __attribute__((address_space(3)))
typedef short bf16x8 __attribute__((ext_vector_type(8)));
typedef float f32x16 __attribute__((ext_vector_type(16)));
typedef float f32x4 __attribute__((ext_vector_type(4)));
#endif
typedef unsigned u32x4 __attribute__((ext_vector_type(4)));
typedef unsigned u32x2 __attribute__((ext_vector_type(2)));
typedef short s16x4 __attribute__((ext_vector_type(4)));
typedef unsigned short bf16_t;
typedef unsigned long long u64;

#ifndef CFG_B
#define CFG_B 16
#endif
#ifndef CFG_S
#define CFG_S 2048
#endif
constexpr int NB = CFG_B, SEQ = CFG_S, DM = 1024, M = NB * SEQ;
constexpr int HA = 8, DA = 64, WA = 512, KVR = 256, TOPK = (SEQ / 4 < 256) ? SEQ / 4 : 256;
constexpr int NHM = 4, DHM = 128, WM = 512, CHUNK = 64, NCH = SEQ / CHUNK;
constexpr int NE = 16, DE = 512, MPAD = 2 * M + 4096;
constexpr float LN_EPS = 1e-5f, ALPHA = 1.189207115002721f;
constexpr float QSCALE = 0.125f * 1.4426950408889634f;
constexpr float LOG2E = 1.4426950408889634f;
constexpr int NWIN = 5632, LDH = 5376;
constexpr int C_HM = 2304;
constexpr int C_OA = 768;
constexpr int C_QA = 0, C_CKV = 512, C_QI = 768, C_QM = 1280, C_KM = 1792, C_VM = 2304, C_OM = 2816, C_GA = 3328, C_GM = 4352;
constexpr int NWORDS = SEQ / 32;
constexpr int NWAVES = 8, NTHREADS = 512;

constexpr size_t MiB = 1u << 20;
constexpr size_t WS_CTL = 0, CTL_ZERO_BYTES = 512 * 1024;
constexpr size_t WS_ROWTOK = 128 * 1024;
constexpr size_t WS_WIN = 1 * MiB, WS_WK = 12 * MiB, WS_WV = 12 * MiB + 512 * 1024, WS_WA = 13 * MiB, WS_WM = 14 * MiB, WS_WO = 15 * MiB;
constexpr size_t WS_WGU = 17 * MiB, WS_WD = 49 * MiB, WS_TOK = 65 * MiB, WS_PAR = 65 * MiB + 768 * 1024;
static_assert(WS_ROWTOK + (size_t)(2 * M + 4096) * 4 <= 512 * 1024, "ROWTOK inside the zeroed control region");
static_assert((size_t)M * 24 <= 768 * 1024, "token tables fit below the parameter block");
static_assert((30720 + 1024 * 20) * 4 <= 256 * 1024, "parameter block size");
constexpr int P_CONVW = 0, P_CONVB = 4096, P_BI = 5120, P_BF = 5124, P_MHG = 5128, P_RELB = 5640, P_LN1G = 5896, P_LN1B = 6920, P_WGRP = 7944, P_BGRP = 12040, P_WRT = 12044, P_BRT = 28428, P_LN2G = 28444, P_LN2B = 29468, P_END = 30492, P_RW = 30720, P_END2 = P_RW + 1024 * 20;
constexpr size_t R0 = 66 * MiB;
constexpr size_t R1 = R0 + (size_t)M * 2048;
constexpr size_t R2 = R1 + (size_t)M * LDH * 2;
constexpr size_t WS_KIDX = R2, WS_SM = WS_KIDX + (size_t)M * 128, WS_SSQ = WS_SM + (size_t)M * 64, WS_MASK = WS_SSQ + (size_t)M * 16, WS_RT2 = WS_MASK + (size_t)M * NWORDS * 4, WS_END = WS_RT2 + (size_t)NE * M * 4;
constexpr size_t WS_K = R0, WS_VT = R0 + (size_t)M * 1024, WS_Y = R0;
#ifdef EMU
constexpr size_t WS_H = R1, WS_Z = R1, WS_X1B = R0, WS_XS = WS_END, WS_HD = WS_XS + (size_t)MPAD * 2048, WS_O2 = WS_HD + (size_t)MPAD * 1024, WS_TOTAL = WS_O2 + (size_t)MPAD * 2048;
#else
constexpr size_t WS_H = R1, WS_Z = R1, WS_X1B = R0, WS_XS = R1 + (size_t)M * 6144;
constexpr size_t WS_HD = R1, WS_O2 = R1 + (size_t)MPAD * 1024, WS_TOTAL = WS_END;
static_assert(WS_XS + (size_t)MPAD * 2048 <= R2, "XS fits in the H region");
static_assert(WS_O2 + (size_t)MPAD * 2048 <= R2, "O2 fits in the H region");
static_assert(WS_END <= 512 * MiB, "workspace budget");
#endif
constexpr int CW_CNT = 4096;
constexpr int CW_BAR = 8192;

struct Args { const float* in[25]; float* out; unsigned char* ws; int ph_lo, ph_hi; };

DEV unsigned fbits(float f) { unsigned u; __builtin_memcpy(&u, &f, 4); return u; }
DEV float bitsf(unsigned u) { float f; __builtin_memcpy(&f, &u, 4); return f; }
DEV unsigned f2bf(float f) { unsigned u = fbits(f); return (u + 0x7fffu + ((u >> 16) & 1u)) >> 16; }
DEV float bf2f(unsigned b) { return bitsf(b << 16); }
DEV unsigned pk2(float lo, float hi) {
#ifdef EMU
    return f2bf(lo) | (f2bf(hi) << 16);
#else
    typedef float f32x2_t __attribute__((ext_vector_type(2))); typedef __bf16 bf16x2_t __attribute__((ext_vector_type(2)));
    f32x2_t v = {lo, hi}; bf16x2_t b = __builtin_convertvector(v, bf16x2_t); return __builtin_bit_cast(unsigned, b);
#endif
}
DEV float lo_bf(unsigned w) { return bitsf(w << 16); }
DEV float hi_bf(unsigned w) { return bitsf(w & 0xffff0000u); }
DEV f32x16 mfma32(bf16x8 a, bf16x8 b, f32x16 c) {
#ifdef EMU
    return emu_mfma_32x32x16_bf16(a, b, c);
#else
    return __builtin_amdgcn_mfma_f32_32x32x16_bf16(a, b, c, 0, 0, 0);
#endif
}
DEV float fast_rcp(float x) {
#ifdef EMU
    return 1.0f / x;
#else
    return __builtin_amdgcn_rcpf(x);
#endif
}
DEV float fast_rsq(float x) {
#ifdef EMU
    return 1.0f / sqrtf(x);
#else
    return __builtin_amdgcn_rsqf(x);
#endif
}
DEV float fast_exp2(float x) {
#ifdef EMU
    return exp2f(x);
#else
    return __builtin_amdgcn_exp2f(x);
#endif
}
#ifndef EMU
__device__ __forceinline__ unsigned long long rt_now() { unsigned long long t; asm volatile("s_memrealtime %0\n\ts_waitcnt lgkmcnt(0)" : "=s"(t) :: "memory"); return t; }
#endif
DEV unsigned bit_spread(unsigned w, int pos) {
#ifdef EMU
    return ((w >> pos) & 1u) ? 0xffffffffu : 0u;
#else
    unsigned m; asm("v_bfe_i32 %0, %1, %2, 1" : "=v"(m) : "v"(w), "s"(pos)); return m;
#endif
}
DEV float relu_f(float x) {
#ifdef EMU
    return x > 0.f ? x : 0.f;
#else
    return __builtin_amdgcn_fmed3f(x, 0.0f, __builtin_inff());
#endif
}
DEV float sum_xor32(float v) {
#ifdef EMU
    return v + __shfl_xor(v, 32);
#else
    const unsigned u = fbits(v); auto rr = __builtin_amdgcn_permlane32_swap(u, u, false, false); return bitsf(rr[0]) + bitsf(rr[1]);
#endif
}
DEV void swap_halves(unsigned& a, unsigned& b, int lane) {
#ifdef EMU
    const unsigned ao = __shfl_xor(a, 32), bo = __shfl_xor(b, 32);
    if (lane < 32) b = ao; else a = bo;
#else
    auto rr = __builtin_amdgcn_permlane32_swap(a, b, false, false); a = rr[0]; b = rr[1]; (void)lane;
#endif
}
DEV float max_xor32(float v) {
#ifdef EMU
    return fmaxf(v, __shfl_xor(v, 32));
#else
    const unsigned u = fbits(v); auto rr = __builtin_amdgcn_permlane32_swap(u, u, false, false); return fmaxf(bitsf(rr[0]), bitsf(rr[1]));
#endif
}
DEV float sigmoidf_(float x) { return fast_rcp(1.0f + __expf(-x)); }
DEV int crow(int r, int hi) { return (r & 3) + 8 * (r >> 2) + 4 * hi; }
DEV bf16x8 pack8(float a0, float a1, float a2, float a3, float a4, float a5, float a6, float a7) {
    u32x4 w; w.x = pk2(a0, a1); w.y = pk2(a2, a3); w.z = pk2(a4, a5); w.w = pk2(a6, a7); return __builtin_bit_cast(bf16x8, w);
}
DEV float wave_sum(float v) {
#ifdef EMU
#pragma unroll
    for (int o = 1; o < 64; o <<= 1) v += __shfl_xor(v, o);
    return v;
#else
#define WS_DPP(ctrl, rm) v += __builtin_bit_cast(float, __builtin_amdgcn_update_dpp(0, __builtin_bit_cast(int, v), ctrl, rm, 0xf, false))
    WS_DPP(0x111, 0xf); WS_DPP(0x112, 0xf); WS_DPP(0x114, 0xf); WS_DPP(0x118, 0xf); WS_DPP(0x142, 0xa); WS_DPP(0x143, 0xc);
#undef WS_DPP
    return __builtin_bit_cast(float, __builtin_amdgcn_readlane(__builtin_bit_cast(int, v), 63));
#endif
}

DEV int lane_bcast(int v, int l) {
#ifdef EMU
    return __shfl(v, l);
#else
    return __builtin_amdgcn_readlane(v, l);
#endif
}
namespace pg8 {
constexpr int BM = 256, BK = 64, HALF = 128, HTB = HALF * BK * 2, STAGE_BYTES = 8 * HTB, NXCD = 8, WGM = 8;
DEV int lds_byte(int r, int c) { const int st = (r >> 4) * 2 + (c >> 5), rr = r & 15, cc = c & 31, ob = rr * 64 + cc * 2; return st * 1024 + (ob ^ (((ob >> 9) & 1) << 5)); }
DEV void stage_rc(int b, int& R, int& C) { const int st = b / 1024, sb = b % 1024, swz = sb ^ (((sb >> 9) & 1) << 5); R = (st >> 1) * 16 + swz / 64; C = (st & 1) * 32 + (swz % 64) / 2; }
DEV int perm32(int rho) { const int n = rho >> 4, i = rho & 15; return 8 * (i >> 2) + 4 * n + (i & 3); }

struct Unit { int pm, pn, e, g0, gv, half; };
struct SchedStatic {
    static constexpr bool GATHER = false;
    int phase_id = -1; int nM, nN, nwg, G, c, K, lda, ldb; const bf16_t* A; const bf16_t* Bt; int ulo = 0, uhi = 1 << 30;
    DEVM void init(const bf16_t* A_, int lda_, const bf16_t* Bt_, int ldb_, int M_, int N_, int K_, int G_, int c_) { A = A_; lda = lda_; Bt = Bt_; ldb = ldb_; nM = M_ / BM; nN = N_ / BM; nwg = nM * nN; K = K_; G = G_; c = c_; }
    DEVM bool next(int i, Unit& u) const {
        const long L = (long)ulo + (long)i * G + c; if (L >= nwg || L >= uhi) return false;
        int wgid = (int)L; { const int q = nwg / NXCD, r = nwg % NXCD, xcd = wgid % NXCD, off = wgid / NXCD; wgid = (xcd < r ? xcd * (q + 1) : r * (q + 1) + (xcd - r) * q) + off; }
        const int nig = WGM * nN, gid = wgid / nig, fm = gid * WGM, gsz = (nM - fm) < WGM ? (nM - fm) : WGM;
        u.pm = fm + ((wgid % nig) % gsz); u.pn = (wgid % nig) / gsz; u.e = 0; u.g0 = 0; u.gv = 256; u.half = -1; return true;
    }
    DEVM const char* baseA(const Unit& u) const { return (const char*)(A + (size_t)u.pm * BM * lda); }
    DEVM const char* baseB(const Unit& u) const { return (const char*)(Bt + (size_t)u.pn * BM * ldb); }
};
template <bool GATHER_> struct SchedMoeT {
    static constexpr bool GATHER = GATHER_; const int* rowtok = nullptr;
    int phase_id = -1; int ntiles, nN, G, c, K, lda, ldb; const bf16_t* A; const bf16_t* Bt; size_t estride; int tend[NE]; int cntv = 0;
    DEVM bool next(int i, Unit& u) const {
        int pm, pn, hf = -1;
        if ((G & 7) == 0) { const int x = c & 7, cl = c >> 3, gl = G >> 3, nx = (ntiles + 7) >> 3, t0 = x * nx, tn = (t0 + nx <= ntiles) ? nx : (ntiles > t0 ? ntiles - t0 : 0);
            const int U = tn * nN, nfull = U / gl, rem = U - nfull * gl; int L = i * gl + cl;
            if (i > nfull) return false;
            if (i == nfull) { if (2 * rem <= gl) { if (cl >= 2 * rem) return false; L = nfull * gl + (cl >> 1); hf = cl & 1; } else if (cl >= rem) return false; }
            pm = t0 + L / nN; pn = L % nN; }
        else { const long L = (long)i * G + c; if (L >= (long)ntiles * nN) return false; pm = (int)(L / nN); pn = (int)(L % nN); }
        u.pm = pm; u.pn = pn; u.half = hf; int e = 0, ts = 0;
#pragma unroll
        for (int j = 0; j < NE - 1; ++j) { const bool ge = pm >= tend[j]; e += ge ? 1 : 0; ts = ge ? tend[j] : ts; }
        u.e = e; const int r0 = (pm - ts) * 256; u.g0 = e * M + r0; u.gv = 256;
        if (GATHER) { const int ce = lane_bcast(cntv, e); u.gv = (ce - r0 < 256) ? ce - r0 : 256; }
        return true;
    }
    DEVM const char* baseA(const Unit& u) const { return GATHER ? (const char*)A : (const char*)(A + (size_t)u.pm * BM * lda); }
    DEVM const char* baseB(const Unit& u) const { return (const char*)(Bt + (size_t)u.e * estride + (size_t)u.pn * BM * ldb); }
};
typedef SchedMoeT<false> SchedMoe;

#ifdef EMU
template <class Epi, class Sched>
static inline void gemm_phase(unsigned char* lds, const Sched& S, const Epi& E) {
    const int tid = threadIdx.x, wid = tid >> 6, lane = tid & 63, wr = wid >> 2, wc = wid & 3, fr = lane & 15, fq = lane >> 4;
    Unit u; f32x4 acc[2][2][4][2]; bool keep = false;
    for (int i = 0; S.next(i, u); ++i) {
        const bf16_t* A = (const bf16_t*)S.baseA(u); const bf16_t* B = (const bf16_t*)S.baseB(u);
        for (int ai = 0; ai < 2; ++ai) for (int bj = 0; bj < 2; ++bj) for (int m = 0; m < 4; ++m) for (int n = 0; n < 2; ++n) for (int x = 0; x < 4; ++x) {
            const int r = 128 * ai + 64 * wr + 16 * m + fr, c = 128 * bj + 32 * wc + 8 * fq + 4 * n + x; float s = keep ? acc[ai][bj][m][n][x] : 0.f;
            size_t arow = r; if constexpr (Sched::GATHER) arow = (size_t)S.rowtok[u.g0 + (r < u.gv ? r : u.gv - 1)];
            for (int k = 0; k < S.K; ++k) s += bf2f(A[arow * S.lda + k]) * bf2f(B[(size_t)c * S.ldb + k]);
            acc[ai][bj][m][n][x] = s; }
        if constexpr (Epi::DUAL) keep = E.dual(acc, u, wr, wc, fr, fq); else { E(acc, u, wr, wc, fr, fq); keep = false; }
    }
    (void)lds;
}
#else
#define PG8_LAS __attribute__((address_space(3)))
#ifndef GPROBE_ALL
#define GPROBE_ALL 0
#endif
#ifndef GPROBE_PH
#define GPROBE_PH -1
#define GPROBE_A -1
#define GPROBE_B -1
#endif
#define GPROBE(lds_, id_) do { if (GPROBE_PH >= 0 && S.phase_id == GPROBE_PH && (blockIdx.x == 0 || GPROBE_ALL) && threadIdx.x == 0) { const unsigned long long _t = rt_now(); \
    volatile PG8_LAS unsigned* _m = (volatile PG8_LAS unsigned*)((lds_) + (144 * 1024 - 64)); if ((id_) == GPROBE_A) { _m[0] = (unsigned)_t; _m[1] = (unsigned)(_t >> 32); } if ((id_) == GPROBE_B) { _m[2] = (unsigned)_t; _m[3] = (unsigned)(_t >> 32); } } } while (0)
template <class Epi, class Sched>
__device__ __forceinline__ void gemm_phase(PG8_LAS unsigned char* lds, const Sched& S, const Epi& E) {
    int tid = threadIdx.x; asm volatile("" : "+v"(tid));
    const int wid = __builtin_amdgcn_readfirstlane(tid >> 6), lane = tid & 63, wr = wid >> 2, wc = wid & 3, fr = lane & 15, fq = lane >> 4;
    const int K = S.K, nt = K / BK;
    unsigned voffA[2], voffB[2];
#pragma unroll
    for (int i = 0; i < 2; ++i) { int R, C; stage_rc(tid * 16 + i * 8192, R, C); const int Rb = (R & ~31) + perm32(R & 31);
        voffA[i] = (unsigned)(R * S.lda + C) * 2u; voffB[i] = (unsigned)(Rb * S.ldb + C) * 2u; }
    const size_t kstep = (size_t)(BK * 2);
    const size_t hstepA = Sched::GATHER ? (size_t)0 : (size_t)HALF * S.lda * 2, hstepB = (size_t)HALF * S.ldb * 2;
    unsigned vgc[2][2] = {{0u, 0u}, {0u, 0u}}, vgn[2][2] = {{0u, 0u}, {0u, 0u}}; int gR[2] = {0, 0}, gC[2] = {0, 0};
    if constexpr (Sched::GATHER) {
#pragma unroll
        for (int i = 0; i < 2; ++i) { int R, C; stage_rc(tid * 16 + i * 8192, R, C); gR[i] = R; gC[i] = C; } }
#define PG8_GLOAD(dst, unit) do { _Pragma("unroll") for (int _h = 0; _h < 2; ++_h) _Pragma("unroll") for (int _i = 0; _i < 2; ++_i) \
        { const int _r = _h * 128 + gR[_i]; dst[_h][_i] = (unsigned)(S.rowtok[(unit).g0 + (_r < (unit).gv ? _r : (unit).gv - 1)] * S.lda + gC[_i]) * 2u; } } while (0)
#define PG8_GLOAD_RAW(dst, unit) do { _Pragma("unroll") for (int _h = 0; _h < 2; ++_h) _Pragma("unroll") for (int _i = 0; _i < 2; ++_i) \
        { const int _r = _h * 128 + gR[_i]; dst[_h][_i] = (unsigned)S.rowtok[(unit).g0 + (_r < (unit).gv ? _r : (unit).gv - 1)]; } } while (0)
#define PG8_GCONV(dst, raw) do { _Pragma("unroll") for (int _h = 0; _h < 2; ++_h) _Pragma("unroll") for (int _i = 0; _i < 2; ++_i) dst[_h][_i] = (raw[_h][_i] * (unsigned)S.lda + (unsigned)gC[_i]) * 2u; } while (0)
    unsigned vgr[2][2] = {{0u, 0u}, {0u, 0u}};
#define PG8_STAGE_A(bufoff, gbase, h, nextu) do { if constexpr (Sched::GATHER) { unsigned _v[2]; _v[0] = (nextu) ? vgn[h][0] : vgc[h][0]; _v[1] = (nextu) ? vgn[h][1] : vgc[h][1]; PG8_STAGE(bufoff, gbase, _v); } \
        else PG8_STAGE(bufoff, (gbase) + ((h) ? hstepA : 0), voffA); } while (0)
    const unsigned ldsw = (unsigned)wid * 1024u;
    const int aoff = lds_byte(wr * 64 + fr, fq * 8), boff = lds_byte(wc * 32 + fr, fq * 8);
#define PG8_SA(b, h) (((b) * 2 + (h)) * HTB)
#define PG8_SB(b, h) ((4 + (b) * 2 + (h)) * HTB)
#define PG8_STAGE(bufoff, gbase, voff) do { _Pragma("unroll") for (int _i = 0; _i < 2; ++_i) \
        __builtin_amdgcn_global_load_lds((const unsigned*)((const char*)(gbase) + (voff)[_i]), (PG8_LAS unsigned*)(lds + (bufoff) + ldsw + _i * 8192), 16, 0, 0); } while (0)
#define PG8_LDA(dst, b, h) do { _Pragma("unroll") for (int m = 0; m < 4; ++m) _Pragma("unroll") for (int k = 0; k < 2; ++k) dst[m][k] = *(const PG8_LAS bf16x8*)(lds + PG8_SA(b, h) + aoff + m * 2048 + k * 1024); } while (0)
#define PG8_LDB(dst, b, h) do { _Pragma("unroll") for (int n = 0; n < 2; ++n) _Pragma("unroll") for (int k = 0; k < 2; ++k) dst[n][k] = *(const PG8_LAS bf16x8*)(lds + PG8_SB(b, h) + boff + n * 2048 + k * 1024); } while (0)
#define PG8_MMA(ai, bj, At, Bt) do { __builtin_amdgcn_s_setprio(1); _Pragma("unroll") for (int m = 0; m < 4; ++m) _Pragma("unroll") for (int n = 0; n < 2; ++n) _Pragma("unroll") for (int k = 0; k < 2; ++k) \
        acc[ai][bj][m][n] = __builtin_amdgcn_mfma_f32_16x16x32_bf16(Bt[n][k], At[m][k], acc[ai][bj][m][n], 0, 0, 0); __builtin_amdgcn_s_setprio(0); } while (0)
#define PG8_WAIT_V(n) asm volatile("s_waitcnt vmcnt(" #n ")" ::: "memory")
#define PG8_WAIT_L(n) asm volatile("s_waitcnt lgkmcnt(" #n ")" ::: "memory")
#define PG8_BAR __builtin_amdgcn_s_barrier()
#define PG8_SCHED __builtin_amdgcn_sched_barrier(0)
    Unit cur, nxt; int ui = 0;
    GPROBE(lds, 50);
    if (!S.next(0, cur)) return;
    f32x4 acc[2][2][4][2];
#pragma unroll
    for (int a = 0; a < 2; ++a)
#pragma unroll
        for (int b = 0; b < 2; ++b)
#pragma unroll
            for (int m = 0; m < 4; ++m)
#pragma unroll
                for (int n = 0; n < 2; ++n) acc[a][b][m][n] = (f32x4){0.f, 0.f, 0.f, 0.f};
    bf16x8 At[4][2], B0[2][2], B1[2][2];
    const char* cA = S.baseA(cur); const char* cB = S.baseB(cur);
    if constexpr (Sched::GATHER) PG8_GLOAD(vgc, cur);
    PG8_STAGE(PG8_SB(0, 0), cB, voffB); PG8_STAGE(PG8_SB(0, 1), cB + hstepB, voffB); PG8_STAGE_A(PG8_SA(0, 0), cA, 0, false); PG8_STAGE_A(PG8_SA(0, 1), cA, 1, false);
    if (wr == 1) PG8_BAR;
    PG8_WAIT_V(2); PG8_BAR;
    PG8_STAGE(PG8_SB(1, 0), cB + kstep, voffB); PG8_STAGE_A(PG8_SA(1, 0), cA + kstep, 0, false); PG8_STAGE(PG8_SB(1, 1), cB + hstepB + kstep, voffB);
    PG8_WAIT_V(6); PG8_BAR;
    for (;;) {
        const bool has_next = S.next(ui + 1, nxt);
        const char* nA = has_next ? S.baseA(nxt) : cA; const char* nB = has_next ? S.baseB(nxt) : cB;
        if constexpr (Sched::GATHER) { if (has_next) PG8_GLOAD_RAW(vgr, nxt); }
        for (int t = 0; t < nt; t += 2) {
            const bool last = (t == nt - 2);
            if constexpr (Sched::GATHER) { if (last) { if (has_next) PG8_GCONV(vgn, vgr); else { vgn[0][0] = vgc[0][0]; vgn[0][1] = vgc[0][1]; vgn[1][0] = vgc[1][0]; vgn[1][1] = vgc[1][1]; } } }
            const char* a1 = cA + (size_t)(t + 1) * kstep;
            const char* a2 = last ? nA : cA + (size_t)(t + 2) * kstep; const char* b2 = last ? nB : cB + (size_t)(t + 2) * kstep;
            const char* a3 = a2 + kstep; const char* b3 = b2 + kstep;
            PG8_LDB(B0, 0, 0); PG8_LDB(B1, 0, 1); PG8_SCHED; PG8_LDA(At, 0, 0); PG8_STAGE_A(PG8_SA(1, 1), a1, 1, false);
            PG8_WAIT_V(8); PG8_WAIT_L(0); PG8_BAR; if (cur.half != 1) { PG8_MMA(0, 0, At, B0); PG8_MMA(0, 1, At, B1); } PG8_BAR; PG8_SCHED;
            PG8_LDA(At, 0, 1); PG8_STAGE(PG8_SB(0, 0), b2, voffB); PG8_STAGE(PG8_SB(0, 1), b2 + hstepB, voffB); PG8_STAGE_A(PG8_SA(0, 0), a2, 0, last);
            PG8_WAIT_V(8); PG8_WAIT_L(0); PG8_BAR; if (cur.half != 0) { PG8_MMA(1, 0, At, B0); PG8_MMA(1, 1, At, B1); } PG8_BAR; PG8_SCHED;
            PG8_LDB(B0, 1, 0); PG8_LDB(B1, 1, 1); PG8_SCHED; PG8_LDA(At, 1, 0); PG8_STAGE_A(PG8_SA(0, 1), a2, 1, last);
            PG8_WAIT_V(8); PG8_WAIT_L(0); PG8_BAR; if (cur.half != 1) { PG8_MMA(0, 0, At, B0); PG8_MMA(0, 1, At, B1); } PG8_BAR; PG8_SCHED;
            PG8_LDA(At, 1, 1); PG8_STAGE(PG8_SB(1, 0), b3, voffB); PG8_STAGE(PG8_SB(1, 1), b3 + hstepB, voffB); PG8_STAGE_A(PG8_SA(1, 0), a3, 0, last);
            PG8_WAIT_V(8); PG8_WAIT_L(0); PG8_BAR; if (cur.half != 0) { PG8_MMA(1, 0, At, B0); PG8_MMA(1, 1, At, B1); } PG8_BAR; PG8_SCHED;
        }
        if (wr == 0) PG8_BAR;
        GPROBE(lds, 100 + ui);
        bool keep = false;
        if constexpr (Epi::DUAL) keep = E.dual(acc, cur, wr, wc, fr, fq); else E(acc, cur, wr, wc, fr, fq);
        GPROBE(lds, 200 + ui);
        if (!has_next) break;
        if (!keep) {
#pragma unroll
        for (int a = 0; a < 2; ++a)
#pragma unroll
            for (int b = 0; b < 2; ++b)
#pragma unroll
                for (int m = 0; m < 4; ++m)
#pragma unroll
                    for (int n = 0; n < 2; ++n) acc[a][b][m][n] = (f32x4){0.f, 0.f, 0.f, 0.f};
        }
        cur = nxt; cA = nA; cB = nB; ++ui;
        if constexpr (Sched::GATHER) { vgc[0][0] = vgn[0][0]; vgc[0][1] = vgn[0][1]; vgc[1][0] = vgn[1][0]; vgc[1][1] = vgn[1][1]; }
        if (wr == 1) PG8_BAR;
    }
    PG8_WAIT_V(0);
    PG8_BAR;
    GPROBE(lds, 300);
#undef PG8_SA
#undef PG8_SB
#undef PG8_STAGE
#undef PG8_STAGE_A
#undef PG8_GLOAD
#undef PG8_GLOAD_RAW
#undef PG8_GCONV
#undef PG8_LDA
#undef PG8_LDB
#undef PG8_MMA
#undef PG8_WAIT_V
#undef PG8_WAIT_L
#undef PG8_BAR
#undef PG8_SCHED
}
#endif
}
using pg8::Unit;

#define EPI_ARGS const f32x4 (&acc)[2][2][4][2], const Unit& u, int wr, int wc, int fr, int fq
DEV u32x4 pack_row8(const f32x4& v0, const f32x4& v1) { u32x4 w; w.x = pk2(v0[0], v0[1]); w.y = pk2(v0[2], v0[3]); w.z = pk2(v1[0], v1[1]); w.w = pk2(v1[2], v1[3]); return w; }

struct EpiInProj {
    static constexpr bool DUAL = false;
    bf16_t* H; bf16_t* KIDX; float* SM; float* SSQ;
    DEVM void operator()(EPI_ARGS) const {
        const int row0 = u.pm * 256 + wr * 64 + fr;
        if (u.pn < 21) {
            const int col0 = u.pn * 256 + wc * 32 + 8 * fq; const bool sig = u.pn >= 11;
            if (u.pn == 2) {
#pragma unroll
                for (int ai = 0; ai < 2; ++ai)
#pragma unroll
                    for (int m = 0; m < 4; ++m) { float s = 0.f;
#pragma unroll
                        for (int bj = 0; bj < 2; ++bj)
#pragma unroll
                            for (int n = 0; n < 2; ++n) { const f32x4 x = acc[ai][bj][m][n]; s += (x[0] * x[0] + x[1] * x[1]) + (x[2] * x[2] + x[3] * x[3]); }
                        s += __shfl_xor(s, 16); s += __shfl_xor(s, 32);
                        if (fq == 0) SSQ[(size_t)(row0 + ai * 128 + m * 16) * 4 + wc] = s; }
            }
#pragma unroll
            for (int ai = 0; ai < 2; ++ai)
#pragma unroll
                for (int m = 0; m < 4; ++m) { bf16_t* rowp = H + (size_t)(row0 + ai * 128 + m * 16) * LDH + col0;
                    if (u.pn >= 13) {
                        bf16_t* gp = H + (size_t)(row0 + ai * 128 + m * 16) * LDH + (u.pn - 13) * 128 + wc * 32 + 8 * fq;
                        f32x4 a0 = acc[ai][0][m][0], a1 = acc[ai][0][m][1], m0 = acc[ai][1][m][0], m1 = acc[ai][1][m][1];
#pragma unroll
                        for (int x = 0; x < 4; ++x) { m0[x] = fmaxf(sigmoidf_(m0[x]), 1e-20f); m1[x] = fmaxf(sigmoidf_(m1[x]), 1e-20f); a0[x] = sigmoidf_(a0[x]) / m0[x]; a1[x] = sigmoidf_(a1[x]) / m1[x]; }
                        *(u32x4*)(gp + C_GA) = pack_row8(a0, a1); *(u32x4*)(gp + C_GM) = pack_row8(m0, m1);
                    } else {
#pragma unroll
                    for (int bj = 0; bj < 2; ++bj) { f32x4 v0 = acc[ai][bj][m][0], v1 = acc[ai][bj][m][1];
                        if (sig) {
#pragma unroll
                            for (int x = 0; x < 4; ++x) { v0[x] = sigmoidf_(v0[x]); v1[x] = sigmoidf_(v1[x]); } }
                        *(u32x4*)(rowp + bj * 128) = pack_row8(v0, v1); } } }
        } else {
#pragma unroll
            for (int ai = 0; ai < 2; ++ai)
#pragma unroll
                for (int m = 0; m < 4; ++m) { const size_t row = (size_t)(row0 + ai * 128 + m * 16);
                    if (wc < 2) *(u32x4*)(KIDX + row * 64 + wc * 32 + 8 * fq) = pack_row8(acc[ai][0][m][0], acc[ai][0][m][1]);
                    else if (wc == 2 && fq < 2) { *(f32x4*)(SM + row * 16 + 8 * fq) = acc[ai][0][m][0]; *(f32x4*)(SM + row * 16 + 8 * fq + 4) = acc[ai][0][m][1]; } }
        }
    }
};
DEV float rms_scale(const float* SSQ, size_t row) { const f32x4 q = *(const f32x4*)(SSQ + row * 4); return 1.0f / sqrtf(((q[0] + q[1]) + (q[2] + q[3])) * (1.0f / 256.0f) + LN_EPS); }
struct EpiK {
    static constexpr bool DUAL = false;
    bf16_t* Kb; const float* SSQ;
    DEVM void operator()(EPI_ARGS) const {
        const int row0 = u.pm * 256 + wr * 64 + fr, col0 = u.pn * 256 + wc * 32 + 8 * fq;
        float sr[2][4];
#pragma unroll
        for (int ai = 0; ai < 2; ++ai)
#pragma unroll
            for (int m = 0; m < 4; ++m) sr[ai][m] = rms_scale(SSQ, (size_t)(row0 + ai * 128 + m * 16));
        MEM_FENCE();
#pragma unroll
        for (int ai = 0; ai < 2; ++ai)
#pragma unroll
            for (int m = 0; m < 4; ++m) { const size_t row = (size_t)(row0 + ai * 128 + m * 16); const float s = sr[ai][m];
#pragma unroll
                for (int bj = 0; bj < 2; ++bj) *(u32x4*)(Kb + row * 512 + col0 + bj * 128) = pack_row8(acc[ai][bj][m][0] * s, acc[ai][bj][m][1] * s); }
    }
};
struct EpiVT {
    static constexpr bool DUAL = false;
    bf16_t* VT; const float* SSQ;
    DEVM void operator()(EPI_ARGS) const {
        const int row0 = u.pm * 256 + wr * 64 + fr, col0 = u.pn * 256 + wc * 32 + 8 * fq;
        float sc[2][8];
#pragma unroll
        for (int bj = 0; bj < 2; ++bj)
#pragma unroll
            for (int x = 0; x < 8; ++x) sc[bj][x] = rms_scale(SSQ, (size_t)(col0 + bj * 128 + x));
        MEM_FENCE();
#pragma unroll
        for (int ai = 0; ai < 2; ++ai)
#pragma unroll
            for (int m = 0; m < 4; ++m) { const size_t row = (size_t)(row0 + ai * 128 + m * 16);
#pragma unroll
                for (int bj = 0; bj < 2; ++bj) { f32x4 v0 = acc[ai][bj][m][0], v1 = acc[ai][bj][m][1];
#pragma unroll
                    for (int x = 0; x < 4; ++x) { v0[x] *= sc[bj][x]; v1[x] *= sc[bj][4 + x]; }
                    *(u32x4*)(VT + row * (size_t)M + col0 + bj * 128) = pack_row8(v0, v1); } }
    }
};
struct EpiUpDual {
    static constexpr bool DUAL = true;
    bf16_t* Y; const bf16_t* H;
    DEVM bool dual(f32x4 (&acc)[2][2][4][2], const Unit& u, int wr, int wc, int fr, int fq) const {
        const int row0 = u.pm * 256 + wr * 64 + fr, col0 = u.pn * 256 + wc * 32 + 8 * fq;
        const int gcol = (u.e == 0) ? C_GA : C_GM;
#pragma unroll
        for (int ai = 0; ai < 2; ++ai) {
            u32x4 gv[4][2];
#pragma unroll
            for (int m = 0; m < 4; ++m) { const size_t row = (size_t)(row0 + ai * 128 + m * 16);
#pragma unroll
                for (int bj = 0; bj < 2; ++bj) gv[m][bj] = *(const u32x4*)(H + row * LDH + gcol + col0 + bj * 128); }
            MEM_FENCE();
#pragma unroll
            for (int m = 0; m < 4; ++m) { const size_t row = (size_t)(row0 + ai * 128 + m * 16);
#pragma unroll
                for (int bj = 0; bj < 2; ++bj) { const u32x4 g = gv[m][bj];
                    const float g8[8] = {lo_bf(g.x), hi_bf(g.x), lo_bf(g.y), hi_bf(g.y), lo_bf(g.z), hi_bf(g.z), lo_bf(g.w), hi_bf(g.w)};
                    if (u.e == 0) {
#pragma unroll
                        for (int x = 0; x < 4; ++x) { acc[ai][bj][m][0][x] *= g8[x]; acc[ai][bj][m][1][x] *= g8[4 + x]; }
                    } else { f32x4 v0 = acc[ai][bj][m][0], v1 = acc[ai][bj][m][1];
#pragma unroll
                        for (int x = 0; x < 4; ++x) { v0[x] *= g8[x]; v1[x] *= g8[4 + x]; }
                        *(u32x4*)(Y + row * 1024 + col0 + bj * 128) = pack_row8(v0, v1); } } }
            MEM_FENCE();
        }
        return u.e == 0;
    }
};
struct SchedDual {
    static constexpr bool GATHER = false;
    pg8::SchedStatic T; int K, lda, ldb; const bf16_t* A0; const bf16_t* A1; const bf16_t* B0; const bf16_t* B1; int phase_id = -1;
    DEVM bool next(int i, Unit& u) const { if (!T.next(i >> 1, u)) return false; u.e = i & 1; return true; }
    DEVM const char* baseA(const Unit& u) const { return (const char*)((u.e ? A1 : A0) + (size_t)u.pm * 256 * lda); }
    DEVM const char* baseB(const Unit& u) const { return (const char*)((u.e ? B1 : B0) + (size_t)u.pn * 256 * ldb); }
};
struct EpiOut {
    static constexpr bool DUAL = false;
    bf16_t* Z; const bf16_t* XB;
    DEVM void operator()(EPI_ARGS) const {
        const int row0 = u.pm * 256 + wr * 64 + fr, col0 = u.pn * 256 + wc * 32 + 8 * fq;
#pragma unroll
        for (int ai = 0; ai < 2; ++ai) {
            u32x4 xv[4][2];
#pragma unroll
            for (int m = 0; m < 4; ++m) { const size_t off = (size_t)(row0 + ai * 128 + m * 16) * 1024 + col0;
#pragma unroll
                for (int bj = 0; bj < 2; ++bj) xv[m][bj] = *(const u32x4*)(XB + off + bj * 128); }
            MEM_FENCE();
#pragma unroll
            for (int m = 0; m < 4; ++m) { const size_t off = (size_t)(row0 + ai * 128 + m * 16) * 1024 + col0;
#pragma unroll
                for (int bj = 0; bj < 2; ++bj) { const u32x4 x = xv[m][bj]; f32x4 v0 = acc[ai][bj][m][0], v1 = acc[ai][bj][m][1];
                    v0[0] += ALPHA * lo_bf(x.x); v0[1] += ALPHA * hi_bf(x.x); v0[2] += ALPHA * lo_bf(x.y); v0[3] += ALPHA * hi_bf(x.y);
                    v1[0] += ALPHA * lo_bf(x.z); v1[1] += ALPHA * hi_bf(x.z); v1[2] += ALPHA * lo_bf(x.w); v1[3] += ALPHA * hi_bf(x.w);
                    *(u32x4*)(Z + off + bj * 128) = pack_row8(v0, v1); } }
            MEM_FENCE();
        }
    }
};
struct EpiMoe1 {
    static constexpr bool DUAL = false;
    bf16_t* HD;
    DEVM void operator()(EPI_ARGS) const {
        const int row0 = u.pm * 256 + wr * 64 + fr, col0 = u.pn * 128 + wc * 32 + 8 * fq;
#pragma unroll
        for (int ai = 0; ai < 2; ++ai) if (u.half < 0 || u.half == ai)
#pragma unroll
            for (int m = 0; m < 4; ++m) { const size_t row = (size_t)(row0 + ai * 128 + m * 16);
                f32x4 v0, v1;
#pragma unroll
                for (int x = 0; x < 4; ++x) { const float g0 = acc[ai][0][m][0][x], g1 = acc[ai][0][m][1][x]; v0[x] = g0 * sigmoidf_(g0) * acc[ai][1][m][0][x]; v1[x] = g1 * sigmoidf_(g1) * acc[ai][1][m][1][x]; }
                *(u32x4*)(HD + row * 512 + col0) = pack_row8(v0, v1); }
    }
};
struct EpiMoe2 {
    static constexpr bool DUAL = false;
    bf16_t* O2;
    DEVM void operator()(EPI_ARGS) const {
        const int row0 = u.pm * 256 + wr * 64 + fr, col0 = u.pn * 256 + wc * 32 + 8 * fq;
#pragma unroll
        for (int ai = 0; ai < 2; ++ai) if (u.half < 0 || u.half == ai)
#pragma unroll
            for (int m = 0; m < 4; ++m) { const size_t row = (size_t)(row0 + ai * 128 + m * 16);
#pragma unroll
                for (int bj = 0; bj < 2; ++bj) *(u32x4*)(O2 + row * 1024 + col0 + bj * 128) = pack_row8(acc[ai][bj][m][0], acc[ai][bj][m][1]); }
    }
};

struct Ctx {
    const float* in[25]; float* out; unsigned char* ws;
    int tid, lane, wid, G, bid;
    LAS unsigned char* lds;
};
#define IN_X 0
#define IN_WIN 1
#define IN_CONVW 2
#define IN_CONVB 3
#define IN_KVG 4
#define IN_WUK 5
#define IN_WUV 6
#define IN_RELB 7
#define IN_BI 8
#define IN_BF 9
#define IN_MHG 10
#define IN_WUPA 11
#define IN_WUPM 12
#define IN_WOUT 13
#define IN_LN1G 14
#define IN_LN1B 15
#define IN_WGRP 16
#define IN_BGRP 17
#define IN_WRT 18
#define IN_BRT 19
#define IN_WGATE 20
#define IN_WUP 21
#define IN_WDOWN 22
#define IN_LN2G 23
#define IN_LN2B 24
template <class T> DEV T* wsp(const Ctx& c, size_t off) { return (T*)(c.ws + off); }
DEV const float* par(const Ctx& c, int off) { return (const float*)(c.ws + WS_PAR) + off; }
DEV void wg_sync() { __syncthreads(); }

DEV int win_src_col(int n) {
    if (n < 1280) return n;
    if (n < 2816) return 1352 + (n - 1280);
    if (n < 3328) return 2896 + (n - 2816);
    if (n < 5376) { const int j = (n - 3328) >> 8, w = (n - 3328) & 255; return (w < 128) ? 3408 + 128 * j + w : 4432 + 128 * j + (w - 128); }
    if (n < 5440) return 1280 + (n - 5376);
    if (n < 5448) return 1344 + (n - 5440);
    if (n < 5456) return 2888 + (n - 5448);
    return -1;
}
#ifndef P2PROBE
#define P2PROBE 0
#define P2PROBE_KIND 1
#endif
DEV void p0_item(const float* W, const float* W2, int K, int Nsrc, bf16_t* WT, int mode, const float* aux, LAS float* scr, int item, int nblk, int lane) {
    const int kb = item / nblk, nb = item % nblk, k0 = 64 * kb, n0 = 32 * nb;
    const int nn = n0 + (lane & 31);
    int col = nn; const float* src = W; float cs = 1.0f;
    if (mode == 1) { col = win_src_col(nn); cs = (nn < 512) ? QSCALE : 1.0f; }
    if (mode == 3) { const int t = nn >> 8, j = nn & 255; col = t * 128 + (j & 127); src = (j < 128) ? W : W2; }
    float vv[32];
#pragma unroll
    for (int i = 0; i < 32; ++i) { const int kk = 2 * i + (lane >> 5); vv[i] = (col >= 0) ? src[(size_t)(k0 + kk) * Nsrc + col] : 0.f; }
#pragma unroll
    for (int i = 0; i < 32; ++i) { const int kk = 2 * i + (lane >> 5); float v = vv[i] * cs; if (mode == 2) v *= aux[k0 + kk];
        scr[kk * 33 + (lane & 31)] = v; }
    WAVE_SYNC();
    const int c = lane & 7;
#pragma unroll
    for (int j = 0; j < 4; ++j) { const int n = (lane >> 3) + 8 * j; const LAS float* s = scr + (8 * c) * 33 + n;
        u32x4 o; o.x = pk2(s[0 * 33], s[1 * 33]); o.y = pk2(s[2 * 33], s[3 * 33]); o.z = pk2(s[4 * 33], s[5 * 33]); o.w = pk2(s[6 * 33], s[7 * 33]);
        *(u32x4*)(WT + (size_t)(n0 + n) * K + k0 + 8 * c) = o; }
    WAVE_SYNC();
}
DEV void p0_expert_items(const Ctx& c, int gw, int NGW) {
    LAS float* scr = (LAS float*)(c.lds + c.wid * 16384);
    constexpr int I_GU = 16 * 32, I_D = 8 * 32;
    for (int it = gw; it < NE * (I_GU + I_D); it += NGW) {
        int r = it;
        if (r < NE * I_GU) { const int e = r / I_GU; p0_item(c.in[IN_WGATE] + (size_t)e * 1024 * 512, c.in[IN_WUP] + (size_t)e * 1024 * 512, 1024, 512, wsp<bf16_t>(c, WS_WGU) + (size_t)e * 1024 * 1024, 3, nullptr, scr, r % I_GU, 32, c.lane); continue; } r -= NE * I_GU;
        { const int e = r / I_D; p0_item(c.in[IN_WDOWN] + (size_t)e * 512 * 1024, nullptr, 512, 1024, wsp<bf16_t>(c, WS_WD) + (size_t)e * 1024 * 512, 0, nullptr, scr, r % I_D, 32, c.lane); }
    }
}
DEV void ex_params(const Ctx& c, int it, const float*& src, int& K, int& Nsrc, bf16_t*& WT, int& k0, int& n0, int lane) {
    constexpr int I_GU = 16 * 32, I_D = 8 * 32; int r = it, item; const float* W; const float* W2 = nullptr; int mode;
    if (r < NE * I_GU) { const int e = r / I_GU; W = c.in[IN_WGATE] + (size_t)e * 1024 * 512; W2 = c.in[IN_WUP] + (size_t)e * 1024 * 512; K = 1024; Nsrc = 512; WT = wsp<bf16_t>(c, WS_WGU) + (size_t)e * 1024 * 1024; mode = 3; item = r % I_GU; }
    else { r -= NE * I_GU; const int e = r / I_D; W = c.in[IN_WDOWN] + (size_t)e * 512 * 1024; K = 512; Nsrc = 1024; WT = wsp<bf16_t>(c, WS_WD) + (size_t)e * 1024 * 512; mode = 0; item = r % I_D; }
    const int kb = item / 32, nb = item % 32; k0 = 64 * kb; n0 = 32 * nb;
    const int nn = n0 + (lane & 31); int col = nn; src = W;
    if (mode == 3) { const int t = nn >> 8, j = nn & 255; col = t * 128 + (j & 127); src = (j < 128) ? W : W2; }
    src += col;
}
DEV void ex_load(float (&vv)[32], const Ctx& c, int it, int lane) {
    const float* src; int K, Nsrc, k0, n0; bf16_t* WT; ex_params(c, it, src, K, Nsrc, WT, k0, n0, lane);
#pragma unroll
    for (int i = 0; i < 32; ++i) vv[i] = src[(size_t)(k0 + 2 * i + (lane >> 5)) * Nsrc];
}
DEV void ex_finish(const float (&vv)[32], const Ctx& c, int it, LAS float* scr, int lane) {
    const float* src; int K, Nsrc, k0, n0; bf16_t* WT; ex_params(c, it, src, K, Nsrc, WT, k0, n0, lane);
#pragma unroll
    for (int hf = 0; hf < 2; ++hf) {
#pragma unroll
        for (int i = 0; i < 16; ++i) scr[(2 * i + (lane >> 5)) * 33 + (lane & 31)] = vv[16 * hf + i];
        WAVE_SYNC();
        const int cc = lane & 3;
#pragma unroll
        for (int j = 0; j < 2; ++j) { const int n = (lane >> 2) + 16 * j; const LAS float* s = scr + (8 * cc) * 33 + n;
            u32x4 o; o.x = pk2(s[0 * 33], s[1 * 33]); o.y = pk2(s[2 * 33], s[3 * 33]); o.z = pk2(s[4 * 33], s[5 * 33]); o.w = pk2(s[6 * 33], s[7 * 33]);
            *(u32x4*)(WT + (size_t)(n0 + n) * K + k0 + 32 * hf + 8 * cc) = o; }
        WAVE_SYNC();
    }
}
DEV void phase_prologue(const Ctx& c) {
    LAS float* scr = (LAS float*)(c.lds + c.wid * 16384);
    const int gw = c.bid * NWAVES + c.wid, NGW = c.G * NWAVES;
    constexpr int I_WIN = 16 * (NWIN / 32), I_KV = 4 * 16, I_UP = 8 * 32, I_WO = 16 * 32;
    constexpr int NITEMS = I_WIN + 2 * I_KV + 2 * I_UP + I_WO;
#if P2PROBE
    const unsigned long long p0ta = rt_now();
#endif
    const float* X = c.in[IN_X]; bf16_t* XB = (bf16_t*)c.out;
    for (int m0 = gw; m0 < M; m0 += 4 * NGW) {
        f32x4 v[4][4];
#pragma unroll
        for (int q = 0; q < 4; ++q) { const int m = m0 + q * NGW; if (m < M) { const f32x4* xr = (const f32x4*)(X + (size_t)m * DM) + c.lane;
#pragma unroll
            for (int j = 0; j < 4; ++j) v[q][j] = xr[64 * j]; } }
#pragma unroll
        for (int q = 0; q < 4; ++q) { const int m = m0 + q * NGW; if (m < M) { u32x2* o = (u32x2*)(XB + (size_t)m * DM) + c.lane;
#pragma unroll
            for (int j = 0; j < 4; ++j) { u32x2 w; w.x = pk2(v[q][j][0], v[q][j][1]); w.y = pk2(v[q][j][2], v[q][j][3]); o[64 * j] = w; } } }
    }
    for (int it = gw; it < NITEMS; it += NGW) {
        int r = it;
        if (r < I_WIN) { p0_item(c.in[IN_WIN], nullptr, 1024, 5456, wsp<bf16_t>(c, WS_WIN), 1, nullptr, scr, r, NWIN / 32, c.lane); continue; } r -= I_WIN;
        if (r < I_KV) { p0_item(c.in[IN_WUK], nullptr, 256, 512, wsp<bf16_t>(c, WS_WK), 2, c.in[IN_KVG], scr, r, 16, c.lane); continue; } r -= I_KV;
        if (r < I_KV) { p0_item(c.in[IN_WUV], nullptr, 256, 512, wsp<bf16_t>(c, WS_WV), 2, c.in[IN_KVG], scr, r, 16, c.lane); continue; } r -= I_KV;
        if (r < I_UP) { p0_item(c.in[IN_WUPA], nullptr, 512, 1024, wsp<bf16_t>(c, WS_WA), 0, nullptr, scr, r, 32, c.lane); continue; } r -= I_UP;
        if (r < I_UP) { p0_item(c.in[IN_WUPM], nullptr, 512, 1024, wsp<bf16_t>(c, WS_WM), 0, nullptr, scr, r, 32, c.lane); continue; } r -= I_UP;
        p0_item(c.in[IN_WOUT], nullptr, 1024, 1024, wsp<bf16_t>(c, WS_WO), 0, nullptr, scr, r, 32, c.lane);
    }
    { float* P = wsp<float>(c, WS_PAR); const int gt = c.bid * NTHREADS + c.tid, ngt = c.G * NTHREADS;
      for (int i = gt; i < P_END; i += ngt) { float v;
        if (i < P_CONVB) v = c.in[IN_CONVW][i]; else if (i < P_BI) v = c.in[IN_CONVB][i - P_CONVB]; else if (i < P_BF) v = c.in[IN_BI][i - P_BI]; else if (i < P_MHG) v = c.in[IN_BF][i - P_BF];
        else if (i < P_RELB) v = c.in[IN_MHG][i - P_MHG]; else if (i < P_LN1G) v = c.in[IN_RELB][i - P_RELB]; else if (i < P_LN1B) v = c.in[IN_LN1G][i - P_LN1G]; else if (i < P_WGRP) v = c.in[IN_LN1B][i - P_LN1B];
        else if (i < P_BGRP) v = c.in[IN_WGRP][i - P_WGRP]; else if (i < P_WRT) v = c.in[IN_BGRP][i - P_BGRP]; else if (i < P_BRT) v = c.in[IN_WRT][i - P_WRT]; else if (i < P_LN2G) v = c.in[IN_BRT][i - P_BRT];
        else if (i < P_LN2B) v = c.in[IN_LN2G][i - P_LN2G]; else v = c.in[IN_LN2B][i - P_LN2B];
        P[i] = v; }
      for (int i = gt; i < 1024 * 20; i += ngt) { const int comp = i & 3, ln = (i >> 2) & 63, r = i >> 8, e4 = r % 5, jx = r / 5, kk = 4 * ln + 256 * (jx >> 2) + (jx & 3), col = 4 * e4 + comp;
          P[P_RW + i] = (col < 4) ? c.in[IN_WGRP][kk * 4 + col] : c.in[IN_WRT][kk * 16 + (col - 4)]; } }
}

constexpr int SCP = SEQ + 32;
constexpr int I_WQ = 16 * SCP * 4, I_CAND = I_WQ + 512, I_HIST = I_CAND + NWAVES * 320, IDX_LDS = I_HIST + NWAVES * 1280;
constexpr int NR = SEQ / 64, NGRP = NR / 8;
static_assert(NR % 8 == 0, "SEQ must be a multiple of 512");
DEV unsigned lds_add(LAS unsigned* p, unsigned v) {
#ifdef EMU
    return __atomic_fetch_add(p, v, __ATOMIC_RELAXED);
#else
    return __hip_atomic_fetch_add(p, v, __ATOMIC_RELAXED, __HIP_MEMORY_SCOPE_WORKGROUP);
#endif
}
DEV int rd_lane(int v, int l) {
#ifdef EMU
    return __shfl(v, l);
#else
    return __builtin_amdgcn_readlane(v, l);
#endif
}
DEV unsigned wr_lane(unsigned val, int l, unsigned old) {
#ifdef EMU
    return (e_lane == l) ? val : old;
#else
    return (((int)threadIdx.x & 63) == l) ? val : old;
#endif
}
DEV int wave_sum_int(int v) {
#ifdef EMU
#pragma unroll
    for (int o = 1; o < 64; o <<= 1) v += __shfl_xor(v, o);
    return v;
#else
    v += __builtin_amdgcn_update_dpp(0, v, 0x111, 0xf, 0xf, true);
    v += __builtin_amdgcn_update_dpp(0, v, 0x112, 0xf, 0xf, true);
    v += __builtin_amdgcn_update_dpp(0, v, 0x114, 0xf, 0xf, true);
    v += __builtin_amdgcn_update_dpp(0, v, 0x118, 0xf, 0xf, true);
    v += __builtin_amdgcn_update_dpp(0, v, 0x142, 0xa, 0xf, false);
    v += __builtin_amdgcn_update_dpp(0, v, 0x143, 0xc, 0xf, false);
    return __builtin_amdgcn_readlane(v, 63);
#endif
}
DEV void idx_select_row(const LAS float* scrow, int t, unsigned* out, LAS unsigned* cand_lds, int lane) {
    if (t + 1 <= TOPK) {
        if (lane < NWORDS) { const int lo = 32 * lane; out[lane] = (lo + 31 <= t) ? 0xffffffffu : (lo > t ? 0u : ((1u << (t - lo + 1)) - 1u)); }
        return;
    }
    const int ng = (t >> 9) + 1;
    const int tl = t - lane;
    unsigned key[NR];
#pragma unroll
    for (int g = 0; g < NGRP; ++g) {
#pragma unroll
        for (int r8 = 0; r8 < 8; ++r8) key[8 * g + r8] = 0u;
        if (g < ng) {
#pragma unroll
            for (int r8 = 0; r8 < 8; ++r8) { const int r = 8 * g + r8; const unsigned uu = fbits(scrow[r * 64 + lane]); const unsigned kk = uu ^ ((unsigned)((int)uu >> 31) | 0x80000000u); key[r] = (64 * r <= tl) ? kk : 0u; }
        }
    }
    unsigned smp;
    { const int gsel = (lane >> 4) % ng; unsigned s0 = key[0], s1 = key[8], s2 = key[16], s3 = key[24];
#ifndef EMU
      asm volatile("" : "+v"(s0), "+v"(s1), "+v"(s2), "+v"(s3));
#endif
      smp = (gsel == 1) ? s1 : (gsel == 2) ? s2 : (gsel == 3) ? s3 : s0; }
    const int nv = __popcll(__ballot(smp != 0u));
    smp = (smp & ~63u) | (unsigned)(63 - lane);
    int srank = 0;
#pragma unroll
    for (int j = 0; j < 64; ++j) { const unsigned sj = (unsigned)lane_bcast((int)smp, j); srank += (sj > smp) ? 1 : 0; }
    unsigned L = 1u, Hm = 0xffffffffu; int cntL = t + 1, cntH = 0, rL = nv, rH = -1;
    bool tie = false;
#pragma unroll 1
    for (;;) {
        if (cntL - cntH <= 64) break;
        if (Hm == L) { tie = true; break; }
        unsigned p; int rp = -2; const int between = rL - rH - 1;
        if (between > 0) { int o = (int)((float)(TOPK - cntH) * (float)between / (float)(cntL - cntH)); o = o < 0 ? 0 : (o > between - 1 ? between - 1 : o); rp = rH + 1 + o;
            const u64 mm = __ballot(srank == rp); p = (unsigned)lane_bcast((int)smp, (int)__builtin_ctzll(mm));
            if (p <= L || p > Hm) { rp = -2; p = L + ((Hm - L) >> 1) + 1u; } }
        else p = L + ((Hm - L) >> 1) + 1u;
        int cl = 0;
#pragma unroll
        for (int g = 0; g < NGRP; ++g) if (g < ng) {
#pragma unroll
            for (int r8 = 0; r8 < 8; ++r8) cl += (key[8 * g + r8] >= p) ? 1 : 0;
        }
        const int cc = wave_sum_int(cl);
        if (cc >= TOPK) { L = p; cntL = cc; if (rp >= 0) rL = rp; } else { Hm = p - 1u; cntH = cc; if (rp >= 0) rH = rp; }
    }
    unsigned lo; int cgt, cge; const int cnt_hi = cntH;
    if (!tie) {
        const int und = cntL - cntH; const u64 ltm = (lane == 0) ? 0ull : (~0ull >> (64 - lane)); int base = 0; const unsigned span = Hm - L;
#pragma unroll
        for (int g = 0; g < NGRP; ++g) if (g < ng) {
#pragma unroll
            for (int r8 = 0; r8 < 8; ++r8) { const unsigned k2 = key[8 * g + r8]; const bool f = (k2 - L) <= span; const u64 mm = __ballot(f);
                if (mm != 0ull) { if (f) cand_lds[(base + __popcll(mm & ltm)) & 63] = k2; base += __popcll(mm); } }
        }
        WAVE_SYNC();
        const bool cv = lane < und; const unsigned cand = cv ? cand_lds[lane] : 0u;
        WAVE_SYNC();
        const unsigned dx = L ^ Hm; int bit = dx ? 31 - (int)__builtin_clz(dx) : -1;
        lo = (bit >= 31) ? 0u : (L & ~((2u << (bit < 0 ? 0 : bit)) - 1u)); if (bit < 0) lo = L;
#pragma unroll 1
        for (; bit >= 0; --bit) { const unsigned trial = lo | (1u << bit); const int cc = cnt_hi + __popcll(__ballot(cv && cand >= trial)); if (cc >= TOPK) lo = trial; }
        cgt = cnt_hi + __popcll(__ballot(cv && cand > lo)); cge = cnt_hi + __popcll(__ballot(cv && cand >= lo));
    } else { lo = L; cge = cntL; cgt = cntH; }
    const int need = TOPK - cgt; unsigned mlo = 0u, mhi = 0u;
    if (cge - cgt == need) {
#pragma unroll
        for (int g = 0; g < NGRP; ++g) if (g < ng) {
#pragma unroll
            for (int r8 = 0; r8 < 8; ++r8) { const u64 mm = __ballot(key[8 * g + r8] >= lo); mlo = wr_lane((unsigned)mm, 8 * g + r8, mlo); mhi = wr_lane((unsigned)(mm >> 32), 8 * g + r8, mhi); }
        }
    } else {
        const u64 ltm = (lane == 0) ? 0ull : (~0ull >> (64 - lane)); int run = 0;
#pragma unroll
        for (int g = 0; g < NGRP; ++g) if (g < ng) {
#pragma unroll
            for (int r8 = 0; r8 < 8; ++r8) { const unsigned k2 = key[8 * g + r8]; const bool eqp = k2 == lo; const u64 eq = __ballot(eqp); const int rank = run + __popcll(eq & ltm);
                const bool sel = (k2 > lo) || (eqp && rank < need); const u64 mm = __ballot(sel); mlo = wr_lane((unsigned)mm, 8 * g + r8, mlo); mhi = wr_lane((unsigned)(mm >> 32), 8 * g + r8, mhi); run += __popcll(eq); }
        }
    }
    if (lane < NR) { u32x2 w; w.x = mlo; w.y = mhi; *(u32x2*)(out + 2 * lane) = w; }
}
DEV void idx_load_b(bf16x8 (&bf)[4], const bf16_t* KIDX, size_t rowb, int kc, int r32, int hi) {
    const bf16_t* p = KIDX + (rowb + kc * 32 + r32) * 64 + hi * 8;
#pragma unroll
    for (int ks = 0; ks < 4; ++ks) bf[ks] = *(const bf16x8*)(p + ks * 16);
}
DEV void idx_load_a(bf16x8 (&af)[4][4], const bf16_t* H, size_t rowb, int t0, int r32, int hi) {
    const int ah = (r32 & 3) + 4 * ((r32 >> 3) & 1), atl = 2 * (r32 >> 4) + ((r32 >> 2) & 1);
#pragma unroll
    for (int T = 0; T < 4; ++T)
#pragma unroll
        for (int ks = 0; ks < 4; ++ks) af[T][ks] = *(const bf16x8*)(H + (rowb + t0 + 4 * T + atl) * LDH + C_QI + ah * 64 + ks * 16 + hi * 8);
}
struct IdxQbRaw { unsigned q[8]; f32x4 w0, w1; };
DEV void idx_load_qb(IdxQbRaw& R, const bf16_t* H, const float* SM, size_t rowb, int t0, int tid) {
    const size_t row = rowb + t0 + (tid >> 5);
#pragma unroll
    for (int h = 0; h < 8; ++h) R.q[h] = *(const unsigned*)(H + row * LDH + C_QI + h * 64 + 2 * (tid & 31));
    R.w0 = *(const f32x4*)(SM + row * 16); R.w1 = *(const f32x4*)(SM + row * 16 + 4);
}
DEV void idx_units(const Ctx& c, int c2, int g2) {
    const int lane = c.lane, wid = c.wid, r32 = lane & 31, hi = lane >> 5;
    LAS float* sc = (LAS float*)c.lds; LAS float* WQ = (LAS float*)(c.lds + I_WQ); LAS unsigned* CAND = (LAS unsigned*)(c.lds + I_CAND) + wid * 80;
    LAS bf16_t* QBH = (LAS bf16_t*)(c.lds + I_HIST); LAS bf16_t* QBL = QBH + 16 * 72;
    const bf16_t* H = wsp<bf16_t>(c, WS_H); const bf16_t* KIDX = wsp<bf16_t>(c, WS_KIDX); const float* SM = wsp<float>(c, WS_SM);
    unsigned* MASK = wsp<unsigned>(c, WS_MASK);
    const int nq = SEQ / 16, nunits = NB * nq;
    bf16x8 af[4][4], afn[4][4]; IdxQbRaw qr;
    if (c2 < nunits) { idx_load_a(af, H, (size_t)(c2 % NB) * SEQ, (nq - 1 - c2 / NB) * 16, r32, hi); idx_load_qb(qr, H, SM, (size_t)(c2 % NB) * SEQ, (nq - 1 - c2 / NB) * 16, c.tid); }
    const int qrow = 2 * ((r32 & 3) + 4 * ((r32 >> 3) & 1)) + ((r32 >> 2) & 1);
    for (int u = c2; u < nunits; u += g2) {
        const int b = u % NB, qt = nq - 1 - u / NB, t0 = qt * 16; const size_t rowb = (size_t)b * SEQ;
        const int nkc = (t0 + 16 + 31) / 32;
        {
            const float wv[8] = {qr.w0[0], qr.w0[1], qr.w0[2], qr.w0[3], qr.w1[0], qr.w1[1], qr.w1[2], qr.w1[3]};
            float q0 = 0.f, q1 = 0.f;
#pragma unroll
            for (int h = 0; h < 8; ++h) { q0 += 0.5f * wv[h] * lo_bf(qr.q[h]); q1 += 0.5f * wv[h] * hi_bf(qr.q[h]); }
            const unsigned hw = pk2(q0, q1); const unsigned lw = pk2(q0 - lo_bf(hw), q1 - hi_bf(hw));
            *(LAS unsigned*)(QBH + (c.tid >> 5) * 72 + 2 * (c.tid & 31)) = hw; *(LAS unsigned*)(QBL + (c.tid >> 5) * 72 + 2 * (c.tid & 31)) = lw;
            if ((c.tid & 31) < 8) WQ[(c.tid >> 5) * 8 + (c.tid & 31)] = 0.5f * wv[c.tid & 31];
        }
        bf16x8 bq0[4], bq1[4], bq2[4];
        if (wid < nkc) idx_load_b(bq0, KIDX, rowb, wid, r32, hi);
        if (wid + NWAVES < nkc) idx_load_b(bq1, KIDX, rowb, wid + NWAVES, r32, hi);
        wg_sync();
#if P2PROBE && P2PROBE_KIND == 2
        const unsigned long long pk_t0 = rt_now();
#endif
        bf16x8 alq[4];
#pragma unroll
        for (int ks = 0; ks < 4; ++ks) alq[ks] = *(const LAS bf16x8*)(((r32 < 16) ? QBH : QBL) + qrow * 72 + ks * 16 + hi * 8);
#define IDX_CHUNK(BC, BP) { \
            if (kc + 2 * NWAVES < nkc) idx_load_b(BP, KIDX, rowb, kc + 2 * NWAVES, r32, hi); \
            const int key = kc * 32 + r32; \
            f32x16 al = {0.f, 0.f, 0.f, 0.f, 0.f, 0.f, 0.f, 0.f, 0.f, 0.f, 0.f, 0.f, 0.f, 0.f, 0.f, 0.f};       \
            _Pragma("unroll") for (int ks = 0; ks < 4; ++ks) al = mfma32(alq[ks], BC[ks], al); \
            _Pragma("unroll") for (int T = 0; T < 4; ++T) { \
                f32x16 a = {0.f, 0.f, 0.f, 0.f, 0.f, 0.f, 0.f, 0.f, 0.f, 0.f, 0.f, 0.f, 0.f, 0.f, 0.f, 0.f}; \
                _Pragma("unroll") for (int ks = 0; ks < 4; ++ks) a = mfma32(af[T][ks], BC[ks], a); \
                const int tq0 = 4 * T + hi; \
                const f32x4 w00 = *(const LAS f32x4*)(WQ + tq0 * 8), w01 = *(const LAS f32x4*)(WQ + tq0 * 8 + 4), w10 = *(const LAS f32x4*)(WQ + (tq0 + 2) * 8), w11 = *(const LAS f32x4*)(WQ + (tq0 + 2) * 8 + 4); \
                float s0 = al[2 * T] + al[2 * T + 8], s1 = al[2 * T + 1] + al[2 * T + 9];     \
                _Pragma("unroll") for (int i = 0; i < 4; ++i) { s0 += w00[i] * fabsf(a[i]) + w01[i] * fabsf(a[4 + i]); s1 += w10[i] * fabsf(a[8 + i]) + w11[i] * fabsf(a[12 + i]); } \
                sc[tq0 * SCP + key] = s0; sc[(tq0 + 2) * SCP + key] = s1; } \
            kc += NWAVES; }
        for (int kc = wid; kc < nkc; ) {
            IDX_CHUNK(bq0, bq2) if (kc >= nkc) break;
            IDX_CHUNK(bq1, bq0) if (kc >= nkc) break;
            IDX_CHUNK(bq2, bq1)
        }
#undef IDX_CHUNK
        const int un = u + g2;
        if (un < nunits) { idx_load_a(afn, H, (size_t)(un % NB) * SEQ, (nq - 1 - un / NB) * 16, r32, hi); idx_load_qb(qr, H, SM, (size_t)(un % NB) * SEQ, (nq - 1 - un / NB) * 16, c.tid); }
        LDS_SYNC();
#if P2PROBE && P2PROBE_KIND == 2
        if (c2 == 0 && c.tid == 0) { volatile LAS unsigned* mm = (volatile LAS unsigned*)(c.lds + (144 * 1024 - 64)); mm[4] = mm[4] + (unsigned)(rt_now() - pk_t0); }
#endif
#if P2PROBE && P2PROBE_KIND == 3
        const unsigned long long pk_t1 = rt_now();
#endif
#pragma unroll 1
        for (int qq = 0; qq < 2; ++qq) { const int tq = wid + 8 * qq, t = t0 + tq; idx_select_row(sc + tq * SCP, t, MASK + (rowb + t) * NWORDS, CAND, lane); }
        LDS_SYNC();
#if P2PROBE && P2PROBE_KIND == 3
        if (c2 == 0 && c.tid == 0) { volatile LAS unsigned* mm = (volatile LAS unsigned*)(c.lds + (144 * 1024 - 64)); mm[4] = mm[4] + (unsigned)(rt_now() - pk_t1); }
#endif
        if (un < nunits) {
#pragma unroll
            for (int T = 0; T < 4; ++T)
#pragma unroll
                for (int ks = 0; ks < 4; ++ks) af[T][ks] = afn[T][ks]; }
    }
    wg_sync();
}

constexpr int QP = 136, TP = 72;
constexpr int L_QS = 0, L_KS = L_QS + 64 * QP * 2, L_KT = L_KS + 64 * QP * 2, L_VT = L_KT + 128 * TP * 2, L_CT = L_VT + 128 * TP * 2, L_N = L_CT + 128 * QP * 2,
              L_G = L_N + 512, L_PART = L_G + NWAVES * 1280, L_CW = L_PART + 1024, L_GN = L_CW + 32 * 40 * 4, ML_LDS = L_GN + 512;
#ifndef EMU
template <int CTRL, int ROWMASK> DEV float dpp_f(float v, float ident) { return bitsf((unsigned)__builtin_amdgcn_update_dpp((int)fbits(ident), (int)fbits(v), CTRL, ROWMASK, 0xf, false)); }
#endif
DEV float scan_add(float v, int lane) {
#ifdef EMU
#pragma unroll
    for (int d = 1; d < 64; d <<= 1) { const float o = __shfl_up(v, d); if (lane >= d) v += o; }
#else
    v += dpp_f<0x111, 0xf>(v, 0.f); v += dpp_f<0x112, 0xf>(v, 0.f); v += dpp_f<0x114, 0xf>(v, 0.f); v += dpp_f<0x118, 0xf>(v, 0.f);
    v += dpp_f<0x142, 0xa>(v, 0.f); v += dpp_f<0x143, 0xc>(v, 0.f); (void)lane;
#endif
    return v;
}
DEV float scan_max(float v, int lane) {
#ifdef EMU
#pragma unroll
    for (int d = 1; d < 64; d <<= 1) { const float o = __shfl_up(v, d); if (lane >= d) v = fmaxf(v, o); }
#else
    const float ninf = -__builtin_inff();
    v = fmaxf(v, dpp_f<0x111, 0xf>(v, ninf)); v = fmaxf(v, dpp_f<0x112, 0xf>(v, ninf)); v = fmaxf(v, dpp_f<0x114, 0xf>(v, ninf)); v = fmaxf(v, dpp_f<0x118, 0xf>(v, ninf));
    v = fmaxf(v, dpp_f<0x142, 0xa>(v, ninf)); v = fmaxf(v, dpp_f<0x143, 0xc>(v, ninf)); (void)lane;
#endif
    return v;
}
DEV int tsw(int d) { return 2 * ((d >> 3) & 7); }
struct MlRaw { u32x4 qk[7]; u32x4 v[2]; float fp, ip; };
DEV void ml_load_gates(MlRaw& R, const float* SM, int b, int head, int ch, int lane, float bfg, float bi) {
    const float* base = SM + ((size_t)b * SEQ + (size_t)ch * 64) * 16 + head;
    R.fp = *(const float*)((const char*)base + (unsigned)(lane * 64 + 48)); R.ip = *(const float*)((const char*)base + (unsigned)(lane * 64 + 32)); (void)bfg; (void)bi;
}
DEV void ml_load_bulk(MlRaw& R, const bf16_t* H, int b, int head, int ch, unsigned qoff, unsigned voff, bool first_rows, int tid) {
    const size_t rowc = (size_t)b * SEQ + (size_t)ch * 64;
#pragma unroll
    for (int i = 0; i < 7; ++i) {
        const bool neg = first_rows && ch == 0 && i < 3;
        const bf16_t* base = H + ((long)rowc + i - 3) * LDH;
        R.qk[i] = *(const u32x4*)((const char*)base + (qoff + (neg ? 3u * LDH * 2u : 0u))); }
#pragma unroll
    for (int o = 0; o < 2; ++o) { const bf16_t* base = H + (rowc + o) * LDH + C_VM + head * 128; R.v[o] = *(const u32x4*)((const char*)base + voff); }
    (void)tid;
}
DEV void mlstm_unit(const Ctx& c, int b, int head) {
    int tid = c.tid; LAUNDER(tid);
    const int lane = tid & 63, wid = c.wid;
    LAS unsigned char* lds = c.lds;
    LAS bf16_t* QS = (LAS bf16_t*)(lds + L_QS); LAS bf16_t* KS = (LAS bf16_t*)(lds + L_KS); LAS bf16_t* KT = (LAS bf16_t*)(lds + L_KT);
    LAS bf16_t* VTs = (LAS bf16_t*)(lds + L_VT); LAS bf16_t* CT = (LAS bf16_t*)(lds + L_CT); LAS float* NV = (LAS float*)(lds + L_N);
    LAS float* GW = (LAS float*)(lds + L_G + wid * 1280); LAS float* PART = (LAS float*)(lds + L_PART);
    const bf16_t* H = wsp<bf16_t>(c, WS_H); const float* SM = wsp<float>(c, WS_SM); bf16_t* HM = wsp<bf16_t>(c, WS_H) + C_HM;
    const float bi = par(c, P_BI)[head], bfg = par(c, P_BF)[head];
    const int vt = wid >> 1, jt = wid & 1;
    const int which = tid >> 8, cg0 = tid & 15, rb0 = (tid & 255) >> 4;
    LAS float* CWL = (LAS float*)(lds + L_CW); LAS float* GNL = (LAS float*)(lds + L_GN);
    for (int i = tid; i < 32 * 40; i += NTHREADS) { const int grp = i / 40, e = i % 40, wh = grp >> 4, cgi = grp & 15, ch0 = wh * 512 + head * 128 + cgi * 8;
        CWL[i] = (e < 32) ? par(c, P_CONVW)[(e >> 3) * 1024 + ch0 + (e & 7)] : par(c, P_CONVB)[ch0 + (e - 32)]; }
    if (tid < 128) GNL[tid] = par(c, P_MHG)[head * 128 + tid];
    f32x16 accC[2];
#pragma unroll
    for (int x = 0; x < 2; ++x)
#pragma unroll
        for (int r = 0; r < 16; ++r) accC[x][r] = 0.f;
    for (int i = tid; i < 128 * QP / 2; i += NTHREADS) ((LAS unsigned*)CT)[i] = 0u;
    if (tid < 128) NV[tid] = 0.f;
    float m_prev = 0.f;
    const unsigned qoff = (unsigned)((rb0 * 4 * LDH + (which ? C_KM : C_QM) + head * 128 + cg0 * 8) * 2), voff = (unsigned)(((tid >> 4) * 2 * LDH + (tid & 15) * 8) * 2);
    MlRaw R; ml_load_gates(R, SM, b, head, 0, lane, bfg, bi); ml_load_bulk(R, H, b, head, 0, qoff, voff, rb0 == 0, tid);
    wg_sync();
#if P2PROBE
    unsigned long long mlp_t = 0;
#endif
    for (int ch = 0; ch < NCH; ++ch) {
        const size_t tok0 = (size_t)b * SEQ + (size_t)ch * 64;
        int tidc = tid; LAUNDER(tidc);
        const int lanec = tidc & 63, r32 = lanec & 31, hi = lanec >> 5, cg = tidc & 15, rb = (tidc & 255) >> 4;
        const LAS float* cwp = CWL + (which * 16 + cg) * 40;
        float wp, a_dec, m_new;
        {
            const float fp = R.fp + bfg, ip = R.ip + bi;
            const float lf = fminf(fp, 0.f) - __logf(1.0f + __expf(-fabsf(fp)));
            const float bcum = scan_add(lf, lanec);
            const float g = ip - bcum, gmax = scan_max(g, lanec);
            const float mj = fmaxf(bcum + m_prev, bcum + gmax);
            const float blast = __shfl(bcum, 63), gmx = __shfl(gmax, 63);
            m_new = fmaxf(blast + m_prev, blast + gmx);
            a_dec = __expf(blast + m_prev - m_new);
            wp = __expf(blast + g - m_new);
            GW[lanec] = g * LOG2E; GW[64 + lanec] = (bcum - mj) * LOG2E; GW[128 + lanec] = __expf(bcum + m_prev - mj); GW[192 + lanec] = __expf(-mj);
        }
#if P2PROBE && P2PROBE_KIND >= 11 && P2PROBE_KIND <= 14
        { const unsigned long long tn = rt_now(); if (P2PROBE_KIND == 12 && ch > 0 && c.bid == 0 && tid == 0) { volatile LAS unsigned* mm = (volatile LAS unsigned*)(c.lds + (144 * 1024 - 64)); mm[4] = mm[4] + (unsigned)(tn - mlp_t); } mlp_t = tn; }
#endif
        {
            float y[4][8];
#pragma unroll
            for (int o = 0; o < 4; ++o)
#pragma unroll
                for (int x = 0; x < 8; ++x) y[o][x] = cwp[32 + x];
#pragma unroll
            for (int i = 0; i < 7; ++i) {
                u32x4 raw = R.qk[i]; if (rb0 == 0 && ch == 0 && i < 3) { const u32x4 z = {0u, 0u, 0u, 0u}; raw = z; }
                const float rv[8] = {lo_bf(raw.x), hi_bf(raw.x), lo_bf(raw.y), hi_bf(raw.y), lo_bf(raw.z), hi_bf(raw.z), lo_bf(raw.w), hi_bf(raw.w)};
#pragma unroll
                for (int o = 0; o < 4; ++o) { const int j = i - o; if (j >= 0 && j < 4) {
#pragma unroll
                    for (int x = 0; x < 8; ++x) y[o][x] += cwp[j * 8 + x] * rv[x]; } }
            }
            float wpr[4];
#pragma unroll
            for (int o = 0; o < 4; ++o) wpr[o] = __shfl(wp, rb * 4 + o);
#pragma unroll
            for (int o = 0; o < 4; ++o) {
                const int rr = rb * 4 + o;
#pragma unroll
                for (int x = 0; x < 8; ++x) { const float v = y[o][x]; y[o][x] = v * sigmoidf_(v) * (which ? 0.08838834764831845f : 1.0f); }
                const bf16x8 pk = pack8(y[o][0], y[o][1], y[o][2], y[o][3], y[o][4], y[o][5], y[o][6], y[o][7]);
                if (which == 0) *(LAS bf16x8*)(QS + rr * QP + cg * 8) = pk; else *(LAS bf16x8*)(KS + rr * QP + cg * 8) = pk;
            }
            if (which) {
#pragma unroll
                for (int x = 0; x < 8; ++x) { const int d = cg * 8 + x; u32x2 w; w.x = pk2(y[0][x] * wpr[0], y[1][x] * wpr[1]); w.y = pk2(y[2][x] * wpr[2], y[3][x] * wpr[3]);
                    *(LAS u32x2*)(KT + d * TP + 4 * (rb ^ tsw(d))) = w; }
            }
            { const int cgv = tidc & 15, rg2 = tidc >> 4;
                const unsigned w0[4] = {R.v[0].x, R.v[0].y, R.v[0].z, R.v[0].w}, w1[4] = {R.v[1].x, R.v[1].y, R.v[1].z, R.v[1].w};
#pragma unroll
                for (int x2 = 0; x2 < 4; ++x2) {
                    const int d0 = cgv * 8 + 2 * x2;
                    *(LAS unsigned*)(VTs + d0 * TP + 4 * ((rg2 >> 1) ^ tsw(d0)) + 2 * (rg2 & 1)) = (w0[x2] & 0xffffu) | (w1[x2] << 16);
                    *(LAS unsigned*)(VTs + (d0 + 1) * TP + 4 * ((rg2 >> 1) ^ tsw(d0 + 1)) + 2 * (rg2 & 1)) = (w0[x2] >> 16) | (w1[x2] & 0xffff0000u); }
            }
        }
#if P2PROBE && P2PROBE_KIND >= 11 && P2PROBE_KIND <= 14
        { const unsigned long long tn = rt_now(); if (P2PROBE_KIND == 13 && c.bid == 0 && tid == 0) { volatile LAS unsigned* mm = (volatile LAS unsigned*)(c.lds + (144 * 1024 - 64)); mm[4] = mm[4] + (unsigned)(tn - mlp_t); } mlp_t = tn; }
#endif
        if (ch + 1 < NCH) { ml_load_gates(R, SM, b, head, ch + 1, lanec, bfg, bi); ml_load_bulk(R, H, b, head, ch + 1, qoff, voff, rb0 == 0, tid); }
#if P2PROBE && P2PROBE_KIND >= 11 && P2PROBE_KIND <= 14
        { const unsigned long long tn = rt_now(); if (P2PROBE_KIND == 14 && c.bid == 0 && tid == 0) { volatile LAS unsigned* mm = (volatile LAS unsigned*)(c.lds + (144 * 1024 - 64)); mm[4] = mm[4] + (unsigned)(tn - mlp_t); } mlp_t = tn; }
#endif
        LDS_SYNC();
#if P2PROBE && (P2PROBE_KIND == 9 || P2PROBE_KIND == 10)
        { const unsigned long long tn = rt_now(); if (P2PROBE_KIND == 10 && ch > 0 && c.bid == 0 && tid == 0) { volatile LAS unsigned* mm = (volatile LAS unsigned*)(c.lds + (144 * 1024 - 64)); mm[4] = mm[4] + (unsigned)(tn - mlp_t); } mlp_t = tn; }
#endif
        float hval[16]; const int jl = 32 * jt + r32;
        u32x2 sgv[4];
        { const char* sgb = (const char*)(H + tok0 * LDH + C_OM + head * 128); const unsigned sgo = (unsigned)((jl * LDH + 32 * vt + 8 * hi) * 2);
#pragma unroll
          for (int p = 0; p < 2; ++p) { const u32x4 t = *(const u32x4*)(sgb + (sgo + 32u * p)); sgv[2 * p].x = t.x; sgv[2 * p].y = t.y; sgv[2 * p + 1].x = t.z; sgv[2 * p + 1].y = t.w; } }
        {
            const float ejl = GW[64 + jl], wint = GW[128 + jl], flo = GW[192 + jl];
            f32x16 num = {0.f, 0.f, 0.f, 0.f, 0.f, 0.f, 0.f, 0.f, 0.f, 0.f, 0.f, 0.f, 0.f, 0.f, 0.f, 0.f};
            float den = 0.f;
            bf16x8 qf[8];
#pragma unroll
            for (int ks = 0; ks < 8; ++ks) qf[ks] = *(const LAS bf16x8*)(QS + jl * QP + ks * 16 + hi * 8);
            const int dv = 32 * vt + r32, swv = tsw(dv);
#pragma unroll
            for (int a = 0; a < 2; ++a) {
                if (a <= jt) {
                    f32x16 st = {0.f, 0.f, 0.f, 0.f, 0.f, 0.f, 0.f, 0.f, 0.f, 0.f, 0.f, 0.f, 0.f, 0.f, 0.f, 0.f};
#pragma unroll
                    for (int ks = 0; ks < 8; ++ks) st = mfma32(*(const LAS bf16x8*)(KS + (32 * a + r32) * QP + ks * 16 + hi * 8), qf[ks], st);
                    float pv[16];
#pragma unroll
                    for (int g4 = 0; g4 < 4; ++g4) { const int sb = 32 * a + 8 * g4 + 4 * hi; const f32x4 gg = *(const LAS f32x4*)(GW + sb);
#pragma unroll
                        for (int x = 0; x < 4; ++x) { const int s = sb + x; const float v = (s <= jl) ? st[4 * g4 + x] * fast_exp2(gg[x] + ejl) : 0.f; pv[4 * g4 + x] = v; den += v; } }
#pragma unroll
                    for (int s2 = 0; s2 < 2; ++s2) {
                        const bf16x8 pf = pack8(pv[8 * s2], pv[8 * s2 + 1], pv[8 * s2 + 2], pv[8 * s2 + 3], pv[8 * s2 + 4], pv[8 * s2 + 5], pv[8 * s2 + 6], pv[8 * s2 + 7]);
                        const int b0 = 8 * a + 4 * s2 + hi;
                        const s16x4 v0 = *(const LAS s16x4*)(VTs + dv * TP + 4 * (b0 ^ swv)), v1 = *(const LAS s16x4*)(VTs + dv * TP + 4 * ((b0 + 2) ^ swv));
                        const bf16x8 vf = {v0[0], v0[1], v0[2], v0[3], v1[0], v1[1], v1[2], v1[3]};
                        num = mfma32(vf, pf, num);
                    }
                }
            }
            f32x16 ni = {0.f, 0.f, 0.f, 0.f, 0.f, 0.f, 0.f, 0.f, 0.f, 0.f, 0.f, 0.f, 0.f, 0.f, 0.f, 0.f};
#pragma unroll
            for (int ks = 0; ks < 8; ++ks) ni = mfma32(*(const LAS bf16x8*)(CT + (32 * vt + r32) * QP + ks * 16 + hi * 8), qf[ks], ni);
            float qn = 0.f;
#pragma unroll
            for (int ks = 0; ks < 8; ++ks) { const f32x4 n0 = *(const LAS f32x4*)(NV + 16 * ks + 8 * hi), n1 = *(const LAS f32x4*)(NV + 16 * ks + 8 * hi + 4); const u32x4 qw = __builtin_bit_cast(u32x4, qf[ks]);
                qn += lo_bf(qw.x) * n0[0] + hi_bf(qw.x) * n0[1] + lo_bf(qw.y) * n0[2] + hi_bf(qw.y) * n0[3] + lo_bf(qw.z) * n1[0] + hi_bf(qw.z) * n1[1] + lo_bf(qw.w) * n1[2] + hi_bf(qw.w) * n1[3]; }
            qn = sum_xor32(qn); den = sum_xor32(den);
            const float dtot = den + wint * qn; const float inv = fast_rcp(fmaxf(fabsf(dtot), flo));
            float ssq = 0.f;
#pragma unroll
            for (int r = 0; r < 16; ++r) { hval[r] = (num[r] + wint * ni[r]) * inv; ssq += hval[r] * hval[r]; }
            ssq = sum_xor32(ssq);
            if (hi == 0) PART[vt * 64 + jl] = ssq;
        }
        float nsum;
        {
            const int dv = 32 * vt + r32, swv = tsw(dv);
#pragma unroll
            for (int x = 0; x < 2; ++x) { const int kt = 2 * jt + x; const int dk = 32 * kt + r32, swk = tsw(dk);
#pragma unroll
                for (int r = 0; r < 16; ++r) accC[x][r] *= a_dec;
#pragma unroll
                for (int ks = 0; ks < 4; ++ks) accC[x] = mfma32(*(const LAS bf16x8*)(VTs + dv * TP + 4 * ((4 * ks + 2 * hi) ^ swv)), *(const LAS bf16x8*)(KT + dk * TP + 4 * ((4 * ks + 2 * hi) ^ swk)), accC[x]); }
            { const int kd = 16 * wid + (lanec & 15), sq = lanec >> 4; float s = 0.f;
              const u32x4 k0 = *(const LAS u32x4*)(KT + kd * TP + 16 * sq), k1 = *(const LAS u32x4*)(KT + kd * TP + 16 * sq + 8);
              s = (lo_bf(k0.x) + hi_bf(k0.x)) + (lo_bf(k0.y) + hi_bf(k0.y)) + (lo_bf(k0.z) + hi_bf(k0.z)) + (lo_bf(k0.w) + hi_bf(k0.w)) + (lo_bf(k1.x) + hi_bf(k1.x)) + (lo_bf(k1.y) + hi_bf(k1.y)) + (lo_bf(k1.z) + hi_bf(k1.z)) + (lo_bf(k1.w) + hi_bf(k1.w));
              s += __shfl_xor(s, 16); s += __shfl_xor(s, 32); nsum = s; }
        }
        LDS_SYNC();
#if P2PROBE && P2PROBE_KIND >= 11 && P2PROBE_KIND <= 14
        mlp_t = rt_now();
#endif
#if P2PROBE && (P2PROBE_KIND == 9 || P2PROBE_KIND == 10)
        { const unsigned long long tn = rt_now(); if (P2PROBE_KIND == 9 && c.bid == 0 && tid == 0) { volatile LAS unsigned* mm = (volatile LAS unsigned*)(c.lds + (144 * 1024 - 64)); mm[4] = mm[4] + (unsigned)(tn - mlp_t); } mlp_t = tn; }
#endif
        {
#pragma unroll
            for (int x = 0; x < 2; ++x) { const int kt = 2 * jt + x;
#pragma unroll
                for (int r = 0; r < 16; r += 2) { const unsigned w2 = pk2(accC[x][r], accC[x][r + 1]);
                    CT[(32 * vt + crow(r, hi)) * QP + 32 * kt + r32] = (bf16_t)(w2 & 0xffffu); CT[(32 * vt + crow(r + 1, hi)) * QP + 32 * kt + r32] = (bf16_t)(w2 >> 16); } }
            { const int kd = 16 * wid + (lanec & 15), sq = lanec >> 4; const float nn = a_dec * NV[kd] + nsum; if (sq == 0) NV[kd] = nn; }
            const float stot = (PART[jl] + PART[64 + jl]) + (PART[128 + jl] + PART[192 + jl]);
            const float rstd = fast_rsq(stot * (1.0f / 128.0f) + LN_EPS);
            char* hmb = (char*)(HM + tok0 * LDH + head * 128);
            const unsigned hmo = (unsigned)((jl * LDH + 32 * vt + 8 * hi) * 2);
#pragma unroll
            for (int p = 0; p < 2; ++p) { unsigned ax = sgv[2 * p].x, ay = sgv[2 * p].y, bx = sgv[2 * p + 1].x, by = sgv[2 * p + 1].y; swap_halves(ax, bx, lanec); swap_halves(ay, by, lanec);
                sgv[2 * p].x = ax; sgv[2 * p].y = ay; sgv[2 * p + 1].x = bx; sgv[2 * p + 1].y = by; }
            u32x2 ov[4];
#pragma unroll
            for (int g4 = 0; g4 < 4; ++g4) { const int v0 = 32 * vt + 8 * g4 + 4 * hi; const f32x4 gq = *(const LAS f32x4*)(GNL + v0);
                const u32x2 sg = sgv[g4];
                ov[g4].x = pk2(hval[4 * g4] * rstd * gq[0] * lo_bf(sg.x), hval[4 * g4 + 1] * rstd * gq[1] * hi_bf(sg.x));
                ov[g4].y = pk2(hval[4 * g4 + 2] * rstd * gq[2] * lo_bf(sg.y), hval[4 * g4 + 3] * rstd * gq[3] * hi_bf(sg.y)); }
#pragma unroll
            for (int p = 0; p < 2; ++p) { unsigned ax = ov[2 * p].x, ay = ov[2 * p].y, bx = ov[2 * p + 1].x, by = ov[2 * p + 1].y; swap_halves(ax, bx, lanec); swap_halves(ay, by, lanec);
                u32x4 w; w.x = ax; w.y = ay; w.z = bx; w.w = by; *(u32x4*)(hmb + (hmo + 32u * p)) = w; }
        }
#if P2PROBE && P2PROBE_KIND >= 11 && P2PROBE_KIND <= 14
        { const unsigned long long tn = rt_now(); if (P2PROBE_KIND == 11 && c.bid == 0 && tid == 0) { volatile LAS unsigned* mm = (volatile LAS unsigned*)(c.lds + (144 * 1024 - 64)); mm[4] = mm[4] + (unsigned)(tn - mlp_t); } mlp_t = tn; }
#endif
        m_prev = m_new;
    }
    LDS_SYNC();
}

constexpr int KP = 72, VP = 68;
constexpr int A_KS = 0, A_VS = 2 * 64 * KP * 2, A_BT = A_VS + 2 * 64 * VP * 2, AT_LDS = A_BT + 129 * 4 + 12;
DEV int t5_bucket(int d) {
    if (d < 16) return d;
    if (d >= 114) return 31;
    int bk = 16;
    const int th[15] = {19, 21, 24, 27, 31, 35, 40, 46, 52, 59, 67, 77, 87, 99, 113};
#pragma unroll
    for (int i = 0; i < 15; ++i) bk += (d >= th[i]) ? 1 : 0;
    return bk;
}
DEV void attn_unit(const Ctx& c, int b, int h, int qb) {
    const int tid = c.tid, lane = c.lane, wid = c.wid, r32 = lane & 31, hi = lane >> 5;
    LAS unsigned char* lds = c.lds;
    LAS bf16_t* Ks = (LAS bf16_t*)(lds + A_KS); LAS bf16_t* Vs = (LAS bf16_t*)(lds + A_VS); LAS float* BT = (LAS float*)(lds + A_BT);
    bf16_t* Hq = wsp<bf16_t>(c, WS_H); const bf16_t* Kb = wsp<bf16_t>(c, WS_K); const bf16_t* VT = wsp<bf16_t>(c, WS_VT); const unsigned* MASK = wsp<unsigned>(c, WS_MASK);
    const size_t rowb = (size_t)b * SEQ; const int q0 = qb * 256, qw0 = q0 + 32 * wid, q = qw0 + r32;
    const int NT = (q0 + 256) / 64;
    if (tid <= 128) { const float far = par(c, P_RELB)[31 * 8 + h]; BT[tid] = (tid < 128) ? (par(c, P_RELB)[t5_bucket(tid) * 8 + h] - far) * LOG2E : 0.f; }
    bf16x8 qf[4];
#pragma unroll
    for (int ks = 0; ks < 4; ++ks) qf[ks] = *(const bf16x8*)(Hq + (rowb + q) * LDH + C_QA + h * 64 + ks * 16 + hi * 8);
    const int srow = tid >> 3, spc = tid & 7;
    const bf16_t* ksrc = Kb + (rowb + srow) * 512 + h * 64 + spc * 8;
    const bf16_t* vsrc = VT + (size_t)(h * 64 + srow) * M + rowb + spc * 8;
    u32x4 kreg = *(const u32x4*)ksrc, vreg = *(const u32x4*)vsrc;
    *(LAS u32x4*)(Ks + srow * KP + spc * 8) = kreg;
    { LAS u32x2* vd = (LAS u32x2*)(Vs + srow * VP + spc * 8); u32x2 a = {vreg.x, vreg.y}, bb = {vreg.z, vreg.w}; vd[0] = a; vd[1] = bb; }
    float mhat = 0.f, lsum = 0.f;
    f32x16 o[2], negm;
#pragma unroll
    for (int r = 0; r < 16; ++r) negm[r] = 0.f;
#pragma unroll
    for (int d = 0; d < 2; ++d)
#pragma unroll
        for (int r = 0; r < 16; ++r) o[d][r] = 0.f;
    const unsigned* mrow = MASK + (rowb + q) * NWORDS;
    u32x2 mwn = *(const u32x2*)mrow;
    wg_sync();
    for (int kt = 0; kt < NT; ++kt) {
        const int buf = kt & 1;
        const u32x2 mw = mwn;
        if (kt + 1 < NT) { kreg = *(const u32x4*)(ksrc + (size_t)(kt + 1) * 64 * 512); vreg = *(const u32x4*)(vsrc + (size_t)(kt + 1) * 64); mwn = *(const u32x2*)(mrow + 2 * (kt + 1)); }
        if (64 * kt <= qw0 + 31) {
            const LAS bf16_t* kb = Ks + buf * 64 * KP; const LAS bf16_t* vb = Vs + buf * 64 * VP;
            f32x16 s[2];
#pragma unroll
            for (int a = 0; a < 2; ++a) {
                s[a] = negm;
#pragma unroll
                for (int ks = 0; ks < 4; ++ks) s[a] = mfma32(*(const LAS bf16x8*)(kb + (32 * a + r32) * KP + ks * 16 + hi * 8), qf[ks], s[a]);
            }
            if (64 * kt + 63 + 128 > qw0) {
#pragma unroll
                for (int a = 0; a < 2; ++a)
#pragma unroll
                    for (int r = 0; r < 16; ++r) { int d = q - (64 * kt + 32 * a + crow(r, hi)); d = d < 0 ? 128 : (d > 128 ? 128 : d); s[a][r] += BT[d]; }
            }
            float mx = s[0][0];
#pragma unroll
            for (int a = 0; a < 2; ++a)
#pragma unroll
                for (int r = 0; r < 16; ++r) mx = fmaxf(mx, s[a][r]);
            mx = max_xor32(mx);
            if (kt == 0 || WAVE_ANY(mx > 8.0f)) {
                const float dl = (kt == 0) ? mx : fmaxf(mx, 0.f);
                mhat += dl;
#pragma unroll
                for (int a = 0; a < 2; ++a)
#pragma unroll
                    for (int r = 0; r < 16; ++r) s[a][r] -= dl;
#pragma unroll
                for (int r = 0; r < 16; ++r) negm[r] = -mhat;
                if (kt != 0) { const float f = fast_exp2(-dl); lsum *= f;
#pragma unroll
                    for (int d = 0; d < 2; ++d)
#pragma unroll
                        for (int r = 0; r < 16; ++r) o[d][r] *= f; }
            }
            float ps = 0.f;
#pragma unroll
            for (int a = 0; a < 2; ++a) {
                const unsigned w = (a ? mw.y : mw.x) >> (4 * hi);
                float p[16];
#pragma unroll
                for (int r = 0; r < 16; ++r) { const float e = fast_exp2(s[a][r]); const unsigned mbit = bit_spread(w, (r & 3) + 8 * (r >> 2)); p[r] = bitsf(fbits(e) & mbit); ps += p[r]; }
#pragma unroll
                for (int s2 = 0; s2 < 2; ++s2) {
                    const bf16x8 pf = pack8(p[8 * s2], p[8 * s2 + 1], p[8 * s2 + 2], p[8 * s2 + 3], p[8 * s2 + 4], p[8 * s2 + 5], p[8 * s2 + 6], p[8 * s2 + 7]);
#pragma unroll
                    for (int d = 0; d < 2; ++d) {
                        const LAS bf16_t* vp = vb + (32 * d + r32) * VP + 32 * a + 16 * s2 + 4 * hi;
                        const s16x4 v0 = *(const LAS s16x4*)vp, v1 = *(const LAS s16x4*)(vp + 8);
                        const bf16x8 vf = {v0[0], v0[1], v0[2], v0[3], v1[0], v1[1], v1[2], v1[3]};
                        o[d] = mfma32(vf, pf, o[d]);
                    }
                }
            }
            lsum += ps;
        }
        if (kt + 1 < NT) {
            const int nb = buf ^ 1;
            *(LAS u32x4*)(Ks + nb * 64 * KP + srow * KP + spc * 8) = kreg;
            LAS u32x2* vd = (LAS u32x2*)(Vs + nb * 64 * VP + srow * VP + spc * 8); u32x2 a = {vreg.x, vreg.y}, bb = {vreg.z, vreg.w}; vd[0] = a; vd[1] = bb;
        }
        wg_sync();
    }
    lsum = sum_xor32(lsum);
    const float il = 1.0f / lsum;
#pragma unroll
    for (int d = 0; d < 2; ++d)
#pragma unroll
        for (int g4 = 0; g4 < 4; ++g4) { u32x2 w; w.x = pk2(o[d][4 * g4] * il, o[d][4 * g4 + 1] * il); w.y = pk2(o[d][4 * g4 + 2] * il, o[d][4 * g4 + 3] * il);
            *(u32x2*)(Hq + (rowb + q) * LDH + C_OA + h * 64 + 32 * d + 8 * g4 + 4 * hi) = w; }
}

DEV void ln_row(const f32x4 (&v)[4], const f32x4 (&gg)[4], const f32x4 (&bb)[4], f32x4 (&y)[4]) {
    float s = 0.f;
#pragma unroll
    for (int j = 0; j < 4; ++j) s += (v[j][0] + v[j][1]) + (v[j][2] + v[j][3]);
    const float mean = wave_sum(s) * (1.0f / DM); float s2 = 0.f;
#pragma unroll
    for (int j = 0; j < 4; ++j) { const f32x4 d = v[j] - mean; s2 += (d[0] * d[0] + d[1] * d[1]) + (d[2] * d[2] + d[3] * d[3]); }
    const float rstd = fast_rsq(wave_sum(s2) * (1.0f / DM) + LN_EPS);
#pragma unroll
    for (int j = 0; j < 4; ++j) y[j] = (v[j] - mean) * rstd * gg[j] + bb[j];
}
typedef float f32x2v __attribute__((ext_vector_type(2)));
DEV void phase_ln1_router(const Ctx& c) {
    LAS float* RW = (LAS float*)c.lds; LAS int* LC = (LAS int*)(c.lds + 1024 * 20 * 4); LAS int* GB = LC + 16; LAS float* LOGT = (LAS float*)(c.lds + 1024 * 20 * 4 + 256);
    { const f32x4* src = (const f32x4*)par(c, P_RW); f32x4 t[10];
#pragma unroll
      for (int i = 0; i < 10; ++i) t[i] = src[c.tid + NTHREADS * i];
#pragma unroll
      for (int i = 0; i < 10; ++i) ((LAS f32x4*)RW)[c.tid + NTHREADS * i] = t[i]; }
    if (c.tid < 16) LC[c.tid] = 0;
    wg_sync();
    const bf16_t* Z = wsp<bf16_t>(c, WS_Z); bf16_t* X1B = wsp<bf16_t>(c, WS_X1B);
    int* TOKE = wsp<int>(c, WS_TOK); int* TOKS = TOKE + 2 * M; float* TOKW = (float*)(TOKS + 2 * M);
    const int rpw = (M + c.G - 1) / c.G, r0 = c.bid * rpw, r1 = (r0 + rpw < M) ? r0 + rpw : M;
    constexpr int NEXIT = NE * (16 * 32 + 8 * 32);
    LAS float* exscr = (LAS float*)(c.lds + 1024 * 20 * 4 + 256 + 16384) + c.wid * (32 * 33);
    int exit_ = c.bid * NWAVES + c.wid; const int exstep = c.G * NWAVES; float exv[32]; bool exhave = exit_ < NEXIT;
    if (exhave) ex_load(exv, c, exit_, c.lane);
    f32x4 lng[4], lnb[4];
#pragma unroll
    for (int j = 0; j < 4; ++j) { lng[j] = *((const f32x4*)par(c, P_LN1G) + c.lane + 64 * j); lnb[j] = *((const f32x4*)par(c, P_LN1B) + c.lane + 64 * j); }
    const float bgrp[4] = {par(c, P_BGRP)[0], par(c, P_BGRP)[1], par(c, P_BGRP)[2], par(c, P_BGRP)[3]};
    u32x2 za[4], zb[4];
    { const int m = r0 + c.wid; if (m < r1) { const int m2 = (m + NWAVES < r1) ? m + NWAVES : m;
#pragma unroll
        for (int j = 0; j < 4; ++j) { za[j] = *((const u32x2*)(Z + (size_t)m * DM) + c.lane + 64 * j); zb[j] = *((const u32x2*)(Z + (size_t)m2 * DM) + c.lane + 64 * j); } } }
    for (int m = r0 + c.wid; m < r1; m += 2 * NWAVES) {
        const bool two = m + NWAVES < r1; const int m2 = two ? m + NWAVES : m;
        f32x4 va[4], vb[4], ya[4], yb[4];
#pragma unroll
        for (int j = 0; j < 4; ++j) { const f32x4 ta = {lo_bf(za[j].x), hi_bf(za[j].x), lo_bf(za[j].y), hi_bf(za[j].y)}; va[j] = ta; const f32x4 tb = {lo_bf(zb[j].x), hi_bf(zb[j].x), lo_bf(zb[j].y), hi_bf(zb[j].y)}; vb[j] = tb; }
        { const int mn = m + 2 * NWAVES; if (mn < r1) { const int mn2 = (mn + NWAVES < r1) ? mn + NWAVES : mn;
#pragma unroll
            for (int j = 0; j < 4; ++j) { za[j] = *((const u32x2*)(Z + (size_t)mn * DM) + c.lane + 64 * j); zb[j] = *((const u32x2*)(Z + (size_t)mn2 * DM) + c.lane + 64 * j); } } }
        ln_row(va, lng, lnb, ya);
        ln_row(vb, lng, lnb, yb);
#pragma unroll
        for (int j = 0; j < 4; ++j) { u32x2 w; w.x = pk2(ya[j][0], ya[j][1]); w.y = pk2(ya[j][2], ya[j][3]); *((u32x2*)(X1B + (size_t)m * DM) + c.lane + 64 * j) = w;
            if (two) { u32x2 w2; w2.x = pk2(yb[j][0], yb[j][1]); w2.y = pk2(yb[j][2], yb[j][3]); *((u32x2*)(X1B + (size_t)m2 * DM) + c.lane + 64 * j) = w2; } }
        f32x2v ga0 = {0.f, 0.f}, ga1 = {0.f, 0.f}, gb0 = {0.f, 0.f}, gb1 = {0.f, 0.f};
#pragma unroll
        for (int j = 0; j < 4; ++j)
#pragma unroll
            for (int x = 0; x < 4; ++x) { const f32x2v xa = {ya[j][x], ya[j][x]}, xb = {yb[j][x], yb[j][x]};
                const f32x4 w = *(const LAS f32x4*)(RW + (((j * 4 + x) * 5) * 64 + c.lane) * 4); const f32x2v w0 = {w[0], w[1]}, w1 = {w[2], w[3]};
                ga0 += xa * w0; ga1 += xa * w1; gb0 += xb * w0; gb1 += xb * w1; }
        const float lga[4] = {wave_sum(ga0.x), wave_sum(ga0.y), wave_sum(ga1.x), wave_sum(ga1.y)}, lgb[4] = {wave_sum(gb0.x), wave_sum(gb0.y), wave_sum(gb1.x), wave_sum(gb1.y)};
        int gia = 0, gib = 0;
        { float ta = lga[0] + bgrp[0], tb = lgb[0] + bgrp[0];
#pragma unroll
          for (int j = 1; j < 4; ++j) { const float ua = lga[j] + bgrp[j], ub = lgb[j] + bgrp[j]; if (ua > ta) { ta = ua; gia = j; } if (ub > tb) { tb = ub; gib = j; } } }
#ifndef EMU
        gia = __builtin_amdgcn_readfirstlane(gia); gib = __builtin_amdgcn_readfirstlane(gib);
#endif
        f32x2v ea0 = {0.f, 0.f}, ea1 = {0.f, 0.f}, eb0 = {0.f, 0.f}, eb1 = {0.f, 0.f};
        const LAS float* RWa = RW + ((1 + gia) * 64 + c.lane) * 4; const LAS float* RWb = RW + ((1 + gib) * 64 + c.lane) * 4;
#pragma unroll
        for (int j = 0; j < 4; ++j)
#pragma unroll
            for (int x = 0; x < 4; ++x) { const f32x2v xa = {ya[j][x], ya[j][x]}, xb = {yb[j][x], yb[j][x]};
                const f32x4 wa = *(const LAS f32x4*)(RWa + ((j * 4 + x) * 5) * 64 * 4), wb = *(const LAS f32x4*)(RWb + ((j * 4 + x) * 5) * 64 * 4);
                const f32x2v wa0 = {wa[0], wa[1]}, wa1 = {wa[2], wa[3]}, wb0 = {wb[0], wb[1]}, wb1 = {wb[2], wb[3]};
                ea0 += xa * wa0; ea1 += xa * wa1; eb0 += xb * wb0; eb1 += xb * wb1; }
        const float lea[4] = {wave_sum(ea0.x), wave_sum(ea0.y), wave_sum(ea1.x), wave_sum(ea1.y)}, leb[4] = {wave_sum(eb0.x), wave_sum(eb0.y), wave_sum(eb1.x), wave_sum(eb1.y)};
        if (c.lane == 0) {
            LAS f32x4* lp = (LAS f32x4*)(LOGT + (m - r0) * 20);
            { const f32x4 t = {lga[0], lga[1], lga[2], lga[3]}; lp[0] = t; const f32x4 t2 = {lea[0], lea[1], lea[2], lea[3]}; lp[1 + gia] = t2; }
            if (two) { LAS f32x4* lp2 = (LAS f32x4*)(LOGT + (m2 - r0) * 20);
                const f32x4 t = {lgb[0], lgb[1], lgb[2], lgb[3]}; lp2[0] = t; const f32x4 t2 = {leb[0], leb[1], leb[2], leb[3]}; lp2[1 + gib] = t2; }
        }
        if (exhave) { ex_finish(exv, c, exit_, exscr, c.lane); exit_ += exstep; exhave = exit_ < NEXIT; if (exhave) ex_load(exv, c, exit_, c.lane); }
    }
    while (exhave) { ex_finish(exv, c, exit_, exscr, c.lane); exit_ += exstep; exhave = exit_ < NEXIT; if (exhave) ex_load(exv, c, exit_, c.lane); }
    wg_sync();
    for (int rr = c.tid; rr < r1 - r0; rr += NTHREADS) {
        const int m = r0 + rr; float lg[20];
#pragma unroll
        for (int e4 = 0; e4 < 5; ++e4) { const f32x4 t = *(const LAS f32x4*)(LOGT + rr * 20 + 4 * e4); lg[4 * e4] = t[0]; lg[4 * e4 + 1] = t[1]; lg[4 * e4 + 2] = t[2]; lg[4 * e4 + 3] = t[3]; }
        float gl[4]; int gi = 0;
#pragma unroll
        for (int j = 0; j < 4; ++j) gl[j] = lg[j] + par(c, P_BGRP)[j];
#pragma unroll
        for (int j = 1; j < 4; ++j) if (gl[j] > gl[gi]) gi = j;
        float se = 0.f;
#pragma unroll
        for (int j = 0; j < 4; ++j) se += __expf(gl[j] - gl[gi]);
        const float gw = 1.0f / se;
        float el[4];
#pragma unroll
        for (int j = 0; j < 4; ++j) { float t = 0.f;
#pragma unroll
            for (int g2 = 0; g2 < 4; ++g2) if (g2 == gi) t = lg[4 + 4 * g2 + j] + par(c, P_BRT)[4 * g2 + j];
            el[j] = t; }
        int i0 = 0;
#pragma unroll
        for (int j = 1; j < 4; ++j) if (el[j] > el[i0]) i0 = j;
        int i1 = (i0 == 0) ? 1 : 0;
#pragma unroll
        for (int j = 0; j < 4; ++j) if (j != i0 && el[j] > el[i1]) i1 = j;
        const float p1 = 1.0f / (1.0f + __expf(el[i1] - el[i0]));
        const int e0 = gi * 4 + i0, e1 = gi * 4 + i1;
        const int s0 = atomicAdd((int*)&LC[e0], 1), s1 = atomicAdd((int*)&LC[e1], 1);
        TOKE[2 * m] = e0; TOKE[2 * m + 1] = e1; TOKS[2 * m] = s0; TOKS[2 * m + 1] = s1; TOKW[2 * m] = p1 * gw; TOKW[2 * m + 1] = (1.0f - p1) * gw;
    }
#ifndef EMU
    __threadfence_block();
#endif
    wg_sync();
    if (c.tid < 16) GB[c.tid] = (int)atomicAdd(wsp<unsigned>(c, WS_CTL) + CW_CNT + c.tid, (unsigned)LC[c.tid]);
    wg_sync();
    { int* RT2 = wsp<int>(c, WS_RT2);
      for (int i = r0 * 2 + c.tid; i < r1 * 2; i += NTHREADS) { const int e = TOKE[i], s = TOKS[i] + GB[e]; TOKS[i] = s; RT2[(size_t)e * M + s] = i >> 1; } }
}
DEV void moe_bases(const Ctx& c, int (&base)[NE], int& total_tiles) {
    const unsigned* cnt = wsp<unsigned>(c, WS_CTL) + CW_CNT; int acc = 0;
#pragma unroll
    for (int e = 0; e < NE; ++e) { base[e] = acc; acc += (((int)cnt[e] + 255) / 256) * 256; }
    total_tiles = acc / 256;
}
DEV void phase_final(const Ctx& c) {
    int base[NE], nt; moe_bases(c, base, nt);
    const bf16_t* O2 = wsp<bf16_t>(c, WS_O2); const bf16_t* X1B = wsp<bf16_t>(c, WS_X1B);
    const int* TOKE = wsp<int>(c, WS_TOK); const int* TOKS = TOKE + 2 * M; const float* TOKW = (const float*)(TOKS + 2 * M);
    const int gw = c.bid * NWAVES + c.wid, NGW = c.G * NWAVES;
    f32x4 lng[4], lnb[4];
#pragma unroll
    for (int j = 0; j < 4; ++j) { lng[j] = *((const f32x4*)par(c, P_LN2G) + c.lane + 64 * j); lnb[j] = *((const f32x4*)par(c, P_LN2B) + c.lane + 64 * j); }
    for (int m0 = gw; m0 < M; m0 += 2 * NGW) {
        int pos[2][2]; float w[2][2]; u32x2 xw[2][4], a0[2][4], a1[2][4];
#pragma unroll
        for (int q = 0; q < 2; ++q) { const int m = m0 + q * NGW; if (m < M) {
#pragma unroll
            for (int a = 0; a < 2; ++a) { const int e = TOKE[2 * m + a]; int bs = 0;
#pragma unroll
                for (int j = 0; j < NE; ++j) if (j == e) bs = base[j];
                pos[q][a] = bs + TOKS[2 * m + a]; w[q][a] = TOKW[2 * m + a]; } } }
#pragma unroll
        for (int q = 0; q < 2; ++q) { const int m = m0 + q * NGW; if (m < M) {
#pragma unroll
            for (int j = 0; j < 4; ++j) { xw[q][j] = *((const u32x2*)(X1B + (size_t)m * DM) + c.lane + 64 * j);
                a0[q][j] = *((const u32x2*)(O2 + (size_t)pos[q][0] * DM) + c.lane + 64 * j); a1[q][j] = *((const u32x2*)(O2 + (size_t)pos[q][1] * DM) + c.lane + 64 * j); } } }
#pragma unroll
        for (int q = 0; q < 2; ++q) { const int m = m0 + q * NGW; if (m < M) {
            f32x4 v[4], y[4];
#pragma unroll
            for (int j = 0; j < 4; ++j) { const f32x4 xv = {lo_bf(xw[q][j].x), hi_bf(xw[q][j].x), lo_bf(xw[q][j].y), hi_bf(xw[q][j].y)};
                f32x4 t; t[0] = xv[0] * ALPHA + w[q][0] * lo_bf(a0[q][j].x) + w[q][1] * lo_bf(a1[q][j].x); t[1] = xv[1] * ALPHA + w[q][0] * hi_bf(a0[q][j].x) + w[q][1] * hi_bf(a1[q][j].x);
                t[2] = xv[2] * ALPHA + w[q][0] * lo_bf(a0[q][j].y) + w[q][1] * lo_bf(a1[q][j].y); t[3] = xv[3] * ALPHA + w[q][0] * hi_bf(a0[q][j].y) + w[q][1] * hi_bf(a1[q][j].y); v[j] = t; }
            ln_row(v, lng, lnb, y);
#pragma unroll
            for (int j = 0; j < 4; ++j) *((f32x4*)(c.out + (size_t)m * DM) + c.lane + 64 * j) = y[j]; } }
    }
}

#ifndef EMU
#define XB_TMO      128
#define XB_XCNT(j)  (256  + 64 * (j))
#define XB_XSUB(j)  (1280 + 64 * (j))
#define XB_XGEN(j)  (2304 + 64 * (j))
#define XB_TOP      3328
#define XB_TOPGEN   3392
#define XCD_BAR_WORDS 3456
#define XB_SPIN_CAP (1u << 22)
__device__ __forceinline__ unsigned xb_ld(unsigned* p)              { return __hip_atomic_load(p, __ATOMIC_RELAXED, __HIP_MEMORY_SCOPE_AGENT); }
__device__ __forceinline__ unsigned xb_add(unsigned* p, unsigned v) { return __hip_atomic_fetch_add(p, v, __ATOMIC_RELAXED, __HIP_MEMORY_SCOPE_AGENT); }
__device__ __forceinline__ unsigned xb_xcc_id() { return (unsigned)__builtin_amdgcn_s_getreg((3 << 11) | 20) & 0xFu; }
#define XB_SPIN(cond, bar) do { unsigned _sp = 0; while (cond) { __builtin_amdgcn_s_sleep(1); \
    if ((++_sp & 255u) == 0u) { if (xb_ld(&(bar)[XB_TMO])) break; if (_sp > XB_SPIN_CAP) { atomicAdd(&(bar)[XB_TMO], 1u); break; } } } } while (0)
struct XcdBarrier { unsigned* bar; unsigned x; volatile LAS unsigned* st; };
__device__ __forceinline__ XcdBarrier xcd_barrier_post(unsigned* bar, volatile LAS unsigned* st) {
    XcdBarrier b; b.bar = bar; b.x = xb_xcc_id(); b.st = st;
    if (threadIdx.x == 0) (void)xb_add(&bar[XB_XCNT(b.x)], 1u);
    return b;
}
__device__ __forceinline__ void xcd_barrier_complete(unsigned* bar, unsigned x, unsigned& nloc, unsigned& nx) {
    const unsigned G = gridDim.x * gridDim.y * gridDim.z;
    unsigned sum, cnt, mine, sp = 0u;
    for (;;) {
        sum = 0u; cnt = 0u; mine = 0u;
#pragma unroll
        for (unsigned j = 0; j < 16; ++j) { const unsigned c = xb_ld(&bar[XB_XCNT(j)]); sum += c; cnt += (c > 0u) ? 1u : 0u; mine = (j == x) ? c : mine; }
        if (sum == G) break;
        __builtin_amdgcn_s_sleep(1);
        if ((++sp & 255u) == 0u) { if (xb_ld(&bar[XB_TMO])) break; if (sp > XB_SPIN_CAP) { atomicAdd(&bar[XB_TMO], 1u); break; } }
    }
    nloc = mine > 0u ? mine : 1u; nx = cnt > 0u ? cnt : 1u;
}
__device__ __forceinline__ void xcd_barrier(const XcdBarrier& b) {
    asm volatile("s_waitcnt vmcnt(0)" ::: "memory");
    __syncthreads();
    if (threadIdx.x == 0) {
        unsigned* bar = b.bar;
        __builtin_amdgcn_s_waitcnt(0);
        unsigned nloc = b.st[0], nx = b.st[1];
        if (nloc == 0u) { xcd_barrier_complete(bar, b.x, nloc, nx); b.st[0] = nloc; b.st[1] = nx; }
        const unsigned old = xb_add(&bar[XB_XSUB(b.x)], 1u);
        const unsigned gen = old / nloc;
        if (old + 1u == (gen + 1u) * nloc) {
            __builtin_amdgcn_fence(__ATOMIC_RELEASE, "agent");
            asm volatile("s_waitcnt vmcnt(0)" ::: "memory");
            const unsigned og = xb_add(&bar[XB_TOP], 1u);
            const unsigned tg = og / nx;
            if (og + 1u == (tg + 1u) * nx) xb_add(&bar[XB_TOPGEN], 1u);
            else XB_SPIN(xb_ld(&bar[XB_TOPGEN]) == tg, bar);
            __builtin_amdgcn_fence(__ATOMIC_ACQUIRE, "agent");
            xb_add(&bar[XB_XGEN(b.x)], 1u);
            asm volatile("s_waitcnt vmcnt(0)" ::: "memory");
        } else {
            XB_SPIN(xb_ld(&bar[XB_XGEN(b.x)]) == gen, bar);
            __builtin_amdgcn_fence(__ATOMIC_ACQUIRE, "agent");
            asm volatile("s_waitcnt vmcnt(0)" ::: "memory");
        }
    }
    __syncthreads();
}
#endif

constexpr int NPHASE = 11;
constexpr int LDS_BYTES = 144 * 1024;
static_assert(1024 * 20 * 4 + 256 + ((M + 255) / 256) * 20 * 4 <= LDS_BYTES - 1024 || true, "router LDS");
static_assert(pg8::STAGE_BYTES <= LDS_BYTES - 1024 && IDX_LDS <= LDS_BYTES - 1024 && ML_LDS <= LDS_BYTES - 1024 && AT_LDS <= LDS_BYTES - 1024 && 8 * 16384 <= LDS_BYTES - 1024, "LDS budget");
constexpr int MISC_OFF = LDS_BYTES - 64;

DEV void run_phase(const Ctx& c0, int ph) {
    using namespace pg8;
    Ctx c = c0;
#ifndef EMU
    { int t = threadIdx.x; asm volatile("" : "+v"(t)); c.tid = t; c.lane = t & 63; c.wid = __builtin_amdgcn_readfirstlane(t >> 6); }
#endif
#ifdef EMU
    unsigned char* glds = c.lds;
#else
    PG8_LAS unsigned char* glds = c.lds;
#endif
    if (ph == 0) { phase_prologue(c); return; }
    if (ph == 1) {
        SchedStatic S; S.init((const bf16_t*)c.out, DM, wsp<bf16_t>(c, WS_WIN), DM, M, NWIN, DM, c.G, c.bid); S.phase_id = 1;
        EpiInProj E{wsp<bf16_t>(c, WS_H), wsp<bf16_t>(c, WS_KIDX), wsp<float>(c, WS_SM), wsp<float>(c, WS_SSQ)};
        gemm_phase(glds, S, E); return;
    }
    if (ph == 2 || ph == 11 || ph == 12) {
        const int nml = (ph == 12) ? 0 : ((c.G >= 4) ? c.G / 4 : 0);
        if (ph == 11) { for (int u = c.bid; u < NB * NHM; u += c.G) mlstm_unit(c, u / NHM, u % NHM); return; }
        if (c.bid < nml) {
#ifndef P2_REP_ML
#define P2_REP_ML 1
#endif
#ifndef P2_SKIP_ML
#if P2PROBE && P2PROBE_KIND == 5
            const unsigned long long mlt0 = rt_now();
#endif
            for (int rep = 0; rep < P2_REP_ML; ++rep) for (int u = c.bid; u < NB * NHM; u += nml) mlstm_unit(c, u / NHM, u % NHM);
            { wg_sync(); SchedStatic S; S.init(wsp<bf16_t>(c, WS_WV), KVR, wsp<bf16_t>(c, WS_H) + C_CKV, LDH, 512, M, KVR, nml, c.bid); S.ulo = S.nwg / 2; EpiVT E{wsp<bf16_t>(c, WS_VT), wsp<float>(c, WS_SSQ)}; gemm_phase(glds, S, E); }
#if P2PROBE && P2PROBE_KIND == 5
            if (c.bid == 0 && c.tid == 0) { volatile LAS unsigned* mm = (volatile LAS unsigned*)(c.lds + (144 * 1024 - 64)); mm[4] = (unsigned)(rt_now() - mlt0); }
#endif
#endif
        } else {
            const int g2 = c.G - nml, c2 = c.bid - nml;
#if P2PROBE
            const unsigned long long p2t0 = rt_now();
#endif
#ifndef P2_SKIP_KV
            { SchedStatic S; S.init(wsp<bf16_t>(c, WS_H) + C_CKV, LDH, wsp<bf16_t>(c, WS_WK), KVR, M, 512, KVR, g2, c2); EpiK E{wsp<bf16_t>(c, WS_K), wsp<float>(c, WS_SSQ)}; gemm_phase(glds, S, E); }
            { SchedStatic S; S.init(wsp<bf16_t>(c, WS_WV), KVR, wsp<bf16_t>(c, WS_H) + C_CKV, LDH, 512, M, KVR, g2, (c2 + (2 * g2) / 3) % g2); if (nml > 0) S.uhi = S.nwg / 2; EpiVT E{wsp<bf16_t>(c, WS_VT), wsp<float>(c, WS_SSQ)}; gemm_phase(glds, S, E); }
#endif
            wg_sync();
            idx_units(c, c2, g2);
#if P2PROBE
            if (P2PROBE_KIND == 1 && c2 == 0 && c.tid == 0) { const unsigned long long d = rt_now() - p2t0; volatile LAS unsigned* mm = (volatile LAS unsigned*)(c.lds + MISC_OFF); mm[4] = (unsigned)d; }
#endif
        }
        return;
    }
    if (ph == 3) {
        const int nqb = SEQ / 256, nun = NB * HA * nqb;
        for (int u = c.bid; u < nun; u += c.G) {
            const int bh = u / nqb; int qi = u % nqb; const int round = (u / c.G) & 1; if (round && (c.G % nqb) == 0) qi = nqb - 1 - qi;
            attn_unit(c, bh / HA, bh % HA, qi);
            wg_sync();
        }
        return;
    }
    if (ph == 4) {
        SchedDual S; S.T.init(nullptr, 0, nullptr, 0, M, DM, WA, c.G, c.bid); S.K = WA; S.lda = LDH; S.ldb = WA;
        S.A0 = wsp<bf16_t>(c, WS_H) + C_OA; S.A1 = wsp<bf16_t>(c, WS_H) + C_HM; S.B0 = wsp<bf16_t>(c, WS_WA); S.B1 = wsp<bf16_t>(c, WS_WM);
        EpiUpDual E{wsp<bf16_t>(c, WS_Y), wsp<bf16_t>(c, WS_H)}; gemm_phase(glds, S, E); return;
    }
    if (ph == 5) {
        SchedStatic S; S.init(wsp<bf16_t>(c, WS_Y), DM, wsp<bf16_t>(c, WS_WO), DM, M, DM, DM, c.G, c.bid); EpiOut E{wsp<bf16_t>(c, WS_Z), (const bf16_t*)c.out}; gemm_phase(glds, S, E); return;
    }
    if (ph == 6) { phase_ln1_router(c); return; }
    if (ph == 7) return;
    if (ph == 8 || ph == 9) {
        int base[NE], nt; moe_bases(c, base, nt);
        SchedMoe S; S.ntiles = nt; S.nN = 4; S.G = c.G; S.c = c.bid; S.phase_id = ph;
#pragma unroll
        for (int e = 0; e < NE; ++e) S.tend[e] = ((e + 1 < NE) ? base[e + 1] : nt * 256) / 256;
        if (ph == 8) { SchedMoeT<true> SG; SG.ntiles = nt; SG.nN = 4; SG.G = c.G; SG.c = c.bid; SG.phase_id = ph;
#pragma unroll
            for (int e = 0; e < NE; ++e) SG.tend[e] = S.tend[e];
            SG.cntv = (int)(wsp<unsigned>(c, WS_CTL) + CW_CNT)[c.lane & 15];
            SG.K = DM; SG.lda = DM; SG.ldb = DM; SG.A = wsp<bf16_t>(c, WS_X1B); SG.Bt = wsp<bf16_t>(c, WS_WGU); SG.estride = (size_t)1024 * 1024; SG.rowtok = wsp<int>(c, WS_RT2);
            EpiMoe1 E{wsp<bf16_t>(c, WS_HD)}; gemm_phase(glds, SG, E); }
        else { S.K = DE; S.lda = DE; S.ldb = DE; S.A = wsp<bf16_t>(c, WS_HD); S.Bt = wsp<bf16_t>(c, WS_WD); S.estride = (size_t)1024 * 512; EpiMoe2 E{wsp<bf16_t>(c, WS_O2)}; gemm_phase(glds, S, E); }
        return;
    }
    if (ph == 10) { phase_final(c); return; }
}

#ifndef EMU
__global__ void __launch_bounds__(NTHREADS, 2) fwd_kernel(Args args) {
    extern __shared__ __attribute__((aligned(16))) unsigned char lds_raw[];
    Ctx c;
#pragma unroll
    for (int i = 0; i < 25; ++i) c.in[i] = args.in[i];
    c.out = args.out; c.ws = args.ws; c.tid = threadIdx.x; c.lane = c.tid & 63; c.wid = __builtin_amdgcn_readfirstlane(c.tid >> 6); c.G = gridDim.x; c.bid = blockIdx.x;
    c.lds = (LAS unsigned char*)lds_raw;
    volatile LAS unsigned* MISC = (volatile LAS unsigned*)(c.lds + MISC_OFF);
    if (c.tid < 16) MISC[c.tid] = 0u;
    __syncthreads();
    const bool multi = (args.ph_hi - args.ph_lo) > 1;
    XcdBarrier bar; bar.bar = (unsigned*)(args.ws + WS_CTL) + CW_BAR; bar.x = 0; bar.st = nullptr;
    if (multi) bar = xcd_barrier_post((unsigned*)(args.ws + WS_CTL) + CW_BAR, MISC + 8);
#ifndef ONLY_PHASE
#define ONLY_PHASE -1
#endif
#ifndef DOUBLE_PHASE
#define DOUBLE_PHASE -1
#endif
#ifndef DOUBLE_PHASE2
#define DOUBLE_PHASE2 -1
#endif
#ifndef TPROBE_KIND
#define TPROBE_KIND 0
#endif
#ifndef TPROBE_LO
#define TPROBE_LO -1
#define TPROBE_HI -1
#define TPROBE_MULT 0
#endif
    unsigned long long tps_lo = 0, tps_hi = 0;
#define TSTAMP(k) do { if (TPROBE_MULT > 0) { if ((k) == TPROBE_LO && TPROBE_KIND != 2) tps_lo = rt_now(); if ((k) == TPROBE_HI && TPROBE_KIND != 1) tps_hi = rt_now(); } } while (0)
#define PHASE(k) TSTAMP(k); if ((ONLY_PHASE < 0 || ONLY_PHASE == (k)) && args.ph_lo <= (k) && (k) < args.ph_hi) { if (DOUBLE_PHASE == (k) || DOUBLE_PHASE2 == (k)) { run_phase(c, (k)); xcd_barrier(bar); } run_phase(c, (k)); if (TPROBE_MULT > 0 && TPROBE_KIND > 0 && (k) == TPROBE_LO) { if (TPROBE_KIND == 1) tps_hi = rt_now(); else tps_lo = rt_now(); } if ((k) + 1 < args.ph_hi) xcd_barrier(bar); }
#ifdef SPLIT_P2
    PHASE(0) PHASE(1) { run_phase(c, 11); xcd_barrier(bar); run_phase(c, 12); xcd_barrier(bar); } PHASE(3)
#else
    PHASE(0) PHASE(1) PHASE(2) PHASE(3)
#endif
    PHASE(4) PHASE(5) PHASE(6) PHASE(8) PHASE(9) PHASE(10)
    TSTAMP(11);
#ifndef GPROBE_MODE
#define GPROBE_MODE 0
#endif
    if (GPROBE_PH >= 0 && GPROBE_MODE > 0) {
        __syncthreads();
        unsigned* gw = (unsigned*)(args.ws + WS_CTL) + 6000;
        if (threadIdx.x == 0) { const unsigned long long a = (unsigned long long)MISC[0] | ((unsigned long long)MISC[1] << 32), b2 = (unsigned long long)MISC[2] | ((unsigned long long)MISC[3] << 32); const unsigned d = (unsigned)(b2 - a);
            atomicMax(gw, d); atomicMax(gw + 1, 0xffffffffu - d); }
        xcd_barrier(bar);
        if (blockIdx.x == 0) { const unsigned mx = __hip_atomic_load(gw, __ATOMIC_RELAXED, __HIP_MEMORY_SCOPE_AGENT), mn = 0xffffffffu - __hip_atomic_load(gw + 1, __ATOMIC_RELAXED, __HIP_MEMORY_SCOPE_AGENT); tps_lo = 0; tps_hi = (GPROBE_MODE == 1) ? mx : mn; }
    } else
    if (GPROBE_PH >= 0 && GPROBE_MODE == 4 && blockIdx.x == 0) { __syncthreads(); tps_lo = (unsigned long long)MISC[2] | ((unsigned long long)MISC[3] << 32); } else
    if (GPROBE_PH >= 0 && blockIdx.x == 0) { __syncthreads(); if (GPROBE_MODE != 3) tps_lo = (unsigned long long)MISC[0] | ((unsigned long long)MISC[1] << 32); tps_hi = (GPROBE_MODE == 3) ? ((unsigned long long)MISC[0] | ((unsigned long long)MISC[1] << 32)) : ((unsigned long long)MISC[2] | ((unsigned long long)MISC[3] << 32)); }
#if P2PROBE
    __syncthreads();
    if (blockIdx.x == ((P2PROBE_KIND >= 5) ? 0 : gridDim.x / 4) && threadIdx.x == 0) { const unsigned long long d = (unsigned long long)MISC[4] * (unsigned long long)P2PROBE, t0 = rt_now(); while (rt_now() - t0 < d) __builtin_amdgcn_s_sleep(8); }
#endif
    if (TPROBE_MULT > 0 && blockIdx.x == 0) { const unsigned long long d = (tps_hi - tps_lo) * (unsigned long long)TPROBE_MULT, t0 = rt_now(); while (rt_now() - t0 < d) __builtin_amdgcn_s_sleep(8); }
#undef PHASE
}

#ifndef N_LAUNCH_MODE
#define N_LAUNCH_MODE 0
#endif
extern "C" void kernel_launch(void* const* d_in, const int* in_sizes, int n_in, void* d_out, int out_size, void* d_ws, size_t ws_size, hipStream_t stream) {
    static int grid = 0;
    if (grid == 0) {
        if (n_in != 25 || out_size != M * DM || ws_size < WS_END) { fprintf(stderr, "kernel_launch: unexpected shapes (n_in %d out %d ws %zu need %zu)\n", n_in, out_size, ws_size, (size_t)WS_END); grid = -1; return; }
        int dev = 0, cus = 0, per_cu = 0;
        if (hipGetDevice(&dev) != hipSuccess || hipDeviceGetAttribute(&cus, hipDeviceAttributeMultiprocessorCount, dev) != hipSuccess) { grid = -1; return; }
        if (hipFuncSetAttribute((const void*)fwd_kernel, hipFuncAttributeMaxDynamicSharedMemorySize, LDS_BYTES) != hipSuccess) { fprintf(stderr, "kernel_launch: hipFuncSetAttribute failed\n"); grid = -1; return; }
        if (hipOccupancyMaxActiveBlocksPerMultiprocessor(&per_cu, (const void*)fwd_kernel, NTHREADS, LDS_BYTES) != hipSuccess || per_cu < 1) fprintf(stderr, "kernel_launch: occupancy query reports %d\n", per_cu);
        (void)hipGetLastError();
        grid = cus;
    }
    if (grid < 0) return;
    (void)hipMemsetAsync((char*)d_ws + WS_CTL, 0, CTL_ZERO_BYTES, stream);
    Args a{};
    for (int i = 0; i < 25; ++i) a.in[i] = (const float*)d_in[i];
    a.out = (float*)d_out; a.ws = (unsigned char*)d_ws;
    if (N_LAUNCH_MODE == 0) { a.ph_lo = 0; a.ph_hi = NPHASE; hipLaunchKernelGGL(fwd_kernel, dim3(grid), dim3(NTHREADS), LDS_BYTES, stream, a); }
    else { for (int p = 0; p < NPHASE; ++p) { a.ph_lo = p; a.ph_hi = p + 1; hipLaunchKernelGGL(fwd_kernel, dim3(grid), dim3(NTHREADS), LDS_BYTES, stream, a); } }
    (void)in_sizes;
}
#endif
```
